# Optimizing an MI355X kernel written in HIP

```python
import math
import jax, jax.numpy as jnp
from jax import lax
import numpy as np

D_MODEL = 1024
BATCH = 8
SEQ = 2048
DEPTH = 4
DEC_BATCH = 128
DEC_SEQ = 4
PAST_LEN = 16384
PAGE_SIZE = 128

N_MIXERS = 3
EXPAND = 2
D_INNER = EXPAND * D_MODEL
CHUNK = 128
SGU_GROUPS = 8
SGU_GROUP_DIM = D_INNER // SGU_GROUPS
CONV_W = 3
S5_IN = 16
S5_GROUPS = D_INNER // S5_IN
S5_STATE = 64
MEM_LEN = 256
XA_HEADS = 4
XA_HEAD_DIM = 128
XA_DIM = XA_HEADS * XA_HEAD_DIM
EPS = 1e-6

LAYER_KINDS = tuple(i % N_MIXERS for i in range(DEPTH))
KIND_INDEX = tuple(sum(1 for j in range(i) if LAYER_KINDS[j] == LAYER_KINDS[i]) for i in range(DEPTH))
N_A = sum(1 for k in LAYER_KINDS if k == 0)
N_B = sum(1 for k in LAYER_KINDS if k == 1)
N_C = sum(1 for k in LAYER_KINDS if k == 2)

kernel_name = "interleaved_sgu_conv_s5_memxattn_decoder_step"


def rmsnorm(x, g):
    xf = x.astype(jnp.float32)
    y = xf * lax.rsqrt(jnp.mean(xf * xf, axis=-1, keepdims=True) + EPS)
    return (y * g.astype(jnp.float32)).astype(x.dtype)


def memory_kv(mem, g, w_kv):
    b, m, _ = mem.shape
    kv = (rmsnorm(mem, g) @ w_kv).reshape(b, m, 2, XA_HEADS, XA_HEAD_DIM)
    return kv[:, :, 0], kv[:, :, 1]


def cross_attention(q, k, v):
    b, l, _ = q.shape
    qh = q.reshape(b, l, XA_HEADS, XA_HEAD_DIM)
    s = jnp.einsum("blhd,bmhd->bhlm", qh, k).astype(jnp.float32) * (XA_HEAD_DIM ** -0.5)
    p = jax.nn.softmax(s, axis=-1).astype(v.dtype)
    return jnp.einsum("bhlm,bmhd->blhd", p, v).reshape(b, l, XA_DIM)


def spatial_gate_prompt(u, v, ws, bs):
    b, l, _ = v.shape
    vc = v.reshape(b, l // CHUNK, CHUNK, SGU_GROUPS, SGU_GROUP_DIM)
    mixed = jnp.einsum("gts,bcsgd->bctgd", jnp.tril(ws), vc) + bs.T[None, None, :, :, None]
    return u * mixed.reshape(b, l, D_INNER)


def spatial_gate_sample(u, v, ws, bs):
    b, t, _ = v.shape
    vt = v.reshape(b, t, SGU_GROUPS, SGU_GROUP_DIM)
    mixed = jnp.einsum("gts,bsgd->btgd", jnp.tril(ws[:, :t, :t]), vt) + bs[:, :t].T[None, :, :, None]
    return u * mixed.reshape(b, t, D_INNER)


def short_conv(xc, buf, w):
    l = xc.shape[1]
    xp = jnp.concatenate([buf, xc], axis=1)
    y = sum(w[k] * xp[:, k:k + l] for k in range(CONV_W))
    return y, xp[:, l:]


def s5_discretize(lam_re, lam_im, log_dt, b_re, b_im):
    dt = jnp.exp(log_dt)[:, None]
    mag = jnp.exp(lam_re * dt)
    ar = mag * jnp.cos(lam_im * dt)
    ai = mag * jnp.sin(lam_im * dt)
    nr, ni = ar - 1, ai
    den = lam_re * lam_re + lam_im * lam_im
    cr = (nr * lam_re + ni * lam_im) / den
    ci = (ni * lam_re - nr * lam_im) / den
    bbr = cr[..., None] * b_re - ci[..., None] * b_im
    bbi = cr[..., None] * b_im + ci[..., None] * b_re
    return ar, ai, bbr, bbi


def _complex_affine_combine(e1, e2):
    a1r, a1i, b1r, b1i = e1
    a2r, a2i, b2r, b2i = e2
    return (a1r * a2r - a1i * a2i,
            a1r * a2i + a1i * a2r,
            a2r * b1r - a2i * b1i + b2r,
            a2r * b1i + a2i * b1r + b2i)


def s5_block(u, h0r, h0i, ar, ai, bbr, bbi, c_re, c_im):
    bur = jnp.einsum("gpi,blgi->blgp", bbr, u)
    bui = jnp.einsum("gpi,blgi->blgp", bbi, u)
    bur = bur.at[:, 0].add(ar * h0r - ai * h0i)
    bui = bui.at[:, 0].add(ar * h0i + ai * h0r)
    a_r = jnp.broadcast_to(ar, bur.shape)
    a_i = jnp.broadcast_to(ai, bui.shape)
    _, _, hr, hi = lax.associative_scan(_complex_affine_combine, (a_r, a_i, bur, bui), axis=1)
    y = jnp.einsum("gip,blgp->blgi", c_re, hr) - jnp.einsum("gip,blgp->blgi", c_im, hi)
    return y, hr[:, -1].astype(h0r.dtype), hi[:, -1].astype(h0i.dtype)


def s5_mixer(u, h0r, h0i, lam_re, lam_im, log_dt, b_re, b_im, c_re, c_im, d, w_glu, b_glu, blocked):
    b, l, _ = u.shape
    ar, ai, bbr, bbi = s5_discretize(lam_re, lam_im, log_dt, b_re, b_im)
    ug = u.reshape(b, l, S5_GROUPS, S5_IN)
    if blocked:
        uc = ug.reshape(b, l // CHUNK, CHUNK, S5_GROUPS, S5_IN).transpose(1, 0, 2, 3, 4)

        def step(carry, u_blk):
            y_blk, hr_, hi_ = s5_block(u_blk, carry[0], carry[1], ar, ai, bbr, bbi, c_re, c_im)
            return (hr_, hi_), y_blk

        (hr, hi), ys = lax.scan(step, (h0r, h0i), uc)
        y = ys.transpose(1, 0, 2, 3, 4).reshape(b, l, D_INNER)
    else:
        y, hr, hi = s5_block(ug, h0r, h0i, ar, ai, bbr, bbi, c_re, c_im)
        y = y.reshape(b, l, D_INNER)
    y = y + d * u
    g = jax.nn.gelu(y)
    return g * jax.nn.sigmoid(g @ w_glu + b_glu), hr, hi


def setup_inputs(seed: int = 0) -> dict:
    key = jax.random.key(seed)
    ks = iter(jax.random.split(key, 40))
    f32 = jnp.float32
    nrm = lambda shape, scale: jax.random.normal(next(ks), shape, f32) * scale
    x_prompt = nrm((BATCH, SEQ, D_MODEL), 1.0)
    x_sample = nrm((DEC_BATCH, DEC_SEQ, D_MODEL), 1.0)
    mem_prompt = nrm((BATCH, MEM_LEN, D_MODEL), 1.0)
    cache_mem_k = nrm((DEPTH, DEC_BATCH, MEM_LEN, XA_HEADS, XA_HEAD_DIM), 1.0)
    cache_mem_v = nrm((DEPTH, DEC_BATCH, MEM_LEN, XA_HEADS, XA_HEAD_DIM), 1.0)
    state_conv = nrm((N_B, DEC_BATCH, CONV_W - 1, D_INNER), 1.0)
    state_s5_re = nrm((N_C, DEC_BATCH, S5_GROUPS, S5_STATE), 0.5)
    state_s5_im = nrm((N_C, DEC_BATCH, S5_GROUPS, S5_STATE), 0.5)
    norm_g = 1.0 + nrm((DEPTH, D_MODEL), 0.1)
    final_g = 1.0 + nrm((D_MODEL,), 0.1)
    mem_norm_g = 1.0 + nrm((DEPTH, D_MODEL), 0.1)
    w_kv = nrm((DEPTH, D_MODEL, 2 * XA_DIM), D_MODEL ** -0.5)
    w_out = nrm((DEPTH, D_INNER + XA_DIM, D_MODEL), 0.5 * (D_INNER + XA_DIM) ** -0.5)
    w_in_a = nrm((N_A, D_MODEL, 3 * D_INNER + XA_DIM), D_MODEL ** -0.5)
    sgu_norm_g = 1.0 + nrm((N_A, D_INNER), 0.1)
    sgu_w = nrm((N_A, SGU_GROUPS, CHUNK, CHUNK), CHUNK ** -0.5)
    sgu_b = 1.0 + nrm((N_A, SGU_GROUPS, CHUNK), 0.1)
    w_in_b = nrm((N_B, D_MODEL, 4 * D_INNER + XA_DIM), D_MODEL ** -0.5)
    conv_w = nrm((N_B, CONV_W, D_INNER), CONV_W ** -0.5)
    w_in_c = nrm((N_C, D_MODEL, 2 * D_INNER + XA_DIM), D_MODEL ** -0.5)
    s5_lam_re = -0.5 + nrm((N_C, S5_GROUPS, S5_STATE), 0.01)
    s5_lam_im = jnp.pi * jnp.arange(S5_STATE, dtype=f32)[None, None, :] + nrm((N_C, S5_GROUPS, S5_STATE), 0.01)
    s5_log_dt = jax.random.uniform(next(ks), (N_C, S5_GROUPS), f32, minval=math.log(1e-3), maxval=math.log(1e-1))
    s5_b_re = nrm((N_C, S5_GROUPS, S5_STATE, S5_IN), (2 * S5_IN) ** -0.5)
    s5_b_im = nrm((N_C, S5_GROUPS, S5_STATE, S5_IN), (2 * S5_IN) ** -0.5)
    s5_c_re = nrm((N_C, S5_GROUPS, S5_IN, S5_STATE), (2 * S5_STATE) ** -0.5)
    s5_c_im = nrm((N_C, S5_GROUPS, S5_IN, S5_STATE), (2 * S5_STATE) ** -0.5)
    s5_d = nrm((N_C, D_INNER), 1.0)
    w_glu = nrm((N_C, D_INNER, D_INNER), D_INNER ** -0.5)
    b_glu = nrm((N_C, D_INNER), 0.01)
    return {"x_prompt": x_prompt, "x_sample": x_sample, "mem_prompt": mem_prompt,
            "cache_mem_k": cache_mem_k, "cache_mem_v": cache_mem_v, "state_conv": state_conv,
            "state_s5_re": state_s5_re, "state_s5_im": state_s5_im,
            "norm_g": norm_g, "final_g": final_g, "mem_norm_g": mem_norm_g, "w_kv": w_kv, "w_out": w_out,
            "w_in_a": w_in_a, "sgu_norm_g": sgu_norm_g, "sgu_w": sgu_w, "sgu_b": sgu_b,
            "w_in_b": w_in_b, "conv_w": conv_w, "w_in_c": w_in_c,
            "s5_lam_re": s5_lam_re, "s5_lam_im": s5_lam_im, "s5_log_dt": s5_log_dt,
            "s5_b_re": s5_b_re, "s5_b_im": s5_b_im, "s5_c_re": s5_c_re, "s5_c_im": s5_c_im,
            "s5_d": s5_d, "w_glu": w_glu, "b_glu": b_glu}


def reference(x_prompt, x_sample, mem_prompt, cache_mem_k, cache_mem_v, state_conv, state_s5_re, state_s5_im,
              norm_g, final_g, mem_norm_g, w_kv, w_out, w_in_a, sgu_norm_g, sgu_w, sgu_b, w_in_b, conv_w, w_in_c,
              s5_lam_re, s5_lam_im, s5_log_dt, s5_b_re, s5_b_im, s5_c_re, s5_c_im, s5_d, w_glu, b_glu):
    E = D_INNER

    def trunk(x, mem_k, mem_v, conv_bufs, s5_re, s5_im, prompt):
        conv_out, s5r_out, s5i_out, chunk_v_out = [], [], [], []
        for i in range(DEPTH):
            kind, j = LAYER_KINDS[i], KIND_INDEX[i]
            h = rmsnorm(x, norm_g[i])
            if kind == 0:
                u, v, z, q = jnp.split(h @ w_in_a[j], [E, 2 * E, 3 * E], axis=-1)
                v = rmsnorm(v, sgu_norm_g[j])
                if prompt:
                    y = spatial_gate_prompt(u, v, sgu_w[j], sgu_b[j])
                else:
                    y = spatial_gate_sample(u, v, sgu_w[j], sgu_b[j])
                    chunk_v_out.append(v)
            elif kind == 1:
                bg, cg, hv, z, q = jnp.split(h @ w_in_b[j], [E, 2 * E, 3 * E, 4 * E], axis=-1)
                y, buf = short_conv(cg * hv, conv_bufs[j], conv_w[j])
                y = bg * y
                conv_out.append(buf)
            else:
                u, z, q = jnp.split(h @ w_in_c[j], [E, 2 * E], axis=-1)
                y, hr, hi = s5_mixer(u, s5_re[j], s5_im[j], s5_lam_re[j], s5_lam_im[j], s5_log_dt[j],
                                     s5_b_re[j], s5_b_im[j], s5_c_re[j], s5_c_im[j], s5_d[j],
                                     w_glu[j], b_glu[j], prompt)
                s5r_out.append(hr)
                s5i_out.append(hi)
            xa = cross_attention(q, mem_k[i], mem_v[i])
            x = x + jnp.concatenate([y * jax.nn.silu(z), xa], axis=-1) @ w_out[i]
        return rmsnorm(x, final_g), conv_out, s5r_out, s5i_out, chunk_v_out

    kv = [memory_kv(mem_prompt, mem_norm_g[i], w_kv[i]) for i in range(DEPTH)]
    mem_k_prompt = jnp.stack([k for k, _ in kv])
    mem_v_prompt = jnp.stack([v for _, v in kv])
    bp = x_prompt.shape[0]
    conv0 = jnp.zeros((N_B, bp, CONV_W - 1, D_INNER), x_prompt.dtype)
    s50 = jnp.zeros((N_C, bp, S5_GROUPS, S5_STATE), x_prompt.dtype)
    y_prompt, conv_p, s5r_p, s5i_p, _ = trunk(x_prompt, mem_k_prompt, mem_v_prompt, conv0, s50, s50, True)

    y_sample, conv_s, s5r_s, s5i_s, cv_s = trunk(x_sample, cache_mem_k, cache_mem_v, state_conv,
                                                 state_s5_re, state_s5_im, False)
    return (y_prompt, y_sample, mem_k_prompt, mem_v_prompt, jnp.stack(conv_p), jnp.stack(conv_s),
            jnp.stack(s5r_p), jnp.stack(s5i_p), jnp.stack(s5r_s), jnp.stack(s5i_s), jnp.stack(cv_s))
```

```cpp
#include <hip/hip_runtime.h>
#include <hip/hip_cooperative_groups.h>
#include <cstdio>
#include <cstdint>
namespace cg = cooperative_groups;

#ifndef MK_ONE_LAUNCH
#define MK_ONE_LAUNCH 1
#endif
#ifndef XHALF_SHFL
#define XHALF_SHFL 0
#endif
#ifndef EPI_DRAIN
#define EPI_DRAIN 1
#endif
#ifndef FLAT_FN_MASK
#define FLAT_FN_MASK 0x00
#endif
#ifndef PROBE_SUB_MASK
#define PROBE_SUB_MASK 0
#endif
#ifndef PROBE_REP_MASK
#define PROBE_REP_MASK 0
#endif

namespace pg8 {
#define PG8_LAS __attribute__((address_space(3)))
typedef unsigned short bf16_t;
typedef short bf16x8 __attribute__((ext_vector_type(8)));
typedef float f32x4 __attribute__((ext_vector_type(4)));
typedef unsigned u32x4 __attribute__((ext_vector_type(4)));
typedef unsigned u32x2 __attribute__((ext_vector_type(2)));
constexpr int BM = 256, BK = 64, HALF = 128, HTB = HALF * BK * 2, STAGE_BYTES = 8 * HTB, NXCD = 8, WGM = 8;

__host__ __device__ __forceinline__ int lds_byte(int r, int c) { const int st = (r >> 4) * 2 + (c >> 5), rr = r & 15, cc = c & 31, ob = rr * 64 + cc * 2; return st * 1024 + (ob ^ (((ob >> 9) & 1) << 5)); }
__host__ __device__ __forceinline__ void stage_rc(int b, int& R, int& C) { const int st = b / 1024, sb = b % 1024, swz = sb ^ (((sb >> 9) & 1) << 5); R = (st >> 1) * 16 + swz / 64; C = (st & 1) * 32 + (swz % 64) / 2; }
__host__ __device__ __forceinline__ int perm32(int rho) { const int n = rho >> 4, i = rho & 15; return 8 * (i >> 2) + 4 * n + (i & 3); }

struct Unit { int pm, pn, ks; };
struct Gemm { const bf16_t* A; const bf16_t* Bt; int M, N, K, ld; };

struct StaticOrder {
    int nM, nN, nwg, G, c, pm0;
    __host__ __device__ void init(int M, int N, int G_, int c_, int pm0_ = 0) { nM = M / BM; nN = N / BM; nwg = nM * nN; G = G_; c = c_; pm0 = pm0_; }
    __host__ __device__ bool next(int i, Unit& u) const {
        const long L = (long)i * G + c; if (L >= nwg) return false;
        int wgid = (int)L; { const int q = nwg / NXCD, r = nwg % NXCD, xcd = wgid % NXCD, off = wgid / NXCD; wgid = (xcd < r ? xcd * (q + 1) : r * (q + 1) + (xcd - r) * q) + off; }
        const int nig = WGM * nN, gid = wgid / nig, fm = gid * WGM, gsz = (nM - fm) < WGM ? (nM - fm) : WGM;
        u.pm = pm0 + fm + ((wgid % nig) % gsz); u.pn = (wgid % nig) / gsz; u.ks = 0; return true;
    }
    __device__ __forceinline__ void a_ready(const Unit&) const {}
    __device__ __forceinline__ void done(const Unit&) const {}
};
template <int NM_, int NN_, int NK_> struct SliceOrder {
    int G, c, pm0;
    __host__ __device__ void init(int G_, int c_, int pm0_) { G = G_; c = c_; pm0 = pm0_; }
    __host__ __device__ bool next(int i, Unit& u) const {
        const int L = i * G + c; if (L >= NM_ * NN_ * NK_) return false;
        const int t = L / NK_; u.ks = L % NK_; u.pn = t % NN_; u.pm = pm0 + t / NN_; return true;
    }
    __device__ __forceinline__ void a_ready(const Unit&) const {}
    __device__ __forceinline__ void done(const Unit&) const {}
};

template <class Epi, class Sched, bool ALIGN_EPI = false, bool SP2 = false>
__device__ __forceinline__ void gemm_phase(PG8_LAS unsigned char* lds, const Gemm g, const Sched& S, const Epi& E) {
    int tid = threadIdx.x; asm volatile("" : "+v"(tid));
    const int wid = __builtin_amdgcn_readfirstlane(tid >> 6), lane = tid & 63, wr = wid >> 2, wc = wid & 3, fr = lane & 15, fq = lane >> 4;
    const int K = g.K, ld = g.ld, nt = K / BK;
    unsigned voffA[2], voffB[2];
#pragma unroll
    for (int i = 0; i < 2; ++i) { int R, C; stage_rc(tid * 16 + i * 8192, R, C); const int Rb = Epi::PERM ? ((R & ~31) + perm32(R & 31)) : R;
        voffA[i] = (unsigned)(R * ld + C) * 2u; voffB[i] = (unsigned)(Rb * ld + C) * 2u; }
    const size_t kstep = (size_t)(BK * 2);
    const size_t hstep = (size_t)HALF * ld * 2;
    const size_t sstep = (size_t)K * 2;
    const size_t tstep = 2 * hstep;
    const unsigned ldsw = (unsigned)wid * 1024u;
    const int aoff = lds_byte(wr * 64 + fr, fq * 8), boff = lds_byte(wc * 32 + fr, fq * 8);
#define PG8_SA(b, h) (((b) * 2 + (h)) * HTB)
#define PG8_SB(b, h) ((4 + (b) * 2 + (h)) * HTB)
#define PG8_STAGE(bufoff, gbase, voff) do { _Pragma("unroll") for (int _i = 0; _i < 2; ++_i) \
        __builtin_amdgcn_global_load_lds((const unsigned*)((const char*)(gbase) + (voff)[_i]), (PG8_LAS unsigned*)(lds + (bufoff) + ldsw + _i * 8192), 16, 0, 0); } while (0)
#define PG8_LDA(dst, b, h) do { _Pragma("unroll") for (int m = 0; m < 4; ++m) _Pragma("unroll") for (int k = 0; k < 2; ++k) dst[m][k] = *(const PG8_LAS bf16x8*)(lds + PG8_SA(b, h) + aoff + m * 2048 + k * 1024); } while (0)
#define PG8_LDB(dst, b, h) do { _Pragma("unroll") for (int n = 0; n < 2; ++n) _Pragma("unroll") for (int k = 0; k < 2; ++k) dst[n][k] = *(const PG8_LAS bf16x8*)(lds + PG8_SB(b, h) + boff + n * 2048 + k * 1024); } while (0)
#define PG8_MMA(ai, bj, At, Bt) do { __builtin_amdgcn_s_setprio(1); _Pragma("unroll") for (int m = 0; m < 4; ++m) _Pragma("unroll") for (int n = 0; n < 2; ++n) _Pragma("unroll") for (int k = 0; k < 2; ++k) \
        acc[ai][bj][m][n] = __builtin_amdgcn_mfma_f32_16x16x32_bf16(Bt[n][k], At[m][k], acc[ai][bj][m][n], 0, 0, 0); __builtin_amdgcn_s_setprio(0); } while (0)
#define PG8_WAIT_V(n) asm volatile("s_waitcnt vmcnt(" #n ")" ::: "memory")
#define PG8_WAIT_L(n) asm volatile("s_waitcnt lgkmcnt(" #n ")" ::: "memory")
#define PG8_BAR __builtin_amdgcn_s_barrier()
#define PG8_SCHED __builtin_amdgcn_sched_barrier(0)
    Unit cur, nxt; int ui = 0;
    if (!S.next(0, cur)) return;
    f32x4 acc[2][2][4][2];
#pragma unroll
    for (int a = 0; a < 2; ++a)
#pragma unroll
        for (int b = 0; b < 2; ++b)
#pragma unroll
            for (int m = 0; m < 4; ++m)
#pragma unroll
                for (int n = 0; n < 2; ++n) acc[a][b][m][n] = (f32x4){0.f, 0.f, 0.f, 0.f};
    bf16x8 At[4][2], B0[2][2], B1[2][2];
    const char* cA = (const char*)g.A + (size_t)cur.pm * tstep + (size_t)cur.ks * sstep; const char* cB = (const char*)g.Bt + (size_t)cur.pn * tstep + (size_t)cur.ks * sstep;
    S.a_ready(cur);
    if constexpr (SP2) {
        PG8_STAGE(PG8_SB(0, 0), cB, voffB); PG8_STAGE(PG8_SB(0, 1), cB + hstep, voffB); PG8_STAGE(PG8_SA(0, 0), cA, voffA); PG8_STAGE(PG8_SA(0, 1), cA + hstep, voffA);
        if (wr == 1) PG8_BAR;
        PG8_WAIT_V(2); PG8_BAR;
        PG8_STAGE(PG8_SB(1, 0), cB + kstep, voffB); PG8_STAGE(PG8_SA(1, 0), cA + kstep, voffA); PG8_STAGE(PG8_SB(1, 1), cB + hstep + kstep, voffB);
        PG8_WAIT_V(6); PG8_BAR;
    } else {
        PG8_STAGE(PG8_SB(0, 0), cB, voffB); PG8_STAGE(PG8_SA(0, 0), cA, voffA); PG8_STAGE(PG8_SB(0, 1), cB + hstep, voffB); PG8_STAGE(PG8_SA(0, 1), cA + hstep, voffA);
        if (wr == 1) PG8_BAR;
        PG8_WAIT_V(4); PG8_BAR;
        PG8_STAGE(PG8_SB(1, 0), cB + kstep, voffB); PG8_STAGE(PG8_SA(1, 0), cA + kstep, voffA); PG8_STAGE(PG8_SB(1, 1), cB + hstep + kstep, voffB);
        PG8_WAIT_V(6); PG8_BAR;
    }
    for (;;) {
        const bool has_next = S.next(ui + 1, nxt);
        const char* nA = has_next ? (const char*)g.A + (size_t)nxt.pm * tstep + (size_t)nxt.ks * sstep : cA; const char* nB = has_next ? (const char*)g.Bt + (size_t)nxt.pn * tstep + (size_t)nxt.ks * sstep : cB;
        for (int t = 0; t < nt; t += 2) {
            const bool last = (t == nt - 2);
            const char* a1 = cA + (size_t)(t + 1) * kstep;
            const char* a2 = last ? nA : cA + (size_t)(t + 2) * kstep; const char* b2 = last ? nB : cB + (size_t)(t + 2) * kstep;
            const char* a3 = a2 + kstep; const char* b3 = b2 + kstep;
            if (last && has_next) S.a_ready(nxt);
            if constexpr (SP2) {
            PG8_LDB(B0, 0, 0); PG8_LDB(B1, 0, 1); PG8_SCHED; PG8_LDA(At, 0, 0); PG8_STAGE(PG8_SA(1, 1), a1 + hstep, voffA);
            PG8_WAIT_V(8); PG8_WAIT_L(0); PG8_BAR; PG8_MMA(0, 0, At, B0); PG8_MMA(0, 1, At, B1); PG8_BAR; PG8_SCHED;
            PG8_LDA(At, 0, 1); PG8_STAGE(PG8_SB(0, 0), b2, voffB); PG8_STAGE(PG8_SB(0, 1), b2 + hstep, voffB); PG8_STAGE(PG8_SA(0, 0), a2, voffA);
            PG8_WAIT_V(8); PG8_WAIT_L(0); PG8_BAR; PG8_MMA(1, 0, At, B0); PG8_MMA(1, 1, At, B1); PG8_BAR; PG8_SCHED;
            PG8_LDB(B0, 1, 0); PG8_LDB(B1, 1, 1); PG8_SCHED; PG8_LDA(At, 1, 0); PG8_STAGE(PG8_SA(0, 1), a2 + hstep, voffA);
            PG8_WAIT_V(8); PG8_WAIT_L(0); PG8_BAR; PG8_MMA(0, 0, At, B0); PG8_MMA(0, 1, At, B1); PG8_BAR; PG8_SCHED;
            PG8_LDA(At, 1, 1); PG8_STAGE(PG8_SB(1, 0), b3, voffB); PG8_STAGE(PG8_SB(1, 1), b3 + hstep, voffB); PG8_STAGE(PG8_SA(1, 0), a3, voffA);
            PG8_WAIT_V(8); PG8_WAIT_L(0); PG8_BAR; PG8_MMA(1, 0, At, B0); PG8_MMA(1, 1, At, B1); PG8_BAR; PG8_SCHED;
            } else {
            PG8_LDB(B0, 0, 0); PG8_SCHED; PG8_LDA(At, 0, 0); PG8_STAGE(PG8_SA(1, 1), a1 + hstep, voffA);
            PG8_WAIT_L(8); PG8_BAR; PG8_WAIT_L(0); PG8_MMA(0, 0, At, B0); PG8_BAR; PG8_SCHED;
            PG8_LDB(B1, 0, 1); PG8_STAGE(PG8_SB(0, 0), b2, voffB);
            PG8_BAR; PG8_WAIT_L(0); PG8_MMA(0, 1, At, B1); PG8_BAR;
            PG8_LDA(At, 0, 1); PG8_STAGE(PG8_SA(0, 0), a2, voffA);
            PG8_BAR; PG8_WAIT_L(0); PG8_MMA(1, 0, At, B0); PG8_BAR; PG8_SCHED;
            PG8_STAGE(PG8_SB(0, 1), b2 + hstep, voffB);
            PG8_WAIT_V(6); PG8_BAR; PG8_MMA(1, 1, At, B1); PG8_BAR;
            PG8_LDB(B0, 1, 0); PG8_SCHED; PG8_LDA(At, 1, 0); PG8_STAGE(PG8_SA(0, 1), a2 + hstep, voffA);
            PG8_WAIT_L(8); PG8_BAR; PG8_WAIT_L(0); PG8_MMA(0, 0, At, B0); PG8_BAR; PG8_SCHED;
            PG8_LDB(B1, 1, 1); PG8_STAGE(PG8_SB(1, 0), b3, voffB);
            PG8_BAR; PG8_WAIT_L(0); PG8_MMA(0, 1, At, B1); PG8_BAR;
            PG8_LDA(At, 1, 1); PG8_STAGE(PG8_SA(1, 0), a3, voffA);
            PG8_BAR; PG8_WAIT_L(0); PG8_MMA(1, 0, At, B0); PG8_BAR; PG8_SCHED;
            PG8_STAGE(PG8_SB(1, 1), b3 + hstep, voffB);
            PG8_WAIT_V(6); PG8_BAR; PG8_MMA(1, 1, At, B1); PG8_BAR;
            }
        }
        if constexpr (ALIGN_EPI) { if (wr == 0) PG8_BAR; }
        if constexpr (!Epi::AFTER_DRAIN) { E(acc, cur, wr, wc, fr, fq); S.done(cur); }
#if EPI_DRAIN
        PG8_WAIT_V(0);
#endif
        if (!has_next) break;
#pragma unroll
        for (int a = 0; a < 2; ++a)
#pragma unroll
            for (int b = 0; b < 2; ++b)
#pragma unroll
                for (int m = 0; m < 4; ++m)
#pragma unroll
                    for (int n = 0; n < 2; ++n) acc[a][b][m][n] = (f32x4){0.f, 0.f, 0.f, 0.f};
        cur = nxt; cA = nA; cB = nB; ++ui;
        if constexpr (ALIGN_EPI) { if (wr == 1) PG8_BAR; }
    }
    PG8_WAIT_V(0);
    if constexpr (!ALIGN_EPI) { if (wr == 0) PG8_BAR; }
    PG8_BAR;
#undef PG8_SA
#undef PG8_SB
#undef PG8_STAGE
#undef PG8_LDA
#undef PG8_LDB
#undef PG8_MMA
#undef PG8_WAIT_V
#undef PG8_WAIT_L
#undef PG8_BAR
#undef PG8_SCHED
}
}

using pg8::bf16_t; using pg8::f32x4; using pg8::u32x4; using pg8::u32x2; using pg8::bf16x8; using pg8::Unit;
#define LAS __attribute__((address_space(3)))
#define GAS __attribute__((address_space(1)))
#define GIN(k) ((const float*)(const GAS float*)F.in[k])
typedef float f32x2 __attribute__((ext_vector_type(2)));
typedef __bf16 bf16x2_t __attribute__((ext_vector_type(2)));
typedef float f32x16 __attribute__((ext_vector_type(16)));

constexpr int DM = 1024, E_ = 2048, XA = 512, NH = 4, HD = 128, MEML = 256;
constexpr int PB = 8, PSEQ = 2048, MP = PB * PSEQ;
constexpr int SBT = 128, SSEQ = 4, MS = SBT * SSEQ;
constexpr int M = MP + MS;
constexpr int NIN_A = 3 * E_ + XA, NIN_B = 4 * E_ + XA, NIN_C = 2 * E_ + XA, KOUT = E_ + XA;
constexpr int S5G = 128, S5P = 64, S5I = 16;
constexpr float EPS = 1e-6f;
constexpr int NWAVES = 8, NTHR = 512;

constexpr size_t O_YP = 0, O_YS = O_YP + (size_t)MP * DM, O_MK = O_YS + (size_t)MS * DM, O_MV = O_MK + 4ull * PB * MEML * XA, O_CP = O_MV + 4ull * PB * MEML * XA,
                 O_CS = O_CP + (size_t)PB * 2 * E_, O_SRP = O_CS + (size_t)SBT * 2 * E_, O_SIP = O_SRP + (size_t)PB * S5G * S5P, O_SRS = O_SIP + (size_t)PB * S5G * S5P,
                 O_SIS = O_SRS + (size_t)SBT * S5G * S5P, O_CV = O_SIS + (size_t)SBT * S5G * S5P, O_END = O_CV + 2ull * SBT * SSEQ * E_;
static_assert(O_END == 30572544ull, "output size");

constexpr size_t MiB = 1u << 20;
constexpr size_t WS_CTL = 0, WS_TAB = 1 * MiB, WS_RSTDM = 3 * MiB, WS_SGUW = 4 * MiB, WS_SSX = 5 * MiB, WS_SSV = 7 * MiB, WS_WKV = 10 * MiB, WS_WGLU = 18 * MiB, WS_WOUT = 26 * MiB,
                 WS_WINA = 46 * MiB, WS_WINB = 72 * MiB, WS_WINC = 89 * MiB, WS_MEMB = 98 * MiB, WS_KB = 102 * MiB, WS_VT = 110 * MiB, WS_XB = 118 * MiB, WS_X = 151 * MiB,
                 WS_B0 = 217 * MiB, WS_B1 = 283 * MiB, WS_QB = 349 * MiB, WS_A2 = 366 * MiB, WS_GB = 449 * MiB, WS_SLAB = 515 * MiB  , WS_END = 548 * MiB;
constexpr size_t T_AR = 0, T_AI = 8192, T_BBR = 16384, T_BBI = 16384 + 131072;

constexpr int RING_BYTES = 131072, LDS_BYTES = 147456;

struct Args { const float* in[30]; float* out; unsigned char* ws; int ph_lo, ph_hi; };

__device__ __forceinline__ unsigned pk2(float lo, float hi) { f32x2 v = {lo, hi}; return __builtin_bit_cast(unsigned, __builtin_convertvector(v, bf16x2_t)); }
__device__ __forceinline__ bf16_t f2bf(float f) { return (bf16_t)(pk2(f, 0.f) & 0xffffu); }
__device__ __forceinline__ float bf2f(unsigned short h) { return __uint_as_float((unsigned)h << 16); }
__device__ __forceinline__ float bflo(unsigned w) { return __uint_as_float(w << 16); }
__device__ __forceinline__ float bfhi(unsigned w) { return __uint_as_float(w & 0xffff0000u); }
__device__ __forceinline__ float sigmoidf_(float x) { return __builtin_amdgcn_rcpf(1.f + __expf(-x)); }
__device__ __forceinline__ float siluf_(float x) { return x * sigmoidf_(x); }
__device__ __forceinline__ float gelu_tanh(float x) { const float y = 0.7978845608028654f * (x + 0.044715f * x * x * x); return x * sigmoidf_(2.f * y); }
__device__ __forceinline__ float wave_sum(float v) {
#pragma unroll
    for (int o = 1; o < 64; o <<= 1) v += __shfl_xor(v, o);
    return v;
}
__device__ __forceinline__ float wave_max(float v) {
#pragma unroll
    for (int o = 1; o < 64; o <<= 1) v = fmaxf(v, __shfl_xor(v, o));
    return v;
}
__device__ __forceinline__ u32x4 pack8(f32x4 a, f32x4 b) { u32x4 w; w.x = pk2(a[0], a[1]); w.y = pk2(a[2], a[3]); w.z = pk2(b[0], b[1]); w.w = pk2(b[2], b[3]); return w; }
__device__ __forceinline__ void unpack8(u32x4 w, float (&f)[8]) { f[0] = bflo(w.x); f[1] = bfhi(w.x); f[2] = bflo(w.y); f[3] = bfhi(w.y); f[4] = bflo(w.z); f[5] = bfhi(w.z); f[6] = bflo(w.w); f[7] = bfhi(w.w); }

__device__ __forceinline__ int src_col(int kind, int np) {
    const int pn = np >> 8, p = np & 255, pos = (p & ~31) + pg8::perm32(p & 31);
    if (kind == 0) {
        if (pn < 16) return pos < 128 ? 128 * pn + pos : 2 * E_ + 128 * pn + (pos - 128);
        if (pn < 24) return E_ + 256 * (pn - 16) + pos;
        return 3 * E_ + 256 * (pn - 24) + pos;
    }
    if (kind == 1) {
        if (pn < 32) { const int qs = 2 * (p >> 7) + ((p >> 4) & 1), ch = 64 * pn + 16 * ((p >> 5) & 3) + (p & 15); return qs * E_ + ch; }
        return 4 * E_ + 256 * (pn - 32) + pos;
    }
    return 256 * pn + pos;
}

__device__ __forceinline__ float sum_rows4(float x) {
    auto a = __builtin_amdgcn_permlane16_swap(__float_as_uint(x), __float_as_uint(x), false, false); const float y = __uint_as_float(a[0]) + __uint_as_float(a[1]);
    auto b = __builtin_amdgcn_permlane32_swap(__float_as_uint(y), __float_as_uint(y), false, false); return __uint_as_float(b[0]) + __uint_as_float(b[1]);
}
__device__ __forceinline__ void rows_rstd16(const float* ssx, int row0, int fq, float (&rs)[2][4]) {
#pragma unroll
    for (int ai = 0; ai < 2; ++ai)
#pragma unroll
        for (int m = 0; m < 4; ++m) {
            const f32x4 v = *(const f32x4*)(ssx + (size_t)(row0 + ai * 128 + m * 16) * 16 + fq * 4);
            const float s = sum_rows4((v[0] + v[1]) + (v[2] + v[3]));
            rs[ai][m] = __builtin_amdgcn_rsqf(s * (1.f / DM) + EPS);
        }
}

struct EpiKV {
    static constexpr bool PERM = false, AFTER_DRAIN = false;
    const float* rstdm; float* outk; float* outv; bf16_t* KB; bf16_t* VT; int layer;
    __device__ __forceinline__ void operator()(const f32x4 (&acc)[2][2][4][2], const Unit& u, int wr, int wc, int fr, int fq) const {
        const int sub = u.pn & 3, isv = sub >> 1, b = u.pm;
        const int key0 = wr * 64 + fr, d0 = 32 * wc + 8 * fq;
        const float* rsp = rstdm + b * 256 + key0;
        float* of = (isv ? outv : outk) + (((size_t)(layer * PB + b) * MEML + key0) * NH + (sub & 1) * 2) * HD + d0;
        const size_t bh0 = (size_t)((layer * PB + b) * NH + (sub & 1) * 2);
        if (!isv) {
            bf16_t* kb = KB + (bh0 * MEML + key0) * HD + d0;
#pragma unroll
            for (int ai = 0; ai < 2; ++ai)
#pragma unroll
                for (int m = 0; m < 4; ++m) { const int kk = ai * 128 + m * 16; const float rs = rsp[kk];
#pragma unroll
                    for (int bj = 0; bj < 2; ++bj) { const f32x4 v0 = acc[ai][bj][m][0] * rs, v1 = acc[ai][bj][m][1] * rs;
                        float* o = of + (size_t)kk * XA + bj * HD; *(f32x4*)o = v0; *(f32x4*)(o + 4) = v1;
                        *(u32x4*)(kb + (size_t)bj * MEML * HD + (size_t)kk * HD) = pack8(v0, v1); }
                    asm volatile("" ::: "memory"); }
        } else {
            bf16_t* vt = VT + (bh0 * HD + d0) * MEML + key0;
#pragma unroll
            for (int ai = 0; ai < 2; ++ai)
#pragma unroll
                for (int m = 0; m < 4; ++m) { const int kk = ai * 128 + m * 16; const float rs = rsp[kk];
#pragma unroll
                    for (int bj = 0; bj < 2; ++bj) { const f32x4 v0 = acc[ai][bj][m][0] * rs, v1 = acc[ai][bj][m][1] * rs;
                        float* o = of + (size_t)kk * XA + bj * HD; *(f32x4*)o = v0; *(f32x4*)(o + 4) = v1;
                        bf16_t* q = vt + (size_t)bj * HD * MEML + kk;
#pragma unroll
                        for (int e = 0; e < 4; ++e) { q[e * MEML] = f2bf(v0[e]); q[(e + 4) * MEML] = f2bf(v1[e]); }
                        asm volatile("" ::: "memory"); } }
        }
    }
};

struct EpiInA {
    static constexpr bool PERM = false, AFTER_DRAIN = false;
    const float* ssx; bf16_t* UZ; bf16_t* VR; bf16_t* QB; float* SSV;
    __device__ __forceinline__ void operator()(const f32x4 (&acc)[2][2][4][2], const Unit& u, int wr, int wc, int fr, int fq) const {
        const int row0 = u.pm * 256 + wr * 64 + fr; float rs[2][4]; rows_rstd16(ssx, row0, fq, rs);
        if (u.pn < 16) {
#pragma unroll
            for (int ai = 0; ai < 2; ++ai)
#pragma unroll
                for (int m = 0; m < 4; ++m) { const int row = row0 + ai * 128 + m * 16; const float r = rs[ai][m]; f32x4 o[2];
#pragma unroll
                    for (int n = 0; n < 2; ++n)
#pragma unroll
                        for (int e = 0; e < 4; ++e) o[n][e] = acc[ai][0][m][n][e] * r * siluf_(acc[ai][1][m][n][e] * r);
                    *(u32x4*)(UZ + (size_t)row * E_ + 128 * u.pn + 32 * wc + 8 * fq) = pack8(o[0], o[1]); }
        } else if (u.pn < 24) {
#pragma unroll
            for (int ai = 0; ai < 2; ++ai)
#pragma unroll
                for (int m = 0; m < 4; ++m) { const int row = row0 + ai * 128 + m * 16; const float r = rs[ai][m]; float ss = 0.f;
#pragma unroll
                    for (int bj = 0; bj < 2; ++bj) { const f32x4 v0 = acc[ai][bj][m][0] * r, v1 = acc[ai][bj][m][1] * r;
                        ss += (v0[0] * v0[0] + v0[1] * v0[1]) + (v0[2] * v0[2] + v0[3] * v0[3]) + (v1[0] * v1[0] + v1[1] * v1[1]) + (v1[2] * v1[2] + v1[3] * v1[3]);
                        *(u32x4*)(VR + (size_t)row * E_ + 256 * (u.pn - 16) + 128 * bj + 32 * wc + 8 * fq) = pack8(v0, v1); }
                    ss = sum_rows4(ss);
                    if (fq == 0) SSV[(size_t)row * 32 + (u.pn - 16) * 4 + wc] = ss; }
        } else {
#pragma unroll
            for (int ai = 0; ai < 2; ++ai)
#pragma unroll
                for (int m = 0; m < 4; ++m) { const int row = row0 + ai * 128 + m * 16; const float r = rs[ai][m] * 0.08838834764831845f;
#pragma unroll
                    for (int bj = 0; bj < 2; ++bj) *(u32x4*)(QB + (size_t)row * XA + 256 * (u.pn - 24) + 128 * bj + 32 * wc + 8 * fq) = pack8(acc[ai][bj][m][0] * r, acc[ai][bj][m][1] * r); }
        }
    }
};

struct EpiInB {
    static constexpr bool PERM = false, AFTER_DRAIN = false;
    const float* ssx; bf16_t* P; bf16_t* G; bf16_t* QB; float* convp; float* convs;
    __device__ __forceinline__ void operator()(const f32x4 (&acc)[2][2][4][2], const Unit& u, int wr, int wc, int fr, int fq) const {
        const int row0 = u.pm * 256 + wr * 64 + fr; float rs[2][4]; rows_rstd16(ssx, row0, fq, rs);
        if (u.pn < 32) {
            const int ch0 = 64 * u.pn + 16 * wc + 4 * fq;
#pragma unroll
            for (int ai = 0; ai < 2; ++ai)
#pragma unroll
                for (int m = 0; m < 4; ++m) { const int row = row0 + ai * 128 + m * 16; const float r = rs[ai][m];
                    const f32x4 bg = acc[ai][0][m][0] * r, cgv = acc[ai][0][m][1] * r, hv = acc[ai][1][m][0] * r, z = acc[ai][1][m][1] * r;
                    f32x4 p = cgv * hv, gg;
#pragma unroll
                    for (int e = 0; e < 4; ++e) gg[e] = bg[e] * siluf_(z[e]);
                    u32x2 wp, wg; wp.x = pk2(p[0], p[1]); wp.y = pk2(p[2], p[3]); wg.x = pk2(gg[0], gg[1]); wg.y = pk2(gg[2], gg[3]);
                    *(u32x2*)(P + (size_t)row * E_ + ch0) = wp; *(u32x2*)(G + (size_t)row * E_ + ch0) = wg;
                    if (row < MP) { const int t = row & (PSEQ - 1); if (t >= PSEQ - 2) *(f32x4*)(convp + ((size_t)(row >> 11) * 2 + (t - (PSEQ - 2))) * E_ + ch0) = p; }
                    else { const int s = row - MP, t = s & 3; if (t >= 2) *(f32x4*)(convs + ((size_t)(s >> 2) * 2 + (t - 2)) * E_ + ch0) = p; } }
        } else {
#pragma unroll
            for (int ai = 0; ai < 2; ++ai)
#pragma unroll
                for (int m = 0; m < 4; ++m) { const int row = row0 + ai * 128 + m * 16; const float r = rs[ai][m] * 0.08838834764831845f;
#pragma unroll
                    for (int bj = 0; bj < 2; ++bj) *(u32x4*)(QB + (size_t)row * XA + 256 * (u.pn - 32) + 128 * bj + 32 * wc + 8 * fq) = pack8(acc[ai][bj][m][0] * r, acc[ai][bj][m][1] * r); }
        }
    }
};

struct EpiInC {
    static constexpr bool PERM = false, AFTER_DRAIN = false;
    const float* ssx; bf16_t* U; bf16_t* SZ; bf16_t* QB;
    __device__ __forceinline__ void operator()(const f32x4 (&acc)[2][2][4][2], const Unit& u, int wr, int wc, int fr, int fq) const {
        const int row0 = u.pm * 256 + wr * 64 + fr; float rs[2][4]; rows_rstd16(ssx, row0, fq, rs);
#pragma unroll
        for (int ai = 0; ai < 2; ++ai)
#pragma unroll
            for (int m = 0; m < 4; ++m) { const int row = row0 + ai * 128 + m * 16; const float r = rs[ai][m];
#pragma unroll
                for (int bj = 0; bj < 2; ++bj) { const int cc = 128 * bj + 32 * wc + 8 * fq;
                    if (u.pn < 8) *(u32x4*)(U + (size_t)row * E_ + 256 * u.pn + cc) = pack8(acc[ai][bj][m][0] * r, acc[ai][bj][m][1] * r);
                    else if (u.pn < 16) { f32x4 a, b2;
#pragma unroll
                        for (int e = 0; e < 4; ++e) { a[e] = siluf_(acc[ai][bj][m][0][e] * r); b2[e] = siluf_(acc[ai][bj][m][1][e] * r); }
                        *(u32x4*)(SZ + (size_t)row * E_ + 256 * (u.pn - 8) + cc) = pack8(a, b2); }
                    else { const float rq = r * 0.08838834764831845f; *(u32x4*)(QB + (size_t)row * XA + 256 * (u.pn - 16) + cc) = pack8(acc[ai][bj][m][0] * rq, acc[ai][bj][m][1] * rq); } } }
    }
};

struct EpiOut {
    static constexpr bool PERM = false, AFTER_DRAIN = false;
    const float* basef; bf16_t* XB; float* SSX;
    __device__ __forceinline__ void operator()(const f32x4 (&acc)[2][2][4][2], const Unit& u, int wr, int wc, int fr, int fq) const {
        const int row0 = u.pm * 256 + wr * 64 + fr;
#pragma unroll
        for (int ai = 0; ai < 2; ++ai)
#pragma unroll
            for (int m = 0; m < 4; ++m) { const int row = row0 + ai * 128 + m * 16; float ss = 0.f;
#pragma unroll
                for (int bj = 0; bj < 2; ++bj) { const int col = 256 * u.pn + 128 * bj + 32 * wc + 8 * fq; f32x4 x0, x1;
                    if (basef) { x0 = *(const f32x4*)(basef + (size_t)row * DM + col); x1 = *(const f32x4*)(basef + (size_t)row * DM + col + 4); }
                    else { float r[8]; unpack8(*(const u32x4*)(XB + (size_t)row * DM + col), r); x0 = (f32x4){r[0], r[1], r[2], r[3]}; x1 = (f32x4){r[4], r[5], r[6], r[7]}; }
                    x0 += acc[ai][bj][m][0]; x1 += acc[ai][bj][m][1];
                    *(u32x4*)(XB + (size_t)row * DM + col) = pack8(x0, x1);
                    ss += (x0[0] * x0[0] + x0[1] * x0[1]) + (x0[2] * x0[2] + x0[3] * x0[3]) + (x1[0] * x1[0] + x1[1] * x1[1]) + (x1[2] * x1[2] + x1[3] * x1[3]); }
                ss = sum_rows4(ss);
                if (fq == 0) SSX[(size_t)row * 16 + u.pn * 4 + wc] = ss; }
    }
};

struct EpiGlu {
    static constexpr bool PERM = false, AFTER_DRAIN = false;
    const bf16_t* GB; const bf16_t* SZ; const float* bias; bf16_t* A2;
    __device__ __forceinline__ void operator()(const f32x4 (&acc)[2][2][4][2], const Unit& u, int wr, int wc, int fr, int fq) const {
        const int row0 = u.pm * 256 + wr * 64 + fr;
#pragma unroll
        for (int ai = 0; ai < 2; ++ai)
#pragma unroll
            for (int m = 0; m < 4; ++m) { const int row = row0 + ai * 128 + m * 16;
#pragma unroll
                for (int bj = 0; bj < 2; ++bj) { const int col = 256 * u.pn + 128 * bj + 32 * wc + 8 * fq;
                    const f32x4 b0 = *(const f32x4*)(bias + col), b1 = *(const f32x4*)(bias + col + 4);
                    float gv[8], sz[8]; unpack8(*(const u32x4*)(GB + (size_t)row * E_ + col), gv); unpack8(*(const u32x4*)(SZ + (size_t)row * E_ + col), sz);
                    f32x4 o0, o1;
#pragma unroll
                    for (int e = 0; e < 4; ++e) { o0[e] = gv[e] * sigmoidf_(acc[ai][bj][m][0][e] + b0[e]) * sz[e]; o1[e] = gv[4 + e] * sigmoidf_(acc[ai][bj][m][1][e] + b1[e]) * sz[4 + e]; }
                    *(u32x4*)(A2 + (size_t)row * KOUT + col) = pack8(o0, o1); } }
    }
};

struct EpiSlab {
    static constexpr bool PERM = false, AFTER_DRAIN = false;
    float* S; int ldc; int row0; size_t kstride;
    __device__ __forceinline__ void operator()(const f32x4 (&acc)[2][2][4][2], const Unit& u, int wr, int wc, int fr, int fq) const {
        float* base = S + (size_t)u.ks * kstride + (size_t)(u.pm * 256 + wr * 64 + fr - row0) * ldc + 256 * u.pn + 32 * wc + 8 * fq;
#pragma unroll
        for (int ai = 0; ai < 2; ++ai)
#pragma unroll
            for (int m = 0; m < 4; ++m)
                { float* o = base + (size_t)(ai * 128 + m * 16) * ldc; *(f32x4*)o = acc[ai][0][m][0]; *(f32x4*)(o + 4) = acc[ai][0][m][1]; *(f32x4*)(o + 128) = acc[ai][1][m][0]; *(f32x4*)(o + 132) = acc[ai][1][m][1];
                  asm volatile("" ::: "memory"); }
    }
};

#ifndef PROBE_EPI2
#define PROBE_EPI2 0
#endif
template <class E_> struct EpiTwice { static constexpr bool PERM = false, AFTER_DRAIN = false; E_ e;
    __device__ __forceinline__ void operator()(const f32x4 (&acc)[2][2][4][2], const Unit& u, int wr, int wc, int fr, int fq) const { e(acc, u, wr, wc, fr, fq); asm volatile("" ::: "memory"); e(acc, u, wr, wc, fr, fq); } };

struct Frame {
    LAS unsigned char* lds; int tid, lane, wave, G, bid;
    const float* const* in; float* out; unsigned char* ws;
};

__device__ __forceinline__ void conv_item(const float* W, int K, int N, const float* gs, int kind, bf16_t* WT, LAS float* scr, int item, int lane) {
    const int nblk = N / 32, kb = item / nblk, nb = item % nblk, k0 = 64 * kb, n0 = 32 * nb, n4 = lane & 7, kr = lane >> 3;
    const int sc = src_col(kind, n0 + 4 * n4);
    f32x4 w[8];
#pragma unroll
    for (int i = 0; i < 8; ++i) w[i] = *(const f32x4*)(W + (size_t)(k0 + kr + 8 * i) * N + sc);
#pragma unroll
    for (int i = 0; i < 8; ++i) { const int kk = kr + 8 * i; const float g = gs ? gs[k0 + kk] : 1.f; LAS float* d = scr + kk * 33 + 4 * n4; d[0] = w[i][0] * g; d[1] = w[i][1] * g; d[2] = w[i][2] * g; d[3] = w[i][3] * g; }
    asm volatile("s_waitcnt lgkmcnt(0)" ::: "memory");
    const int c = lane & 7;
#pragma unroll
    for (int j = 0; j < 4; ++j) { const int n = (lane >> 3) + 8 * j; const LAS float* s = scr + (8 * c) * 33 + n;
        u32x4 o; o.x = pk2(s[0 * 33], s[1 * 33]); o.y = pk2(s[2 * 33], s[3 * 33]); o.z = pk2(s[4 * 33], s[5 * 33]); o.w = pk2(s[6 * 33], s[7 * 33]);
        *(u32x4*)(WT + (size_t)(n0 + n) * K + k0 + 8 * c) = o; }
    asm volatile("s_waitcnt lgkmcnt(0)" ::: "memory");
}

__device__ __forceinline__ void p0_prologue(Frame& F) {
    LAS float* scr = (LAS float*)(F.lds + F.wave * 16384);
    const int gw = F.bid * NWAVES + F.wave, NGW = F.G * NWAVES, lane = F.lane;
    unsigned char* ws = F.ws;
    constexpr int I_A = 16 * (NIN_A / 32), I_B = 16 * (NIN_B / 32), I_C = 16 * (NIN_C / 32), I_O = (KOUT / 64) * (DM / 32), I_KV = 16 * (DM / 32), I_GLU = (E_ / 64) * (E_ / 32);
    constexpr int NITEMS = 2 * I_A + I_B + I_C + 4 * I_O + 4 * I_KV + I_GLU;
    for (int it = gw; it < NITEMS; it += NGW) {
        int r = it;
        if (r < 2 * I_A) { const int j = r / I_A; r -= j * I_A; conv_item(GIN(13) + (size_t)j * DM * NIN_A, DM, NIN_A, GIN(8) + (j == 0 ? 0 : 3) * DM, 0, (bf16_t*)(ws + WS_WINA) + (size_t)j * NIN_A * DM, scr, r, lane); continue; } r -= 2 * I_A;
        if (r < I_B) { conv_item(GIN(17), DM, NIN_B, GIN(8) + 1 * DM, 1, (bf16_t*)(ws + WS_WINB), scr, r, lane); continue; } r -= I_B;
        if (r < I_C) { conv_item(GIN(19), DM, NIN_C, GIN(8) + 2 * DM, 2, (bf16_t*)(ws + WS_WINC), scr, r, lane); continue; } r -= I_C;
        if (r < 4 * I_O) { const int j = r / I_O; r -= j * I_O; conv_item(GIN(12) + (size_t)j * KOUT * DM, KOUT, DM, nullptr, 2, (bf16_t*)(ws + WS_WOUT) + (size_t)j * DM * KOUT, scr, r, lane); continue; } r -= 4 * I_O;
        if (r < 4 * I_KV) { const int j = r / I_KV; r -= j * I_KV; conv_item(GIN(11) + (size_t)j * DM * DM, DM, DM, GIN(10) + j * DM, 2, (bf16_t*)(ws + WS_WKV) + (size_t)j * DM * DM, scr, r, lane); continue; } r -= 4 * I_KV;
        conv_item(GIN(28), E_, E_, nullptr, 2, (bf16_t*)(ws + WS_WGLU), scr, r, lane);
    }
    {
        bf16_t* XB = (bf16_t*)(ws + WS_XB); float* SSX = (float*)(ws + WS_SSX);
        for (int row = gw; row < M; row += NGW) {
            const float* xr = row < MP ? GIN(0) + (size_t)row * DM : GIN(1) + (size_t)(row - MP) * DM;
            float ss = 0.f;
#pragma unroll
            for (int j = 0; j < 4; ++j) { const f32x4 v = *((const f32x4*)xr + lane + 64 * j); ss += (v[0] * v[0] + v[1] * v[1]) + (v[2] * v[2] + v[3] * v[3]);
                u32x2 w; w.x = pk2(v[0], v[1]); w.y = pk2(v[2], v[3]); *((u32x2*)(XB + (size_t)row * DM) + lane + 64 * j) = w; }
            asm volatile("s_waitcnt vmcnt(0)" ::: "memory");
            ss = wave_sum(ss);
            if (lane < 16) SSX[(size_t)row * 16 + lane] = lane == 0 ? ss : 0.f;
        }
    }
    {
        bf16_t* MB = (bf16_t*)(ws + WS_MEMB); float* RM = (float*)(ws + WS_RSTDM);
        for (int row = gw; row < PB * MEML; row += NGW) {
            const float* xr = GIN(2) + (size_t)row * DM; float ss = 0.f;
#pragma unroll
            for (int j = 0; j < 4; ++j) { const f32x4 v = *((const f32x4*)xr + lane + 64 * j); ss += (v[0] * v[0] + v[1] * v[1]) + (v[2] * v[2] + v[3] * v[3]);
                u32x2 w; w.x = pk2(v[0], v[1]); w.y = pk2(v[2], v[3]); *((u32x2*)(MB + (size_t)row * DM) + lane + 64 * j) = w; }
            asm volatile("s_waitcnt vmcnt(0)" ::: "memory");
            ss = wave_sum(ss);
            if (lane == 0) RM[row] = 1.0f / sqrtf(ss * (1.f / DM) + EPS);
        }
    }
    {
        float* TAB = (float*)(ws + WS_TAB);
        for (int g = gw; g < S5G; g += NGW) {
            const int gp = g * S5P + lane;
            const float lr = GIN(20)[gp], li = GIN(21)[gp], dt = expf(GIN(22)[g]);
            const float th = li * dt, em1 = expm1f(lr * dt), mag = em1 + 1.f, cs = cosf(th), sn = sinf(th), sh = sinf(0.5f * th);
            const float ar = mag * cs, ai = mag * sn;
            const float nr = em1 * cs - 2.f * sh * sh, ni = ai;
            const float den = lr * lr + li * li, cr = (nr * lr + ni * li) / den, ci = (ni * lr - nr * li) / den;
            TAB[T_AR + gp] = ar; TAB[T_AI + gp] = ai;
#pragma unroll
            for (int i = 0; i < S5I; ++i) { const float br = GIN(23)[(size_t)gp * S5I + i], bi = GIN(24)[(size_t)gp * S5I + i];
                TAB[T_BBR + (size_t)gp * S5I + i] = cr * br - ci * bi; TAB[T_BBI + (size_t)gp * S5I + i] = cr * bi + ci * br; }
        }
    }
    {
        bf16_t* SW = (bf16_t*)(ws + WS_SGUW);
        for (int i = (F.bid * NTHR + F.tid); i < 2 * 8 * 128 * 128; i += F.G * NTHR) { const int t = (i >> 7) & 127, s = i & 127; SW[i] = f2bf(s <= t ? GIN(15)[i] : 0.f); }
    }
}

typedef short v4i16_t __attribute__((ext_vector_type(4)));
constexpr int SG_VSTR = 576, SG_WSTR = 272, SG_WOFF = 128 * SG_VSTR, SG_ROFF = SG_WOFF + 128 * SG_WSTR;
static_assert(SG_ROFF + 512 <= RING_BYTES, "sgu LDS");
__device__ __forceinline__ void sgu_phase_mfma(Frame& F, int j) {
    const bf16_t* UZ = (const bf16_t*)(F.ws + WS_B0); const bf16_t* VR = (const bf16_t*)(F.ws + WS_B1); const float* SSV = (const float*)(F.ws + WS_SSV);
    const bf16_t* SW = (const bf16_t*)(F.ws + WS_SGUW) + (size_t)j * 8 * 128 * 128; bf16_t* A2 = (bf16_t*)(F.ws + WS_A2);
    const float* gn = GIN(14) + (size_t)j * E_; const float* bsv = GIN(16) + (size_t)j * 8 * 128;
    LAS unsigned char* lds = F.lds; LAS float* rsl = (LAS float*)(lds + SG_ROFF);
    const int tid = F.tid, lane = F.lane, wid = F.wave, c = lane & 31, hh = lane >> 5;
    for (int un = F.bid; un < 128 * 8; un += F.G) {
        const int ch = un >> 3, g = un & 7, rbase = ch * 128;
        __syncthreads();
        if (tid < 128) { const float* p = SSV + (size_t)(rbase + tid) * 32; float sq = 0.f;
#pragma unroll
            for (int k = 0; k < 8; ++k) { const f32x4 v = *((const f32x4*)p + k); sq += (v[0] + v[1]) + (v[2] + v[3]); }
            rsl[tid] = __builtin_amdgcn_rsqf(sq * (1.f / E_) + EPS); }
#pragma unroll
        for (int i = 0; i < 4; ++i) { const int chn = tid + NTHR * i, row = chn >> 4, c16 = chn & 15;
            *(LAS u32x4*)(lds + SG_WOFF + row * SG_WSTR + c16 * 16) = *(const u32x4*)(SW + (size_t)g * 128 * 128 + row * 128 + c16 * 8); }
        __syncthreads();
#pragma unroll
        for (int i = 0; i < 8; ++i) { const int chn = tid + NTHR * i, sr = chn >> 5, c8 = chn & 31; float v[8]; unpack8(*(const u32x4*)(VR + (size_t)(rbase + sr) * E_ + 256 * g + 8 * c8), v);
            const float r = rsl[sr]; const f32x4 g0 = *(const f32x4*)(gn + 256 * g + 8 * c8), g1 = *(const f32x4*)(gn + 256 * g + 8 * c8 + 4); f32x4 a, b2;
#pragma unroll
            for (int e = 0; e < 4; ++e) { a[e] = v[e] * r * g0[e]; b2[e] = v[4 + e] * r * g1[e]; }
            *(LAS u32x4*)(lds + sr * SG_VSTR + c8 * 16) = pack8(a, b2); }
        __syncthreads();
        f32x16 acc[4];
#pragma unroll
        for (int ti = 0; ti < 4; ++ti) acc[ti] = (f32x16){};
        const LAS unsigned char* abase = lds + (8 * hh + ((lane & 15) >> 2)) * SG_VSTR + (32 * wid + 16 * ((lane >> 4) & 1) + 4 * (lane & 3)) * 2;
#pragma unroll
        for (int s2 = 0; s2 < 8; ++s2) {
            const v4i16_t lo = __builtin_amdgcn_ds_read_tr16_b64_v4i16((LAS v4i16_t*)(abase + (16 * s2) * SG_VSTR));
            const v4i16_t hi = __builtin_amdgcn_ds_read_tr16_b64_v4i16((LAS v4i16_t*)(abase + (16 * s2 + 4) * SG_VSTR));
            const bf16x8 a = (bf16x8){lo[0], lo[1], lo[2], lo[3], hi[0], hi[1], hi[2], hi[3]};
#pragma unroll
            for (int ti = s2 >> 1; ti < 4; ++ti) { const bf16x8 b = *(const LAS bf16x8*)(lds + SG_WOFF + (32 * ti + c) * SG_WSTR + (16 * s2 + 8 * hh) * 2);
                acc[ti] = __builtin_amdgcn_mfma_f32_32x32x16_bf16(a, b, acc[ti], 0, 0, 0); }
        }
#pragma unroll
        for (int ti = 0; ti < 4; ++ti) { const int t = 32 * ti + c; const size_t row = (size_t)(rbase + t); const float bias = bsv[g * 128 + t];
#pragma unroll
            for (int g4 = 0; g4 < 4; ++g4) { const int d = 256 * g + 32 * wid + 8 * g4 + 4 * hh; const u32x2 uz = *(const u32x2*)(UZ + row * E_ + d);
                u32x2 w; w.x = pk2(bflo(uz.x) * (acc[ti][4 * g4] + bias), bfhi(uz.x) * (acc[ti][4 * g4 + 1] + bias)); w.y = pk2(bflo(uz.y) * (acc[ti][4 * g4 + 2] + bias), bfhi(uz.y) * (acc[ti][4 * g4 + 3] + bias));
                *(u32x2*)(A2 + row * KOUT + d) = w; } }
    }
}

__device__ __forceinline__ void sgu_sample_phase(Frame& F, int j) {
    const bf16_t* UZ = (const bf16_t*)(F.ws + WS_B0); const bf16_t* VR = (const bf16_t*)(F.ws + WS_B1); const float* SSV = (const float*)(F.ws + WS_SSV);
    const bf16_t* SW = (const bf16_t*)(F.ws + WS_SGUW) + (size_t)j * 8 * 128 * 128; bf16_t* A2 = (bf16_t*)(F.ws + WS_A2);
    const float* gn = GIN(14) + (size_t)j * E_; const float* bsv = GIN(16) + (size_t)j * 8 * 128; float* cvout = F.out + O_CV + (size_t)j * SBT * SSEQ * E_;
    const int gw = F.bid * NWAVES + F.wave, NGW = F.G * NWAVES, lane = F.lane;
    for (int task = gw; task < SBT * 8; task += NGW) {
        const int b = task >> 3, g = task & 7; const size_t r0 = (size_t)MP + b * SSEQ; const int ch = 256 * g + 4 * lane;
        float rs[SSEQ];
#pragma unroll
        for (int t = 0; t < SSEQ; ++t) { float v = lane < 32 ? SSV[(r0 + t) * 32 + lane] : 0.f; v = wave_sum(v); rs[t] = __builtin_amdgcn_rsqf(v * (1.f / E_) + EPS); }
        const f32x4 g4 = *(const f32x4*)(gn + ch);
        f32x4 vn[SSEQ];
#pragma unroll
        for (int t = 0; t < SSEQ; ++t) { const u32x2 w = *(const u32x2*)(VR + (r0 + t) * E_ + ch); const f32x4 v = (f32x4){bflo(w.x), bfhi(w.x), bflo(w.y), bfhi(w.y)}; vn[t] = v * rs[t] * g4;
            *(f32x4*)(cvout + (size_t)(b * SSEQ + t) * E_ + ch) = vn[t];
            u32x2 q; q.x = pk2(vn[t][0], vn[t][1]); q.y = pk2(vn[t][2], vn[t][3]); vn[t] = (f32x4){bflo(q.x), bfhi(q.x), bflo(q.y), bfhi(q.y)}; }
#pragma unroll
        for (int t = 0; t < SSEQ; ++t) { f32x4 a = {0.f, 0.f, 0.f, 0.f};
#pragma unroll
            for (int sq = 0; sq <= t; ++sq) a += vn[sq] * bf2f(SW[(size_t)g * 128 * 128 + t * 128 + sq]);
            a += bsv[g * 128 + t];
            const u32x2 uz = *(const u32x2*)(UZ + (r0 + t) * E_ + ch);
            u32x2 w; w.x = pk2(bflo(uz.x) * a[0], bfhi(uz.x) * a[1]); w.y = pk2(bflo(uz.y) * a[2], bfhi(uz.y) * a[3]);
            *(u32x2*)(A2 + (r0 + t) * KOUT + ch) = w; }
    }
}

__device__ __forceinline__ void conv_phase(Frame& F) {
    const bf16_t* P = (const bf16_t*)(F.ws + WS_B0); const bf16_t* G = (const bf16_t*)(F.ws + WS_B1); bf16_t* A2 = (bf16_t*)(F.ws + WS_A2);
    const float* cw = GIN(18); const float* st = GIN(5);
    for (int i = F.bid * NTHR + F.tid; i < (M / 32) * 256; i += F.G * NTHR) {
        const int seg = i >> 8, c0 = (i & 255) * 8, r0 = seg * 32;
        float w0[8], w1[8], w2[8];
#pragma unroll
        for (int e = 0; e < 8; ++e) { w0[e] = cw[c0 + e]; w1[e] = cw[E_ + c0 + e]; w2[e] = cw[2 * E_ + c0 + e]; }
        float x1[8], x2[8];
        if (r0 < MP) { if ((r0 & (PSEQ - 1)) == 0) { for (int e = 0; e < 8; ++e) { x1[e] = 0.f; x2[e] = 0.f; } }
                       else { unpack8(*(const u32x4*)(P + (size_t)(r0 - 1) * E_ + c0), x1); unpack8(*(const u32x4*)(P + (size_t)(r0 - 2) * E_ + c0), x2); } }
#pragma unroll 4
        for (int rr = 0; rr < 32; ++rr) {
            const int row = r0 + rr;
            if (row >= MP && ((row - MP) & 3) == 0) { const float* buf = st + (size_t)((row - MP) >> 2) * 2 * E_ + c0;
                for (int e = 0; e < 8; ++e) { x2[e] = buf[e]; x1[e] = buf[E_ + e]; } }
            float x0[8], gg[8]; unpack8(*(const u32x4*)(P + (size_t)row * E_ + c0), x0); unpack8(*(const u32x4*)(G + (size_t)row * E_ + c0), gg);
            f32x4 o0, o1;
#pragma unroll
            for (int e = 0; e < 8; ++e) { const float y = w0[e] * x2[e] + w1[e] * x1[e] + w2[e] * x0[e]; const float r = y * gg[e]; if (e < 4) o0[e] = r; else o1[e - 4] = r; x2[e] = x1[e]; x1[e] = x0[e]; }
            *(u32x4*)(A2 + (size_t)row * KOUT + c0) = pack8(o0, o1);
        }
    }
}

__device__ __forceinline__ void s5_sample_phase(Frame& F) {
    const bf16_t* U = (const bf16_t*)(F.ws + WS_B0); bf16_t* GBo = (bf16_t*)(F.ws + WS_GB); const float* TAB = (const float*)(F.ws + WS_TAB);
    const float* cre = GIN(25); const float* cim = GIN(26); const float* dsk = GIN(27);
    const int gw = F.bid * NWAVES + F.wave, NGW = F.G * NWAVES, lane = F.lane;
    for (int task = gw; task < S5G * (SBT / 16); task += NGW) {
        const int g = task & (S5G - 1), bc = task >> 7, gp = g * S5P + lane;
        const float ar = TAB[T_AR + gp], ai = TAB[T_AI + gp];
        float bbr[16], bbi[16], cr[16], ci[16];
#pragma unroll
        for (int i = 0; i < 16; ++i) { bbr[i] = TAB[T_BBR + (size_t)gp * 16 + i]; bbi[i] = TAB[T_BBI + (size_t)gp * 16 + i]; cr[i] = cre[((size_t)g * 16 + i) * S5P + lane]; ci[i] = cim[((size_t)g * 16 + i) * S5P + lane]; }
        const float dmine = dsk[g * 16 + (lane >> 2)];
        for (int bi = 0; bi < 16; ++bi) {
            const int sq = bc * 16 + bi; const size_t rbase = (size_t)MP + sq * SSEQ; const size_t so = ((size_t)sq * S5G + g) * S5P + lane;
            float hr = GIN(6)[so], hi = GIN(7)[so];
            u32x4 ur[SSEQ][2];
#pragma unroll
            for (int t = 0; t < SSEQ; ++t) { const bf16_t* up = U + (rbase + t) * E_ + g * 16; ur[t][0] = *(const u32x4*)up; ur[t][1] = *(const u32x4*)(up + 8); }
#pragma unroll
            for (int t = 0; t < SSEQ; ++t) {
                float u[16]; { float a[8], b[8]; unpack8(ur[t][0], a); unpack8(ur[t][1], b);
#pragma unroll
                    for (int i = 0; i < 8; ++i) { u[i] = a[i]; u[8 + i] = b[i]; } }
                float br = 0.f, bi2 = 0.f;
#pragma unroll
                for (int i = 0; i < 16; ++i) { br += bbr[i] * u[i]; bi2 += bbi[i] * u[i]; }
                const float nhr = ar * hr - ai * hi + br, nhi = ar * hi + ai * hr + bi2; hr = nhr; hi = nhi;
                float v[16];
#pragma unroll
                for (int i = 0; i < 16; ++i) v[i] = cr[i] * hr - ci[i] * hi;
                float w8[8];
                { const bool up5 = (lane & 32) != 0;
#pragma unroll
                  for (int i = 0; i < 8; ++i) { const float keep = up5 ? v[8 + i] : v[i], send = up5 ? v[i] : v[8 + i]; w8[i] = keep + __shfl_xor(send, 32); } }
                float w4[4];
                { const bool upb = (lane & 16) != 0;
#pragma unroll
                  for (int i = 0; i < 4; ++i) { const float keep = upb ? w8[4 + i] : w8[i], send = upb ? w8[i] : w8[4 + i]; w4[i] = keep + __shfl_xor(send, 16); } }
                float w2[2];
                { const bool upb = (lane & 8) != 0;
#pragma unroll
                  for (int i = 0; i < 2; ++i) { const float keep = upb ? w4[2 + i] : w4[i], send = upb ? w4[i] : w4[2 + i]; w2[i] = keep + __shfl_xor(send, 8); } }
                float w1;
                { const bool upb = (lane & 4) != 0; const float keep = upb ? w2[1] : w2[0], send = upb ? w2[0] : w2[1]; w1 = keep + __shfl_xor(send, 4); }
                w1 += __shfl_xor(w1, 2); w1 += __shfl_xor(w1, 1);
                float umine = 0.f;
#pragma unroll
                for (int i = 0; i < 16; ++i) umine = ((lane >> 2) == i) ? u[i] : umine;
                const float y = w1 + dmine * umine;
                if ((lane & 3) == 0) GBo[(rbase + t) * E_ + g * 16 + (lane >> 2)] = f2bf(gelu_tanh(y));
                asm volatile("s_waitcnt vmcnt(0)" ::: "memory");
            }
            F.out[O_SRS + so] = hr; F.out[O_SIS + so] = hi;
        }
    }
}

#if XHALF_SHFL
__device__ __forceinline__ void xhalf(float v, float& lo, float& hi) { const int l_ = threadIdx.x & 31; lo = __shfl(v, l_); hi = __shfl(v, l_ + 32); }
#else
__device__ __forceinline__ void xhalf(float v, float& lo, float& hi) { auto rr = __builtin_amdgcn_permlane32_swap(__float_as_uint(v), __float_as_uint(v), false, false); lo = __uint_as_float(rr[0]); hi = __uint_as_float(rr[1]);
 }
#endif
__device__ __forceinline__ void cmuladd(float& xr, float& xi, float ar, float ai, float pr, float pi) { float t = fmaf(-ai, pi, xr); asm("" : "+v"(t)); xr = fmaf(ar, pr, t); xi = fmaf(ar, pi, fmaf(ai, pr, xi)); }
constexpr int S5_HSTR = 272, S5_UOFF = 32 * S5_HSTR, S5_OOFF = S5_UOFF + 1024, S5_HT = S5_OOFF + 4096;
__device__ __forceinline__ void s5_prompt_mfma(Frame& F) {
    const bf16_t* U = (const bf16_t*)(F.ws + WS_B0); bf16_t* GBo = (bf16_t*)(F.ws + WS_GB); const float* TAB = (const float*)(F.ws + WS_TAB);
    const float* cre = GIN(25); const float* cim = GIN(26); const float* dsk = GIN(27);
    const int lane = F.lane, wid = F.wave, c = lane & 31, hh = lane >> 5, col = lane & 15, fq = lane >> 4;
    LAS unsigned char* ht = F.lds + wid * S5_HT;
    for (int task = F.bid * NWAVES + wid; task < PB * S5G; task += F.G * NWAVES) {
        const int b = task >> 7, g = task & 127;
        bf16x8 bfr[2], bfi[2]; float p_r[2][4], p_i[2][4];
#pragma unroll
        for (int st = 0; st < 2; ++st) { const int gp = g * S5P + 32 * st + c;
            const float* pr = TAB + T_BBR + (size_t)gp * 16 + 8 * hh; const float* pi = TAB + T_BBI + (size_t)gp * 16 + 8 * hh;
            bfr[st] = __builtin_bit_cast(bf16x8, pack8(*(const f32x4*)pr, *(const f32x4*)(pr + 4))); bfi[st] = __builtin_bit_cast(bf16x8, pack8(*(const f32x4*)pi, *(const f32x4*)(pi + 4)));
            const float ar = TAB[T_AR + gp], ai = TAB[T_AI + gp]; p_r[st][0] = ar; p_i[st][0] = ai;
#pragma unroll
            for (int n = 1; n < 4; ++n) { p_r[st][n] = p_r[st][n - 1] * ar - p_i[st][n - 1] * ai; p_i[st][n] = p_r[st][n - 1] * ai + p_i[st][n - 1] * ar; } }
        bf16x8 cf[4];
#pragma unroll
        for (int s4 = 0; s4 < 4; ++s4) { const size_t o = ((size_t)g * 16 + col) * S5P + 16 * s4 + 4 * fq; const f32x4 cr4 = *(const f32x4*)(cre + o), ci4 = *(const f32x4*)(cim + o);
            u32x4 w; w.x = pk2(cr4[0], -ci4[0]); w.y = pk2(cr4[1], -ci4[1]); w.z = pk2(cr4[2], -ci4[2]); w.w = pk2(cr4[3], -ci4[3]); cf[s4] = __builtin_bit_cast(bf16x8, w); }
        const f32x4 d4 = *(const f32x4*)(dsk + 16 * g + 4 * fq);
        float car_r[2] = {0.f, 0.f}, car_i[2] = {0.f, 0.f};
        const bf16_t* up = U + ((size_t)b * PSEQ + c) * E_ + 16 * g + 8 * hh;
        bf16x8 ub[4];
#pragma unroll
        for (int q = 0; q < 4; ++q) ub[q] = *(const GAS bf16x8*)(up + (size_t)q * 32 * E_);
        for (int tg = 0; tg < PSEQ / 128; ++tg) {
          bf16x8 nb[4];
#pragma unroll
          for (int q = 0; q < 4; ++q) nb[q] = *(const GAS bf16x8*)(up + (size_t)(4 * (tg + 1 < PSEQ / 128 ? tg + 1 : tg) + q) * 32 * E_);
#pragma unroll
          for (int q = 0; q < 4; ++q) {
            const int ti = 4 * tg + q; const bf16x8 ua = ub[q];
            *(LAS bf16x8*)(ht + S5_UOFF + c * 32 + hh * 16) = ua;
#pragma unroll
            for (int st = 0; st < 2; ++st) {
                f32x16 xr = __builtin_amdgcn_mfma_f32_32x32x16_bf16(ua, bfr[st], (f32x16){}, 0, 0, 0);
                f32x16 xi = __builtin_amdgcn_mfma_f32_32x32x16_bf16(ua, bfi[st], (f32x16){}, 0, 0, 0);
                const float a1r = p_r[st][0], a1i = p_i[st][0], a4r = p_r[st][3], a4i = p_i[st][3];
#pragma unroll
                for (int k = 0; k < 4; ++k)
#pragma unroll
                    for (int jj = 1; jj < 4; ++jj) { float tr = xr[4 * k + jj], tq = xi[4 * k + jj]; cmuladd(tr, tq, a1r, a1i, xr[4 * k + jj - 1], xi[4 * k + jj - 1]); xr[4 * k + jj] = tr; xi[4 * k + jj] = tq; }
                float er = car_r[st], ei = car_i[st], cin_r[4], cin_i[4];
#pragma unroll
                for (int k = 0; k < 4; ++k) {
                    float lor, hir, loi, hii; xhalf(xr[4 * k + 3], lor, hir); xhalf(xi[4 * k + 3], loi, hii);
                    const float c0r = er, c0i = ei;
                    float nr = lor, ni = loi; cmuladd(nr, ni, a4r, a4i, er, ei); er = nr; ei = ni;
                    const float c1r = er, c1i = ei;
                    nr = hir; ni = hii; cmuladd(nr, ni, a4r, a4i, er, ei); er = nr; ei = ni;
                    cin_r[k] = hh ? c1r : c0r; cin_i[k] = hh ? c1i : c0i;
                }
                car_r[st] = er; car_i[st] = ei;
#pragma unroll
                for (int k = 0; k < 4; ++k)
#pragma unroll
                    for (int jj = 0; jj < 4; ++jj) { float tr = xr[4 * k + jj], tq = xi[4 * k + jj]; cmuladd(tr, tq, p_r[st][jj], p_i[st][jj], cin_r[k], cin_i[k]);
                        *(LAS unsigned*)(ht + (8 * k + 4 * hh + jj) * S5_HSTR + 128 * st + 4 * c) = pk2(tr, tq); }
            }
            asm volatile("" ::: "memory");
#pragma unroll
            for (int tt = 0; tt < 2; ++tt) {
                f32x4 y = {0.f, 0.f, 0.f, 0.f};
#pragma unroll
                for (int s4 = 0; s4 < 4; ++s4) { const bf16x8 hb = *(const LAS bf16x8*)(ht + (16 * tt + col) * S5_HSTR + (32 * s4 + 8 * fq) * 2); y = __builtin_amdgcn_mfma_f32_16x16x32_bf16(cf[s4], hb, y, 0, 0, 0); }
                const size_t row = (size_t)b * PSEQ + 32 * ti + 16 * tt + col; const u32x2 uw = *(const LAS u32x2*)(ht + S5_UOFF + (16 * tt + col) * 32 + fq * 8);
                u32x2 w; w.x = pk2(gelu_tanh(y[0] + d4[0] * bflo(uw.x)), gelu_tanh(y[1] + d4[1] * bfhi(uw.x))); w.y = pk2(gelu_tanh(y[2] + d4[2] * bflo(uw.y)), gelu_tanh(y[3] + d4[3] * bfhi(uw.y)));
                *(LAS u32x2*)(ht + S5_OOFF + q * 1024 + (16 * tt + col) * 32 + fq * 8) = w;
            }
            asm volatile("" ::: "memory");
          }
#pragma unroll
          for (int q = 0; q < 4; ++q)
#pragma unroll
            for (int tt = 0; tt < 2; ++tt) *(GAS u32x2*)(GBo + ((size_t)b * PSEQ + 32 * (4 * tg + q) + 16 * tt + col) * E_ + 16 * g + 4 * fq) = *(const LAS u32x2*)(ht + S5_OOFF + q * 1024 + (16 * tt + col) * 32 + fq * 8);
          asm volatile("s_waitcnt vmcnt(0)" ::: "memory");
#pragma unroll
          for (int q = 0; q < 4; ++q) ub[q] = nb[q];
        }
        const size_t so = ((size_t)b * S5G + g) * S5P + 32 * hh + c;
        F.out[O_SRP + so] = hh ? car_r[1] : car_r[0]; F.out[O_SIP + so] = hh ? car_i[1] : car_i[0];
    }
}

constexpr int AK_STR = 272, AV_STR = 520, AV_OFF = 256 * AK_STR;
static_assert(AV_OFF + 128 * AV_STR <= RING_BYTES + 8192, "attention LDS");
__device__ __forceinline__ void attn_prompt_phase(Frame& F, int layer) {
    const bf16_t* QB = (const bf16_t*)(F.ws + WS_QB); const bf16_t* KBp = (const bf16_t*)(F.ws + WS_KB); const bf16_t* VTp = (const bf16_t*)(F.ws + WS_VT); bf16_t* A2 = (bf16_t*)(F.ws + WS_A2);
    const int tid = F.tid, lane = F.lane, wid = F.wave, c = lane & 31, hh = lane >> 5;
    LAS unsigned char* lds = F.lds;
    for (int un = F.bid; un < PB * NH * 8; un += F.G) {
        const int bh = un >> 3, qb = un & 7, b = bh >> 2, h = bh & 3;
        const bf16_t* Kg = KBp + (size_t)((layer * PB + b) * NH + h) * MEML * HD; const bf16_t* Vg = VTp + (size_t)((layer * PB + b) * NH + h) * MEML * HD;
        __syncthreads();
        { u32x4 kr[8], vr[8];
#pragma unroll
          for (int i = 0; i < 8; ++i) { const int chn = tid + NTHR * i; kr[i] = *(const u32x4*)(Kg + (chn >> 4) * HD + (chn & 15) * 8); vr[i] = *(const u32x4*)(Vg + (chn >> 5) * MEML + (chn & 31) * 8); }
#pragma unroll
          for (int i = 0; i < 8; ++i) { const int chn = tid + NTHR * i, row = chn >> 4, c16 = chn & 15; *(LAS u32x4*)(lds + row * AK_STR + c16 * 16) = kr[i]; }
#pragma unroll
          for (int i = 0; i < 8; ++i) { const int chn = tid + NTHR * i, row = chn >> 5, c16 = chn & 31; const u32x4 v = vr[i];
            LAS u32x2* p = (LAS u32x2*)(lds + AV_OFF + row * AV_STR + c16 * 16); u32x2 lo, hi; lo.x = v.x; lo.y = v.y; hi.x = v.z; hi.y = v.w; p[0] = lo; p[1] = hi; } }
        __syncthreads();
        const size_t qrow = (size_t)b * PSEQ + qb * 256 + wid * 32 + c;
        f32x16 S[8];
#pragma unroll
        for (int kt = 0; kt < 8; ++kt) S[kt] = (f32x16){};
#pragma unroll
        for (int s = 0; s < 8; ++s) {
            const bf16x8 qf = *(const bf16x8*)(QB + qrow * XA + h * HD + 16 * s + 8 * hh);
#pragma unroll
            for (int kt = 0; kt < 8; ++kt) { const bf16x8 kf = *(const LAS bf16x8*)(lds + (32 * kt + c) * AK_STR + (16 * s + 8 * hh) * 2); S[kt] = __builtin_amdgcn_mfma_f32_32x32x16_bf16(kf, qf, S[kt], 0, 0, 0); }
        }
        float mx = -3.0e38f;
#pragma unroll
        for (int kt = 0; kt < 8; ++kt)
#pragma unroll
            for (int r = 0; r < 16; ++r) mx = fmaxf(mx, S[kt][r]);
        mx = fmaxf(mx, __shfl_xor(mx, 32));
        float sum = 0.f; bf16x8 pf[8][2];
#pragma unroll
        for (int kt = 0; kt < 8; ++kt) {
            float p[16];
#pragma unroll
            for (int r = 0; r < 16; ++r) { p[r] = __expf(S[kt][r] - mx); sum += p[r]; }
#pragma unroll
            for (int s2 = 0; s2 < 2; ++s2) { u32x4 w; w.x = pk2(p[8 * s2], p[8 * s2 + 1]); w.y = pk2(p[8 * s2 + 2], p[8 * s2 + 3]); w.z = pk2(p[8 * s2 + 4], p[8 * s2 + 5]); w.w = pk2(p[8 * s2 + 6], p[8 * s2 + 7]);
                pf[kt][s2] = __builtin_bit_cast(bf16x8, w); }
        }
        sum += __shfl_xor(sum, 32);
        const float inv = 1.f / sum;
        bf16_t* orow = A2 + qrow * KOUT + E_ + h * HD;
#pragma unroll
        for (int dt = 0; dt < 4; ++dt) {
            f32x16 o = {};
#pragma unroll
            for (int kt = 0; kt < 8; ++kt)
#pragma unroll
                for (int s2 = 0; s2 < 2; ++s2) {
                    const LAS unsigned char* vb = lds + AV_OFF + (32 * dt + c) * AV_STR + (32 * kt + 16 * s2 + 4 * hh) * 2;
                    const u32x2 lo = *(const LAS u32x2*)vb, hi = *(const LAS u32x2*)(vb + 16);
                    u32x4 w; w.x = lo.x; w.y = lo.y; w.z = hi.x; w.w = hi.y;
                    o = __builtin_amdgcn_mfma_f32_32x32x16_bf16(__builtin_bit_cast(bf16x8, w), pf[kt][s2], o, 0, 0, 0);
                }
#pragma unroll
            for (int g4 = 0; g4 < 4; ++g4) { u32x2 w; w.x = pk2(o[4 * g4] * inv, o[4 * g4 + 1] * inv); w.y = pk2(o[4 * g4 + 2] * inv, o[4 * g4 + 3] * inv);
                *(u32x2*)(orow + 32 * dt + 8 * g4 + 4 * hh) = w; }
        }
    }
}

__device__ __forceinline__ void attn_sample_phase(Frame& F, int layer) {
    const bf16_t* QB = (const bf16_t*)(F.ws + WS_QB); bf16_t* A2 = (bf16_t*)(F.ws + WS_A2);
    const float* CK = GIN(3) + (size_t)layer * SBT * MEML * XA; const float* CV = GIN(4) + (size_t)layer * SBT * MEML * XA;
    LAS float* sl = (LAS float*)F.lds;
    LAS float* pt = (LAS float*)(F.lds + 4096);
    LAS float* ol = (LAS float*)(F.lds + 8192);
    const int tid = F.tid, lane = F.lane, wid = F.wave, par = lane >> 5, d4 = lane & 31;
    const size_t lane_off = ((size_t)(32 * wid + par) * NH) * HD + 4 * d4;
    f32x4 kr[16];
    int un = F.bid;
    if (un < SBT * NH) { const size_t o = (size_t)(un >> 2) * MEML * XA + (size_t)(un & 3) * HD + lane_off;
#pragma unroll
        for (int j = 0; j < 16; ++j) kr[j] = *(const f32x4*)(CK + o + (size_t)j * 2 * XA); }
    for (; un < SBT * NH; un += F.G) {
        const int b = un >> 2, h = un & 3; const int nun = un + F.G; const bool has_next = nun < SBT * NH;
        const size_t no = (size_t)((has_next ? nun : un) >> 2) * MEML * XA + (size_t)((has_next ? nun : un) & 3) * HD + lane_off;
        f32x4 vr[16];
        { const size_t co = (size_t)b * MEML * XA + (size_t)h * HD + lane_off;
#pragma unroll
          for (int j = 0; j < 16; ++j) vr[j] = *(const f32x4*)(CV + co + (size_t)j * 2 * XA); }
        f32x4 q4[4];
#pragma unroll
        for (int qi = 0; qi < 4; ++qi) { const u32x2 w = *(const u32x2*)(QB + (size_t)(MP + b * 4 + qi) * XA + h * HD + 4 * d4); q4[qi] = (f32x4){bflo(w.x), bfhi(w.x), bflo(w.y), bfhi(w.y)}; }
        asm volatile("s_waitcnt vmcnt(0)" ::: "memory");
        __syncthreads();
        const bool b4 = (lane & 16) != 0, b3 = (lane & 8) != 0;
#pragma unroll
        for (int j = 0; j < 16; ++j) {
            float v[4];
#pragma unroll
            for (int qi = 0; qi < 4; ++qi) v[qi] = (kr[j][0] * q4[qi][0] + kr[j][1] * q4[qi][1]) + (kr[j][2] * q4[qi][2] + kr[j][3] * q4[qi][3]);
            const float w0 = (b4 ? v[2] : v[0]) + __shfl_xor(b4 ? v[0] : v[2], 16), w1 = (b4 ? v[3] : v[1]) + __shfl_xor(b4 ? v[1] : v[3], 16);
            float z = (b3 ? w1 : w0) + __shfl_xor(b3 ? w0 : w1, 8);
            z += __shfl_xor(z, 4); z += __shfl_xor(z, 2); z += __shfl_xor(z, 1);
            if ((lane & 7) == 0) sl[(2 * (int)b4 + (int)b3) * 256 + 32 * wid + 2 * j + par] = z;
        }
#pragma unroll
        for (int j = 0; j < 16; ++j) kr[j] = *(const f32x4*)(CK + no + (size_t)j * 2 * XA);
        __syncthreads();
        if (wid < 4) { float v[4], mx = -3.0e38f;
#pragma unroll
            for (int j = 0; j < 4; ++j) { v[j] = sl[wid * 256 + lane + 64 * j]; mx = fmaxf(mx, v[j]); }
            mx = wave_max(mx); float sm = 0.f;
#pragma unroll
            for (int j = 0; j < 4; ++j) { v[j] = __expf(v[j] - mx); sm += v[j]; }
            sm = wave_sum(sm); const float inv = 1.f / sm;
#pragma unroll
            for (int j = 0; j < 4; ++j) pt[(lane + 64 * j) * 4 + wid] = v[j] * inv; }
        __syncthreads();
        f32x4 o[4];
#pragma unroll
        for (int qi = 0; qi < 4; ++qi) o[qi] = (f32x4){0.f, 0.f, 0.f, 0.f};
#pragma unroll
        for (int j = 0; j < 16; ++j) { const f32x4 p = *(const LAS f32x4*)(pt + (32 * wid + 2 * j + par) * 4);
#pragma unroll
            for (int qi = 0; qi < 4; ++qi) o[qi] += vr[j] * p[qi]; }
#pragma unroll
        for (int qi = 0; qi < 4; ++qi) {
#pragma unroll
            for (int e = 0; e < 4; ++e) o[qi][e] += __shfl_xor(o[qi][e], 32);
            if (par == 0) *(LAS f32x4*)(ol + (wid * 4 + qi) * 128 + 4 * d4) = o[qi]; }
        __syncthreads();
        { const int qi = tid >> 7, d = tid & 127; float acc = 0.f;
#pragma unroll
          for (int w = 0; w < 8; ++w) acc += ol[(w * 4 + qi) * 128 + d];
          A2[(size_t)(MP + b * 4 + qi) * KOUT + E_ + h * HD + d] = f2bf(acc); }
    }
}

constexpr int NK_OUT = 10, NK_GLU = 8;
__device__ __forceinline__ void fixup_out_rows(Frame& F, const float* basef  ) {
    if (F.wave < 2) for (int r = F.bid * 2 + F.wave; r < MS; r += F.G * 2) {
        const int lane = F.lane; const float* slab = (const float*)(F.ws + WS_SLAB);
        bf16_t* XB = (bf16_t*)(F.ws + WS_XB) + (size_t)(MP + r) * DM; float ss = 0.f;
#pragma unroll
        for (int j = 0; j < 4; ++j) { f32x4 v;
            if (basef) v = *((const f32x4*)(basef + (size_t)r * DM) + lane + 64 * j);
            else { const u32x2 w = *((const u32x2*)XB + lane + 64 * j); v = (f32x4){bflo(w.x), bfhi(w.x), bflo(w.y), bfhi(w.y)}; }
#pragma unroll
            for (int ks = 0; ks < NK_OUT; ++ks) v += *((const f32x4*)(slab + ((size_t)ks * MS + r) * DM) + lane + 64 * j);
            u32x2 w; w.x = pk2(v[0], v[1]); w.y = pk2(v[2], v[3]); *((u32x2*)XB + lane + 64 * j) = w;
            ss += (v[0] * v[0] + v[1] * v[1]) + (v[2] * v[2] + v[3] * v[3]); }
        asm volatile("s_waitcnt vmcnt(0)" ::: "memory");
        ss = wave_sum(ss);
        if (lane < 16) ((float*)(F.ws + WS_SSX))[(size_t)(MP + r) * 16 + lane] = lane == 0 ? ss : 0.f;
    }
}
__device__ __forceinline__ void fixup_glu_rows(Frame& F) {
    if (F.wave < 2) for (int r = F.bid * 2 + F.wave; r < MS; r += F.G * 2) {
        const int lane = F.lane; const float* slab = (const float*)(F.ws + WS_SLAB); const float* bias = GIN(29);
        const bf16_t* GBp = (const bf16_t*)(F.ws + WS_GB) + (size_t)(MP + r) * E_; const bf16_t* SZ = (const bf16_t*)(F.ws + WS_B1) + (size_t)(MP + r) * E_; bf16_t* A2 = (bf16_t*)(F.ws + WS_A2) + (size_t)(MP + r) * KOUT;
#pragma unroll
        for (int j = 0; j < 4; ++j) { const int c0 = 8 * (lane + 64 * j); f32x4 t0 = *(const f32x4*)(bias + c0), t1 = *(const f32x4*)(bias + c0 + 4);
#pragma unroll
            for (int ks = 0; ks < NK_GLU; ++ks) { const float* sp = slab + ((size_t)ks * MS + r) * E_ + c0; t0 += *(const f32x4*)sp; t1 += *(const f32x4*)(sp + 4); }
            float gv[8], sz[8]; unpack8(*(const u32x4*)(GBp + c0), gv); unpack8(*(const u32x4*)(SZ + c0), sz); f32x4 o0, o1;
#pragma unroll
            for (int e = 0; e < 4; ++e) { o0[e] = gv[e] * sigmoidf_(t0[e]) * sz[e]; o1[e] = gv[4 + e] * sigmoidf_(t1[e]) * sz[4 + e]; }
            *(u32x4*)(A2 + c0) = pack8(o0, o1); }
    }
}
__device__ __forceinline__ void counter_signal(unsigned* cnt) {
    asm volatile("s_waitcnt vmcnt(0)" ::: "memory"); __syncthreads();
    if (threadIdx.x == 0) { __builtin_amdgcn_fence(__ATOMIC_RELEASE, "agent"); asm volatile("s_waitcnt vmcnt(0)" ::: "memory"); __hip_atomic_fetch_add(cnt, 1u, __ATOMIC_RELAXED, __HIP_MEMORY_SCOPE_AGENT); }
}
__device__ __forceinline__ void counter_wait(unsigned* cnt, unsigned want) {
    if (threadIdx.x == 0) { unsigned sp = 0; while (__hip_atomic_load(cnt, __ATOMIC_RELAXED, __HIP_MEMORY_SCOPE_AGENT) < want) { __builtin_amdgcn_s_sleep(2); if (++sp > (1u << 22)) break; }
        __builtin_amdgcn_fence(__ATOMIC_ACQUIRE, "agent"); asm volatile("s_waitcnt vmcnt(0)" ::: "memory"); }
    __syncthreads();
}

__device__ __forceinline__ void final_row(Frame& F, int row) {
    const bf16_t* XBp = (const bf16_t*)(F.ws + WS_XB); const float* SSX = (const float*)(F.ws + WS_SSX); const float* fg = GIN(9); const int lane = F.lane;
    float s = lane < 16 ? SSX[(size_t)row * 16 + lane] : 0.f; s = wave_sum(s);
    const float r = __builtin_amdgcn_rsqf(s * (1.f / DM) + EPS);
    float* o = row < MP ? F.out + O_YP + (size_t)row * DM : F.out + O_YS + (size_t)(row - MP) * DM;
#pragma unroll
    for (int j = 0; j < 4; ++j) { const u32x2 w = *((const u32x2*)(XBp + (size_t)row * DM) + lane + 64 * j); const f32x4 v = (f32x4){bflo(w.x), bfhi(w.x), bflo(w.y), bfhi(w.y)}; const f32x4 gq = *((const f32x4*)fg + lane + 64 * j); *((f32x4*)o + lane + 64 * j) = v * r * gq; }
}
__device__ __forceinline__ void final_phase(Frame& F) {
    const int gw = F.bid * NWAVES + F.wave, NGW = F.G * NWAVES;
    if (F.wave < 2) { asm volatile("s_waitcnt vmcnt(0)" ::: "memory"); for (int r = F.bid * 2 + F.wave; r < MS; r += F.G * 2) final_row(F, MP + r); }
#pragma unroll 2
    for (int row = gw; row < MP; row += NGW) final_row(F, row);
}

#define XB_TMO      128
#define XB_XCNT(j)  (256  + 64 * (j))
#define XB_XSUB(j)  (1280 + 64 * (j))
#define XB_XGEN(j)  (2304 + 64 * (j))
#define XB_TOP      3328
#define XB_TOPGEN   3392
#define XCD_BAR_WORDS 3456
#define XB_SPIN_CAP (1u << 20)
__device__ __forceinline__ unsigned xb_ld(unsigned* p)              { return __hip_atomic_load(p, __ATOMIC_RELAXED, __HIP_MEMORY_SCOPE_AGENT); }
__device__ __forceinline__ unsigned xb_add(unsigned* p, unsigned v) { return __hip_atomic_fetch_add(p, v, __ATOMIC_RELAXED, __HIP_MEMORY_SCOPE_AGENT); }
__device__ __forceinline__ unsigned xb_xcc_id() { return (unsigned)__builtin_amdgcn_s_getreg((3 << 11) | 20) & 0xFu; }
#define XB_SPIN(cond, bar) do { unsigned _sp = 0; while (cond) { __builtin_amdgcn_s_sleep(1); \
    if ((++_sp & 255u) == 0u) { if (xb_ld(&(bar)[XB_TMO])) break; if (_sp > XB_SPIN_CAP) { atomicAdd(&(bar)[XB_TMO], 1u); break; } } } } while (0)
struct XcdBarrier { unsigned* bar; unsigned x; volatile LAS unsigned* st; };
__device__ __forceinline__ XcdBarrier xcd_barrier_post(unsigned* bar, volatile LAS unsigned* st) {
    XcdBarrier b; b.bar = bar; b.x = xb_xcc_id(); b.st = st;
    if (threadIdx.x == 0) (void)xb_add(&bar[XB_XCNT(b.x)], 1u);
    return b;
}
__device__ __forceinline__ void xcd_barrier_complete(unsigned* bar, unsigned x, unsigned& nloc, unsigned& nx) {
    const unsigned G = gridDim.x * gridDim.y * gridDim.z;
    unsigned sum, cnt, mine, sp = 0u;
    for (;;) {
        sum = 0u; cnt = 0u; mine = 0u;
#pragma unroll
        for (unsigned j = 0; j < 16; ++j) { const unsigned c = xb_ld(&bar[XB_XCNT(j)]); sum += c; cnt += (c > 0u) ? 1u : 0u; mine = (j == x) ? c : mine; }
        if (sum == G) break;
        __builtin_amdgcn_s_sleep(1);
        if ((++sp & 255u) == 0u) { if (xb_ld(&bar[XB_TMO])) break; if (sp > XB_SPIN_CAP) { atomicAdd(&bar[XB_TMO], 1u); break; } }
    }
    nloc = mine > 0u ? mine : 1u; nx = cnt > 0u ? cnt : 1u;
}
__device__ __forceinline__ void xcd_barrier(const XcdBarrier& b) {
    asm volatile("s_waitcnt vmcnt(0)" ::: "memory");
    __syncthreads();
    if (threadIdx.x == 0) {
        unsigned* bar = b.bar;
        __builtin_amdgcn_s_waitcnt(0);
        unsigned nloc = b.st[0], nx = b.st[1];
        if (nloc == 0u) { xcd_barrier_complete(bar, b.x, nloc, nx); b.st[0] = nloc; b.st[1] = nx; }
        const unsigned old = xb_add(&bar[XB_XSUB(b.x)], 1u);
        const unsigned gen = old / nloc;
        if (old + 1u == (gen + 1u) * nloc) {
            __builtin_amdgcn_fence(__ATOMIC_RELEASE, "agent");
            asm volatile("s_waitcnt vmcnt(0)" ::: "memory");
            const unsigned og = xb_add(&bar[XB_TOP], 1u);
            const unsigned tg = og / nx;
            if (og + 1u == (tg + 1u) * nx) xb_add(&bar[XB_TOPGEN], 1u);
            else XB_SPIN(xb_ld(&bar[XB_TOPGEN]) == tg, bar);
            __builtin_amdgcn_fence(__ATOMIC_ACQUIRE, "agent");
            xb_add(&bar[XB_XGEN(b.x)], 1u);
            asm volatile("s_waitcnt vmcnt(0)" ::: "memory");
        } else {
            XB_SPIN(xb_ld(&bar[XB_XGEN(b.x)]) == gen, bar);
            __builtin_amdgcn_fence(__ATOMIC_ACQUIRE, "agent");
            asm volatile("s_waitcnt vmcnt(0)" ::: "memory");
        }
    }
    __syncthreads();
}

constexpr int NPHASE = 15;
__global__ void __launch_bounds__(NTHR, 2) fwd_kernel(Args args) {
    extern __shared__ __attribute__((aligned(16))) unsigned char lds_raw[];
    Frame F; F.lds = (LAS unsigned char*)lds_raw; F.G = gridDim.x; F.bid = blockIdx.x;
    F.in = args.in; F.out = (float*)(GAS float*)args.out; F.ws = (unsigned char*)(GAS unsigned char*)args.ws;
    unsigned char* ws = F.ws;
#define REFRESH() do { int t_ = threadIdx.x; asm volatile("" : "+v"(t_)); F.tid = t_; F.lane = t_ & 63; F.wave = __builtin_amdgcn_readfirstlane(t_ >> 6); \
        GAS unsigned char* wsg_ = (GAS unsigned char*)args.ws; asm volatile("" : "+s"(wsg_)); ws = (unsigned char*)wsg_; F.ws = ws; } while (0)
    const int lo = args.ph_lo, hi = args.ph_hi;
#if MK_ONE_LAUNCH
    cg::grid_group grid = cg::this_grid();
    if (lo < 0) grid.sync();
    { volatile LAS unsigned* st0 = (volatile LAS unsigned*)(F.lds + LDS_BYTES - 64); if (threadIdx.x < 16) st0[threadIdx.x] = 0u; }
    __syncthreads();
    const XcdBarrier xbar = xcd_barrier_post((unsigned*)(args.ws + WS_CTL), (volatile LAS unsigned*)(F.lds + LDS_BYTES - 64));
#define SEAM(k) do { if (lo <= (k) && (k) + 1 < hi) xcd_barrier(xbar); } while (0)
#else
#define SEAM(k) do { } while (0)
#endif
#ifndef PHASE_MASK
#define PHASE_MASK 0x7fff
#endif
#define REP(k) for (int rep_ = 0; rep_ <= (((PROBE_REP_MASK) >> (k)) & 1); ++rep_)
#define WSSEL(bit) do { if ((FLAT_FN_MASK >> (bit)) & 1) { unsigned char* w_ = args.ws; asm volatile("" : "+s"(w_)); F.ws = w_; } else { GAS unsigned char* g_ = (GAS unsigned char*)args.ws; asm volatile("" : "+s"(g_)); F.ws = (unsigned char*)g_; } } while (0)
#define IN(k) ((((PHASE_MASK) >> (k)) & 1) && lo <= (k) && (k) < hi)
#define XB ((bf16_t*)(ws + WS_XB))
#define X ((float*)(ws + WS_X))
#define SSX ((float*)(ws + WS_SSX))
#define SSV ((float*)(ws + WS_SSV))
#define B0 ((bf16_t*)(ws + WS_B0))
#define B1 ((bf16_t*)(ws + WS_B1))
#define QBp ((bf16_t*)(ws + WS_QB))
#define A2 ((bf16_t*)(ws + WS_A2))
#define GBp ((bf16_t*)(ws + WS_GB))
    const int G = F.G, bid = F.bid;

    if (IN(0)) REP(0) { REFRESH(); WSSEL(0); p0_prologue(F); __syncthreads(); } SEAM(0);
#define CNT(k) ((unsigned*)(ws + WS_CTL) + 4096 + 64 * (k))
#define WOUT(l) ((const bf16_t*)(ws + WS_WOUT) + (size_t)(l) * DM * KOUT)
#define INPROJ(EpiT, E, W, N, cnt) do { \
        pg8::Gemm g{XB, (W), M, (N), DM, DM}; pg8::StaticOrder S; S.init(MP, (N), G, bid); pg8::gemm_phase<EpiT, pg8::StaticOrder, true, true>(F.lds, g, S, E); \
        if (cnt) counter_wait(cnt, (unsigned)G); \
        const int rem = ((MP / 256) * ((N) / 256)) % G; pg8::StaticOrder S2; S2.init(MS, (N), G, (bid + G - rem) % G, MP / 256); pg8::gemm_phase<EpiT, pg8::StaticOrder, true, true>(F.lds, g, S2, E); } while (0)
#define OUTPROJ(l, bp) do { \
        { pg8::Gemm g{A2, WOUT(l), M, DM, KOUT, KOUT}; pg8::StaticOrder S; S.init(MP, DM, G, bid); EpiOut E{(bp), XB, SSX}; pg8::gemm_phase<EpiOut, pg8::StaticOrder, true, true>(F.lds, g, S, E); } \
        { pg8::Gemm g{A2, WOUT(l), M, DM, 256, KOUT}; typedef pg8::SliceOrder<MS / 256, DM / 256, NK_OUT> SO; SO S; S.init(G, bid, MP / 256); EpiSlab E{(float*)(ws + WS_SLAB), DM, MP, (size_t)MS * DM}; pg8::gemm_phase<EpiSlab, SO, true, true>(F.lds, g, S, E); } } while (0)
#define KVPROJ(l, c0) do { pg8::Gemm g{(const bf16_t*)(ws + WS_MEMB), (const bf16_t*)(ws + WS_WKV) + (size_t)(l) * DM * DM, PB * MEML, DM, DM, DM}; pg8::StaticOrder S; S.init(g.M, g.N, G, (bid + G - (c0)) % G); \
        EpiKV E{(const float*)(ws + WS_RSTDM), F.out + O_MK, F.out + O_MV, (bf16_t*)(ws + WS_KB), (bf16_t*)(ws + WS_VT), (l)}; pg8::gemm_phase<EpiKV, pg8::StaticOrder, true, true>(F.lds, g, S, E); } while (0)
    if (IN(1)) REP(1) { REFRESH();
        { EpiInA E{SSX, B0, B1, QBp, SSV}; INPROJ(EpiInA, E, (const bf16_t*)(ws + WS_WINA), NIN_A, (unsigned*)nullptr); }
        KVPROJ(0, 180);
    } SEAM(1);
    if (IN(2)) REP(2) { REFRESH(); WSSEL(1);
        if (bid & 1) { attn_sample_phase(F, 0); attn_prompt_phase(F, 0); sgu_phase_mfma(F, 0); sgu_sample_phase(F, 0); }
        else { sgu_phase_mfma(F, 0); sgu_sample_phase(F, 0); attn_prompt_phase(F, 0); attn_sample_phase(F, 0); } } SEAM(2);
    if (IN(3)) REP(3) { REFRESH(); OUTPROJ(0, GIN(0)); } SEAM(3);
    if (IN(4)) REP(4) { REFRESH(); fixup_out_rows(F, GIN(1)); counter_signal(CNT(0));
#if PROBE_EPI2
        EpiTwice<EpiInB> E{EpiInB{SSX, B0, B1, QBp, F.out + O_CP, F.out + O_CS}}; INPROJ(EpiTwice<EpiInB>, E, (const bf16_t*)(ws + WS_WINB), NIN_B, CNT(0)); KVPROJ(1, 196); } SEAM(4);
#else
        EpiInB E{SSX, B0, B1, QBp, F.out + O_CP, F.out + O_CS}; INPROJ(EpiInB, E, (const bf16_t*)(ws + WS_WINB), NIN_B, CNT(0)); KVPROJ(1, 196); } SEAM(4);
#endif
    if (IN(5)) REP(5) { REFRESH(); WSSEL(3);
        if (bid & 1) { attn_sample_phase(F, 1); attn_prompt_phase(F, 1); conv_phase(F); }
        else { conv_phase(F); attn_prompt_phase(F, 1); attn_sample_phase(F, 1); } } SEAM(5);
    if (IN(6)) REP(6) { REFRESH(); OUTPROJ(1, (const float*)nullptr); } SEAM(6);
    if (IN(7)) REP(7) { REFRESH(); fixup_out_rows(F, (const float*)nullptr); counter_signal(CNT(1));
        EpiInC E{SSX, B0, B1, QBp}; INPROJ(EpiInC, E, (const bf16_t*)(ws + WS_WINC), NIN_C, CNT(1)); KVPROJ(2, 164); KVPROJ(3, 196); } SEAM(7);
    if (IN(8)) REP(8) { REFRESH();
        const int half = G / 2;
        if (bid < half) { F.G = half; WSSEL(4); s5_prompt_mfma(F); if (PROBE_SUB_MASK & 8) s5_prompt_mfma(F); }
        else { F.bid = bid - half; F.G = G - half; for (int r2 = 0; r2 <= ((PROBE_SUB_MASK >> 4) & 1); ++r2) { WSSEL(6); attn_prompt_phase(F, 2); WSSEL(7); attn_sample_phase(F, 2); WSSEL(5); s5_sample_phase(F); } }
        F.bid = bid; F.G = G; } SEAM(8);
    if (IN(9)) REP(9) { REFRESH();
        { pg8::Gemm g{GBp, (const bf16_t*)(ws + WS_WGLU), M, E_, E_, E_}; pg8::StaticOrder S; S.init(MP, E_, G, bid); EpiGlu E{GBp, B1, GIN(29), A2}; pg8::gemm_phase<EpiGlu, pg8::StaticOrder, true, true>(F.lds, g, S, E); }
        { pg8::Gemm g{GBp, (const bf16_t*)(ws + WS_WGLU), M, E_, 256, E_}; typedef pg8::SliceOrder<MS / 256, E_ / 256, NK_GLU> SG; SG S; S.init(G, bid, MP / 256); EpiSlab E{(float*)(ws + WS_SLAB), E_, MP, (size_t)MS * E_}; pg8::gemm_phase<EpiSlab, SG, true, true>(F.lds, g, S, E); } } SEAM(9);
    if (IN(10)) REP(10) { REFRESH(); fixup_glu_rows(F); counter_signal(CNT(2));
        { pg8::Gemm g{A2, WOUT(2), M, DM, KOUT, KOUT}; pg8::StaticOrder S; S.init(MP, DM, G, bid); EpiOut E{(const float*)nullptr, XB, SSX}; pg8::gemm_phase<EpiOut, pg8::StaticOrder, true, true>(F.lds, g, S, E); }
        counter_wait(CNT(2), (unsigned)G);
        { pg8::Gemm g{A2, WOUT(2), M, DM, 256, KOUT}; typedef pg8::SliceOrder<MS / 256, DM / 256, NK_OUT> SO; SO S; S.init(G, bid, MP / 256); EpiSlab E{(float*)(ws + WS_SLAB), DM, MP, (size_t)MS * DM}; pg8::gemm_phase<EpiSlab, SO, true, true>(F.lds, g, S, E); } } SEAM(10);
    if (IN(11)) REP(11) { REFRESH(); fixup_out_rows(F, (const float*)nullptr); counter_signal(CNT(3));
        EpiInA E{SSX, B0, B1, QBp, SSV}; INPROJ(EpiInA, E, (const bf16_t*)(ws + WS_WINA) + (size_t)NIN_A * DM, NIN_A, CNT(3)); } SEAM(11);
    if (IN(12)) REP(12) { REFRESH(); WSSEL(1);
        if (bid & 1) { attn_sample_phase(F, 3); attn_prompt_phase(F, 3); sgu_phase_mfma(F, 1); sgu_sample_phase(F, 1); }
        else { sgu_phase_mfma(F, 1); sgu_sample_phase(F, 1); attn_prompt_phase(F, 3); attn_sample_phase(F, 3); } } SEAM(12);
    if (IN(13)) REP(13) { REFRESH(); OUTPROJ(3, (const float*)nullptr); } SEAM(13);
    if (IN(14)) REP(14) { REFRESH(); WSSEL(8); fixup_out_rows(F, (const float*)nullptr); final_phase(F); }
#undef CNT
#undef WOUT
#undef KVPROJ
#undef INPROJ
#undef OUTPROJ
#undef IN
#undef REP
#undef SEAM
#undef XB
#undef X
#undef SSX
#undef SSV
#undef B0
#undef B1
#undef QBp
#undef A2
#undef GBp
#undef REFRESH
}

extern "C" void kernel_launch(void* const* d_in, const int* in_sizes, int n_in, void* d_out, int out_size, void* d_ws, size_t ws_size, hipStream_t stream) {
    static int grid = 0;
    if (grid == 0) {
        if (n_in != 30 || out_size != (int)O_END || ws_size < WS_END) { fprintf(stderr, "kernel_launch: unexpected shapes (n_in %d out %d ws %zu)\n", n_in, out_size, ws_size); grid = -1; return; }
        int dev = 0, cus = 0, per_cu = 0;
        (void)hipGetDevice(&dev); (void)hipDeviceGetAttribute(&cus, hipDeviceAttributeMultiprocessorCount, dev);
        if (hipFuncSetAttribute((const void*)fwd_kernel, hipFuncAttributeMaxDynamicSharedMemorySize, LDS_BYTES) != hipSuccess) { fprintf(stderr, "kernel_launch: hipFuncSetAttribute failed\n"); grid = -1; return; }
        if (hipOccupancyMaxActiveBlocksPerMultiprocessor(&per_cu, (const void*)fwd_kernel, NTHR, LDS_BYTES) != hipSuccess || per_cu < 1) { fprintf(stderr, "kernel_launch: occupancy query says %d\n", per_cu); (void)hipGetLastError(); per_cu = 1; }
        grid = cus;
    }
    if (grid < 0) return;
    Args a{};
    for (int i = 0; i < 30; ++i) a.in[i] = (const float*)d_in[i];
    a.out = (float*)d_out; a.ws = (unsigned char*)d_ws;
#if MK_ONE_LAUNCH
    (void)hipMemsetAsync((char*)d_ws + WS_CTL, 0, 65536, stream);
    a.ph_lo = 0; a.ph_hi = NPHASE;
    void* kargs[] = {&a};
    hipError_t e = hipLaunchCooperativeKernel((const void*)fwd_kernel, dim3(grid), dim3(NTHR), kargs, LDS_BYTES, stream);
    if (e != hipSuccess) fprintf(stderr, "cooperative launch failed: %s (grid %d)\n", hipGetErrorString(e), grid);
#else
    for (int p = 0; p < NPHASE; ++p) { a.ph_lo = p; a.ph_hi = p + 1; hipLaunchKernelGGL(fwd_kernel, dim3(grid), dim3(NTHR), LDS_BYTES, stream, a); }
#endif
}
```

```cpp
#include <hip/hip_runtime.h>
#include <hip/hip_cooperative_groups.h>
#include <cstdio>
#include <cstdint>
namespace cg = cooperative_groups;

#ifndef MK_ONE_LAUNCH
#define MK_ONE_LAUNCH 1
#endif
#ifndef XHALF_SHFL
#define XHALF_SHFL 0
#endif
#ifndef EPI_DRAIN
#define EPI_DRAIN 1
#endif
#ifndef FLAT_FN_MASK
#define FLAT_FN_MASK 0x00
#endif
#ifndef PROBE_SUB_MASK
#define PROBE_SUB_MASK 0
#endif
#ifndef PROBE_REP_MASK
#define PROBE_REP_MASK 0
#endif

namespace pg8 {
#define PG8_LAS __attribute__((address_space(3)))
typedef unsigned short bf16_t;
typedef short bf16x8 __attribute__((ext_vector_type(8)));
typedef float f32x4 __attribute__((ext_vector_type(4)));
typedef unsigned u32x4 __attribute__((ext_vector_type(4)));
typedef unsigned u32x2 __attribute__((ext_vector_type(2)));
constexpr int BM = 256, BK = 64, HALF = 128, HTB = HALF * BK * 2, STAGE_BYTES = 8 * HTB, NXCD = 8, WGM = 8;

__host__ __device__ __forceinline__ int lds_byte(int r, int c) { const int st = (r >> 4) * 2 + (c >> 5), rr = r & 15, cc = c & 31, ob = rr * 64 + cc * 2; return st * 1024 + (ob ^ (((ob >> 9) & 1) << 5)); }
__host__ __device__ __forceinline__ void stage_rc(int b, int& R, int& C) { const int st = b / 1024, sb = b % 1024, swz = sb ^ (((sb >> 9) & 1) << 5); R = (st >> 1) * 16 + swz / 64; C = (st & 1) * 32 + (swz % 64) / 2; }
__host__ __device__ __forceinline__ int perm32(int rho) { const int n = rho >> 4, i = rho & 15; return 8 * (i >> 2) + 4 * n + (i & 3); }

struct Unit { int pm, pn, ks; };
struct Gemm { const bf16_t* A; const bf16_t* Bt; int M, N, K, ld; };

struct StaticOrder {
    int nM, nN, nwg, G, c, pm0;
    __host__ __device__ void init(int M, int N, int G_, int c_, int pm0_ = 0) { nM = M / BM; nN = N / BM; nwg = nM * nN; G = G_; c = c_; pm0 = pm0_; }
    __host__ __device__ bool next(int i, Unit& u) const {
        const long L = (long)i * G + c; if (L >= nwg) return false;
        int wgid = (int)L; { const int q = nwg / NXCD, r = nwg % NXCD, xcd = wgid % NXCD, off = wgid / NXCD; wgid = (xcd < r ? xcd * (q + 1) : r * (q + 1) + (xcd - r) * q) + off; }
        const int nig = WGM * nN, gid = wgid / nig, fm = gid * WGM, gsz = (nM - fm) < WGM ? (nM - fm) : WGM;
        u.pm = pm0 + fm + ((wgid % nig) % gsz); u.pn = (wgid % nig) / gsz; u.ks = 0; return true;
    }
    __device__ __forceinline__ void a_ready(const Unit&) const {}
    __device__ __forceinline__ void done(const Unit&) const {}
};
template <int NM_, int NN_, int NK_> struct SliceOrder {
    int G, c, pm0;
    __host__ __device__ void init(int G_, int c_, int pm0_) { G = G_; c = c_; pm0 = pm0_; }
    __host__ __device__ bool next(int i, Unit& u) const {
        const int L = i * G + c; if (L >= NM_ * NN_ * NK_) return false;
        const int t = L / NK_; u.ks = L % NK_; u.pn = t % NN_; u.pm = pm0 + t / NN_; return true;
    }
    __device__ __forceinline__ void a_ready(const Unit&) const {}
    __device__ __forceinline__ void done(const Unit&) const {}
};

template <class Epi, class Sched, bool ALIGN_EPI = false, bool SP2 = false>
__device__ __forceinline__ void gemm_phase(PG8_LAS unsigned char* lds, const Gemm g, const Sched& S, const Epi& E) {
    int tid = threadIdx.x; asm volatile("" : "+v"(tid));
    const int wid = __builtin_amdgcn_readfirstlane(tid >> 6), lane = tid & 63, wr = wid >> 2, wc = wid & 3, fr = lane & 15, fq = lane >> 4;
    const int K = g.K, ld = g.ld, nt = K / BK;
    unsigned voffA[2], voffB[2];
#pragma unroll
    for (int i = 0; i < 2; ++i) { int R, C; stage_rc(tid * 16 + i * 8192, R, C); const int Rb = Epi::PERM ? ((R & ~31) + perm32(R & 31)) : R;
        voffA[i] = (unsigned)(R * ld + C) * 2u; voffB[i] = (unsigned)(Rb * ld + C) * 2u; }
    const size_t kstep = (size_t)(BK * 2);
    const size_t hstep = (size_t)HALF * ld * 2;
    const size_t sstep = (size_t)K * 2;
    const size_t tstep = 2 * hstep;
    const unsigned ldsw = (unsigned)wid * 1024u;
    const int aoff = lds_byte(wr * 64 + fr, fq * 8), boff = lds_byte(wc * 32 + fr, fq * 8);
#define PG8_SA(b, h) (((b) * 2 + (h)) * HTB)
#define PG8_SB(b, h) ((4 + (b) * 2 + (h)) * HTB)
#define PG8_STAGE(bufoff, gbase, voff) do { _Pragma("unroll") for (int _i = 0; _i < 2; ++_i) \
        __builtin_amdgcn_global_load_lds((const unsigned*)((const char*)(gbase) + (voff)[_i]), (PG8_LAS unsigned*)(lds + (bufoff) + ldsw + _i * 8192), 16, 0, 0); } while (0)
#define PG8_LDA(dst, b, h) do { _Pragma("unroll") for (int m = 0; m < 4; ++m) _Pragma("unroll") for (int k = 0; k < 2; ++k) dst[m][k] = *(const PG8_LAS bf16x8*)(lds + PG8_SA(b, h) + aoff + m * 2048 + k * 1024); } while (0)
#define PG8_LDB(dst, b, h) do { _Pragma("unroll") for (int n = 0; n < 2; ++n) _Pragma("unroll") for (int k = 0; k < 2; ++k) dst[n][k] = *(const PG8_LAS bf16x8*)(lds + PG8_SB(b, h) + boff + n * 2048 + k * 1024); } while (0)
#define PG8_MMA(ai, bj, At, Bt) do { __builtin_amdgcn_s_setprio(1); _Pragma("unroll") for (int m = 0; m < 4; ++m) _Pragma("unroll") for (int n = 0; n < 2; ++n) _Pragma("unroll") for (int k = 0; k < 2; ++k) \
        acc[ai][bj][m][n] = __builtin_amdgcn_mfma_f32_16x16x32_bf16(Bt[n][k], At[m][k], acc[ai][bj][m][n], 0, 0, 0); __builtin_amdgcn_s_setprio(0); } while (0)
#define PG8_WAIT_V(n) asm volatile("s_waitcnt vmcnt(" #n ")" ::: "memory")
#define PG8_WAIT_L(n) asm volatile("s_waitcnt lgkmcnt(" #n ")" ::: "memory")
#define PG8_BAR __builtin_amdgcn_s_barrier()
#define PG8_SCHED __builtin_amdgcn_sched_barrier(0)
    Unit cur, nxt; int ui = 0;
    if (!S.next(0, cur)) return;
    f32x4 acc[2][2][4][2];
#pragma unroll
    for (int a = 0; a < 2; ++a)
#pragma unroll
        for (int b = 0; b < 2; ++b)
#pragma unroll
            for (int m = 0; m < 4; ++m)
#pragma unroll
                for (int n = 0; n < 2; ++n) acc[a][b][m][n] = (f32x4){0.f, 0.f, 0.f, 0.f};
    bf16x8 At[4][2], B0[2][2], B1[2][2];
    const char* cA = (const char*)g.A + (size_t)cur.pm * tstep + (size_t)cur.ks * sstep; const char* cB = (const char*)g.Bt + (size_t)cur.pn * tstep + (size_t)cur.ks * sstep;
    S.a_ready(cur);
    if constexpr (SP2) {
        PG8_STAGE(PG8_SB(0, 0), cB, voffB); PG8_STAGE(PG8_SB(0, 1), cB + hstep, voffB); PG8_STAGE(PG8_SA(0, 0), cA, voffA); PG8_STAGE(PG8_SA(0, 1), cA + hstep, voffA);
        if (wr == 1) PG8_BAR;
        PG8_WAIT_V(2); PG8_BAR;
        PG8_STAGE(PG8_SB(1, 0), cB + kstep, voffB); PG8_STAGE(PG8_SA(1, 0), cA + kstep, voffA); PG8_STAGE(PG8_SB(1, 1), cB + hstep + kstep, voffB);
        PG8_WAIT_V(6); PG8_BAR;
    } else {
        PG8_STAGE(PG8_SB(0, 0), cB, voffB); PG8_STAGE(PG8_SA(0, 0), cA, voffA); PG8_STAGE(PG8_SB(0, 1), cB + hstep, voffB); PG8_STAGE(PG8_SA(0, 1), cA + hstep, voffA);
        if (wr == 1) PG8_BAR;
        PG8_WAIT_V(4); PG8_BAR;
        PG8_STAGE(PG8_SB(1, 0), cB + kstep, voffB); PG8_STAGE(PG8_SA(1, 0), cA + kstep, voffA); PG8_STAGE(PG8_SB(1, 1), cB + hstep + kstep, voffB);
        PG8_WAIT_V(6); PG8_BAR;
    }
    for (;;) {
        const bool has_next = S.next(ui + 1, nxt);
        const char* nA = has_next ? (const char*)g.A + (size_t)nxt.pm * tstep + (size_t)nxt.ks * sstep : cA; const char* nB = has_next ? (const char*)g.Bt + (size_t)nxt.pn * tstep + (size_t)nxt.ks * sstep : cB;
        for (int t = 0; t < nt; t += 2) {
            const bool last = (t == nt - 2);
            const char* a1 = cA + (size_t)(t + 1) * kstep;
            const char* a2 = last ? nA : cA + (size_t)(t + 2) * kstep; const char* b2 = last ? nB : cB + (size_t)(t + 2) * kstep;
            const char* a3 = a2 + kstep; const char* b3 = b2 + kstep;
            if (last && has_next) S.a_ready(nxt);
            if constexpr (SP2) {
            PG8_LDB(B0, 0, 0); PG8_LDB(B1, 0, 1); PG8_SCHED; PG8_LDA(At, 0, 0); PG8_STAGE(PG8_SA(1, 1), a1 + hstep, voffA);
            PG8_WAIT_V(8); PG8_WAIT_L(0); PG8_BAR; PG8_MMA(0, 0, At, B0); PG8_MMA(0, 1, At, B1); PG8_BAR; PG8_SCHED;
            PG8_LDA(At, 0, 1); PG8_STAGE(PG8_SB(0, 0), b2, voffB); PG8_STAGE(PG8_SB(0, 1), b2 + hstep, voffB); PG8_STAGE(PG8_SA(0, 0), a2, voffA);
            PG8_WAIT_V(8); PG8_WAIT_L(0); PG8_BAR; PG8_MMA(1, 0, At, B0); PG8_MMA(1, 1, At, B1); PG8_BAR; PG8_SCHED;
            PG8_LDB(B0, 1, 0); PG8_LDB(B1, 1, 1); PG8_SCHED; PG8_LDA(At, 1, 0); PG8_STAGE(PG8_SA(0, 1), a2 + hstep, voffA);
            PG8_WAIT_V(8); PG8_WAIT_L(0); PG8_BAR; PG8_MMA(0, 0, At, B0); PG8_MMA(0, 1, At, B1); PG8_BAR; PG8_SCHED;
            PG8_LDA(At, 1, 1); PG8_STAGE(PG8_SB(1, 0), b3, voffB); PG8_STAGE(PG8_SB(1, 1), b3 + hstep, voffB); PG8_STAGE(PG8_SA(1, 0), a3, voffA);
            PG8_WAIT_V(8); PG8_WAIT_L(0); PG8_BAR; PG8_MMA(1, 0, At, B0); PG8_MMA(1, 1, At, B1); PG8_BAR; PG8_SCHED;
            } else {
            PG8_LDB(B0, 0, 0); PG8_SCHED; PG8_LDA(At, 0, 0); PG8_STAGE(PG8_SA(1, 1), a1 + hstep, voffA);
            PG8_WAIT_L(8); PG8_BAR; PG8_WAIT_L(0); PG8_MMA(0, 0, At, B0); PG8_BAR; PG8_SCHED;
            PG8_LDB(B1, 0, 1); PG8_STAGE(PG8_SB(0, 0), b2, voffB);
            PG8_BAR; PG8_WAIT_L(0); PG8_MMA(0, 1, At, B1); PG8_BAR;
            PG8_LDA(At, 0, 1); PG8_STAGE(PG8_SA(0, 0), a2, voffA);
            PG8_BAR; PG8_WAIT_L(0); PG8_MMA(1, 0, At, B0); PG8_BAR; PG8_SCHED;
            PG8_STAGE(PG8_SB(0, 1), b2 + hstep, voffB);
            PG8_WAIT_V(6); PG8_BAR; PG8_MMA(1, 1, At, B1); PG8_BAR;
            PG8_LDB(B0, 1, 0); PG8_SCHED; PG8_LDA(At, 1, 0); PG8_STAGE(PG8_SA(0, 1), a2 + hstep, voffA);
            PG8_WAIT_L(8); PG8_BAR; PG8_WAIT_L(0); PG8_MMA(0, 0, At, B0); PG8_BAR; PG8_SCHED;
            PG8_LDB(B1, 1, 1); PG8_STAGE(PG8_SB(1, 0), b3, voffB);
            PG8_BAR; PG8_WAIT_L(0); PG8_MMA(0, 1, At, B1); PG8_BAR;
            PG8_LDA(At, 1, 1); PG8_STAGE(PG8_SA(1, 0), a3, voffA);
            PG8_BAR; PG8_WAIT_L(0); PG8_MMA(1, 0, At, B0); PG8_BAR; PG8_SCHED;
            PG8_STAGE(PG8_SB(1, 1), b3 + hstep, voffB);
            PG8_WAIT_V(6); PG8_BAR; PG8_MMA(1, 1, At, B1); PG8_BAR;
            }
        }
        if constexpr (ALIGN_EPI) { if (wr == 0) PG8_BAR; }
        if constexpr (!Epi::AFTER_DRAIN) { E(acc, cur, wr, wc, fr, fq); S.done(cur); }
#if EPI_DRAIN
        PG8_WAIT_V(0);
#endif
        if (!has_next) break;
#pragma unroll
        for (int a = 0; a < 2; ++a)
#pragma unroll
            for (int b = 0; b < 2; ++b)
#pragma unroll
                for (int m = 0; m < 4; ++m)
#pragma unroll
                    for (int n = 0; n < 2; ++n) acc[a][b][m][n] = (f32x4){0.f, 0.f, 0.f, 0.f};
        cur = nxt; cA = nA; cB = nB; ++ui;
        if constexpr (ALIGN_EPI) { if (wr == 1) PG8_BAR; }
    }
    PG8_WAIT_V(0);
    if constexpr (!ALIGN_EPI) { if (wr == 0) PG8_BAR; }
    PG8_BAR;
#undef PG8_SA
#undef PG8_SB
#undef PG8_STAGE
#undef PG8_LDA
#undef PG8_LDB
#undef PG8_MMA
#undef PG8_WAIT_V
#undef PG8_WAIT_L
#undef PG8_BAR
#undef PG8_SCHED
}
}

using pg8::bf16_t; using pg8::f32x4; using pg8::u32x4; using pg8::u32x2; using pg8::bf16x8; using pg8::Unit;
#define LAS __attribute__((address_space(3)))
#define GAS __attribute__((address_space(1)))
#define GIN(k) ((const float*)(const GAS float*)F.in[k])
typedef float f32x2 __attribute__((ext_vector_type(2)));
typedef __bf16 bf16x2_t __attribute__((ext_vector_type(2)));
typedef float f32x16 __attribute__((ext_vector_type(16)));

constexpr int DM = 1024, E_ = 2048, XA = 512, NH = 4, HD = 128, MEML = 256;
constexpr int PB = 8, PSEQ = 2048, MP = PB * PSEQ;
constexpr int SBT = 128, SSEQ = 4, MS = SBT * SSEQ;
constexpr int M = MP + MS;
constexpr int NIN_A = 3 * E_ + XA, NIN_B = 4 * E_ + XA, NIN_C = 2 * E_ + XA, KOUT = E_ + XA;
constexpr int S5G = 128, S5P = 64, S5I = 16;
constexpr float EPS = 1e-6f;
constexpr int NWAVES = 8, NTHR = 512;

constexpr size_t O_YP = 0, O_YS = O_YP + (size_t)MP * DM, O_MK = O_YS + (size_t)MS * DM, O_MV = O_MK + 4ull * PB * MEML * XA, O_CP = O_MV + 4ull * PB * MEML * XA,
                 O_CS = O_CP + (size_t)PB * 2 * E_, O_SRP = O_CS + (size_t)SBT * 2 * E_, O_SIP = O_SRP + (size_t)PB * S5G * S5P, O_SRS = O_SIP + (size_t)PB * S5G * S5P,
                 O_SIS = O_SRS + (size_t)SBT * S5G * S5P, O_CV = O_SIS + (size_t)SBT * S5G * S5P, O_END = O_CV + 2ull * SBT * SSEQ * E_;
static_assert(O_END == 30572544ull, "output size");

constexpr size_t MiB = 1u << 20;
constexpr size_t WS_CTL = 0, WS_TAB = 1 * MiB, WS_RSTDM = 3 * MiB, WS_SGUW = 4 * MiB, WS_SSX = 5 * MiB, WS_SSV = 7 * MiB, WS_WKV = 10 * MiB, WS_WGLU = 18 * MiB, WS_WOUT = 26 * MiB,
                 WS_WINA = 46 * MiB, WS_WINB = 72 * MiB, WS_WINC = 89 * MiB, WS_MEMB = 98 * MiB, WS_KB = 102 * MiB, WS_VT = 110 * MiB, WS_XB = 118 * MiB, WS_X = 151 * MiB,
                 WS_B0 = 217 * MiB, WS_B1 = 283 * MiB, WS_QB = 349 * MiB, WS_A2 = 366 * MiB, WS_GB = 449 * MiB, WS_SLAB = 515 * MiB  , WS_END = 548 * MiB;
constexpr size_t T_AR = 0, T_AI = 8192, T_BBR = 16384, T_BBI = 16384 + 131072;

constexpr int RING_BYTES = 131072, LDS_BYTES = 147456;

struct Args { const float* in[30]; float* out; unsigned char* ws; int ph_lo, ph_hi; };

__device__ __forceinline__ unsigned pk2(float lo, float hi) { f32x2 v = {lo, hi}; return __builtin_bit_cast(unsigned, __builtin_convertvector(v, bf16x2_t)); }
__device__ __forceinline__ bf16_t f2bf(float f) { return (bf16_t)(pk2(f, 0.f) & 0xffffu); }
__device__ __forceinline__ float bf2f(unsigned short h) { return __uint_as_float((unsigned)h << 16); }
__device__ __forceinline__ float bflo(unsigned w) { return __uint_as_float(w << 16); }
__device__ __forceinline__ float bfhi(unsigned w) { return __uint_as_float(w & 0xffff0000u); }
__device__ __forceinline__ float sigmoidf_(float x) { return __builtin_amdgcn_rcpf(1.f + __expf(-x)); }
__device__ __forceinline__ float siluf_(float x) { return x * sigmoidf_(x); }
__device__ __forceinline__ float gelu_tanh(float x) { const float y = 0.7978845608028654f * (x + 0.044715f * x * x * x); return x * sigmoidf_(2.f * y); }
__device__ __forceinline__ float wave_sum(float v) {
#pragma unroll
    for (int o = 1; o < 64; o <<= 1) v += __shfl_xor(v, o);
    return v;
}
__device__ __forceinline__ float wave_max(float v) {
#pragma unroll
    for (int o = 1; o < 64; o <<= 1) v = fmaxf(v, __shfl_xor(v, o));
    return v;
}
__device__ __forceinline__ u32x4 pack8(f32x4 a, f32x4 b) { u32x4 w; w.x = pk2(a[0], a[1]); w.y = pk2(a[2], a[3]); w.z = pk2(b[0], b[1]); w.w = pk2(b[2], b[3]); return w; }
__device__ __forceinline__ void unpack8(u32x4 w, float (&f)[8]) { f[0] = bflo(w.x); f[1] = bfhi(w.x); f[2] = bflo(w.y); f[3] = bfhi(w.y); f[4] = bflo(w.z); f[5] = bfhi(w.z); f[6] = bflo(w.w); f[7] = bfhi(w.w); }

__device__ __forceinline__ int src_col(int kind, int np) {
    const int pn = np >> 8, p = np & 255, pos = (p & ~31) + pg8::perm32(p & 31);
    if (kind == 0) {
        if (pn < 16) return pos < 128 ? 128 * pn + pos : 2 * E_ + 128 * pn + (pos - 128);
        if (pn < 24) return E_ + 256 * (pn - 16) + pos;
        return 3 * E_ + 256 * (pn - 24) + pos;
    }
    if (kind == 1) {
        if (pn < 32) { const int qs = 2 * (p >> 7) + ((p >> 4) & 1), ch = 64 * pn + 16 * ((p >> 5) & 3) + (p & 15); return qs * E_ + ch; }
        return 4 * E_ + 256 * (pn - 32) + pos;
    }
    return 256 * pn + pos;
}

__device__ __forceinline__ float sum_rows4(float x) {
    auto a = __builtin_amdgcn_permlane16_swap(__float_as_uint(x), __float_as_uint(x), false, false); const float y = __uint_as_float(a[0]) + __uint_as_float(a[1]);
    auto b = __builtin_amdgcn_permlane32_swap(__float_as_uint(y), __float_as_uint(y), false, false); return __uint_as_float(b[0]) + __uint_as_float(b[1]);
}
__device__ __forceinline__ void rows_rstd16(const float* ssx, int row0, int fq, float (&rs)[2][4]) {
#pragma unroll
    for (int ai = 0; ai < 2; ++ai)
#pragma unroll
        for (int m = 0; m < 4; ++m) {
            const f32x4 v = *(const f32x4*)(ssx + (size_t)(row0 + ai * 128 + m * 16) * 16 + fq * 4);
            const float s = sum_rows4((v[0] + v[1]) + (v[2] + v[3]));
            rs[ai][m] = __builtin_amdgcn_rsqf(s * (1.f / DM) + EPS);
        }
}

struct EpiKV {
    static constexpr bool PERM = false, AFTER_DRAIN = false;
    const float* rstdm; float* outk; float* outv; bf16_t* KB; bf16_t* VT; int layer;
    __device__ __forceinline__ void operator()(const f32x4 (&acc)[2][2][4][2], const Unit& u, int wr, int wc, int fr, int fq) const {
        const int sub = u.pn & 3, isv = sub >> 1, b = u.pm;
        const int key0 = wr * 64 + fr, d0 = 32 * wc + 8 * fq;
        const float* rsp = rstdm + b * 256 + key0;
        float* of = (isv ? outv : outk) + (((size_t)(layer * PB + b) * MEML + key0) * NH + (sub & 1) * 2) * HD + d0;
        const size_t bh0 = (size_t)((layer * PB + b) * NH + (sub & 1) * 2);
        if (!isv) {
            bf16_t* kb = KB + (bh0 * MEML + key0) * HD + d0;
#pragma unroll
            for (int ai = 0; ai < 2; ++ai)
#pragma unroll
                for (int m = 0; m < 4; ++m) { const int kk = ai * 128 + m * 16; const float rs = rsp[kk];
#pragma unroll
                    for (int bj = 0; bj < 2; ++bj) { const f32x4 v0 = acc[ai][bj][m][0] * rs, v1 = acc[ai][bj][m][1] * rs;
                        float* o = of + (size_t)kk * XA + bj * HD; *(f32x4*)o = v0; *(f32x4*)(o + 4) = v1;
                        *(u32x4*)(kb + (size_t)bj * MEML * HD + (size_t)kk * HD) = pack8(v0, v1); }
                    asm volatile("" ::: "memory"); }
        } else {
            bf16_t* vt = VT + (bh0 * HD + d0) * MEML + key0;
#pragma unroll
            for (int ai = 0; ai < 2; ++ai)
#pragma unroll
                for (int m = 0; m < 4; ++m) { const int kk = ai * 128 + m * 16; const float rs = rsp[kk];
#pragma unroll
                    for (int bj = 0; bj < 2; ++bj) { const f32x4 v0 = acc[ai][bj][m][0] * rs, v1 = acc[ai][bj][m][1] * rs;
                        float* o = of + (size_t)kk * XA + bj * HD; *(f32x4*)o = v0; *(f32x4*)(o + 4) = v1;
                        bf16_t* q = vt + (size_t)bj * HD * MEML + kk;
#pragma unroll
                        for (int e = 0; e < 4; ++e) { q[e * MEML] = f2bf(v0[e]); q[(e + 4) * MEML] = f2bf(v1[e]); }
                        asm volatile("" ::: "memory"); } }
        }
    }
};

struct EpiInA {
    static constexpr bool PERM = false, AFTER_DRAIN = false;
    const float* ssx; bf16_t* UZ; bf16_t* VR; bf16_t* QB; float* SSV;
    __device__ __forceinline__ void operator()(const f32x4 (&acc)[2][2][4][2], const Unit& u, int wr, int wc, int fr, int fq) const {
        const int row0 = u.pm * 256 + wr * 64 + fr; float rs[2][4]; rows_rstd16(ssx, row0, fq, rs);
        if (u.pn < 16) {
#pragma unroll
            for (int ai = 0; ai < 2; ++ai)
#pragma unroll
                for (int m = 0; m < 4; ++m) { const int row = row0 + ai * 128 + m * 16; const float r = rs[ai][m]; f32x4 o[2];
#pragma unroll
                    for (int n = 0; n < 2; ++n)
#pragma unroll
                        for (int e = 0; e < 4; ++e) o[n][e] = acc[ai][0][m][n][e] * r * siluf_(acc[ai][1][m][n][e] * r);
                    *(u32x4*)(UZ + (size_t)row * E_ + 128 * u.pn + 32 * wc + 8 * fq) = pack8(o[0], o[1]); }
        } else if (u.pn < 24) {
#pragma unroll
            for (int ai = 0; ai < 2; ++ai)
#pragma unroll
                for (int m = 0; m < 4; ++m) { const int row = row0 + ai * 128 + m * 16; const float r = rs[ai][m]; float ss = 0.f;
#pragma unroll
                    for (int bj = 0; bj < 2; ++bj) { const f32x4 v0 = acc[ai][bj][m][0] * r, v1 = acc[ai][bj][m][1] * r;
                        ss += (v0[0] * v0[0] + v0[1] * v0[1]) + (v0[2] * v0[2] + v0[3] * v0[3]) + (v1[0] * v1[0] + v1[1] * v1[1]) + (v1[2] * v1[2] + v1[3] * v1[3]);
                        *(u32x4*)(VR + (size_t)row * E_ + 256 * (u.pn - 16) + 128 * bj + 32 * wc + 8 * fq) = pack8(v0, v1); }
                    ss = sum_rows4(ss);
                    if (fq == 0) SSV[(size_t)row * 32 + (u.pn - 16) * 4 + wc] = ss; }
        } else {
#pragma unroll
            for (int ai = 0; ai < 2; ++ai)
#pragma unroll
                for (int m = 0; m < 4; ++m) { const int row = row0 + ai * 128 + m * 16; const float r = rs[ai][m] * 0.08838834764831845f;
#pragma unroll
                    for (int bj = 0; bj < 2; ++bj) *(u32x4*)(QB + (size_t)row * XA + 256 * (u.pn - 24) + 128 * bj + 32 * wc + 8 * fq) = pack8(acc[ai][bj][m][0] * r, acc[ai][bj][m][1] * r); }
        }
    }
};

struct EpiInB {
    static constexpr bool PERM = false, AFTER_DRAIN = false;
    const float* ssx; bf16_t* P; bf16_t* G; bf16_t* QB; float* convp; float* convs;
    __device__ __forceinline__ void operator()(const f32x4 (&acc)[2][2][4][2], const Unit& u, int wr, int wc, int fr, int fq) const {
        const int row0 = u.pm * 256 + wr * 64 + fr; float rs[2][4]; rows_rstd16(ssx, row0, fq, rs);
        if (u.pn < 32) {
            const int ch0 = 64 * u.pn + 16 * wc + 4 * fq;
#pragma unroll
            for (int ai = 0; ai < 2; ++ai)
#pragma unroll
                for (int m = 0; m < 4; ++m) { const int row = row0 + ai * 128 + m * 16; const float r = rs[ai][m];
                    const f32x4 bg = acc[ai][0][m][0] * r, cgv = acc[ai][0][m][1] * r, hv = acc[ai][1][m][0] * r, z = acc[ai][1][m][1] * r;
                    f32x4 p = cgv * hv, gg;
#pragma unroll
                    for (int e = 0; e < 4; ++e) gg[e] = bg[e] * siluf_(z[e]);
                    u32x2 wp, wg; wp.x = pk2(p[0], p[1]); wp.y = pk2(p[2], p[3]); wg.x = pk2(gg[0], gg[1]); wg.y = pk2(gg[2], gg[3]);
                    *(u32x2*)(P + (size_t)row * E_ + ch0) = wp; *(u32x2*)(G + (size_t)row * E_ + ch0) = wg;
                    if (row < MP) { const int t = row & (PSEQ - 1); if (t >= PSEQ - 2) *(f32x4*)(convp + ((size_t)(row >> 11) * 2 + (t - (PSEQ - 2))) * E_ + ch0) = p; }
                    else { const int s = row - MP, t = s & 3; if (t >= 2) *(f32x4*)(convs + ((size_t)(s >> 2) * 2 + (t - 2)) * E_ + ch0) = p; } }
        } else {
#pragma unroll
            for (int ai = 0; ai < 2; ++ai)
#pragma unroll
                for (int m = 0; m < 4; ++m) { const int row = row0 + ai * 128 + m * 16; const float r = rs[ai][m] * 0.08838834764831845f;
#pragma unroll
                    for (int bj = 0; bj < 2; ++bj) *(u32x4*)(QB + (size_t)row * XA + 256 * (u.pn - 32) + 128 * bj + 32 * wc + 8 * fq) = pack8(acc[ai][bj][m][0] * r, acc[ai][bj][m][1] * r); }
        }
    }
};

struct EpiInC {
    static constexpr bool PERM = false, AFTER_DRAIN = false;
    const float* ssx; bf16_t* U; bf16_t* SZ; bf16_t* QB;
    __device__ __forceinline__ void operator()(const f32x4 (&acc)[2][2][4][2], const Unit& u, int wr, int wc, int fr, int fq) const {
        const int row0 = u.pm * 256 + wr * 64 + fr; float rs[2][4]; rows_rstd16(ssx, row0, fq, rs);
#pragma unroll
        for (int ai = 0; ai < 2; ++ai)
#pragma unroll
            for (int m = 0; m < 4; ++m) { const int row = row0 + ai * 128 + m * 16; const float r = rs[ai][m];
#pragma unroll
                for (int bj = 0; bj < 2; ++bj) { const int cc = 128 * bj + 32 * wc + 8 * fq;
                    if (u.pn < 8) *(u32x4*)(U + (size_t)row * E_ + 256 * u.pn + cc) = pack8(acc[ai][bj][m][0] * r, acc[ai][bj][m][1] * r);
                    else if (u.pn < 16) { f32x4 a, b2;
#pragma unroll
                        for (int e = 0; e < 4; ++e) { a[e] = siluf_(acc[ai][bj][m][0][e] * r); b2[e] = siluf_(acc[ai][bj][m][1][e] * r); }
                        *(u32x4*)(SZ + (size_t)row * E_ + 256 * (u.pn - 8) + cc) = pack8(a, b2); }
                    else { const float rq = r * 0.08838834764831845f; *(u32x4*)(QB + (size_t)row * XA + 256 * (u.pn - 16) + cc) = pack8(acc[ai][bj][m][0] * rq, acc[ai][bj][m][1] * rq); } } }
    }
};

struct EpiOut {
    static constexpr bool PERM = false, AFTER_DRAIN = false;
    const float* basef; bf16_t* XB; float* SSX;
    __device__ __forceinline__ void operator()(const f32x4 (&acc)[2][2][4][2], const Unit& u, int wr, int wc, int fr, int fq) const {
        const int row0 = u.pm * 256 + wr * 64 + fr;
#pragma unroll
        for (int ai = 0; ai < 2; ++ai)
#pragma unroll
            for (int m = 0; m < 4; ++m) { const int row = row0 + ai * 128 + m * 16; float ss = 0.f;
#pragma unroll
                for (int bj = 0; bj < 2; ++bj) { const int col = 256 * u.pn + 128 * bj + 32 * wc + 8 * fq; f32x4 x0, x1;
                    if (basef) { x0 = *(const f32x4*)(basef + (size_t)row * DM + col); x1 = *(const f32x4*)(basef + (size_t)row * DM + col + 4); }
                    else { float r[8]; unpack8(*(const u32x4*)(XB + (size_t)row * DM + col), r); x0 = (f32x4){r[0], r[1], r[2], r[3]}; x1 = (f32x4){r[4], r[5], r[6], r[7]}; }
                    x0 += acc[ai][bj][m][0]; x1 += acc[ai][bj][m][1];
                    *(u32x4*)(XB + (size_t)row * DM + col) = pack8(x0, x1);
                    ss += (x0[0] * x0[0] + x0[1] * x0[1]) + (x0[2] * x0[2] + x0[3] * x0[3]) + (x1[0] * x1[0] + x1[1] * x1[1]) + (x1[2] * x1[2] + x1[3] * x1[3]); }
                ss = sum_rows4(ss);
                if (fq == 0) SSX[(size_t)row * 16 + u.pn * 4 + wc] = ss; }
    }
};

struct EpiGlu {
    static constexpr bool PERM = false, AFTER_DRAIN = false;
    const bf16_t* GB; const bf16_t* SZ; const float* bias; bf16_t* A2;
    __device__ __forceinline__ void operator()(const f32x4 (&acc)[2][2][4][2], const Unit& u, int wr, int wc, int fr, int fq) const {
        const int row0 = u.pm * 256 + wr * 64 + fr;
#pragma unroll
        for (int ai = 0; ai < 2; ++ai)
#pragma unroll
            for (int m = 0; m < 4; ++m) { const int row = row0 + ai * 128 + m * 16;
#pragma unroll
                for (int bj = 0; bj < 2; ++bj) { const int col = 256 * u.pn + 128 * bj + 32 * wc + 8 * fq;
                    const f32x4 b0 = *(const f32x4*)(bias + col), b1 = *(const f32x4*)(bias + col + 4);
                    float gv[8], sz[8]; unpack8(*(const u32x4*)(GB + (size_t)row * E_ + col), gv); unpack8(*(const u32x4*)(SZ + (size_t)row * E_ + col), sz);
                    f32x4 o0, o1;
#pragma unroll
                    for (int e = 0; e < 4; ++e) { o0[e] = gv[e] * sigmoidf_(acc[ai][bj][m][0][e] + b0[e]) * sz[e]; o1[e] = gv[4 + e] * sigmoidf_(acc[ai][bj][m][1][e] + b1[e]) * sz[4 + e]; }
                    *(u32x4*)(A2 + (size_t)row * KOUT + col) = pack8(o0, o1); } }
    }
};

struct EpiSlab {
    static constexpr bool PERM = false, AFTER_DRAIN = false;
    float* S; int ldc; int row0; size_t kstride;
    __device__ __forceinline__ void operator()(const f32x4 (&acc)[2][2][4][2], const Unit& u, int wr, int wc, int fr, int fq) const {
        float* base = S + (size_t)u.ks * kstride + (size_t)(u.pm * 256 + wr * 64 + fr - row0) * ldc + 256 * u.pn + 32 * wc + 8 * fq;
#pragma unroll
        for (int ai = 0; ai < 2; ++ai)
#pragma unroll
            for (int m = 0; m < 4; ++m)
                { float* o = base + (size_t)(ai * 128 + m * 16) * ldc; *(f32x4*)o = acc[ai][0][m][0]; *(f32x4*)(o + 4) = acc[ai][0][m][1]; *(f32x4*)(o + 128) = acc[ai][1][m][0]; *(f32x4*)(o + 132) = acc[ai][1][m][1];
                  asm volatile("" ::: "memory"); }
    }
};

#ifndef PROBE_EPI2
#define PROBE_EPI2 0
#endif
template <class E_> struct EpiTwice { static constexpr bool PERM = false, AFTER_DRAIN = false; E_ e;
    __device__ __forceinline__ void operator()(const f32x4 (&acc)[2][2][4][2], const Unit& u, int wr, int wc, int fr, int fq) const { e(acc, u, wr, wc, fr, fq); asm volatile("" ::: "memory"); e(acc, u, wr, wc, fr, fq); } };

struct Frame {
    LAS unsigned char* lds; int tid, lane, wave, G, bid;
    const float* const* in; float* out; unsigned char* ws;
};

__device__ __forceinline__ void conv_item(const float* W, int K, int N, const float* gs, int kind, bf16_t* WT, LAS float* scr, int item, int lane) {
    const int nblk = N / 32, kb = item / nblk, nb = item % nblk, k0 = 64 * kb, n0 = 32 * nb, n4 = lane & 7, kr = lane >> 3;
    const int sc = src_col(kind, n0 + 4 * n4);
    f32x4 w[8];
#pragma unroll
    for (int i = 0; i < 8; ++i) w[i] = *(const f32x4*)(W + (size_t)(k0 + kr + 8 * i) * N + sc);
#pragma unroll
    for (int i = 0; i < 8; ++i) { const int kk = kr + 8 * i; const float g = gs ? gs[k0 + kk] : 1.f; LAS float* d = scr + kk * 33 + 4 * n4; d[0] = w[i][0] * g; d[1] = w[i][1] * g; d[2] = w[i][2] * g; d[3] = w[i][3] * g; }
    asm volatile("s_waitcnt lgkmcnt(0)" ::: "memory");
    const int c = lane & 7;
#pragma unroll
    for (int j = 0; j < 4; ++j) { const int n = (lane >> 3) + 8 * j; const LAS float* s = scr + (8 * c) * 33 + n;
        u32x4 o; o.x = pk2(s[0 * 33], s[1 * 33]); o.y = pk2(s[2 * 33], s[3 * 33]); o.z = pk2(s[4 * 33], s[5 * 33]); o.w = pk2(s[6 * 33], s[7 * 33]);
        *(u32x4*)(WT + (size_t)(n0 + n) * K + k0 + 8 * c) = o; }
    asm volatile("s_waitcnt lgkmcnt(0)" ::: "memory");
}

__device__ __forceinline__ void p0_prologue(Frame& F) {
    LAS float* scr = (LAS float*)(F.lds + F.wave * 16384);
    const int gw = F.bid * NWAVES + F.wave, NGW = F.G * NWAVES, lane = F.lane;
    unsigned char* ws = F.ws;
    constexpr int I_A = 16 * (NIN_A / 32), I_B = 16 * (NIN_B / 32), I_C = 16 * (NIN_C / 32), I_O = (KOUT / 64) * (DM / 32), I_KV = 16 * (DM / 32), I_GLU = (E_ / 64) * (E_ / 32);
    constexpr int NITEMS = 2 * I_A + I_B + I_C + 4 * I_O + 4 * I_KV + I_GLU;
    for (int it = gw; it < NITEMS; it += NGW) {
        int r = it;
        if (r < 2 * I_A) { const int j = r / I_A; r -= j * I_A; conv_item(GIN(13) + (size_t)j * DM * NIN_A, DM, NIN_A, GIN(8) + (j == 0 ? 0 : 3) * DM, 0, (bf16_t*)(ws + WS_WINA) + (size_t)j * NIN_A * DM, scr, r, lane); continue; } r -= 2 * I_A;
        if (r < I_B) { conv_item(GIN(17), DM, NIN_B, GIN(8) + 1 * DM, 1, (bf16_t*)(ws + WS_WINB), scr, r, lane); continue; } r -= I_B;
        if (r < I_C) { conv_item(GIN(19), DM, NIN_C, GIN(8) + 2 * DM, 2, (bf16_t*)(ws + WS_WINC), scr, r, lane); continue; } r -= I_C;
        if (r < 4 * I_O) { const int j = r / I_O; r -= j * I_O; conv_item(GIN(12) + (size_t)j * KOUT * DM, KOUT, DM, nullptr, 2, (bf16_t*)(ws + WS_WOUT) + (size_t)j * DM * KOUT, scr, r, lane); continue; } r -= 4 * I_O;
        if (r < 4 * I_KV) { const int j = r / I_KV; r -= j * I_KV; conv_item(GIN(11) + (size_t)j * DM * DM, DM, DM, GIN(10) + j * DM, 2, (bf16_t*)(ws + WS_WKV) + (size_t)j * DM * DM, scr, r, lane); continue; } r -= 4 * I_KV;
        conv_item(GIN(28), E_, E_, nullptr, 2, (bf16_t*)(ws + WS_WGLU), scr, r, lane);
    }
    {
        bf16_t* XB = (bf16_t*)(ws + WS_XB); float* SSX = (float*)(ws + WS_SSX);
        for (int row = gw; row < M; row += NGW) {
            const float* xr = row < MP ? GIN(0) + (size_t)row * DM : GIN(1) + (size_t)(row - MP) * DM;
            float ss = 0.f;
#pragma unroll
            for (int j = 0; j < 4; ++j) { const f32x4 v = *((const f32x4*)xr + lane + 64 * j); ss += (v[0] * v[0] + v[1] * v[1]) + (v[2] * v[2] + v[3] * v[3]);
                u32x2 w; w.x = pk2(v[0], v[1]); w.y = pk2(v[2], v[3]); *((u32x2*)(XB + (size_t)row * DM) + lane + 64 * j) = w; }
            asm volatile("s_waitcnt vmcnt(0)" ::: "memory");
            ss = wave_sum(ss);
            if (lane < 16) SSX[(size_t)row * 16 + lane] = lane == 0 ? ss : 0.f;
        }
    }
    {
        bf16_t* MB = (bf16_t*)(ws + WS_MEMB); float* RM = (float*)(ws + WS_RSTDM);
        for (int row = gw; row < PB * MEML; row += NGW) {
            const float* xr = GIN(2) + (size_t)row * DM; float ss = 0.f;
#pragma unroll
            for (int j = 0; j < 4; ++j) { const f32x4 v = *((const f32x4*)xr + lane + 64 * j); ss += (v[0] * v[0] + v[1] * v[1]) + (v[2] * v[2] + v[3] * v[3]);
                u32x2 w; w.x = pk2(v[0], v[1]); w.y = pk2(v[2], v[3]); *((u32x2*)(MB + (size_t)row * DM) + lane + 64 * j) = w; }
            asm volatile("s_waitcnt vmcnt(0)" ::: "memory");
            ss = wave_sum(ss);
            if (lane == 0) RM[row] = 1.0f / sqrtf(ss * (1.f / DM) + EPS);
        }
    }
    {
        float* TAB = (float*)(ws + WS_TAB);
        for (int g = gw; g < S5G; g += NGW) {
            const int gp = g * S5P + lane;
            const float lr = GIN(20)[gp], li = GIN(21)[gp], dt = expf(GIN(22)[g]);
            const float th = li * dt, em1 = expm1f(lr * dt), mag = em1 + 1.f, cs = cosf(th), sn = sinf(th), sh = sinf(0.5f * th);
            const float ar = mag * cs, ai = mag * sn;
            const float nr = em1 * cs - 2.f * sh * sh, ni = ai;
            const float den = lr * lr + li * li, cr = (nr * lr + ni * li) / den, ci = (ni * lr - nr * li) / den;
            TAB[T_AR + gp] = ar; TAB[T_AI + gp] = ai;
#pragma unroll
            for (int i = 0; i < S5I; ++i) { const float br = GIN(23)[(size_t)gp * S5I + i], bi = GIN(24)[(size_t)gp * S5I + i];
                TAB[T_BBR + (size_t)gp * S5I + i] = cr * br - ci * bi; TAB[T_BBI + (size_t)gp * S5I + i] = cr * bi + ci * br; }
        }
    }
    {
        bf16_t* SW = (bf16_t*)(ws + WS_SGUW);
        for (int i = (F.bid * NTHR + F.tid); i < 2 * 8 * 128 * 128; i += F.G * NTHR) { const int t = (i >> 7) & 127, s = i & 127; SW[i] = f2bf(s <= t ? GIN(15)[i] : 0.f); }
    }
}

typedef short v4i16_t __attribute__((ext_vector_type(4)));
constexpr int SG_VSTR = 576, SG_WSTR = 272, SG_WOFF = 128 * SG_VSTR, SG_ROFF = SG_WOFF + 128 * SG_WSTR;
static_assert(SG_ROFF + 512 <= RING_BYTES, "sgu LDS");
__device__ __forceinline__ void sgu_phase_mfma(Frame& F, int j) {
    const bf16_t* UZ = (const bf16_t*)(F.ws + WS_B0); const bf16_t* VR = (const bf16_t*)(F.ws + WS_B1); const float* SSV = (const float*)(F.ws + WS_SSV);
    const bf16_t* SW = (const bf16_t*)(F.ws + WS_SGUW) + (size_t)j * 8 * 128 * 128; bf16_t* A2 = (bf16_t*)(F.ws + WS_A2);
    const float* gn = GIN(14) + (size_t)j * E_; const float* bsv = GIN(16) + (size_t)j * 8 * 128;
    LAS unsigned char* lds = F.lds; LAS float* rsl = (LAS float*)(lds + SG_ROFF);
    const int tid = F.tid, lane = F.lane, wid = F.wave, c = lane & 31, hh = lane >> 5;
    for (int un = F.bid; un < 128 * 8; un += F.G) {
        const int ch = un >> 3, g = un & 7, rbase = ch * 128;
        __syncthreads();
        if (tid < 128) { const float* p = SSV + (size_t)(rbase + tid) * 32; float sq = 0.f;
#pragma unroll
            for (int k = 0; k < 8; ++k) { const f32x4 v = *((const f32x4*)p + k); sq += (v[0] + v[1]) + (v[2] + v[3]); }
            rsl[tid] = __builtin_amdgcn_rsqf(sq * (1.f / E_) + EPS); }
#pragma unroll
        for (int i = 0; i < 4; ++i) { const int chn = tid + NTHR * i, row = chn >> 4, c16 = chn & 15;
            *(LAS u32x4*)(lds + SG_WOFF + row * SG_WSTR + c16 * 16) = *(const u32x4*)(SW + (size_t)g * 128 * 128 + row * 128 + c16 * 8); }
        __syncthreads();
#pragma unroll
        for (int i = 0; i < 8; ++i) { const int chn = tid + NTHR * i, sr = chn >> 5, c8 = chn & 31; float v[8]; unpack8(*(const u32x4*)(VR + (size_t)(rbase + sr) * E_ + 256 * g + 8 * c8), v);
            const float r = rsl[sr]; const f32x4 g0 = *(const f32x4*)(gn + 256 * g + 8 * c8), g1 = *(const f32x4*)(gn + 256 * g + 8 * c8 + 4); f32x4 a, b2;
#pragma unroll
            for (int e = 0; e < 4; ++e) { a[e] = v[e] * r * g0[e]; b2[e] = v[4 + e] * r * g1[e]; }
            *(LAS u32x4*)(lds + sr * SG_VSTR + c8 * 16) = pack8(a, b2); }
        __syncthreads();
        f32x16 acc[4];
#pragma unroll
        for (int ti = 0; ti < 4; ++ti) acc[ti] = (f32x16){};
        const LAS unsigned char* abase = lds + (8 * hh + ((lane & 15) >> 2)) * SG_VSTR + (32 * wid + 16 * ((lane >> 4) & 1) + 4 * (lane & 3)) * 2;
#pragma unroll
        for (int s2 = 0; s2 < 8; ++s2) {
            const v4i16_t lo = __builtin_amdgcn_ds_read_tr16_b64_v4i16((LAS v4i16_t*)(abase + (16 * s2) * SG_VSTR));
            const v4i16_t hi = __builtin_amdgcn_ds_read_tr16_b64_v4i16((LAS v4i16_t*)(abase + (16 * s2 + 4) * SG_VSTR));
            const bf16x8 a = (bf16x8){lo[0], lo[1], lo[2], lo[3], hi[0], hi[1], hi[2], hi[3]};
#pragma unroll
            for (int ti = s2 >> 1; ti < 4; ++ti) { const bf16x8 b = *(const LAS bf16x8*)(lds + SG_WOFF + (32 * ti + c) * SG_WSTR + (16 * s2 + 8 * hh) * 2);
                acc[ti] = __builtin_amdgcn_mfma_f32_32x32x16_bf16(a, b, acc[ti], 0, 0, 0); }
        }
#pragma unroll
        for (int ti = 0; ti < 4; ++ti) { const int t = 32 * ti + c; const size_t row = (size_t)(rbase + t); const float bias = bsv[g * 128 + t];
#pragma unroll
            for (int g4 = 0; g4 < 4; ++g4) { const int d = 256 * g + 32 * wid + 8 * g4 + 4 * hh; const u32x2 uz = *(const u32x2*)(UZ + row * E_ + d);
                u32x2 w; w.x = pk2(bflo(uz.x) * (acc[ti][4 * g4] + bias), bfhi(uz.x) * (acc[ti][4 * g4 + 1] + bias)); w.y = pk2(bflo(uz.y) * (acc[ti][4 * g4 + 2] + bias), bfhi(uz.y) * (acc[ti][4 * g4 + 3] + bias));
                *(u32x2*)(A2 + row * KOUT + d) = w; } }
    }
}

__device__ __forceinline__ void sgu_sample_phase(Frame& F, int j) {
    const bf16_t* UZ = (const bf16_t*)(F.ws + WS_B0); const bf16_t* VR = (const bf16_t*)(F.ws + WS_B1); const float* SSV = (const float*)(F.ws + WS_SSV);
    const bf16_t* SW = (const bf16_t*)(F.ws + WS_SGUW) + (size_t)j * 8 * 128 * 128; bf16_t* A2 = (bf16_t*)(F.ws + WS_A2);
    const float* gn = GIN(14) + (size_t)j * E_; const float* bsv = GIN(16) + (size_t)j * 8 * 128; float* cvout = F.out + O_CV + (size_t)j * SBT * SSEQ * E_;
    const int gw = F.bid * NWAVES + F.wave, NGW = F.G * NWAVES, lane = F.lane;
    for (int task = gw; task < SBT * 8; task += NGW) {
        const int b = task >> 3, g = task & 7; const size_t r0 = (size_t)MP + b * SSEQ; const int ch = 256 * g + 4 * lane;
        float rs[SSEQ];
#pragma unroll
        for (int t = 0; t < SSEQ; ++t) { float v = lane < 32 ? SSV[(r0 + t) * 32 + lane] : 0.f; v = wave_sum(v); rs[t] = __builtin_amdgcn_rsqf(v * (1.f / E_) + EPS); }
        const f32x4 g4 = *(const f32x4*)(gn + ch);
        f32x4 vn[SSEQ];
#pragma unroll
        for (int t = 0; t < SSEQ; ++t) { const u32x2 w = *(const u32x2*)(VR + (r0 + t) * E_ + ch); const f32x4 v = (f32x4){bflo(w.x), bfhi(w.x), bflo(w.y), bfhi(w.y)}; vn[t] = v * rs[t] * g4;
            *(f32x4*)(cvout + (size_t)(b * SSEQ + t) * E_ + ch) = vn[t];
            u32x2 q; q.x = pk2(vn[t][0], vn[t][1]); q.y = pk2(vn[t][2], vn[t][3]); vn[t] = (f32x4){bflo(q.x), bfhi(q.x), bflo(q.y), bfhi(q.y)}; }
#pragma unroll
        for (int t = 0; t < SSEQ; ++t) { f32x4 a = {0.f, 0.f, 0.f, 0.f};
#pragma unroll
            for (int sq = 0; sq <= t; ++sq) a += vn[sq] * bf2f(SW[(size_t)g * 128 * 128 + t * 128 + sq]);
            a += bsv[g * 128 + t];
            const u32x2 uz = *(const u32x2*)(UZ + (r0 + t) * E_ + ch);
            u32x2 w; w.x = pk2(bflo(uz.x) * a[0], bfhi(uz.x) * a[1]); w.y = pk2(bflo(uz.y) * a[2], bfhi(uz.y) * a[3]);
            *(u32x2*)(A2 + (r0 + t) * KOUT + ch) = w; }
    }
}

__device__ __forceinline__ void conv_phase(Frame& F) {
    const bf16_t* P = (const bf16_t*)(F.ws + WS_B0); const bf16_t* G = (const bf16_t*)(F.ws + WS_B1); bf16_t* A2 = (bf16_t*)(F.ws + WS_A2);
    const float* cw = GIN(18); const float* st = GIN(5);
    for (int i = F.bid * NTHR + F.tid; i < (M / 32) * 256; i += F.G * NTHR) {
        const int seg = i >> 8, c0 = (i & 255) * 8, r0 = seg * 32;
        float w0[8], w1[8], w2[8];
#pragma unroll
        for (int e = 0; e < 8; ++e) { w0[e] = cw[c0 + e]; w1[e] = cw[E_ + c0 + e]; w2[e] = cw[2 * E_ + c0 + e]; }
        float x1[8], x2[8];
        if (r0 < MP) { if ((r0 & (PSEQ - 1)) == 0) { for (int e = 0; e < 8; ++e) { x1[e] = 0.f; x2[e] = 0.f; } }
                       else { unpack8(*(const u32x4*)(P + (size_t)(r0 - 1) * E_ + c0), x1); unpack8(*(const u32x4*)(P + (size_t)(r0 - 2) * E_ + c0), x2); } }
#pragma unroll 4
        for (int rr = 0; rr < 32; ++rr) {
            const int row = r0 + rr;
            if (row >= MP && ((row - MP) & 3) == 0) { const float* buf = st + (size_t)((row - MP) >> 2) * 2 * E_ + c0;
                for (int e = 0; e < 8; ++e) { x2[e] = buf[e]; x1[e] = buf[E_ + e]; } }
            float x0[8], gg[8]; unpack8(*(const u32x4*)(P + (size_t)row * E_ + c0), x0); unpack8(*(const u32x4*)(G + (size_t)row * E_ + c0), gg);
            f32x4 o0, o1;
#pragma unroll
            for (int e = 0; e < 8; ++e) { const float y = w0[e] * x2[e] + w1[e] * x1[e] + w2[e] * x0[e]; const float r = y * gg[e]; if (e < 4) o0[e] = r; else o1[e - 4] = r; x2[e] = x1[e]; x1[e] = x0[e]; }
            *(u32x4*)(A2 + (size_t)row * KOUT + c0) = pack8(o0, o1);
        }
    }
}

__device__ __forceinline__ void s5_sample_phase(Frame& F) {
    const bf16_t* U = (const bf16_t*)(F.ws + WS_B0); bf16_t* GBo = (bf16_t*)(F.ws + WS_GB); const float* TAB = (const float*)(F.ws + WS_TAB);
    const float* cre = GIN(25); const float* cim = GIN(26); const float* dsk = GIN(27);
    const int gw = F.bid * NWAVES + F.wave, NGW = F.G * NWAVES, lane = F.lane;
    for (int task = gw; task < S5G * (SBT / 16); task += NGW) {
        const int g = task & (S5G - 1), bc = task >> 7, gp = g * S5P + lane;
        const float ar = TAB[T_AR + gp], ai = TAB[T_AI + gp];
        float bbr[16], bbi[16], cr[16], ci[16];
#pragma unroll
        for (int i = 0; i < 16; ++i) { bbr[i] = TAB[T_BBR + (size_t)gp * 16 + i]; bbi[i] = TAB[T_BBI + (size_t)gp * 16 + i]; cr[i] = cre[((size_t)g * 16 + i) * S5P + lane]; ci[i] = cim[((size_t)g * 16 + i) * S5P + lane]; }
        const float dmine = dsk[g * 16 + (lane >> 2)];
        for (int bi = 0; bi < 16; ++bi) {
            const int sq = bc * 16 + bi; const size_t rbase = (size_t)MP + sq * SSEQ; const size_t so = ((size_t)sq * S5G + g) * S5P + lane;
            float hr = GIN(6)[so], hi = GIN(7)[so];
            u32x4 ur[SSEQ][2];
#pragma unroll
            for (int t = 0; t < SSEQ; ++t) { const bf16_t* up = U + (rbase + t) * E_ + g * 16; ur[t][0] = *(const u32x4*)up; ur[t][1] = *(const u32x4*)(up + 8); }
#pragma unroll
            for (int t = 0; t < SSEQ; ++t) {
                float u[16]; { float a[8], b[8]; unpack8(ur[t][0], a); unpack8(ur[t][1], b);
#pragma unroll
                    for (int i = 0; i < 8; ++i) { u[i] = a[i]; u[8 + i] = b[i]; } }
                float br = 0.f, bi2 = 0.f;
#pragma unroll
                for (int i = 0; i < 16; ++i) { br += bbr[i] * u[i]; bi2 += bbi[i] * u[i]; }
                const float nhr = ar * hr - ai * hi + br, nhi = ar * hi + ai * hr + bi2; hr = nhr; hi = nhi;
                float v[16];
#pragma unroll
                for (int i = 0; i < 16; ++i) v[i] = cr[i] * hr - ci[i] * hi;
                float w8[8];
                { const bool up5 = (lane & 32) != 0;
#pragma unroll
                  for (int i = 0; i < 8; ++i) { const float keep = up5 ? v[8 + i] : v[i], send = up5 ? v[i] : v[8 + i]; w8[i] = keep + __shfl_xor(send, 32); } }
                float w4[4];
                { const bool upb = (lane & 16) != 0;
#pragma unroll
                  for (int i = 0; i < 4; ++i) { const float keep = upb ? w8[4 + i] : w8[i], send = upb ? w8[i] : w8[4 + i]; w4[i] = keep + __shfl_xor(send, 16); } }
                float w2[2];
                { const bool upb = (lane & 8) != 0;
#pragma unroll
                  for (int i = 0; i < 2; ++i) { const float keep = upb ? w4[2 + i] : w4[i], send = upb ? w4[i] : w4[2 + i]; w2[i] = keep + __shfl_xor(send, 8); } }
                float w1;
                { const bool upb = (lane & 4) != 0; const float keep = upb ? w2[1] : w2[0], send = upb ? w2[0] : w2[1]; w1 = keep + __shfl_xor(send, 4); }
                w1 += __shfl_xor(w1, 2); w1 += __shfl_xor(w1, 1);
                float umine = 0.f;
#pragma unroll
                for (int i = 0; i < 16; ++i) umine = ((lane >> 2) == i) ? u[i] : umine;
                const float y = w1 + dmine * umine;
                if ((lane & 3) == 0) GBo[(rbase + t) * E_ + g * 16 + (lane >> 2)] = f2bf(gelu_tanh(y));
                asm volatile("s_waitcnt vmcnt(0)" ::: "memory");
            }
            F.out[O_SRS + so] = hr; F.out[O_SIS + so] = hi;
        }
    }
}

#if XHALF_SHFL
__device__ __forceinline__ void xhalf(float v, float& lo, float& hi) { const int l_ = threadIdx.x & 31; lo = __shfl(v, l_); hi = __shfl(v, l_ + 32); }
#else
__device__ __forceinline__ void xhalf(float v, float& lo, float& hi) { auto rr = __builtin_amdgcn_permlane32_swap(__float_as_uint(v), __float_as_uint(v), false, false); lo = __uint_as_float(rr[0]); hi = __uint_as_float(rr[1]);
 }
#endif
__device__ __forceinline__ void cmuladd(float& xr, float& xi, float ar, float ai, float pr, float pi) { float t = fmaf(-ai, pi, xr); asm("" : "+v"(t)); xr = fmaf(ar, pr, t); xi = fmaf(ar, pi, fmaf(ai, pr, xi)); }
constexpr int S5_HSTR = 272, S5_UOFF = 32 * S5_HSTR, S5_OOFF = S5_UOFF + 1024, S5_HT = S5_OOFF + 4096;
__device__ __forceinline__ void s5_prompt_mfma(Frame& F) {
    const bf16_t* U = (const bf16_t*)(F.ws + WS_B0); bf16_t* GBo = (bf16_t*)(F.ws + WS_GB); const float* TAB = (const float*)(F.ws + WS_TAB);
    const float* cre = GIN(25); const float* cim = GIN(26); const float* dsk = GIN(27);
    const int lane = F.lane, wid = F.wave, c = lane & 31, hh = lane >> 5, col = lane & 15, fq = lane >> 4;
    LAS unsigned char* ht = F.lds + wid * S5_HT;
    for (int task = F.bid * NWAVES + wid; task < PB * S5G; task += F.G * NWAVES) {
        const int b = task >> 7, g = task & 127;
        bf16x8 bfr[2], bfi[2]; float p_r[2][4], p_i[2][4];
#pragma unroll
        for (int st = 0; st < 2; ++st) { const int gp = g * S5P + 32 * st + c;
            const float* pr = TAB + T_BBR + (size_t)gp * 16 + 8 * hh; const float* pi = TAB + T_BBI + (size_t)gp * 16 + 8 * hh;
            bfr[st] = __builtin_bit_cast(bf16x8, pack8(*(const f32x4*)pr, *(const f32x4*)(pr + 4))); bfi[st] = __builtin_bit_cast(bf16x8, pack8(*(const f32x4*)pi, *(const f32x4*)(pi + 4)));
            const float ar = TAB[T_AR + gp], ai = TAB[T_AI + gp]; p_r[st][0] = ar; p_i[st][0] = ai;
#pragma unroll
            for (int n = 1; n < 4; ++n) { p_r[st][n] = p_r[st][n - 1] * ar - p_i[st][n - 1] * ai; p_i[st][n] = p_r[st][n - 1] * ai + p_i[st][n - 1] * ar; } }
        bf16x8 cf[4];
#pragma unroll
        for (int s4 = 0; s4 < 4; ++s4) { const size_t o = ((size_t)g * 16 + col) * S5P + 16 * s4 + 4 * fq; const f32x4 cr4 = *(const f32x4*)(cre + o), ci4 = *(const f32x4*)(cim + o);
            u32x4 w; w.x = pk2(cr4[0], -ci4[0]); w.y = pk2(cr4[1], -ci4[1]); w.z = pk2(cr4[2], -ci4[2]); w.w = pk2(cr4[3], -ci4[3]); cf[s4] = __builtin_bit_cast(bf16x8, w); }
        const f32x4 d4 = *(const f32x4*)(dsk + 16 * g + 4 * fq);
        float car_r[2] = {0.f, 0.f}, car_i[2] = {0.f, 0.f};
        const bf16_t* up = U + ((size_t)b * PSEQ + c) * E_ + 16 * g + 8 * hh;
        bf16x8 ub[4];
#pragma unroll
        for (int q = 0; q < 4; ++q) ub[q] = *(const GAS bf16x8*)(up + (size_t)q * 32 * E_);
        for (int tg = 0; tg < PSEQ / 128; ++tg) {
          bf16x8 nb[4];
#pragma unroll
          for (int q = 0; q < 4; ++q) nb[q] = *(const GAS bf16x8*)(up + (size_t)(4 * (tg + 1 < PSEQ / 128 ? tg + 1 : tg) + q) * 32 * E_);
#pragma unroll
          for (int q = 0; q < 4; ++q) {
            const int ti = 4 * tg + q; const bf16x8 ua = ub[q];
            *(LAS bf16x8*)(ht + S5_UOFF + c * 32 + hh * 16) = ua;
#pragma unroll
            for (int st = 0; st < 2; ++st) {
                f32x16 xr = __builtin_amdgcn_mfma_f32_32x32x16_bf16(ua, bfr[st], (f32x16){}, 0, 0, 0);
                f32x16 xi = __builtin_amdgcn_mfma_f32_32x32x16_bf16(ua, bfi[st], (f32x16){}, 0, 0, 0);
                const float a1r = p_r[st][0], a1i = p_i[st][0], a4r = p_r[st][3], a4i = p_i[st][3];
#pragma unroll
                for (int k = 0; k < 4; ++k)
#pragma unroll
                    for (int jj = 1; jj < 4; ++jj) { float tr = xr[4 * k + jj], tq = xi[4 * k + jj]; cmuladd(tr, tq, a1r, a1i, xr[4 * k + jj - 1], xi[4 * k + jj - 1]); xr[4 * k + jj] = tr; xi[4 * k + jj] = tq; }
                float er = car_r[st], ei = car_i[st], cin_r[4], cin_i[4];
#pragma unroll
                for (int k = 0; k < 4; ++k) {
                    float lor, hir, loi, hii; xhalf(xr[4 * k + 3], lor, hir); xhalf(xi[4 * k + 3], loi, hii);
                    const float c0r = er, c0i = ei;
                    float nr = lor, ni = loi; cmuladd(nr, ni, a4r, a4i, er, ei); er = nr; ei = ni;
                    const float c1r = er, c1i = ei;
                    nr = hir; ni = hii; cmuladd(nr, ni, a4r, a4i, er, ei); er = nr; ei = ni;
                    cin_r[k] = hh ? c1r : c0r; cin_i[k] = hh ? c1i : c0i;
                }
                car_r[st] = er; car_i[st] = ei;
#pragma unroll
                for (int k = 0; k < 4; ++k)
#pragma unroll
                    for (int jj = 0; jj < 4; ++jj) { float tr = xr[4 * k + jj], tq = xi[4 * k + jj]; cmuladd(tr, tq, p_r[st][jj], p_i[st][jj], cin_r[k], cin_i[k]);
                        *(LAS unsigned*)(ht + (8 * k + 4 * hh + jj) * S5_HSTR + 128 * st + 4 * c) = pk2(tr, tq); }
            }
            asm volatile("" ::: "memory");
#pragma unroll
            for (int tt = 0; tt < 2; ++tt) {
                f32x4 y = {0.f, 0.f, 0.f, 0.f};
#pragma unroll
                for (int s4 = 0; s4 < 4; ++s4) { const bf16x8 hb = *(const LAS bf16x8*)(ht + (16 * tt + col) * S5_HSTR + (32 * s4 + 8 * fq) * 2); y = __builtin_amdgcn_mfma_f32_16x16x32_bf16(cf[s4], hb, y, 0, 0, 0); }
                const size_t row = (size_t)b * PSEQ + 32 * ti + 16 * tt + col; const u32x2 uw = *(const LAS u32x2*)(ht + S5_UOFF + (16 * tt + col) * 32 + fq * 8);
                u32x2 w; w.x = pk2(gelu_tanh(y[0] + d4[0] * bflo(uw.x)), gelu_tanh(y[1] + d4[1] * bfhi(uw.x))); w.y = pk2(gelu_tanh(y[2] + d4[2] * bflo(uw.y)), gelu_tanh(y[3] + d4[3] * bfhi(uw.y)));
                *(LAS u32x2*)(ht + S5_OOFF + q * 1024 + (16 * tt + col) * 32 + fq * 8) = w;
            }
            asm volatile("" ::: "memory");
          }
#pragma unroll
          for (int q = 0; q < 4; ++q)
#pragma unroll
            for (int tt = 0; tt < 2; ++tt) *(GAS u32x2*)(GBo + ((size_t)b * PSEQ + 32 * (4 * tg + q) + 16 * tt + col) * E_ + 16 * g + 4 * fq) = *(const LAS u32x2*)(ht + S5_OOFF + q * 1024 + (16 * tt + col) * 32 + fq * 8);
          asm volatile("s_waitcnt vmcnt(0)" ::: "memory");
#pragma unroll
          for (int q = 0; q < 4; ++q) ub[q] = nb[q];
        }
        const size_t so = ((size_t)b * S5G + g) * S5P + 32 * hh + c;
        F.out[O_SRP + so] = hh ? car_r[1] : car_r[0]; F.out[O_SIP + so] = hh ? car_i[1] : car_i[0];
    }
}

constexpr int AK_STR = 272, AV_STR = 520, AV_OFF = 256 * AK_STR;
static_assert(AV_OFF + 128 * AV_STR <= RING_BYTES + 8192, "attention LDS");
__device__ __forceinline__ void attn_prompt_phase(Frame& F, int layer) {
    const bf16_t* QB = (const bf16_t*)(F.ws + WS_QB); const bf16_t* KBp = (const bf16_t*)(F.ws + WS_KB); const bf16_t* VTp = (const bf16_t*)(F.ws + WS_VT); bf16_t* A2 = (bf16_t*)(F.ws + WS_A2);
    const int tid = F.tid, lane = F.lane, wid = F.wave, c = lane & 31, hh = lane >> 5;
    LAS unsigned char* lds = F.lds;
    for (int un = F.bid; un < PB * NH * 8; un += F.G) {
        const int bh = un >> 3, qb = un & 7, b = bh >> 2, h = bh & 3;
        const bf16_t* Kg = KBp + (size_t)((layer * PB + b) * NH + h) * MEML * HD; const bf16_t* Vg = VTp + (size_t)((layer * PB + b) * NH + h) * MEML * HD;
        __syncthreads();
        { u32x4 kr[8], vr[8];
#pragma unroll
          for (int i = 0; i < 8; ++i) { const int chn = tid + NTHR * i; kr[i] = *(const u32x4*)(Kg + (chn >> 4) * HD + (chn & 15) * 8); vr[i] = *(const u32x4*)(Vg + (chn >> 5) * MEML + (chn & 31) * 8); }
#pragma unroll
          for (int i = 0; i < 8; ++i) { const int chn = tid + NTHR * i, row = chn >> 4, c16 = chn & 15; *(LAS u32x4*)(lds + row * AK_STR + c16 * 16) = kr[i]; }
#pragma unroll
          for (int i = 0; i < 8; ++i) { const int chn = tid + NTHR * i, row = chn >> 5, c16 = chn & 31; const u32x4 v = vr[i];
            LAS u32x2* p = (LAS u32x2*)(lds + AV_OFF + row * AV_STR + c16 * 16); u32x2 lo, hi; lo.x = v.x; lo.y = v.y; hi.x = v.z; hi.y = v.w; p[0] = lo; p[1] = hi; } }
        __syncthreads();
        const size_t qrow = (size_t)b * PSEQ + qb * 256 + wid * 32 + c;
        f32x16 S[8];
#pragma unroll
        for (int kt = 0; kt < 8; ++kt) S[kt] = (f32x16){};
#pragma unroll
        for (int s = 0; s < 8; ++s) {
            const bf16x8 qf = *(const bf16x8*)(QB + qrow * XA + h * HD + 16 * s + 8 * hh);
#pragma unroll
            for (int kt = 0; kt < 8; ++kt) { const bf16x8 kf = *(const LAS bf16x8*)(lds + (32 * kt + c) * AK_STR + (16 * s + 8 * hh) * 2); S[kt] = __builtin_amdgcn_mfma_f32_32x32x16_bf16(kf, qf, S[kt], 0, 0, 0); }
        }
        float mx = -3.0e38f;
#pragma unroll
        for (int kt = 0; kt < 8; ++kt)
#pragma unroll
            for (int r = 0; r < 16; ++r) mx = fmaxf(mx, S[kt][r]);
        mx = fmaxf(mx, __shfl_xor(mx, 32));
        float sum = 0.f; bf16x8 pf[8][2];
#pragma unroll
        for (int kt = 0; kt < 8; ++kt) {
            float p[16];
#pragma unroll
            for (int r = 0; r < 16; ++r) { p[r] = __expf(S[kt][r] - mx); sum += p[r]; }
#pragma unroll
            for (int s2 = 0; s2 < 2; ++s2) { u32x4 w; w.x = pk2(p[8 * s2], p[8 * s2 + 1]); w.y = pk2(p[8 * s2 + 2], p[8 * s2 + 3]); w.z = pk2(p[8 * s2 + 4], p[8 * s2 + 5]); w.w = pk2(p[8 * s2 + 6], p[8 * s2 + 7]);
                pf[kt][s2] = __builtin_bit_cast(bf16x8, w); }
        }
        sum += __shfl_xor(sum, 32);
        const float inv = 1.f / sum;
        bf16_t* orow = A2 + qrow * KOUT + E_ + h * HD;
#pragma unroll
        for (int dt = 0; dt < 4; ++dt) {
            f32x16 o = {};
#pragma unroll
            for (int kt = 0; kt < 8; ++kt)
#pragma unroll
                for (int s2 = 0; s2 < 2; ++s2) {
                    const LAS unsigned char* vb = lds + AV_OFF + (32 * dt + c) * AV_STR + (32 * kt + 16 * s2 + 4 * hh) * 2;
                    const u32x2 lo = *(const LAS u32x2*)vb, hi = *(const LAS u32x2*)(vb + 16);
                    u32x4 w; w.x = lo.x; w.y = lo.y; w.z = hi.x; w.w = hi.y;
                    o = __builtin_amdgcn_mfma_f32_32x32x16_bf16(__builtin_bit_cast(bf16x8, w), pf[kt][s2], o, 0, 0, 0);
                }
#pragma unroll
            for (int g4 = 0; g4 < 4; ++g4) { u32x2 w; w.x = pk2(o[4 * g4] * inv, o[4 * g4 + 1] * inv); w.y = pk2(o[4 * g4 + 2] * inv, o[4 * g4 + 3] * inv);
                *(u32x2*)(orow + 32 * dt + 8 * g4 + 4 * hh) = w; }
        }
    }
}

__device__ __forceinline__ void attn_sample_phase(Frame& F, int layer) {
    const bf16_t* QB = (const bf16_t*)(F.ws + WS_QB); bf16_t* A2 = (bf16_t*)(F.ws + WS_A2);
    const float* CK = GIN(3) + (size_t)layer * SBT * MEML * XA; const float* CV = GIN(4) + (size_t)layer * SBT * MEML * XA;
    LAS float* sl = (LAS float*)F.lds;
    LAS float* pt = (LAS float*)(F.lds + 4096);
    LAS float* ol = (LAS float*)(F.lds + 8192);
    const int tid = F.tid, lane = F.lane, wid = F.wave, par = lane >> 5, d4 = lane & 31;
    const size_t lane_off = ((size_t)(32 * wid + par) * NH) * HD + 4 * d4;
    f32x4 kr[16];
    int un = F.bid;
    if (un < SBT * NH) { const size_t o = (size_t)(un >> 2) * MEML * XA + (size_t)(un & 3) * HD + lane_off;
#pragma unroll
        for (int j = 0; j < 16; ++j) kr[j] = *(const f32x4*)(CK + o + (size_t)j * 2 * XA); }
    for (; un < SBT * NH; un += F.G) {
        const int b = un >> 2, h = un & 3; const int nun = un + F.G; const bool has_next = nun < SBT * NH;
        const size_t no = (size_t)((has_next ? nun : un) >> 2) * MEML * XA + (size_t)((has_next ? nun : un) & 3) * HD + lane_off;
        f32x4 vr[16];
        { const size_t co = (size_t)b * MEML * XA + (size_t)h * HD + lane_off;
#pragma unroll
          for (int j = 0; j < 16; ++j) vr[j] = *(const f32x4*)(CV + co + (size_t)j * 2 * XA); }
        f32x4 q4[4];
#pragma unroll
        for (int qi = 0; qi < 4; ++qi) { const u32x2 w = *(const u32x2*)(QB + (size_t)(MP + b * 4 + qi) * XA + h * HD + 4 * d4); q4[qi] = (f32x4){bflo(w.x), bfhi(w.x), bflo(w.y), bfhi(w.y)}; }
        asm volatile("s_waitcnt vmcnt(0)" ::: "memory");
        __syncthreads();
        const bool b4 = (lane & 16) != 0, b3 = (lane & 8) != 0;
#pragma unroll
        for (int j = 0; j < 16; ++j) {
            float v[4];
#pragma unroll
            for (int qi = 0; qi < 4; ++qi) v[qi] = (kr[j][0] * q4[qi][0] + kr[j][1] * q4[qi][1]) + (kr[j][2] * q4[qi][2] + kr[j][3] * q4[qi][3]);
            const float w0 = (b4 ? v[2] : v[0]) + __shfl_xor(b4 ? v[0] : v[2], 16), w1 = (b4 ? v[3] : v[1]) + __shfl_xor(b4 ? v[1] : v[3], 16);
            float z = (b3 ? w1 : w0) + __shfl_xor(b3 ? w0 : w1, 8);
            z += __shfl_xor(z, 4); z += __shfl_xor(z, 2); z += __shfl_xor(z, 1);
            if ((lane & 7) == 0) sl[(2 * (int)b4 + (int)b3) * 256 + 32 * wid + 2 * j + par] = z;
        }
#pragma unroll
        for (int j = 0; j < 16; ++j) kr[j] = *(const f32x4*)(CK + no + (size_t)j * 2 * XA);
        __syncthreads();
        if (wid < 4) { float v[4], mx = -3.0e38f;
#pragma unroll
            for (int j = 0; j < 4; ++j) { v[j] = sl[wid * 256 + lane + 64 * j]; mx = fmaxf(mx, v[j]); }
            mx = wave_max(mx); float sm = 0.f;
#pragma unroll
            for (int j = 0; j < 4; ++j) { v[j] = __expf(v[j] - mx); sm += v[j]; }
            sm = wave_sum(sm); const float inv = 1.f / sm;
#pragma unroll
            for (int j = 0; j < 4; ++j) pt[(lane + 64 * j) * 4 + wid] = v[j] * inv; }
        __syncthreads();
        f32x4 o[4];
#pragma unroll
        for (int qi = 0; qi < 4; ++qi) o[qi] = (f32x4){0.f, 0.f, 0.f, 0.f};
#pragma unroll
        for (int j = 0; j < 16; ++j) { const f32x4 p = *(const LAS f32x4*)(pt + (32 * wid + 2 * j + par) * 4);
#pragma unroll
            for (int qi = 0; qi < 4; ++qi) o[qi] += vr[j] * p[qi]; }
#pragma unroll
        for (int qi = 0; qi < 4; ++qi) {
#pragma unroll
            for (int e = 0; e < 4; ++e) o[qi][e] += __shfl_xor(o[qi][e], 32);
            if (par == 0) *(LAS f32x4*)(ol + (wid * 4 + qi) * 128 + 4 * d4) = o[qi]; }
        __syncthreads();
        { const int qi = tid >> 7, d = tid & 127; float acc = 0.f;
#pragma unroll
          for (int w = 0; w < 8; ++w) acc += ol[(w * 4 + qi) * 128 + d];
          A2[(size_t)(MP + b * 4 + qi) * KOUT + E_ + h * HD + d] = f2bf(acc); }
    }
}

constexpr int NK_OUT = 10, NK_GLU = 8;
__device__ __forceinline__ void fixup_out_rows(Frame& F, const float* basef  , int vb, int nvb  ) {
    for (int r = vb * NWAVES + F.wave; r < MS; r += nvb * NWAVES) {
        const int lane = F.lane; const float* slab = (const float*)(F.ws + WS_SLAB);
        bf16_t* XB = (bf16_t*)(F.ws + WS_XB) + (size_t)(MP + r) * DM; float ss = 0.f;
#pragma unroll
        for (int j = 0; j < 4; ++j) { f32x4 v;
            if (basef) v = *((const f32x4*)(basef + (size_t)r * DM) + lane + 64 * j);
            else { const u32x2 w = *((const u32x2*)XB + lane + 64 * j); v = (f32x4){bflo(w.x), bfhi(w.x), bflo(w.y), bfhi(w.y)}; }
#pragma unroll
            for (int ks = 0; ks < NK_OUT; ++ks) v += *((const f32x4*)(slab + ((size_t)ks * MS + r) * DM) + lane + 64 * j);
            u32x2 w; w.x = pk2(v[0], v[1]); w.y = pk2(v[2], v[3]); *((u32x2*)XB + lane + 64 * j) = w;
            ss += (v[0] * v[0] + v[1] * v[1]) + (v[2] * v[2] + v[3] * v[3]); }
        asm volatile("s_waitcnt vmcnt(0)" ::: "memory");
        ss = wave_sum(ss);
        if (lane < 16) ((float*)(F.ws + WS_SSX))[(size_t)(MP + r) * 16 + lane] = lane == 0 ? ss : 0.f;
    }
}
__device__ __forceinline__ void fixup_glu_rows(Frame& F) {
    if (F.wave < 2) for (int r = F.bid * 2 + F.wave; r < MS; r += F.G * 2) {
        const int lane = F.lane; const float* slab = (const float*)(F.ws + WS_SLAB); const float* bias = GIN(29);
        const bf16_t* GBp = (const bf16_t*)(F.ws + WS_GB) + (size_t)(MP + r) * E_; const bf16_t* SZ = (const bf16_t*)(F.ws + WS_B1) + (size_t)(MP + r) * E_; bf16_t* A2 = (bf16_t*)(F.ws + WS_A2) + (size_t)(MP + r) * KOUT;
#pragma unroll
        for (int j = 0; j < 4; ++j) { const int c0 = 8 * (lane + 64 * j); f32x4 t0 = *(const f32x4*)(bias + c0), t1 = *(const f32x4*)(bias + c0 + 4);
#pragma unroll
            for (int ks = 0; ks < NK_GLU; ++ks) { const float* sp = slab + ((size_t)ks * MS + r) * E_ + c0; t0 += *(const f32x4*)sp; t1 += *(const f32x4*)(sp + 4); }
            float gv[8], sz[8]; unpack8(*(const u32x4*)(GBp + c0), gv); unpack8(*(const u32x4*)(SZ + c0), sz); f32x4 o0, o1;
#pragma unroll
            for (int e = 0; e < 4; ++e) { o0[e] = gv[e] * sigmoidf_(t0[e]) * sz[e]; o1[e] = gv[4 + e] * sigmoidf_(t1[e]) * sz[4 + e]; }
            *(u32x4*)(A2 + c0) = pack8(o0, o1); }
    }
}
__device__ __forceinline__ void counter_signal(unsigned* cnt) {
    asm volatile("s_waitcnt vmcnt(0)" ::: "memory"); __syncthreads();
    if (threadIdx.x == 0) { __builtin_amdgcn_fence(__ATOMIC_RELEASE, "agent"); asm volatile("s_waitcnt vmcnt(0)" ::: "memory"); __hip_atomic_fetch_add(cnt, 1u, __ATOMIC_RELAXED, __HIP_MEMORY_SCOPE_AGENT); }
}
__device__ __forceinline__ void counter_wait(unsigned* cnt, unsigned want) {
    if (threadIdx.x == 0) { unsigned sp = 0; while (__hip_atomic_load(cnt, __ATOMIC_RELAXED, __HIP_MEMORY_SCOPE_AGENT) < want) { __builtin_amdgcn_s_sleep(2); if (++sp > (1u << 22)) break; }
        __builtin_amdgcn_fence(__ATOMIC_ACQUIRE, "agent"); asm volatile("s_waitcnt vmcnt(0)" ::: "memory"); }
    __syncthreads();
}

__device__ __forceinline__ void final_row(Frame& F, int row) {
    const bf16_t* XBp = (const bf16_t*)(F.ws + WS_XB); const float* SSX = (const float*)(F.ws + WS_SSX); const float* fg = GIN(9); const int lane = F.lane;
    float s = lane < 16 ? SSX[(size_t)row * 16 + lane] : 0.f; s = wave_sum(s);
    const float r = __builtin_amdgcn_rsqf(s * (1.f / DM) + EPS);
    float* o = row < MP ? F.out + O_YP + (size_t)row * DM : F.out + O_YS + (size_t)(row - MP) * DM;
#pragma unroll
    for (int j = 0; j < 4; ++j) { const u32x2 w = *((const u32x2*)(XBp + (size_t)row * DM) + lane + 64 * j); const f32x4 v = (f32x4){bflo(w.x), bfhi(w.x), bflo(w.y), bfhi(w.y)}; const f32x4 gq = *((const f32x4*)fg + lane + 64 * j); *((f32x4*)o + lane + 64 * j) = v * r * gq; }
}
__device__ __forceinline__ void final_phase(Frame& F) {
    const int gw = F.bid * NWAVES + F.wave, NGW = F.G * NWAVES;
    asm volatile("s_waitcnt vmcnt(0)" ::: "memory"); for (int r = F.bid * NWAVES + F.wave; r < MS; r += F.G * NWAVES) final_row(F, MP + r);
#pragma unroll 2
    for (int row = gw; row < MP; row += NGW) final_row(F, row);
}

#define XB_TMO      128
#define XB_XCNT(j)  (256  + 64 * (j))
#define XB_XSUB(j)  (1280 + 64 * (j))
#define XB_XGEN(j)  (2304 + 64 * (j))
#define XB_TOP      3328
#define XB_TOPGEN   3392
#define XCD_BAR_WORDS 3456
#define XB_SPIN_CAP (1u << 20)
__device__ __forceinline__ unsigned xb_ld(unsigned* p)              { return __hip_atomic_load(p, __ATOMIC_RELAXED, __HIP_MEMORY_SCOPE_AGENT); }
__device__ __forceinline__ unsigned xb_add(unsigned* p, unsigned v) { return __hip_atomic_fetch_add(p, v, __ATOMIC_RELAXED, __HIP_MEMORY_SCOPE_AGENT); }
__device__ __forceinline__ unsigned xb_xcc_id() { return (unsigned)__builtin_amdgcn_s_getreg((3 << 11) | 20) & 0xFu; }
#define XB_SPIN(cond, bar) do { unsigned _sp = 0; while (cond) { __builtin_amdgcn_s_sleep(1); \
    if ((++_sp & 255u) == 0u) { if (xb_ld(&(bar)[XB_TMO])) break; if (_sp > XB_SPIN_CAP) { atomicAdd(&(bar)[XB_TMO], 1u); break; } } } } while (0)
struct XcdBarrier { unsigned* bar; unsigned x; volatile LAS unsigned* st; };
__device__ __forceinline__ XcdBarrier xcd_barrier_post(unsigned* bar, volatile LAS unsigned* st) {
    XcdBarrier b; b.bar = bar; b.x = xb_xcc_id(); b.st = st;
    if (threadIdx.x == 0) (void)xb_add(&bar[XB_XCNT(b.x)], 1u);
    return b;
}
__device__ __forceinline__ void xcd_barrier_complete(unsigned* bar, unsigned x, unsigned& nloc, unsigned& nx) {
    const unsigned G = gridDim.x * gridDim.y * gridDim.z;
    unsigned sum, cnt, mine, sp = 0u;
    for (;;) {
        sum = 0u; cnt = 0u; mine = 0u;
#pragma unroll
        for (unsigned j = 0; j < 16; ++j) { const unsigned c = xb_ld(&bar[XB_XCNT(j)]); sum += c; cnt += (c > 0u) ? 1u : 0u; mine = (j == x) ? c : mine; }
        if (sum == G) break;
        __builtin_amdgcn_s_sleep(1);
        if ((++sp & 255u) == 0u) { if (xb_ld(&bar[XB_TMO])) break; if (sp > XB_SPIN_CAP) { atomicAdd(&bar[XB_TMO], 1u); break; } }
    }
    nloc = mine > 0u ? mine : 1u; nx = cnt > 0u ? cnt : 1u;
}
__device__ __forceinline__ void xcd_barrier(const XcdBarrier& b) {
    asm volatile("s_waitcnt vmcnt(0)" ::: "memory");
    __syncthreads();
    if (threadIdx.x == 0) {
        unsigned* bar = b.bar;
        __builtin_amdgcn_s_waitcnt(0);
        unsigned nloc = b.st[0], nx = b.st[1];
        if (nloc == 0u) { xcd_barrier_complete(bar, b.x, nloc, nx); b.st[0] = nloc; b.st[1] = nx; }
        const unsigned old = xb_add(&bar[XB_XSUB(b.x)], 1u);
        const unsigned gen = old / nloc;
        if (old + 1u == (gen + 1u) * nloc) {
            __builtin_amdgcn_fence(__ATOMIC_RELEASE, "agent");
            asm volatile("s_waitcnt vmcnt(0)" ::: "memory");
            const unsigned og = xb_add(&bar[XB_TOP], 1u);
            const unsigned tg = og / nx;
            if (og + 1u == (tg + 1u) * nx) xb_add(&bar[XB_TOPGEN], 1u);
            else XB_SPIN(xb_ld(&bar[XB_TOPGEN]) == tg, bar);
            __builtin_amdgcn_fence(__ATOMIC_ACQUIRE, "agent");
            xb_add(&bar[XB_XGEN(b.x)], 1u);
            asm volatile("s_waitcnt vmcnt(0)" ::: "memory");
        } else {
            XB_SPIN(xb_ld(&bar[XB_XGEN(b.x)]) == gen, bar);
            __builtin_amdgcn_fence(__ATOMIC_ACQUIRE, "agent");
            asm volatile("s_waitcnt vmcnt(0)" ::: "memory");
        }
    }
    __syncthreads();
}

constexpr int NPHASE = 15;
__global__ void __launch_bounds__(NTHR, 2) fwd_kernel(Args args) {
    extern __shared__ __attribute__((aligned(16))) unsigned char lds_raw[];
    Frame F; F.lds = (LAS unsigned char*)lds_raw; F.G = gridDim.x; F.bid = blockIdx.x;
    F.in = args.in; F.out = (float*)(GAS float*)args.out; F.ws = (unsigned char*)(GAS unsigned char*)args.ws;
    unsigned char* ws = F.ws;
#define REFRESH() do { int t_ = threadIdx.x; asm volatile("" : "+v"(t_)); F.tid = t_; F.lane = t_ & 63; F.wave = __builtin_amdgcn_readfirstlane(t_ >> 6); \
        GAS unsigned char* wsg_ = (GAS unsigned char*)args.ws; asm volatile("" : "+s"(wsg_)); ws = (unsigned char*)wsg_; F.ws = ws; } while (0)
    const int lo = args.ph_lo, hi = args.ph_hi;
#if MK_ONE_LAUNCH
    cg::grid_group grid = cg::this_grid();
    if (lo < 0) grid.sync();
    { volatile LAS unsigned* st0 = (volatile LAS unsigned*)(F.lds + LDS_BYTES - 64); if (threadIdx.x < 16) st0[threadIdx.x] = 0u; }
    __syncthreads();
    const XcdBarrier xbar = xcd_barrier_post((unsigned*)(args.ws + WS_CTL), (volatile LAS unsigned*)(F.lds + LDS_BYTES - 64));
#define SEAM(k) do { if (lo <= (k) && (k) + 1 < hi) xcd_barrier(xbar); } while (0)
#else
#define SEAM(k) do { } while (0)
#endif
#ifndef PHASE_MASK
#define PHASE_MASK 0x7fff
#endif
#define REP(k) for (int rep_ = 0; rep_ <= (((PROBE_REP_MASK) >> (k)) & 1); ++rep_)
#define WSSEL(bit) do { if ((FLAT_FN_MASK >> (bit)) & 1) { unsigned char* w_ = args.ws; asm volatile("" : "+s"(w_)); F.ws = w_; } else { GAS unsigned char* g_ = (GAS unsigned char*)args.ws; asm volatile("" : "+s"(g_)); F.ws = (unsigned char*)g_; } } while (0)
#define IN(k) ((((PHASE_MASK) >> (k)) & 1) && lo <= (k) && (k) < hi)
#define XB ((bf16_t*)(ws + WS_XB))
#define X ((float*)(ws + WS_X))
#define SSX ((float*)(ws + WS_SSX))
#define SSV ((float*)(ws + WS_SSV))
#define B0 ((bf16_t*)(ws + WS_B0))
#define B1 ((bf16_t*)(ws + WS_B1))
#define QBp ((bf16_t*)(ws + WS_QB))
#define A2 ((bf16_t*)(ws + WS_A2))
#define GBp ((bf16_t*)(ws + WS_GB))
    const int G = F.G, bid = F.bid;

    if (IN(0)) REP(0) { REFRESH(); WSSEL(0); p0_prologue(F); __syncthreads(); } SEAM(0);
#define CNT(k) ((unsigned*)(ws + WS_CTL) + 4096 + 64 * (k))
#define WOUT(l) ((const bf16_t*)(ws + WS_WOUT) + (size_t)(l) * DM * KOUT)
#define INPROJ(EpiT, E, W, N, cnt, want) do { \
        pg8::Gemm g{XB, (W), M, (N), DM, DM}; pg8::StaticOrder S; S.init(MP, (N), G, bid); pg8::gemm_phase<EpiT, pg8::StaticOrder, true, true>(F.lds, g, S, E); \
        if (cnt) counter_wait(cnt, (unsigned)(want)); \
        const int rem = ((MP / 256) * ((N) / 256)) % G; pg8::StaticOrder S2; S2.init(MS, (N), G, (bid + G - rem) % G, MP / 256); pg8::gemm_phase<EpiT, pg8::StaticOrder, true, true>(F.lds, g, S2, E); } while (0)
#define OUTPROJ_PROMPT(l, bp) do { pg8::Gemm g{A2, WOUT(l), M, DM, KOUT, KOUT}; pg8::StaticOrder S; S.init(MP, DM, G, bid); EpiOut E{(bp), XB, SSX}; pg8::gemm_phase<EpiOut, pg8::StaticOrder, true, true>(F.lds, g, S, E); } while (0)
#define OUTPROJ_SLICES(l, c, nb) do { pg8::Gemm g{A2, WOUT(l), M, DM, 256, KOUT}; typedef pg8::SliceOrder<MS / 256, DM / 256, NK_OUT> SO; SO S; S.init((nb), (c), MP / 256); \
        EpiSlab E{(float*)(ws + WS_SLAB), DM, MP, (size_t)MS * DM}; pg8::gemm_phase<EpiSlab, SO, true, true>(F.lds, g, S, E); } while (0)
#define SLICEFIX(l, sb0, basef, cA, cB) do { if (bid >= (sb0)) { const int nsb_ = G - (sb0); OUTPROJ_SLICES(l, bid - (sb0), nsb_); counter_signal(cA); counter_wait(cA, (unsigned)nsb_); \
        fixup_out_rows(F, (basef), bid - (sb0), nsb_); counter_signal(cB); } } while (0)
#define KVPROJ(l, c0) do { pg8::Gemm g{(const bf16_t*)(ws + WS_MEMB), (const bf16_t*)(ws + WS_WKV) + (size_t)(l) * DM * DM, PB * MEML, DM, DM, DM}; pg8::StaticOrder S; S.init(g.M, g.N, G, (bid + G - (c0)) % G); \
        EpiKV E{(const float*)(ws + WS_RSTDM), F.out + O_MK, F.out + O_MV, (bf16_t*)(ws + WS_KB), (bf16_t*)(ws + WS_VT), (l)}; pg8::gemm_phase<EpiKV, pg8::StaticOrder, true, true>(F.lds, g, S, E); } while (0)
    if (IN(1)) REP(1) { REFRESH();
        { EpiInA E{SSX, B0, B1, QBp, SSV}; INPROJ(EpiInA, E, (const bf16_t*)(ws + WS_WINA), NIN_A, (unsigned*)nullptr, 0); }
        KVPROJ(0, 180); KVPROJ(1, 212);
    } SEAM(1);
    if (IN(2)) REP(2) { REFRESH(); WSSEL(1);
        sgu_phase_mfma(F, 0); sgu_sample_phase(F, 0); attn_prompt_phase(F, 0); attn_sample_phase(F, 0); } SEAM(2);
    if (IN(3)) REP(3) { REFRESH(); OUTPROJ_PROMPT(0, GIN(0)); } SEAM(3);
    if (IN(4)) REP(4) { REFRESH(); SLICEFIX(0, 196, GIN(1), CNT(0), CNT(4));
        EpiInB E{SSX, B0, B1, QBp, F.out + O_CP, F.out + O_CS}; INPROJ(EpiInB, E, (const bf16_t*)(ws + WS_WINB), NIN_B, CNT(4), G - 196); } SEAM(4);
    if (IN(5)) REP(5) { REFRESH(); WSSEL(3);
        conv_phase(F); attn_prompt_phase(F, 1); attn_sample_phase(F, 1); } SEAM(5);
    if (IN(6)) REP(6) { REFRESH(); OUTPROJ_PROMPT(1, (const float*)nullptr); } SEAM(6);
    if (IN(7)) REP(7) { REFRESH(); SLICEFIX(1, 196, (const float*)nullptr, CNT(1), CNT(5));
        EpiInC E{SSX, B0, B1, QBp}; INPROJ(EpiInC, E, (const bf16_t*)(ws + WS_WINC), NIN_C, CNT(5), G - 196); KVPROJ(2, 164); } SEAM(7);
    if (IN(8)) REP(8) { REFRESH();
        const int half = G / 2;
        if (bid < half) { F.G = half; WSSEL(4); s5_prompt_mfma(F); if (PROBE_SUB_MASK & 8) s5_prompt_mfma(F); }
        else { F.bid = bid - half; F.G = G - half; for (int r2 = 0; r2 <= ((PROBE_SUB_MASK >> 4) & 1); ++r2) { WSSEL(6); attn_prompt_phase(F, 2); WSSEL(7); attn_sample_phase(F, 2); WSSEL(5); s5_sample_phase(F); } }
        F.bid = bid; F.G = G; } SEAM(8);
    if (IN(9)) REP(9) { REFRESH();
        { pg8::Gemm g{GBp, (const bf16_t*)(ws + WS_WGLU), M, E_, E_, E_}; pg8::StaticOrder S; S.init(MP, E_, G, bid); EpiGlu E{GBp, B1, GIN(29), A2}; pg8::gemm_phase<EpiGlu, pg8::StaticOrder, true, true>(F.lds, g, S, E); }
        { pg8::Gemm g{GBp, (const bf16_t*)(ws + WS_WGLU), M, E_, 256, E_}; typedef pg8::SliceOrder<MS / 256, E_ / 256, NK_GLU> SG; SG S; S.init(G, bid, MP / 256); EpiSlab E{(float*)(ws + WS_SLAB), E_, MP, (size_t)MS * E_}; pg8::gemm_phase<EpiSlab, SG, true, true>(F.lds, g, S, E); } } SEAM(9);
    if (IN(10)) REP(10) { REFRESH(); fixup_glu_rows(F);
        OUTPROJ_PROMPT(2, (const float*)nullptr); } SEAM(10);
    if (IN(11)) REP(11) { REFRESH(); SLICEFIX(2, 212, (const float*)nullptr, CNT(3), CNT(6));
        EpiInA E{SSX, B0, B1, QBp, SSV}; INPROJ(EpiInA, E, (const bf16_t*)(ws + WS_WINA) + (size_t)NIN_A * DM, NIN_A, CNT(6), G - 212); KVPROJ(3, 180); } SEAM(11);
    if (IN(12)) REP(12) { REFRESH(); WSSEL(1);
        sgu_phase_mfma(F, 1); sgu_sample_phase(F, 1); attn_prompt_phase(F, 3); attn_sample_phase(F, 3); } SEAM(12);
    if (IN(13)) REP(13) { REFRESH(); OUTPROJ_PROMPT(3, (const float*)nullptr); OUTPROJ_SLICES(3, bid, G); } SEAM(13);
    if (IN(14)) REP(14) { REFRESH(); WSSEL(8); fixup_out_rows(F, (const float*)nullptr, bid, G); final_phase(F); }
#undef CNT
#undef WOUT
#undef KVPROJ
#undef INPROJ
#undef OUTPROJ_PROMPT
#undef OUTPROJ_SLICES
#undef SLICEFIX
#undef IN
#undef REP
#undef SEAM
#undef XB
#undef X
#undef SSX
#undef SSV
#undef B0
#undef B1
#undef QBp
#undef A2
#undef GBp
#undef REFRESH
}

extern "C" void kernel_launch(void* const* d_in, const int* in_sizes, int n_in, void* d_out, int out_size, void* d_ws, size_t ws_size, hipStream_t stream) {
    static int grid = 0;
    if (grid == 0) {
        if (n_in != 30 || out_size != (int)O_END || ws_size < WS_END) { fprintf(stderr, "kernel_launch: unexpected shapes (n_in %d out %d ws %zu)\n", n_in, out_size, ws_size); grid = -1; return; }
        int dev = 0, cus = 0, per_cu = 0;
        (void)hipGetDevice(&dev); (void)hipDeviceGetAttribute(&cus, hipDeviceAttributeMultiprocessorCount, dev);
        if (hipFuncSetAttribute((const void*)fwd_kernel, hipFuncAttributeMaxDynamicSharedMemorySize, LDS_BYTES) != hipSuccess) { fprintf(stderr, "kernel_launch: hipFuncSetAttribute failed\n"); grid = -1; return; }
        if (hipOccupancyMaxActiveBlocksPerMultiprocessor(&per_cu, (const void*)fwd_kernel, NTHR, LDS_BYTES) != hipSuccess || per_cu < 1) { fprintf(stderr, "kernel_launch: occupancy query says %d\n", per_cu); (void)hipGetLastError(); per_cu = 1; }
        grid = cus;
    }
    if (grid < 0) return;
    Args a{};
    for (int i = 0; i < 30; ++i) a.in[i] = (const float*)d_in[i];
    a.out = (float*)d_out; a.ws = (unsigned char*)d_ws;
#if MK_ONE_LAUNCH
    (void)hipMemsetAsync((char*)d_ws + WS_CTL, 0, 65536, stream);
    a.ph_lo = 0; a.ph_hi = NPHASE;
    void* kargs[] = {&a};
    hipError_t e = hipLaunchCooperativeKernel((const void*)fwd_kernel, dim3(grid), dim3(NTHR), kargs, LDS_BYTES, stream);
    if (e != hipSuccess) fprintf(stderr, "cooperative launch failed: %s (grid %d)\n", hipGetErrorString(e), grid);
#else
    for (int p = 0; p < NPHASE; ++p) { a.ph_lo = p; a.ph_hi = p + 1; hipLaunchKernelGGL(fwd_kernel, dim3(grid), dim3(NTHR), LDS_BYTES, stream, a); }
#endif
}
```

```cpp
#include <hip/hip_runtime.h>
#include <hip/hip_cooperative_groups.h>
#include <cstdio>
#include <cstdint>
namespace cg = cooperative_groups;

#ifndef MK_ONE_LAUNCH
#define MK_ONE_LAUNCH 1
#endif
#ifndef XHALF_SHFL
#define XHALF_SHFL 0
#endif
#ifndef EPI_DRAIN
#define EPI_DRAIN 1
#endif
#ifndef FLAT_FN_MASK
#define FLAT_FN_MASK 0x00
#endif
#ifndef PROBE_SUB_MASK
#define PROBE_SUB_MASK 0
#endif
#ifndef PROBE_REP_MASK
#define PROBE_REP_MASK 0
#endif

namespace pg8 {
#define PG8_LAS __attribute__((address_space(3)))
typedef unsigned short bf16_t;
typedef short bf16x8 __attribute__((ext_vector_type(8)));
typedef float f32x4 __attribute__((ext_vector_type(4)));
typedef unsigned u32x4 __attribute__((ext_vector_type(4)));
typedef unsigned u32x2 __attribute__((ext_vector_type(2)));
constexpr int BM = 256, BK = 64, HALF = 128, HTB = HALF * BK * 2, STAGE_BYTES = 8 * HTB, NXCD = 8, WGM = 8;

__host__ __device__ __forceinline__ int lds_byte(int r, int c) { const int st = (r >> 4) * 2 + (c >> 5), rr = r & 15, cc = c & 31, ob = rr * 64 + cc * 2; return st * 1024 + (ob ^ (((ob >> 9) & 1) << 5)); }
__host__ __device__ __forceinline__ void stage_rc(int b, int& R, int& C) { const int st = b / 1024, sb = b % 1024, swz = sb ^ (((sb >> 9) & 1) << 5); R = (st >> 1) * 16 + swz / 64; C = (st & 1) * 32 + (swz % 64) / 2; }
__host__ __device__ __forceinline__ int perm32(int rho) { const int n = rho >> 4, i = rho & 15; return 8 * (i >> 2) + 4 * n + (i & 3); }

struct Unit { int pm, pn, ks; };
struct Gemm { const bf16_t* A; const bf16_t* Bt; int M, N, K, ld; };

struct StaticOrder {
    int nM, nN, nwg, G, c, pm0;
    __host__ __device__ void init(int M, int N, int G_, int c_, int pm0_ = 0) { nM = M / BM; nN = N / BM; nwg = nM * nN; G = G_; c = c_; pm0 = pm0_; }
    __host__ __device__ bool next(int i, Unit& u) const {
        const long L = (long)i * G + c; if (L >= nwg) return false;
        int wgid = (int)L; { const int q = nwg / NXCD, r = nwg % NXCD, xcd = wgid % NXCD, off = wgid / NXCD; wgid = (xcd < r ? xcd * (q + 1) : r * (q + 1) + (xcd - r) * q) + off; }
        const int nig = WGM * nN, gid = wgid / nig, fm = gid * WGM, gsz = (nM - fm) < WGM ? (nM - fm) : WGM;
        u.pm = pm0 + fm + ((wgid % nig) % gsz); u.pn = (wgid % nig) / gsz; u.ks = 0; return true;
    }
    __device__ __forceinline__ void a_ready(const Unit&) const {}
    __device__ __forceinline__ void done(const Unit&) const {}
};
template <int NM_, int NN_, int NK_> struct SliceOrder {
    int G, c, pm0;
    __host__ __device__ void init(int G_, int c_, int pm0_) { G = G_; c = c_; pm0 = pm0_; }
    __host__ __device__ bool next(int i, Unit& u) const {
        const int L = i * G + c; if (L >= NM_ * NN_ * NK_) return false;
        const int t = L / NK_; u.ks = L % NK_; u.pn = t % NN_; u.pm = pm0 + t / NN_; return true;
    }
    __device__ __forceinline__ void a_ready(const Unit&) const {}
    __device__ __forceinline__ void done(const Unit&) const {}
};

template <class Epi, class Sched, bool ALIGN_EPI = false, bool SP2 = false>
__device__ __forceinline__ void gemm_phase(PG8_LAS unsigned char* lds, const Gemm g, const Sched& S, const Epi& E) {
    int tid = threadIdx.x; asm volatile("" : "+v"(tid));
    const int wid = __builtin_amdgcn_readfirstlane(tid >> 6), lane = tid & 63, wr = wid >> 2, wc = wid & 3, fr = lane & 15, fq = lane >> 4;
    const int K = g.K, ld = g.ld, nt = K / BK;
    unsigned voffA[2], voffB[2];
#pragma unroll
    for (int i = 0; i < 2; ++i) { int R, C; stage_rc(tid * 16 + i * 8192, R, C); const int Rb = Epi::PERM ? ((R & ~31) + perm32(R & 31)) : R;
        voffA[i] = (unsigned)(R * ld + C) * 2u; voffB[i] = (unsigned)(Rb * ld + C) * 2u; }
    const size_t kstep = (size_t)(BK * 2);
    const size_t hstep = (size_t)HALF * ld * 2;
    const size_t sstep = (size_t)K * 2;
    const size_t tstep = 2 * hstep;
    const unsigned ldsw = (unsigned)wid * 1024u;
    const int aoff = lds_byte(wr * 64 + fr, fq * 8), boff = lds_byte(wc * 32 + fr, fq * 8);
#define PG8_SA(b, h) (((b) * 2 + (h)) * HTB)
#define PG8_SB(b, h) ((4 + (b) * 2 + (h)) * HTB)
#define PG8_STAGE(bufoff, gbase, voff) do { _Pragma("unroll") for (int _i = 0; _i < 2; ++_i) \
        __builtin_amdgcn_global_load_lds((const unsigned*)((const char*)(gbase) + (voff)[_i]), (PG8_LAS unsigned*)(lds + (bufoff) + ldsw + _i * 8192), 16, 0, 0); } while (0)
#define PG8_LDA(dst, b, h) do { _Pragma("unroll") for (int m = 0; m < 4; ++m) _Pragma("unroll") for (int k = 0; k < 2; ++k) dst[m][k] = *(const PG8_LAS bf16x8*)(lds + PG8_SA(b, h) + aoff + m * 2048 + k * 1024); } while (0)
#define PG8_LDB(dst, b, h) do { _Pragma("unroll") for (int n = 0; n < 2; ++n) _Pragma("unroll") for (int k = 0; k < 2; ++k) dst[n][k] = *(const PG8_LAS bf16x8*)(lds + PG8_SB(b, h) + boff + n * 2048 + k * 1024); } while (0)
#define PG8_MMA(ai, bj, At, Bt) do { __builtin_amdgcn_s_setprio(1); _Pragma("unroll") for (int m = 0; m < 4; ++m) _Pragma("unroll") for (int n = 0; n < 2; ++n) _Pragma("unroll") for (int k = 0; k < 2; ++k) \
        acc[ai][bj][m][n] = __builtin_amdgcn_mfma_f32_16x16x32_bf16(Bt[n][k], At[m][k], acc[ai][bj][m][n], 0, 0, 0); __builtin_amdgcn_s_setprio(0); } while (0)
#define PG8_WAIT_V(n) asm volatile("s_waitcnt vmcnt(" #n ")" ::: "memory")
#define PG8_WAIT_L(n) asm volatile("s_waitcnt lgkmcnt(" #n ")" ::: "memory")
#define PG8_BAR __builtin_amdgcn_s_barrier()
#define PG8_SCHED __builtin_amdgcn_sched_barrier(0)
    Unit cur, nxt; int ui = 0;
    if (!S.next(0, cur)) return;
    f32x4 acc[2][2][4][2];
#pragma unroll
    for (int a = 0; a < 2; ++a)
#pragma unroll
        for (int b = 0; b < 2; ++b)
#pragma unroll
            for (int m = 0; m < 4; ++m)
#pragma unroll
                for (int n = 0; n < 2; ++n) acc[a][b][m][n] = (f32x4){0.f, 0.f, 0.f, 0.f};
    bf16x8 At[4][2], B0[2][2], B1[2][2];
    const char* cA = (const char*)g.A + (size_t)cur.pm * tstep + (size_t)cur.ks * sstep; const char* cB = (const char*)g.Bt + (size_t)cur.pn * tstep + (size_t)cur.ks * sstep;
    S.a_ready(cur);
    if constexpr (SP2) {
        PG8_STAGE(PG8_SB(0, 0), cB, voffB); PG8_STAGE(PG8_SB(0, 1), cB + hstep, voffB); PG8_STAGE(PG8_SA(0, 0), cA, voffA); PG8_STAGE(PG8_SA(0, 1), cA + hstep, voffA);
        if (wr == 1) PG8_BAR;
        PG8_WAIT_V(2); PG8_BAR;
        PG8_STAGE(PG8_SB(1, 0), cB + kstep, voffB); PG8_STAGE(PG8_SA(1, 0), cA + kstep, voffA); PG8_STAGE(PG8_SB(1, 1), cB + hstep + kstep, voffB);
        PG8_WAIT_V(6); PG8_BAR;
    } else {
        PG8_STAGE(PG8_SB(0, 0), cB, voffB); PG8_STAGE(PG8_SA(0, 0), cA, voffA); PG8_STAGE(PG8_SB(0, 1), cB + hstep, voffB); PG8_STAGE(PG8_SA(0, 1), cA + hstep, voffA);
        if (wr == 1) PG8_BAR;
        PG8_WAIT_V(4); PG8_BAR;
        PG8_STAGE(PG8_SB(1, 0), cB + kstep, voffB); PG8_STAGE(PG8_SA(1, 0), cA + kstep, voffA); PG8_STAGE(PG8_SB(1, 1), cB + hstep + kstep, voffB);
        PG8_WAIT_V(6); PG8_BAR;
    }
    for (;;) {
        const bool has_next = S.next(ui + 1, nxt);
        const char* nA = has_next ? (const char*)g.A + (size_t)nxt.pm * tstep + (size_t)nxt.ks * sstep : cA; const char* nB = has_next ? (const char*)g.Bt + (size_t)nxt.pn * tstep + (size_t)nxt.ks * sstep : cB;
        for (int t = 0; t < nt; t += 2) {
            const bool last = (t == nt - 2);
            const char* a1 = cA + (size_t)(t + 1) * kstep;
            const char* a2 = last ? nA : cA + (size_t)(t + 2) * kstep; const char* b2 = last ? nB : cB + (size_t)(t + 2) * kstep;
            const char* a3 = a2 + kstep; const char* b3 = b2 + kstep;
            if (last && has_next) S.a_ready(nxt);
            if constexpr (SP2) {
            PG8_LDB(B0, 0, 0); PG8_LDB(B1, 0, 1); PG8_SCHED; PG8_LDA(At, 0, 0); PG8_STAGE(PG8_SA(1, 1), a1 + hstep, voffA);
            PG8_WAIT_V(8); PG8_WAIT_L(0); PG8_BAR; PG8_MMA(0, 0, At, B0); PG8_MMA(0, 1, At, B1); PG8_BAR; PG8_SCHED;
            PG8_LDA(At, 0, 1); PG8_STAGE(PG8_SB(0, 0), b2, voffB); PG8_STAGE(PG8_SB(0, 1), b2 + hstep, voffB); PG8_STAGE(PG8_SA(0, 0), a2, voffA);
            PG8_WAIT_V(8); PG8_WAIT_L(0); PG8_BAR; PG8_MMA(1, 0, At, B0); PG8_MMA(1, 1, At, B1); PG8_BAR; PG8_SCHED;
            PG8_LDB(B0, 1, 0); PG8_LDB(B1, 1, 1); PG8_SCHED; PG8_LDA(At, 1, 0); PG8_STAGE(PG8_SA(0, 1), a2 + hstep, voffA);
            PG8_WAIT_V(8); PG8_WAIT_L(0); PG8_BAR; PG8_MMA(0, 0, At, B0); PG8_MMA(0, 1, At, B1); PG8_BAR; PG8_SCHED;
            PG8_LDA(At, 1, 1); PG8_STAGE(PG8_SB(1, 0), b3, voffB); PG8_STAGE(PG8_SB(1, 1), b3 + hstep, voffB); PG8_STAGE(PG8_SA(1, 0), a3, voffA);
            PG8_WAIT_V(8); PG8_WAIT_L(0); PG8_BAR; PG8_MMA(1, 0, At, B0); PG8_MMA(1, 1, At, B1); PG8_BAR; PG8_SCHED;
            } else {
            PG8_LDB(B0, 0, 0); PG8_SCHED; PG8_LDA(At, 0, 0); PG8_STAGE(PG8_SA(1, 1), a1 + hstep, voffA);
            PG8_WAIT_L(8); PG8_BAR; PG8_WAIT_L(0); PG8_MMA(0, 0, At, B0); PG8_BAR; PG8_SCHED;
            PG8_LDB(B1, 0, 1); PG8_STAGE(PG8_SB(0, 0), b2, voffB);
            PG8_BAR; PG8_WAIT_L(0); PG8_MMA(0, 1, At, B1); PG8_BAR;
            PG8_LDA(At, 0, 1); PG8_STAGE(PG8_SA(0, 0), a2, voffA);
            PG8_BAR; PG8_WAIT_L(0); PG8_MMA(1, 0, At, B0); PG8_BAR; PG8_SCHED;
            PG8_STAGE(PG8_SB(0, 1), b2 + hstep, voffB);
            PG8_WAIT_V(6); PG8_BAR; PG8_MMA(1, 1, At, B1); PG8_BAR;
            PG8_LDB(B0, 1, 0); PG8_SCHED; PG8_LDA(At, 1, 0); PG8_STAGE(PG8_SA(0, 1), a2 + hstep, voffA);
            PG8_WAIT_L(8); PG8_BAR; PG8_WAIT_L(0); PG8_MMA(0, 0, At, B0); PG8_BAR; PG8_SCHED;
            PG8_LDB(B1, 1, 1); PG8_STAGE(PG8_SB(1, 0), b3, voffB);
            PG8_BAR; PG8_WAIT_L(0); PG8_MMA(0, 1, At, B1); PG8_BAR;
            PG8_LDA(At, 1, 1); PG8_STAGE(PG8_SA(1, 0), a3, voffA);
            PG8_BAR; PG8_WAIT_L(0); PG8_MMA(1, 0, At, B0); PG8_BAR; PG8_SCHED;
            PG8_STAGE(PG8_SB(1, 1), b3 + hstep, voffB);
            PG8_WAIT_V(6); PG8_BAR; PG8_MMA(1, 1, At, B1); PG8_BAR;
            }
        }
        if constexpr (ALIGN_EPI) { if (wr == 0) PG8_BAR; }
        if constexpr (!Epi::AFTER_DRAIN) { E(acc, cur, wr, wc, fr, fq); S.done(cur); }
#if EPI_DRAIN
        PG8_WAIT_V(0);
#endif
        if (!has_next) break;
#pragma unroll
        for (int a = 0; a < 2; ++a)
#pragma unroll
            for (int b = 0; b < 2; ++b)
#pragma unroll
                for (int m = 0; m < 4; ++m)
#pragma unroll
                    for (int n = 0; n < 2; ++n) acc[a][b][m][n] = (f32x4){0.f, 0.f, 0.f, 0.f};
        cur = nxt; cA = nA; cB = nB; ++ui;
        if constexpr (ALIGN_EPI) { if (wr == 1) PG8_BAR; }
    }
    PG8_WAIT_V(0);
    if constexpr (!ALIGN_EPI) { if (wr == 0) PG8_BAR; }
    PG8_BAR;
#undef PG8_SA
#undef PG8_SB
#undef PG8_STAGE
#undef PG8_LDA
#undef PG8_LDB
#undef PG8_MMA
#undef PG8_WAIT_V
#undef PG8_WAIT_L
#undef PG8_BAR
#undef PG8_SCHED
}
}

using pg8::bf16_t; using pg8::f32x4; using pg8::u32x4; using pg8::u32x2; using pg8::bf16x8; using pg8::Unit;
#define LAS __attribute__((address_space(3)))
#define GAS __attribute__((address_space(1)))
#define GIN(k) ((const float*)(const GAS float*)F.in[k])
typedef float f32x2 __attribute__((ext_vector_type(2)));
typedef __bf16 bf16x2_t __attribute__((ext_vector_type(2)));
typedef float f32x16 __attribute__((ext_vector_type(16)));

constexpr int DM = 1024, E_ = 2048, XA = 512, NH = 4, HD = 128, MEML = 256;
constexpr int PB = 8, PSEQ = 2048, MP = PB * PSEQ;
constexpr int SBT = 128, SSEQ = 4, MS = SBT * SSEQ;
constexpr int M = MP + MS;
constexpr int NIN_A = 3 * E_ + XA, NIN_B = 4 * E_ + XA, NIN_C = 2 * E_ + XA, KOUT = E_ + XA;
constexpr int S5G = 128, S5P = 64, S5I = 16;
constexpr float EPS = 1e-6f;
constexpr int NWAVES = 8, NTHR = 512;

constexpr size_t O_YP = 0, O_YS = O_YP + (size_t)MP * DM, O_MK = O_YS + (size_t)MS * DM, O_MV = O_MK + 4ull * PB * MEML * XA, O_CP = O_MV + 4ull * PB * MEML * XA,
                 O_CS = O_CP + (size_t)PB * 2 * E_, O_SRP = O_CS + (size_t)SBT * 2 * E_, O_SIP = O_SRP + (size_t)PB * S5G * S5P, O_SRS = O_SIP + (size_t)PB * S5G * S5P,
                 O_SIS = O_SRS + (size_t)SBT * S5G * S5P, O_CV = O_SIS + (size_t)SBT * S5G * S5P, O_END = O_CV + 2ull * SBT * SSEQ * E_;
static_assert(O_END == 30572544ull, "output size");

constexpr size_t MiB = 1u << 20;
constexpr size_t WS_CTL = 0, WS_TAB = 1 * MiB, WS_RSTDM = 3 * MiB, WS_SGUW = 4 * MiB, WS_SSX = 5 * MiB, WS_SSV = 7 * MiB, WS_WKV = 10 * MiB, WS_WGLU = 18 * MiB, WS_WOUT = 26 * MiB,
                 WS_WINA = 46 * MiB, WS_WINB = 72 * MiB, WS_WINC = 89 * MiB, WS_MEMB = 98 * MiB, WS_KB = 102 * MiB, WS_VT = 110 * MiB, WS_XB = 118 * MiB, WS_X = 151 * MiB,
                 WS_B0 = 217 * MiB, WS_B1 = 283 * MiB, WS_QB = 349 * MiB, WS_A2 = 366 * MiB, WS_GB = 449 * MiB, WS_SLAB = 515 * MiB  , WS_END = 548 * MiB;
constexpr size_t T_AR = 0, T_AI = 8192, T_BBR = 16384, T_BBI = 16384 + 131072;

constexpr int RING_BYTES = 131072, LDS_BYTES = 147456;

struct Args { const float* in[30]; float* out; unsigned char* ws; int ph_lo, ph_hi; };

__device__ __forceinline__ unsigned pk2(float lo, float hi) { f32x2 v = {lo, hi}; return __builtin_bit_cast(unsigned, __builtin_convertvector(v, bf16x2_t)); }
__device__ __forceinline__ bf16_t f2bf(float f) { return (bf16_t)(pk2(f, 0.f) & 0xffffu); }
__device__ __forceinline__ float bf2f(unsigned short h) { return __uint_as_float((unsigned)h << 16); }
__device__ __forceinline__ float bflo(unsigned w) { return __uint_as_float(w << 16); }
__device__ __forceinline__ float bfhi(unsigned w) { return __uint_as_float(w & 0xffff0000u); }
__device__ __forceinline__ float sigmoidf_(float x) { return __builtin_amdgcn_rcpf(1.f + __expf(-x)); }
__device__ __forceinline__ float siluf_(float x) { return x * sigmoidf_(x); }
__device__ __forceinline__ float gelu_tanh(float x) { const float y = 0.7978845608028654f * (x + 0.044715f * x * x * x); return x * sigmoidf_(2.f * y); }
__device__ __forceinline__ float wave_sum(float v) {
#pragma unroll
    for (int o = 1; o < 64; o <<= 1) v += __shfl_xor(v, o);
    return v;
}
__device__ __forceinline__ float wave_max(float v) {
#pragma unroll
    for (int o = 1; o < 64; o <<= 1) v = fmaxf(v, __shfl_xor(v, o));
    return v;
}
__device__ __forceinline__ u32x4 pack8(f32x4 a, f32x4 b) { u32x4 w; w.x = pk2(a[0], a[1]); w.y = pk2(a[2], a[3]); w.z = pk2(b[0], b[1]); w.w = pk2(b[2], b[3]); return w; }
__device__ __forceinline__ void unpack8(u32x4 w, float (&f)[8]) { f[0] = bflo(w.x); f[1] = bfhi(w.x); f[2] = bflo(w.y); f[3] = bfhi(w.y); f[4] = bflo(w.z); f[5] = bfhi(w.z); f[6] = bflo(w.w); f[7] = bfhi(w.w); }

__device__ __forceinline__ int src_col(int kind, int np) {
    const int pn = np >> 8, p = np & 255, pos = (p & ~31) + pg8::perm32(p & 31);
    if (kind == 0) {
        if (pn < 16) return pos < 128 ? 128 * pn + pos : 2 * E_ + 128 * pn + (pos - 128);
        if (pn < 24) return E_ + 256 * (pn - 16) + pos;
        return 3 * E_ + 256 * (pn - 24) + pos;
    }
    if (kind == 1) {
        if (pn < 32) { const int qs = 2 * (p >> 7) + ((p >> 4) & 1), ch = 64 * pn + 16 * ((p >> 5) & 3) + (p & 15); return qs * E_ + ch; }
        return 4 * E_ + 256 * (pn - 32) + pos;
    }
    return 256 * pn + pos;
}

__device__ __forceinline__ float sum_rows4(float x) {
    auto a = __builtin_amdgcn_permlane16_swap(__float_as_uint(x), __float_as_uint(x), false, false); const float y = __uint_as_float(a[0]) + __uint_as_float(a[1]);
    auto b = __builtin_amdgcn_permlane32_swap(__float_as_uint(y), __float_as_uint(y), false, false); return __uint_as_float(b[0]) + __uint_as_float(b[1]);
}
__device__ __forceinline__ void rows_rstd16(const float* ssx, int row0, int fq, float (&rs)[2][4]) {
#pragma unroll
    for (int ai = 0; ai < 2; ++ai)
#pragma unroll
        for (int m = 0; m < 4; ++m) {
            const f32x4 v = *(const f32x4*)(ssx + (size_t)(row0 + ai * 128 + m * 16) * 16 + fq * 4);
            const float s = sum_rows4((v[0] + v[1]) + (v[2] + v[3]));
            rs[ai][m] = __builtin_amdgcn_rsqf(s * (1.f / DM) + EPS);
        }
}

struct EpiKV {
    static constexpr bool PERM = false, AFTER_DRAIN = false;
    const float* rstdm; float* outk; float* outv; bf16_t* KB; bf16_t* VT; int layer;
    __device__ __forceinline__ void operator()(const f32x4 (&acc)[2][2][4][2], const Unit& u, int wr, int wc, int fr, int fq) const {
        const int sub = u.pn & 3, isv = sub >> 1, b = u.pm;
        const int key0 = wr * 64 + fr, d0 = 32 * wc + 8 * fq;
        const float* rsp = rstdm + b * 256 + key0;
        float* of = (isv ? outv : outk) + (((size_t)(layer * PB + b) * MEML + key0) * NH + (sub & 1) * 2) * HD + d0;
        const size_t bh0 = (size_t)((layer * PB + b) * NH + (sub & 1) * 2);
        if (!isv) {
            bf16_t* kb = KB + (bh0 * MEML + key0) * HD + d0;
#pragma unroll
            for (int ai = 0; ai < 2; ++ai)
#pragma unroll
                for (int m = 0; m < 4; ++m) { const int kk = ai * 128 + m * 16; const float rs = rsp[kk];
#pragma unroll
                    for (int bj = 0; bj < 2; ++bj) { const f32x4 v0 = acc[ai][bj][m][0] * rs, v1 = acc[ai][bj][m][1] * rs;
                        float* o = of + (size_t)kk * XA + bj * HD; *(f32x4*)o = v0; *(f32x4*)(o + 4) = v1;
                        *(u32x4*)(kb + (size_t)bj * MEML * HD + (size_t)kk * HD) = pack8(v0, v1); }
                    asm volatile("" ::: "memory"); }
        } else {
            bf16_t* vt = VT + (bh0 * HD + d0) * MEML + key0;
#pragma unroll
            for (int ai = 0; ai < 2; ++ai)
#pragma unroll
                for (int m = 0; m < 4; ++m) { const int kk = ai * 128 + m * 16; const float rs = rsp[kk];
#pragma unroll
                    for (int bj = 0; bj < 2; ++bj) { const f32x4 v0 = acc[ai][bj][m][0] * rs, v1 = acc[ai][bj][m][1] * rs;
                        float* o = of + (size_t)kk * XA + bj * HD; *(f32x4*)o = v0; *(f32x4*)(o + 4) = v1;
                        bf16_t* q = vt + (size_t)bj * HD * MEML + kk;
#pragma unroll
                        for (int e = 0; e < 4; ++e) { q[e * MEML] = f2bf(v0[e]); q[(e + 4) * MEML] = f2bf(v1[e]); }
                        asm volatile("" ::: "memory"); } }
        }
    }
};

struct EpiInA {
    static constexpr bool PERM = false, AFTER_DRAIN = false;
    const float* ssx; bf16_t* UZ; bf16_t* VR; bf16_t* QB; float* SSV;
    __device__ __forceinline__ void operator()(const f32x4 (&acc)[2][2][4][2], const Unit& u, int wr, int wc, int fr, int fq) const {
        const int row0 = u.pm * 256 + wr * 64 + fr; float rs[2][4]; rows_rstd16(ssx, row0, fq, rs);
        if (u.pn < 16) {
#pragma unroll
            for (int ai = 0; ai < 2; ++ai)
#pragma unroll
                for (int m = 0; m < 4; ++m) { const int row = row0 + ai * 128 + m * 16; const float r = rs[ai][m]; f32x4 o[2];
#pragma unroll
                    for (int n = 0; n < 2; ++n)
#pragma unroll
                        for (int e = 0; e < 4; ++e) o[n][e] = acc[ai][0][m][n][e] * r * siluf_(acc[ai][1][m][n][e] * r);
                    *(u32x4*)(UZ + (size_t)row * E_ + 128 * u.pn + 32 * wc + 8 * fq) = pack8(o[0], o[1]); }
        } else if (u.pn < 24) {
#pragma unroll
            for (int ai = 0; ai < 2; ++ai)
#pragma unroll
                for (int m = 0; m < 4; ++m) { const int row = row0 + ai * 128 + m * 16; const float r = rs[ai][m]; float ss = 0.f;
#pragma unroll
                    for (int bj = 0; bj < 2; ++bj) { const f32x4 v0 = acc[ai][bj][m][0] * r, v1 = acc[ai][bj][m][1] * r;
                        ss += (v0[0] * v0[0] + v0[1] * v0[1]) + (v0[2] * v0[2] + v0[3] * v0[3]) + (v1[0] * v1[0] + v1[1] * v1[1]) + (v1[2] * v1[2] + v1[3] * v1[3]);
                        *(u32x4*)(VR + (size_t)row * E_ + 256 * (u.pn - 16) + 128 * bj + 32 * wc + 8 * fq) = pack8(v0, v1); }
                    ss = sum_rows4(ss);
                    if (fq == 0) SSV[(size_t)row * 32 + (u.pn - 16) * 4 + wc] = ss; }
        } else {
#pragma unroll
            for (int ai = 0; ai < 2; ++ai)
#pragma unroll
                for (int m = 0; m < 4; ++m) { const int row = row0 + ai * 128 + m * 16; const float r = rs[ai][m] * 0.08838834764831845f;
#pragma unroll
                    for (int bj = 0; bj < 2; ++bj) *(u32x4*)(QB + (size_t)row * XA + 256 * (u.pn - 24) + 128 * bj + 32 * wc + 8 * fq) = pack8(acc[ai][bj][m][0] * r, acc[ai][bj][m][1] * r); }
        }
    }
};

struct EpiInB {
    static constexpr bool PERM = false, AFTER_DRAIN = false;
    const float* ssx; bf16_t* P; bf16_t* G; bf16_t* QB; float* convp; float* convs;
    __device__ __forceinline__ void operator()(const f32x4 (&acc)[2][2][4][2], const Unit& u, int wr, int wc, int fr, int fq) const {
        const int row0 = u.pm * 256 + wr * 64 + fr; float rs[2][4]; rows_rstd16(ssx, row0, fq, rs);
        if (u.pn < 32) {
            const int ch0 = 64 * u.pn + 16 * wc + 4 * fq;
#pragma unroll
            for (int ai = 0; ai < 2; ++ai)
#pragma unroll
                for (int m = 0; m < 4; ++m) { const int row = row0 + ai * 128 + m * 16; const float r = rs[ai][m];
                    const f32x4 bg = acc[ai][0][m][0] * r, cgv = acc[ai][0][m][1] * r, hv = acc[ai][1][m][0] * r, z = acc[ai][1][m][1] * r;
                    f32x4 p = cgv * hv, gg;
#pragma unroll
                    for (int e = 0; e < 4; ++e) gg[e] = bg[e] * siluf_(z[e]);
                    u32x2 wp, wg; wp.x = pk2(p[0], p[1]); wp.y = pk2(p[2], p[3]); wg.x = pk2(gg[0], gg[1]); wg.y = pk2(gg[2], gg[3]);
                    *(u32x2*)(P + (size_t)row * E_ + ch0) = wp; *(u32x2*)(G + (size_t)row * E_ + ch0) = wg;
                    if (row < MP) { const int t = row & (PSEQ - 1); if (t >= PSEQ - 2) *(f32x4*)(convp + ((size_t)(row >> 11) * 2 + (t - (PSEQ - 2))) * E_ + ch0) = p; }
                    else { const int s = row - MP, t = s & 3; if (t >= 2) *(f32x4*)(convs + ((size_t)(s >> 2) * 2 + (t - 2)) * E_ + ch0) = p; } }
        } else {
#pragma unroll
            for (int ai = 0; ai < 2; ++ai)
#pragma unroll
                for (int m = 0; m < 4; ++m) { const int row = row0 + ai * 128 + m * 16; const float r = rs[ai][m] * 0.08838834764831845f;
#pragma unroll
                    for (int bj = 0; bj < 2; ++bj) *(u32x4*)(QB + (size_t)row * XA + 256 * (u.pn - 32) + 128 * bj + 32 * wc + 8 * fq) = pack8(acc[ai][bj][m][0] * r, acc[ai][bj][m][1] * r); }
        }
    }
};

struct EpiInC {
    static constexpr bool PERM = false, AFTER_DRAIN = false;
    const float* ssx; bf16_t* U; bf16_t* SZ; bf16_t* QB;
    __device__ __forceinline__ void operator()(const f32x4 (&acc)[2][2][4][2], const Unit& u, int wr, int wc, int fr, int fq) const {
        const int row0 = u.pm * 256 + wr * 64 + fr; float rs[2][4]; rows_rstd16(ssx, row0, fq, rs);
#pragma unroll
        for (int ai = 0; ai < 2; ++ai)
#pragma unroll
            for (int m = 0; m < 4; ++m) { const int row = row0 + ai * 128 + m * 16; const float r = rs[ai][m];
#pragma unroll
                for (int bj = 0; bj < 2; ++bj) { const int cc = 128 * bj + 32 * wc + 8 * fq;
                    if (u.pn < 8) *(u32x4*)(U + (size_t)row * E_ + 256 * u.pn + cc) = pack8(acc[ai][bj][m][0] * r, acc[ai][bj][m][1] * r);
                    else if (u.pn < 16) { f32x4 a, b2;
#pragma unroll
                        for (int e = 0; e < 4; ++e) { a[e] = siluf_(acc[ai][bj][m][0][e] * r); b2[e] = siluf_(acc[ai][bj][m][1][e] * r); }
                        *(u32x4*)(SZ + (size_t)row * E_ + 256 * (u.pn - 8) + cc) = pack8(a, b2); }
                    else { const float rq = r * 0.08838834764831845f; *(u32x4*)(QB + (size_t)row * XA + 256 * (u.pn - 16) + cc) = pack8(acc[ai][bj][m][0] * rq, acc[ai][bj][m][1] * rq); } } }
    }
};

struct EpiOut {
    static constexpr bool PERM = false, AFTER_DRAIN = false;
    const float* basef; bf16_t* XB; float* SSX;
    __device__ __forceinline__ void operator()(const f32x4 (&acc)[2][2][4][2], const Unit& u, int wr, int wc, int fr, int fq) const {
        const int row0 = u.pm * 256 + wr * 64 + fr;
#pragma unroll
        for (int ai = 0; ai < 2; ++ai)
#pragma unroll
            for (int m = 0; m < 4; ++m) { const int row = row0 + ai * 128 + m * 16; float ss = 0.f;
#pragma unroll
                for (int bj = 0; bj < 2; ++bj) { const int col = 256 * u.pn + 128 * bj + 32 * wc + 8 * fq; f32x4 x0, x1;
                    if (basef) { x0 = *(const f32x4*)(basef + (size_t)row * DM + col); x1 = *(const f32x4*)(basef + (size_t)row * DM + col + 4); }
                    else { float r[8]; unpack8(*(const u32x4*)(XB + (size_t)row * DM + col), r); x0 = (f32x4){r[0], r[1], r[2], r[3]}; x1 = (f32x4){r[4], r[5], r[6], r[7]}; }
                    x0 += acc[ai][bj][m][0]; x1 += acc[ai][bj][m][1];
                    *(u32x4*)(XB + (size_t)row * DM + col) = pack8(x0, x1);
                    ss += (x0[0] * x0[0] + x0[1] * x0[1]) + (x0[2] * x0[2] + x0[3] * x0[3]) + (x1[0] * x1[0] + x1[1] * x1[1]) + (x1[2] * x1[2] + x1[3] * x1[3]); }
                ss = sum_rows4(ss);
                if (fq == 0) SSX[(size_t)row * 16 + u.pn * 4 + wc] = ss; }
    }
};

struct EpiGlu {
    static constexpr bool PERM = false, AFTER_DRAIN = false;
    const bf16_t* GB; const bf16_t* SZ; const float* bias; bf16_t* A2;
    __device__ __forceinline__ void operator()(const f32x4 (&acc)[2][2][4][2], const Unit& u, int wr, int wc, int fr, int fq) const {
        const int row0 = u.pm * 256 + wr * 64 + fr;
#pragma unroll
        for (int ai = 0; ai < 2; ++ai)
#pragma unroll
            for (int m = 0; m < 4; ++m) { const int row = row0 + ai * 128 + m * 16;
#pragma unroll
                for (int bj = 0; bj < 2; ++bj) { const int col = 256 * u.pn + 128 * bj + 32 * wc + 8 * fq;
                    const f32x4 b0 = *(const f32x4*)(bias + col), b1 = *(const f32x4*)(bias + col + 4);
                    float gv[8], sz[8]; unpack8(*(const u32x4*)(GB + (size_t)row * E_ + col), gv); unpack8(*(const u32x4*)(SZ + (size_t)row * E_ + col), sz);
                    f32x4 o0, o1;
#pragma unroll
                    for (int e = 0; e < 4; ++e) { o0[e] = gv[e] * sigmoidf_(acc[ai][bj][m][0][e] + b0[e]) * sz[e]; o1[e] = gv[4 + e] * sigmoidf_(acc[ai][bj][m][1][e] + b1[e]) * sz[4 + e]; }
                    *(u32x4*)(A2 + (size_t)row * KOUT + col) = pack8(o0, o1); } }
    }
};

struct EpiSlab {
    static constexpr bool PERM = false, AFTER_DRAIN = false;
    float* S; int ldc; int row0; size_t kstride;
    __device__ __forceinline__ void operator()(const f32x4 (&acc)[2][2][4][2], const Unit& u, int wr, int wc, int fr, int fq) const {
        float* base = S + (size_t)u.ks * kstride + (size_t)(u.pm * 256 + wr * 64 + fr - row0) * ldc + 256 * u.pn + 32 * wc + 8 * fq;
#pragma unroll
        for (int ai = 0; ai < 2; ++ai)
#pragma unroll
            for (int m = 0; m < 4; ++m)
                { float* o = base + (size_t)(ai * 128 + m * 16) * ldc; *(f32x4*)o = acc[ai][0][m][0]; *(f32x4*)(o + 4) = acc[ai][0][m][1]; *(f32x4*)(o + 128) = acc[ai][1][m][0]; *(f32x4*)(o + 132) = acc[ai][1][m][1];
                  asm volatile("" ::: "memory"); }
    }
};

#ifndef PROBE_EPI2
#define PROBE_EPI2 0
#endif
template <class E_> struct EpiTwice { static constexpr bool PERM = false, AFTER_DRAIN = false; E_ e;
    __device__ __forceinline__ void operator()(const f32x4 (&acc)[2][2][4][2], const Unit& u, int wr, int wc, int fr, int fq) const { e(acc, u, wr, wc, fr, fq); asm volatile("" ::: "memory"); e(acc, u, wr, wc, fr, fq); } };

struct Frame {
    LAS unsigned char* lds; int tid, lane, wave, G, bid;
    const float* const* in; float* out; unsigned char* ws;
};

struct WItem { const float* W; const float* gs; bf16_t* WT; int K, N, kind, r; };
__device__ __forceinline__ WItem witem(Frame& F, int it) {
    constexpr int I_A = 16 * (NIN_A / 32), I_B = 16 * (NIN_B / 32), I_C = 16 * (NIN_C / 32), I_O = (KOUT / 64) * (DM / 32), I_KV = 16 * (DM / 32);
    unsigned char* ws = F.ws; int r = it; WItem w;
    if (r < 2 * I_A) { const int j = r / I_A; r -= j * I_A; w = WItem{GIN(13) + (size_t)j * DM * NIN_A, GIN(8) + (j == 0 ? 0 : 3) * DM, (bf16_t*)(ws + WS_WINA) + (size_t)j * NIN_A * DM, DM, NIN_A, 0, r}; return w; } r -= 2 * I_A;
    if (r < I_B) { w = WItem{GIN(17), GIN(8) + 1 * DM, (bf16_t*)(ws + WS_WINB), DM, NIN_B, 1, r}; return w; } r -= I_B;
    if (r < I_C) { w = WItem{GIN(19), GIN(8) + 2 * DM, (bf16_t*)(ws + WS_WINC), DM, NIN_C, 2, r}; return w; } r -= I_C;
    if (r < 4 * I_O) { const int j = r / I_O; r -= j * I_O; w = WItem{GIN(12) + (size_t)j * KOUT * DM, nullptr, (bf16_t*)(ws + WS_WOUT) + (size_t)j * DM * KOUT, KOUT, DM, 2, r}; return w; } r -= 4 * I_O;
    if (r < 4 * I_KV) { const int j = r / I_KV; r -= j * I_KV; w = WItem{GIN(11) + (size_t)j * DM * DM, GIN(10) + j * DM, (bf16_t*)(ws + WS_WKV) + (size_t)j * DM * DM, DM, DM, 2, r}; return w; } r -= 4 * I_KV;
    w = WItem{GIN(28), nullptr, (bf16_t*)(ws + WS_WGLU), E_, E_, 2, r}; return w;
}
__device__ __forceinline__ void witem_load(const WItem& w, int lane, f32x4 (&x)[8]) {
    const int nblk = w.N / 32, kb = w.r / nblk, nb = w.r % nblk, k0 = 64 * kb, n0 = 32 * nb, n4 = lane & 7, kr = lane >> 3;
    const int sc = src_col(w.kind, n0 + 4 * n4);
#pragma unroll
    for (int i = 0; i < 8; ++i) x[i] = *(const f32x4*)(w.W + (size_t)(k0 + kr + 8 * i) * w.N + sc);
}
__device__ __forceinline__ void witem_finish(const WItem& w, int lane, const f32x4 (&x)[8], LAS float* scr) {
    const int nblk = w.N / 32, kb = w.r / nblk, nb = w.r % nblk, k0 = 64 * kb, n0 = 32 * nb, n4 = lane & 7, kr = lane >> 3;
    asm volatile("s_waitcnt vmcnt(8)" ::: "memory");
#pragma unroll
    for (int i = 0; i < 8; ++i) { const int kk = kr + 8 * i; const float g = w.gs ? w.gs[k0 + kk] : 1.f; LAS float* d = scr + kk * 33 + 4 * n4; d[0] = x[i][0] * g; d[1] = x[i][1] * g; d[2] = x[i][2] * g; d[3] = x[i][3] * g; }
    asm volatile("s_waitcnt lgkmcnt(0)" ::: "memory");
    const int c = lane & 7;
#pragma unroll
    for (int j = 0; j < 4; ++j) { const int n = (lane >> 3) + 8 * j; const LAS float* sp = scr + (8 * c) * 33 + n;
        u32x4 o; o.x = pk2(sp[0 * 33], sp[1 * 33]); o.y = pk2(sp[2 * 33], sp[3 * 33]); o.z = pk2(sp[4 * 33], sp[5 * 33]); o.w = pk2(sp[6 * 33], sp[7 * 33]);
        *(u32x4*)(w.WT + (size_t)(n0 + n) * w.K + k0 + 8 * c) = o; }
    asm volatile("s_waitcnt lgkmcnt(0)" ::: "memory");
}

__device__ __forceinline__ void p0_prologue(Frame& F) {
    LAS float* scr = (LAS float*)(F.lds + F.wave * 16384);
    const int gw = F.bid * NWAVES + F.wave, NGW = F.G * NWAVES, lane = F.lane;
    unsigned char* ws = F.ws;
    constexpr int NITEMS = 2 * 16 * (NIN_A / 32) + 16 * (NIN_B / 32) + 16 * (NIN_C / 32) + 4 * (KOUT / 64) * (DM / 32) + 4 * 16 * (DM / 32) + (E_ / 64) * (E_ / 32);
    if (gw < NITEMS) {
        WItem wc = witem(F, gw); f32x4 xa[8]; witem_load(wc, lane, xa);
        for (int it = gw; it < NITEMS; it += NGW) {
            const int nit = it + NGW < NITEMS ? it + NGW : it; const WItem wn = witem(F, nit); f32x4 xb[8]; witem_load(wn, lane, xb);
            witem_finish(wc, lane, xa, scr);
            wc = wn;
#pragma unroll
            for (int i = 0; i < 8; ++i) xa[i] = xb[i];
        }
    }
    {
        bf16_t* XB = (bf16_t*)(ws + WS_XB); float* SSX = (float*)(ws + WS_SSX);
        for (int row = gw; row < M; row += 2 * NGW) {
            const int row2 = row + NGW < M ? row + NGW : row;
            const float* xr = row < MP ? GIN(0) + (size_t)row * DM : GIN(1) + (size_t)(row - MP) * DM;
            const float* xr2 = row2 < MP ? GIN(0) + (size_t)row2 * DM : GIN(1) + (size_t)(row2 - MP) * DM;
            f32x4 v[4], v2[4];
#pragma unroll
            for (int j = 0; j < 4; ++j) { v[j] = *((const f32x4*)xr + lane + 64 * j); v2[j] = *((const f32x4*)xr2 + lane + 64 * j); }
            float ss = 0.f, ss2 = 0.f;
#pragma unroll
            for (int j = 0; j < 4; ++j) { ss += (v[j][0] * v[j][0] + v[j][1] * v[j][1]) + (v[j][2] * v[j][2] + v[j][3] * v[j][3]); ss2 += (v2[j][0] * v2[j][0] + v2[j][1] * v2[j][1]) + (v2[j][2] * v2[j][2] + v2[j][3] * v2[j][3]);
                u32x2 w; w.x = pk2(v[j][0], v[j][1]); w.y = pk2(v[j][2], v[j][3]); *((u32x2*)(XB + (size_t)row * DM) + lane + 64 * j) = w;
                u32x2 w2; w2.x = pk2(v2[j][0], v2[j][1]); w2.y = pk2(v2[j][2], v2[j][3]); *((u32x2*)(XB + (size_t)row2 * DM) + lane + 64 * j) = w2; }
            asm volatile("s_waitcnt vmcnt(0)" ::: "memory");
            ss = wave_sum(ss); ss2 = wave_sum(ss2);
            if (lane < 16) { SSX[(size_t)row * 16 + lane] = lane == 0 ? ss : 0.f; SSX[(size_t)row2 * 16 + lane] = lane == 0 ? ss2 : 0.f; }
        }
    }
    {
        bf16_t* MB = (bf16_t*)(ws + WS_MEMB); float* RM = (float*)(ws + WS_RSTDM);
        for (int row = gw; row < PB * MEML; row += NGW) {
            const float* xr = GIN(2) + (size_t)row * DM; float ss = 0.f;
#pragma unroll
            for (int j = 0; j < 4; ++j) { const f32x4 v = *((const f32x4*)xr + lane + 64 * j); ss += (v[0] * v[0] + v[1] * v[1]) + (v[2] * v[2] + v[3] * v[3]);
                u32x2 w; w.x = pk2(v[0], v[1]); w.y = pk2(v[2], v[3]); *((u32x2*)(MB + (size_t)row * DM) + lane + 64 * j) = w; }
            asm volatile("s_waitcnt vmcnt(0)" ::: "memory");
            ss = wave_sum(ss);
            if (lane == 0) RM[row] = 1.0f / sqrtf(ss * (1.f / DM) + EPS);
        }
    }
    {
        float* TAB = (float*)(ws + WS_TAB);
        for (int g = gw; g < S5G; g += NGW) {
            const int gp = g * S5P + lane;
            const float lr = GIN(20)[gp], li = GIN(21)[gp], dt = expf(GIN(22)[g]);
            const float th = li * dt, em1 = expm1f(lr * dt), mag = em1 + 1.f, cs = cosf(th), sn = sinf(th), sh = sinf(0.5f * th);
            const float ar = mag * cs, ai = mag * sn;
            const float nr = em1 * cs - 2.f * sh * sh, ni = ai;
            const float den = lr * lr + li * li, cr = (nr * lr + ni * li) / den, ci = (ni * lr - nr * li) / den;
            TAB[T_AR + gp] = ar; TAB[T_AI + gp] = ai;
#pragma unroll
            for (int i = 0; i < S5I; ++i) { const float br = GIN(23)[(size_t)gp * S5I + i], bi = GIN(24)[(size_t)gp * S5I + i];
                TAB[T_BBR + (size_t)gp * S5I + i] = cr * br - ci * bi; TAB[T_BBI + (size_t)gp * S5I + i] = cr * bi + ci * br; }
        }
    }
    {
        bf16_t* SW = (bf16_t*)(ws + WS_SGUW);
        for (int i = (F.bid * NTHR + F.tid); i < 2 * 8 * 128 * 128; i += F.G * NTHR) { const int t = (i >> 7) & 127, s = i & 127; SW[i] = f2bf(s <= t ? GIN(15)[i] : 0.f); }
    }
}

typedef short v4i16_t __attribute__((ext_vector_type(4)));
constexpr int SG_VSTR = 576, SG_WSTR = 272, SG_WOFF = 128 * SG_VSTR, SG_ROFF = SG_WOFF + 128 * SG_WSTR;
static_assert(SG_ROFF + 1024 <= RING_BYTES, "sgu LDS");
__device__ __forceinline__ void sgu_phase_mfma(Frame& F, int j) {
    const bf16_t* UZ = (const bf16_t*)(F.ws + WS_B0); const bf16_t* VR = (const bf16_t*)(F.ws + WS_B1); const float* SSV = (const float*)(F.ws + WS_SSV);
    const bf16_t* SW = (const bf16_t*)(F.ws + WS_SGUW) + (size_t)j * 8 * 128 * 128; bf16_t* A2 = (bf16_t*)(F.ws + WS_A2);
    const float* gn = GIN(14) + (size_t)j * E_; const float* bsv = GIN(16) + (size_t)j * 8 * 128;
    LAS unsigned char* lds = F.lds; LAS float* rsl = (LAS float*)(lds + SG_ROFF);
    const int tid = F.tid, lane = F.lane, wid = F.wave, c = lane & 31, hh = lane >> 5;
    const bool same_g = (F.G & 7) == 0; int gld = -1, cur = 0;
    u32x4 vr[8];
    { const int un = F.bid; if (un < 128 * 8) { const int rbase = (un >> 3) * 128, g = un & 7;
#pragma unroll
        for (int i = 0; i < 8; ++i) { const int chn = tid + NTHR * i; vr[i] = *(const u32x4*)(VR + (size_t)(rbase + (chn >> 5)) * E_ + 256 * g + 8 * (chn & 31)); }
        __syncthreads();
        if (tid < 128) { const float* p = SSV + (size_t)(rbase + tid) * 32; float sq = 0.f;
#pragma unroll
            for (int k = 0; k < 8; ++k) { const f32x4 v = *((const f32x4*)p + k); sq += (v[0] + v[1]) + (v[2] + v[3]); }
            rsl[tid] = __builtin_amdgcn_rsqf(sq * (1.f / E_) + EPS); } } }
    for (int un = F.bid; un < 128 * 8; un += F.G) {
        const int ch = un >> 3, g = un & 7, rbase = ch * 128; const int nun = un + F.G < 128 * 8 ? un + F.G : un, nrb = (nun >> 3) * 128, ng = nun & 7;
        asm volatile("s_waitcnt vmcnt(0)" ::: "memory");
        __syncthreads();
        if (!same_g || gld != g) { gld = g;
#pragma unroll
            for (int i = 0; i < 4; ++i) { const int chn = tid + NTHR * i, row = chn >> 4, c16 = chn & 15;
                *(LAS u32x4*)(lds + SG_WOFF + row * SG_WSTR + c16 * 16) = *(const u32x4*)(SW + (size_t)g * 128 * 128 + row * 128 + c16 * 8); } }
#pragma unroll
        for (int i = 0; i < 8; ++i) { const int chn = tid + NTHR * i, sr = chn >> 5, c8 = chn & 31; float v[8]; unpack8(vr[i], v);
            const float r = rsl[cur * 128 + sr]; const f32x4 g0 = *(const f32x4*)(gn + 256 * g + 8 * c8), g1 = *(const f32x4*)(gn + 256 * g + 8 * c8 + 4); f32x4 a, b2;
#pragma unroll
            for (int e = 0; e < 4; ++e) { a[e] = v[e] * r * g0[e]; b2[e] = v[4 + e] * r * g1[e]; }
            *(LAS u32x4*)(lds + sr * SG_VSTR + c8 * 16) = pack8(a, b2); }
#pragma unroll
        for (int i = 0; i < 8; ++i) { const int chn = tid + NTHR * i; vr[i] = *(const u32x4*)(VR + (size_t)(nrb + (chn >> 5)) * E_ + 256 * ng + 8 * (chn & 31)); }
        if (tid < 128) { const float* p = SSV + (size_t)(nrb + tid) * 32; float sq = 0.f;
#pragma unroll
            for (int k = 0; k < 8; ++k) { const f32x4 v = *((const f32x4*)p + k); sq += (v[0] + v[1]) + (v[2] + v[3]); }
            rsl[(cur ^ 1) * 128 + tid] = __builtin_amdgcn_rsqf(sq * (1.f / E_) + EPS); }
        u32x2 uzr[4][4];
#pragma unroll
        for (int ti = 0; ti < 4; ++ti)
#pragma unroll
            for (int g4 = 0; g4 < 4; ++g4) uzr[ti][g4] = *(const u32x2*)(UZ + (size_t)(rbase + 32 * ti + c) * E_ + 256 * g + 32 * wid + 8 * g4 + 4 * hh);
        __syncthreads();
        f32x16 acc[4];
#pragma unroll
        for (int ti = 0; ti < 4; ++ti) acc[ti] = (f32x16){};
        const LAS unsigned char* abase = lds + (8 * hh + ((lane & 15) >> 2)) * SG_VSTR + (32 * wid + 16 * ((lane >> 4) & 1) + 4 * (lane & 3)) * 2;
#pragma unroll
        for (int s2 = 0; s2 < 8; ++s2) {
            const v4i16_t lo = __builtin_amdgcn_ds_read_tr16_b64_v4i16((LAS v4i16_t*)(abase + (16 * s2) * SG_VSTR));
            const v4i16_t hi = __builtin_amdgcn_ds_read_tr16_b64_v4i16((LAS v4i16_t*)(abase + (16 * s2 + 4) * SG_VSTR));
            const bf16x8 a = (bf16x8){lo[0], lo[1], lo[2], lo[3], hi[0], hi[1], hi[2], hi[3]};
#pragma unroll
            for (int ti = s2 >> 1; ti < 4; ++ti) { const bf16x8 b = *(const LAS bf16x8*)(lds + SG_WOFF + (32 * ti + c) * SG_WSTR + (16 * s2 + 8 * hh) * 2);
                acc[ti] = __builtin_amdgcn_mfma_f32_32x32x16_bf16(a, b, acc[ti], 0, 0, 0); }
        }
#pragma unroll
        for (int ti = 0; ti < 4; ++ti) { const int t = 32 * ti + c; const size_t row = (size_t)(rbase + t); const float bias = bsv[g * 128 + t];
#pragma unroll
            for (int g4 = 0; g4 < 4; ++g4) { const int d = 256 * g + 32 * wid + 8 * g4 + 4 * hh; const u32x2 uz = uzr[ti][g4];
                u32x2 w; w.x = pk2(bflo(uz.x) * (acc[ti][4 * g4] + bias), bfhi(uz.x) * (acc[ti][4 * g4 + 1] + bias)); w.y = pk2(bflo(uz.y) * (acc[ti][4 * g4 + 2] + bias), bfhi(uz.y) * (acc[ti][4 * g4 + 3] + bias));
                *(u32x2*)(A2 + row * KOUT + d) = w; } }
        cur ^= 1;
    }
}

__device__ __forceinline__ void sgu_sample_phase(Frame& F, int j) {
    const bf16_t* UZ = (const bf16_t*)(F.ws + WS_B0); const bf16_t* VR = (const bf16_t*)(F.ws + WS_B1); const float* SSV = (const float*)(F.ws + WS_SSV);
    const bf16_t* SW = (const bf16_t*)(F.ws + WS_SGUW) + (size_t)j * 8 * 128 * 128; bf16_t* A2 = (bf16_t*)(F.ws + WS_A2);
    const float* gn = GIN(14) + (size_t)j * E_; const float* bsv = GIN(16) + (size_t)j * 8 * 128; float* cvout = F.out + O_CV + (size_t)j * SBT * SSEQ * E_;
    const int gw = F.bid * NWAVES + F.wave, NGW = F.G * NWAVES, lane = F.lane;
    for (int task = gw; task < SBT * 8; task += NGW) {
        const int b = task >> 3, g = task & 7; const size_t r0 = (size_t)MP + b * SSEQ; const int ch = 256 * g + 4 * lane;
        float rs[SSEQ];
#pragma unroll
        for (int t = 0; t < SSEQ; ++t) { float v = lane < 32 ? SSV[(r0 + t) * 32 + lane] : 0.f; v = wave_sum(v); rs[t] = __builtin_amdgcn_rsqf(v * (1.f / E_) + EPS); }
        const f32x4 g4 = *(const f32x4*)(gn + ch);
        f32x4 vn[SSEQ];
#pragma unroll
        for (int t = 0; t < SSEQ; ++t) { const u32x2 w = *(const u32x2*)(VR + (r0 + t) * E_ + ch); const f32x4 v = (f32x4){bflo(w.x), bfhi(w.x), bflo(w.y), bfhi(w.y)}; vn[t] = v * rs[t] * g4;
            *(f32x4*)(cvout + (size_t)(b * SSEQ + t) * E_ + ch) = vn[t];
            u32x2 q; q.x = pk2(vn[t][0], vn[t][1]); q.y = pk2(vn[t][2], vn[t][3]); vn[t] = (f32x4){bflo(q.x), bfhi(q.x), bflo(q.y), bfhi(q.y)}; }
#pragma unroll
        for (int t = 0; t < SSEQ; ++t) { f32x4 a = {0.f, 0.f, 0.f, 0.f};
#pragma unroll
            for (int sq = 0; sq <= t; ++sq) a += vn[sq] * bf2f(SW[(size_t)g * 128 * 128 + t * 128 + sq]);
            a += bsv[g * 128 + t];
            const u32x2 uz = *(const u32x2*)(UZ + (r0 + t) * E_ + ch);
            u32x2 w; w.x = pk2(bflo(uz.x) * a[0], bfhi(uz.x) * a[1]); w.y = pk2(bflo(uz.y) * a[2], bfhi(uz.y) * a[3]);
            *(u32x2*)(A2 + (r0 + t) * KOUT + ch) = w; }
    }
}

__device__ __forceinline__ void conv_phase(Frame& F) {
    const bf16_t* P = (const bf16_t*)(F.ws + WS_B0); const bf16_t* G = (const bf16_t*)(F.ws + WS_B1); bf16_t* A2 = (bf16_t*)(F.ws + WS_A2);
    const float* cw = GIN(18); const float* st = GIN(5);
    for (int i = F.bid * NTHR + F.tid; i < (M / 32) * 256; i += F.G * NTHR) {
        const int seg = i >> 8, c0 = (i & 255) * 8, r0 = seg * 32;
        float w0[8], w1[8], w2[8];
#pragma unroll
        for (int e = 0; e < 8; ++e) { w0[e] = cw[c0 + e]; w1[e] = cw[E_ + c0 + e]; w2[e] = cw[2 * E_ + c0 + e]; }
        float x1[8], x2[8];
        if (r0 < MP) { if ((r0 & (PSEQ - 1)) == 0) { for (int e = 0; e < 8; ++e) { x1[e] = 0.f; x2[e] = 0.f; } }
                       else { unpack8(*(const u32x4*)(P + (size_t)(r0 - 1) * E_ + c0), x1); unpack8(*(const u32x4*)(P + (size_t)(r0 - 2) * E_ + c0), x2); } }
#pragma unroll 4
        for (int rr = 0; rr < 32; ++rr) {
            const int row = r0 + rr;
            if (row >= MP && ((row - MP) & 3) == 0) { const float* buf = st + (size_t)((row - MP) >> 2) * 2 * E_ + c0;
                for (int e = 0; e < 8; ++e) { x2[e] = buf[e]; x1[e] = buf[E_ + e]; } }
            float x0[8], gg[8]; unpack8(*(const u32x4*)(P + (size_t)row * E_ + c0), x0); unpack8(*(const u32x4*)(G + (size_t)row * E_ + c0), gg);
            f32x4 o0, o1;
#pragma unroll
            for (int e = 0; e < 8; ++e) { const float y = w0[e] * x2[e] + w1[e] * x1[e] + w2[e] * x0[e]; const float r = y * gg[e]; if (e < 4) o0[e] = r; else o1[e - 4] = r; x2[e] = x1[e]; x1[e] = x0[e]; }
            *(u32x4*)(A2 + (size_t)row * KOUT + c0) = pack8(o0, o1);
        }
    }
}

__device__ __forceinline__ void s5_sample_phase(Frame& F) {
    const bf16_t* U = (const bf16_t*)(F.ws + WS_B0); bf16_t* GBo = (bf16_t*)(F.ws + WS_GB); const float* TAB = (const float*)(F.ws + WS_TAB);
    const float* cre = GIN(25); const float* cim = GIN(26); const float* dsk = GIN(27);
    const int gw = F.bid * NWAVES + F.wave, NGW = F.G * NWAVES, lane = F.lane;
    for (int task = gw; task < S5G * (SBT / 16); task += NGW) {
        const int g = task & (S5G - 1), bc = task >> 7, gp = g * S5P + lane;
        const float ar = TAB[T_AR + gp], ai = TAB[T_AI + gp];
        float bbr[16], bbi[16], cr[16], ci[16];
#pragma unroll
        for (int i = 0; i < 16; ++i) { bbr[i] = TAB[T_BBR + (size_t)gp * 16 + i]; bbi[i] = TAB[T_BBI + (size_t)gp * 16 + i]; cr[i] = cre[((size_t)g * 16 + i) * S5P + lane]; ci[i] = cim[((size_t)g * 16 + i) * S5P + lane]; }
        const float dmine = dsk[g * 16 + (lane >> 2)];
        for (int bi = 0; bi < 16; ++bi) {
            const int sq = bc * 16 + bi; const size_t rbase = (size_t)MP + sq * SSEQ; const size_t so = ((size_t)sq * S5G + g) * S5P + lane;
            float hr = GIN(6)[so], hi = GIN(7)[so];
            u32x4 ur[SSEQ][2];
#pragma unroll
            for (int t = 0; t < SSEQ; ++t) { const bf16_t* up = U + (rbase + t) * E_ + g * 16; ur[t][0] = *(const u32x4*)up; ur[t][1] = *(const u32x4*)(up + 8); }
#pragma unroll
            for (int t = 0; t < SSEQ; ++t) {
                float u[16]; { float a[8], b[8]; unpack8(ur[t][0], a); unpack8(ur[t][1], b);
#pragma unroll
                    for (int i = 0; i < 8; ++i) { u[i] = a[i]; u[8 + i] = b[i]; } }
                float br = 0.f, bi2 = 0.f;
#pragma unroll
                for (int i = 0; i < 16; ++i) { br += bbr[i] * u[i]; bi2 += bbi[i] * u[i]; }
                const float nhr = ar * hr - ai * hi + br, nhi = ar * hi + ai * hr + bi2; hr = nhr; hi = nhi;
                float v[16];
#pragma unroll
                for (int i = 0; i < 16; ++i) v[i] = cr[i] * hr - ci[i] * hi;
                float w8[8];
                { const bool up5 = (lane & 32) != 0;
#pragma unroll
                  for (int i = 0; i < 8; ++i) { const float keep = up5 ? v[8 + i] : v[i], send = up5 ? v[i] : v[8 + i]; w8[i] = keep + __shfl_xor(send, 32); } }
                float w4[4];
                { const bool upb = (lane & 16) != 0;
#pragma unroll
                  for (int i = 0; i < 4; ++i) { const float keep = upb ? w8[4 + i] : w8[i], send = upb ? w8[i] : w8[4 + i]; w4[i] = keep + __shfl_xor(send, 16); } }
                float w2[2];
                { const bool upb = (lane & 8) != 0;
#pragma unroll
                  for (int i = 0; i < 2; ++i) { const float keep = upb ? w4[2 + i] : w4[i], send = upb ? w4[i] : w4[2 + i]; w2[i] = keep + __shfl_xor(send, 8); } }
                float w1;
                { const bool upb = (lane & 4) != 0; const float keep = upb ? w2[1] : w2[0], send = upb ? w2[0] : w2[1]; w1 = keep + __shfl_xor(send, 4); }
                w1 += __shfl_xor(w1, 2); w1 += __shfl_xor(w1, 1);
                float umine = 0.f;
#pragma unroll
                for (int i = 0; i < 16; ++i) umine = ((lane >> 2) == i) ? u[i] : umine;
                const float y = w1 + dmine * umine;
                if ((lane & 3) == 0) GBo[(rbase + t) * E_ + g * 16 + (lane >> 2)] = f2bf(gelu_tanh(y));
                asm volatile("s_waitcnt vmcnt(0)" ::: "memory");
            }
            F.out[O_SRS + so] = hr; F.out[O_SIS + so] = hi;
        }
    }
}

#if XHALF_SHFL
__device__ __forceinline__ void xhalf(float v, float& lo, float& hi) { const int l_ = threadIdx.x & 31; lo = __shfl(v, l_); hi = __shfl(v, l_ + 32); }
#else
__device__ __forceinline__ void xhalf(float v, float& lo, float& hi) { auto rr = __builtin_amdgcn_permlane32_swap(__float_as_uint(v), __float_as_uint(v), false, false); lo = __uint_as_float(rr[0]); hi = __uint_as_float(rr[1]);
 }
#endif
__device__ __forceinline__ void cmuladd(float& xr, float& xi, float ar, float ai, float pr, float pi) { float t = fmaf(-ai, pi, xr); asm("" : "+v"(t)); xr = fmaf(ar, pr, t); xi = fmaf(ar, pi, fmaf(ai, pr, xi)); }
constexpr int S5_HSTR = 272, S5_UOFF = 32 * S5_HSTR, S5_OOFF = S5_UOFF + 1024, S5_HT = S5_OOFF + 4096;
__device__ __forceinline__ void s5_prompt_mfma(Frame& F) {
    const bf16_t* U = (const bf16_t*)(F.ws + WS_B0); bf16_t* GBo = (bf16_t*)(F.ws + WS_GB); const float* TAB = (const float*)(F.ws + WS_TAB);
    const float* cre = GIN(25); const float* cim = GIN(26); const float* dsk = GIN(27);
    const int lane = F.lane, wid = F.wave, c = lane & 31, hh = lane >> 5, col = lane & 15, fq = lane >> 4;
    LAS unsigned char* ht = F.lds + wid * S5_HT;
    for (int task = F.bid * NWAVES + wid; task < PB * S5G; task += F.G * NWAVES) {
        const int b = task >> 7, g = task & 127;
        bf16x8 bfr[2], bfi[2]; float p_r[2][4], p_i[2][4];
#pragma unroll
        for (int st = 0; st < 2; ++st) { const int gp = g * S5P + 32 * st + c;
            const float* pr = TAB + T_BBR + (size_t)gp * 16 + 8 * hh; const float* pi = TAB + T_BBI + (size_t)gp * 16 + 8 * hh;
            bfr[st] = __builtin_bit_cast(bf16x8, pack8(*(const f32x4*)pr, *(const f32x4*)(pr + 4))); bfi[st] = __builtin_bit_cast(bf16x8, pack8(*(const f32x4*)pi, *(const f32x4*)(pi + 4)));
            const float ar = TAB[T_AR + gp], ai = TAB[T_AI + gp]; p_r[st][0] = ar; p_i[st][0] = ai;
#pragma unroll
            for (int n = 1; n < 4; ++n) { p_r[st][n] = p_r[st][n - 1] * ar - p_i[st][n - 1] * ai; p_i[st][n] = p_r[st][n - 1] * ai + p_i[st][n - 1] * ar; } }
        bf16x8 cf[4];
#pragma unroll
        for (int s4 = 0; s4 < 4; ++s4) { const size_t o = ((size_t)g * 16 + col) * S5P + 16 * s4 + 4 * fq; const f32x4 cr4 = *(const f32x4*)(cre + o), ci4 = *(const f32x4*)(cim + o);
            u32x4 w; w.x = pk2(cr4[0], -ci4[0]); w.y = pk2(cr4[1], -ci4[1]); w.z = pk2(cr4[2], -ci4[2]); w.w = pk2(cr4[3], -ci4[3]); cf[s4] = __builtin_bit_cast(bf16x8, w); }
        const f32x4 d4 = *(const f32x4*)(dsk + 16 * g + 4 * fq);
        float car_r[2] = {0.f, 0.f}, car_i[2] = {0.f, 0.f};
        const bf16_t* up = U + ((size_t)b * PSEQ + c) * E_ + 16 * g + 8 * hh;
        bf16x8 ub[4];
#pragma unroll
        for (int q = 0; q < 4; ++q) ub[q] = *(const GAS bf16x8*)(up + (size_t)q * 32 * E_);
        for (int tg = 0; tg < PSEQ / 128; ++tg) {
          bf16x8 nb[4];
#pragma unroll
          for (int q = 0; q < 4; ++q) nb[q] = *(const GAS bf16x8*)(up + (size_t)(4 * (tg + 1 < PSEQ / 128 ? tg + 1 : tg) + q) * 32 * E_);
#pragma unroll
          for (int q = 0; q < 4; ++q) {
            const int ti = 4 * tg + q; const bf16x8 ua = ub[q];
            *(LAS bf16x8*)(ht + S5_UOFF + c * 32 + hh * 16) = ua;
#pragma unroll
            for (int st = 0; st < 2; ++st) {
                f32x16 xr = __builtin_amdgcn_mfma_f32_32x32x16_bf16(ua, bfr[st], (f32x16){}, 0, 0, 0);
                f32x16 xi = __builtin_amdgcn_mfma_f32_32x32x16_bf16(ua, bfi[st], (f32x16){}, 0, 0, 0);
                const float a1r = p_r[st][0], a1i = p_i[st][0], a4r = p_r[st][3], a4i = p_i[st][3];
#pragma unroll
                for (int k = 0; k < 4; ++k)
#pragma unroll
                    for (int jj = 1; jj < 4; ++jj) { float tr = xr[4 * k + jj], tq = xi[4 * k + jj]; cmuladd(tr, tq, a1r, a1i, xr[4 * k + jj - 1], xi[4 * k + jj - 1]); xr[4 * k + jj] = tr; xi[4 * k + jj] = tq; }
                float er = car_r[st], ei = car_i[st], cin_r[4], cin_i[4];
#pragma unroll
                for (int k = 0; k < 4; ++k) {
                    float lor, hir, loi, hii; xhalf(xr[4 * k + 3], lor, hir); xhalf(xi[4 * k + 3], loi, hii);
                    const float c0r = er, c0i = ei;
                    float nr = lor, ni = loi; cmuladd(nr, ni, a4r, a4i, er, ei); er = nr; ei = ni;
                    const float c1r = er, c1i = ei;
                    nr = hir; ni = hii; cmuladd(nr, ni, a4r, a4i, er, ei); er = nr; ei = ni;
                    cin_r[k] = hh ? c1r : c0r; cin_i[k] = hh ? c1i : c0i;
                }
                car_r[st] = er; car_i[st] = ei;
#pragma unroll
                for (int k = 0; k < 4; ++k)
#pragma unroll
                    for (int jj = 0; jj < 4; ++jj) { float tr = xr[4 * k + jj], tq = xi[4 * k + jj]; cmuladd(tr, tq, p_r[st][jj], p_i[st][jj], cin_r[k], cin_i[k]);
                        *(LAS unsigned*)(ht + (8 * k + 4 * hh + jj) * S5_HSTR + 128 * st + 4 * c) = pk2(tr, tq); }
            }
            asm volatile("" ::: "memory");
#pragma unroll
            for (int tt = 0; tt < 2; ++tt) {
                f32x4 y = {0.f, 0.f, 0.f, 0.f};
#pragma unroll
                for (int s4 = 0; s4 < 4; ++s4) { const bf16x8 hb = *(const LAS bf16x8*)(ht + (16 * tt + col) * S5_HSTR + (32 * s4 + 8 * fq) * 2); y = __builtin_amdgcn_mfma_f32_16x16x32_bf16(cf[s4], hb, y, 0, 0, 0); }
                const size_t row = (size_t)b * PSEQ + 32 * ti + 16 * tt + col; const u32x2 uw = *(const LAS u32x2*)(ht + S5_UOFF + (16 * tt + col) * 32 + fq * 8);
                u32x2 w; w.x = pk2(gelu_tanh(y[0] + d4[0] * bflo(uw.x)), gelu_tanh(y[1] + d4[1] * bfhi(uw.x))); w.y = pk2(gelu_tanh(y[2] + d4[2] * bflo(uw.y)), gelu_tanh(y[3] + d4[3] * bfhi(uw.y)));
                *(LAS u32x2*)(ht + S5_OOFF + q * 1024 + (16 * tt + col) * 32 + fq * 8) = w;
            }
            asm volatile("" ::: "memory");
          }
#pragma unroll
          for (int q = 0; q < 4; ++q)
#pragma unroll
            for (int tt = 0; tt < 2; ++tt) *(GAS u32x2*)(GBo + ((size_t)b * PSEQ + 32 * (4 * tg + q) + 16 * tt + col) * E_ + 16 * g + 4 * fq) = *(const LAS u32x2*)(ht + S5_OOFF + q * 1024 + (16 * tt + col) * 32 + fq * 8);
          asm volatile("s_waitcnt vmcnt(0)" ::: "memory");
#pragma unroll
          for (int q = 0; q < 4; ++q) ub[q] = nb[q];
        }
        const size_t so = ((size_t)b * S5G + g) * S5P + 32 * hh + c;
        F.out[O_SRP + so] = hh ? car_r[1] : car_r[0]; F.out[O_SIP + so] = hh ? car_i[1] : car_i[0];
    }
}

constexpr int AK_STR = 272, AV_STR = 520, AV_OFF = 256 * AK_STR;
static_assert(AV_OFF + 128 * AV_STR <= RING_BYTES + 8192, "attention LDS");
__device__ __forceinline__ void attn_prompt_phase(Frame& F, int layer) {
    const bf16_t* QB = (const bf16_t*)(F.ws + WS_QB); const bf16_t* KBp = (const bf16_t*)(F.ws + WS_KB); const bf16_t* VTp = (const bf16_t*)(F.ws + WS_VT); bf16_t* A2 = (bf16_t*)(F.ws + WS_A2);
    const int tid = F.tid, lane = F.lane, wid = F.wave, c = lane & 31, hh = lane >> 5;
    LAS unsigned char* lds = F.lds;
    for (int un = F.bid; un < PB * NH * 8; un += F.G) {
        const int bh = un >> 3, qb = un & 7, b = bh >> 2, h = bh & 3;
        const bf16_t* Kg = KBp + (size_t)((layer * PB + b) * NH + h) * MEML * HD; const bf16_t* Vg = VTp + (size_t)((layer * PB + b) * NH + h) * MEML * HD;
        __syncthreads();
        { u32x4 kr[8], vr[8];
#pragma unroll
          for (int i = 0; i < 8; ++i) { const int chn = tid + NTHR * i; kr[i] = *(const u32x4*)(Kg + (chn >> 4) * HD + (chn & 15) * 8); vr[i] = *(const u32x4*)(Vg + (chn >> 5) * MEML + (chn & 31) * 8); }
#pragma unroll
          for (int i = 0; i < 8; ++i) { const int chn = tid + NTHR * i, row = chn >> 4, c16 = chn & 15; *(LAS u32x4*)(lds + row * AK_STR + c16 * 16) = kr[i]; }
#pragma unroll
          for (int i = 0; i < 8; ++i) { const int chn = tid + NTHR * i, row = chn >> 5, c16 = chn & 31; const u32x4 v = vr[i];
            LAS u32x2* p = (LAS u32x2*)(lds + AV_OFF + row * AV_STR + c16 * 16); u32x2 lo, hi; lo.x = v.x; lo.y = v.y; hi.x = v.z; hi.y = v.w; p[0] = lo; p[1] = hi; } }
        __syncthreads();
        const size_t qrow = (size_t)b * PSEQ + qb * 256 + wid * 32 + c;
        f32x16 S[8];
#pragma unroll
        for (int kt = 0; kt < 8; ++kt) S[kt] = (f32x16){};
#pragma unroll
        for (int s = 0; s < 8; ++s) {
            const bf16x8 qf = *(const bf16x8*)(QB + qrow * XA + h * HD + 16 * s + 8 * hh);
#pragma unroll
            for (int kt = 0; kt < 8; ++kt) { const bf16x8 kf = *(const LAS bf16x8*)(lds + (32 * kt + c) * AK_STR + (16 * s + 8 * hh) * 2); S[kt] = __builtin_amdgcn_mfma_f32_32x32x16_bf16(kf, qf, S[kt], 0, 0, 0); }
        }
        float mx = -3.0e38f;
#pragma unroll
        for (int kt = 0; kt < 8; ++kt)
#pragma unroll
            for (int r = 0; r < 16; ++r) mx = fmaxf(mx, S[kt][r]);
        mx = fmaxf(mx, __shfl_xor(mx, 32));
        float sum = 0.f; bf16x8 pf[8][2];
#pragma unroll
        for (int kt = 0; kt < 8; ++kt) {
            float p[16];
#pragma unroll
            for (int r = 0; r < 16; ++r) { p[r] = __expf(S[kt][r] - mx); sum += p[r]; }
#pragma unroll
            for (int s2 = 0; s2 < 2; ++s2) { u32x4 w; w.x = pk2(p[8 * s2], p[8 * s2 + 1]); w.y = pk2(p[8 * s2 + 2], p[8 * s2 + 3]); w.z = pk2(p[8 * s2 + 4], p[8 * s2 + 5]); w.w = pk2(p[8 * s2 + 6], p[8 * s2 + 7]);
                pf[kt][s2] = __builtin_bit_cast(bf16x8, w); }
        }
        sum += __shfl_xor(sum, 32);
        const float inv = 1.f / sum;
        bf16_t* orow = A2 + qrow * KOUT + E_ + h * HD;
#pragma unroll
        for (int dt = 0; dt < 4; ++dt) {
            f32x16 o = {};
#pragma unroll
            for (int kt = 0; kt < 8; ++kt)
#pragma unroll
                for (int s2 = 0; s2 < 2; ++s2) {
                    const LAS unsigned char* vb = lds + AV_OFF + (32 * dt + c) * AV_STR + (32 * kt + 16 * s2 + 4 * hh) * 2;
                    const u32x2 lo = *(const LAS u32x2*)vb, hi = *(const LAS u32x2*)(vb + 16);
                    u32x4 w; w.x = lo.x; w.y = lo.y; w.z = hi.x; w.w = hi.y;
                    o = __builtin_amdgcn_mfma_f32_32x32x16_bf16(__builtin_bit_cast(bf16x8, w), pf[kt][s2], o, 0, 0, 0);
                }
#pragma unroll
            for (int g4 = 0; g4 < 4; ++g4) { u32x2 w; w.x = pk2(o[4 * g4] * inv, o[4 * g4 + 1] * inv); w.y = pk2(o[4 * g4 + 2] * inv, o[4 * g4 + 3] * inv);
                *(u32x2*)(orow + 32 * dt + 8 * g4 + 4 * hh) = w; }
        }
    }
}

__device__ __forceinline__ void attn_sample_phase(Frame& F, int layer) {
    const bf16_t* QB = (const bf16_t*)(F.ws + WS_QB); bf16_t* A2 = (bf16_t*)(F.ws + WS_A2);
    const float* CK = GIN(3) + (size_t)layer * SBT * MEML * XA; const float* CV = GIN(4) + (size_t)layer * SBT * MEML * XA;
    LAS float* sl = (LAS float*)F.lds;
    LAS float* pt = (LAS float*)(F.lds + 4096);
    LAS float* ol = (LAS float*)(F.lds + 8192);
    const int tid = F.tid, lane = F.lane, wid = F.wave, par = lane >> 5, d4 = lane & 31;
    const size_t lane_off = ((size_t)(32 * wid + par) * NH) * HD + 4 * d4;
    f32x4 kr[16];
    int un = F.bid;
    if (un < SBT * NH) { const size_t o = (size_t)(un >> 2) * MEML * XA + (size_t)(un & 3) * HD + lane_off;
#pragma unroll
        for (int j = 0; j < 16; ++j) kr[j] = *(const f32x4*)(CK + o + (size_t)j * 2 * XA); }
    for (; un < SBT * NH; un += F.G) {
        const int b = un >> 2, h = un & 3; const int nun = un + F.G; const bool has_next = nun < SBT * NH;
        const size_t no = (size_t)((has_next ? nun : un) >> 2) * MEML * XA + (size_t)((has_next ? nun : un) & 3) * HD + lane_off;
        f32x4 vr[16];
        { const size_t co = (size_t)b * MEML * XA + (size_t)h * HD + lane_off;
#pragma unroll
          for (int j = 0; j < 16; ++j) vr[j] = *(const f32x4*)(CV + co + (size_t)j * 2 * XA); }
        f32x4 q4[4];
#pragma unroll
        for (int qi = 0; qi < 4; ++qi) { const u32x2 w = *(const u32x2*)(QB + (size_t)(MP + b * 4 + qi) * XA + h * HD + 4 * d4); q4[qi] = (f32x4){bflo(w.x), bfhi(w.x), bflo(w.y), bfhi(w.y)}; }
        asm volatile("s_waitcnt vmcnt(0)" ::: "memory");
        __syncthreads();
        const bool b4 = (lane & 16) != 0, b3 = (lane & 8) != 0;
#pragma unroll
        for (int j = 0; j < 16; ++j) {
            float v[4];
#pragma unroll
            for (int qi = 0; qi < 4; ++qi) v[qi] = (kr[j][0] * q4[qi][0] + kr[j][1] * q4[qi][1]) + (kr[j][2] * q4[qi][2] + kr[j][3] * q4[qi][3]);
            const float w0 = (b4 ? v[2] : v[0]) + __shfl_xor(b4 ? v[0] : v[2], 16), w1 = (b4 ? v[3] : v[1]) + __shfl_xor(b4 ? v[1] : v[3], 16);
            float z = (b3 ? w1 : w0) + __shfl_xor(b3 ? w0 : w1, 8);
            z += __shfl_xor(z, 4); z += __shfl_xor(z, 2); z += __shfl_xor(z, 1);
            if ((lane & 7) == 0) sl[(2 * (int)b4 + (int)b3) * 256 + 32 * wid + 2 * j + par] = z;
        }
#pragma unroll
        for (int j = 0; j < 16; ++j) kr[j] = *(const f32x4*)(CK + no + (size_t)j * 2 * XA);
        __syncthreads();
        if (wid < 4) { float v[4], mx = -3.0e38f;
#pragma unroll
            for (int j = 0; j < 4; ++j) { v[j] = sl[wid * 256 + lane + 64 * j]; mx = fmaxf(mx, v[j]); }
            mx = wave_max(mx); float sm = 0.f;
#pragma unroll
            for (int j = 0; j < 4; ++j) { v[j] = __expf(v[j] - mx); sm += v[j]; }
            sm = wave_sum(sm); const float inv = 1.f / sm;
#pragma unroll
            for (int j = 0; j < 4; ++j) pt[(lane + 64 * j) * 4 + wid] = v[j] * inv; }
        __syncthreads();
        f32x4 o[4];
#pragma unroll
        for (int qi = 0; qi < 4; ++qi) o[qi] = (f32x4){0.f, 0.f, 0.f, 0.f};
#pragma unroll
        for (int j = 0; j < 16; ++j) { const f32x4 p = *(const LAS f32x4*)(pt + (32 * wid + 2 * j + par) * 4);
#pragma unroll
            for (int qi = 0; qi < 4; ++qi) o[qi] += vr[j] * p[qi]; }
#pragma unroll
        for (int qi = 0; qi < 4; ++qi) {
#pragma unroll
            for (int e = 0; e < 4; ++e) o[qi][e] += __shfl_xor(o[qi][e], 32);
            if (par == 0) *(LAS f32x4*)(ol + (wid * 4 + qi) * 128 + 4 * d4) = o[qi]; }
        __syncthreads();
        { const int qi = tid >> 7, d = tid & 127; float acc = 0.f;
#pragma unroll
          for (int w = 0; w < 8; ++w) acc += ol[(w * 4 + qi) * 128 + d];
          A2[(size_t)(MP + b * 4 + qi) * KOUT + E_ + h * HD + d] = f2bf(acc); }
    }
}

constexpr int NK_OUT = 10, NK_GLU = 8;
__device__ __forceinline__ void fixup_out_rows(Frame& F, const float* basef  , int vb, int nvb  ) {
    for (int r = vb * NWAVES + F.wave; r < MS; r += nvb * NWAVES) {
        const int lane = F.lane; const float* slab = (const float*)(F.ws + WS_SLAB);
        bf16_t* XB = (bf16_t*)(F.ws + WS_XB) + (size_t)(MP + r) * DM; float ss = 0.f;
#pragma unroll
        for (int j = 0; j < 4; ++j) { f32x4 v;
            if (basef) v = *((const f32x4*)(basef + (size_t)r * DM) + lane + 64 * j);
            else { const u32x2 w = *((const u32x2*)XB + lane + 64 * j); v = (f32x4){bflo(w.x), bfhi(w.x), bflo(w.y), bfhi(w.y)}; }
#pragma unroll
            for (int ks = 0; ks < NK_OUT; ++ks) v += *((const f32x4*)(slab + ((size_t)ks * MS + r) * DM) + lane + 64 * j);
            u32x2 w; w.x = pk2(v[0], v[1]); w.y = pk2(v[2], v[3]); *((u32x2*)XB + lane + 64 * j) = w;
            ss += (v[0] * v[0] + v[1] * v[1]) + (v[2] * v[2] + v[3] * v[3]); }
        asm volatile("s_waitcnt vmcnt(0)" ::: "memory");
        ss = wave_sum(ss);
        if (lane < 16) ((float*)(F.ws + WS_SSX))[(size_t)(MP + r) * 16 + lane] = lane == 0 ? ss : 0.f;
    }
}
__device__ __forceinline__ void fixup_glu_rows(Frame& F) {
    if (F.wave < 2) for (int r = F.bid * 2 + F.wave; r < MS; r += F.G * 2) {
        const int lane = F.lane; const float* slab = (const float*)(F.ws + WS_SLAB); const float* bias = GIN(29);
        const bf16_t* GBp = (const bf16_t*)(F.ws + WS_GB) + (size_t)(MP + r) * E_; const bf16_t* SZ = (const bf16_t*)(F.ws + WS_B1) + (size_t)(MP + r) * E_; bf16_t* A2 = (bf16_t*)(F.ws + WS_A2) + (size_t)(MP + r) * KOUT;
#pragma unroll
        for (int j = 0; j < 4; ++j) { const int c0 = 8 * (lane + 64 * j); f32x4 t0 = *(const f32x4*)(bias + c0), t1 = *(const f32x4*)(bias + c0 + 4);
#pragma unroll
            for (int ks = 0; ks < NK_GLU; ++ks) { const float* sp = slab + ((size_t)ks * MS + r) * E_ + c0; t0 += *(const f32x4*)sp; t1 += *(const f32x4*)(sp + 4); }
            float gv[8], sz[8]; unpack8(*(const u32x4*)(GBp + c0), gv); unpack8(*(const u32x4*)(SZ + c0), sz); f32x4 o0, o1;
#pragma unroll
            for (int e = 0; e < 4; ++e) { o0[e] = gv[e] * sigmoidf_(t0[e]) * sz[e]; o1[e] = gv[4 + e] * sigmoidf_(t1[e]) * sz[4 + e]; }
            *(u32x4*)(A2 + c0) = pack8(o0, o1); }
    }
}
__device__ __forceinline__ void counter_signal(unsigned* cnt) {
    asm volatile("s_waitcnt vmcnt(0)" ::: "memory"); __syncthreads();
    if (threadIdx.x == 0) { __builtin_amdgcn_fence(__ATOMIC_RELEASE, "agent"); asm volatile("s_waitcnt vmcnt(0)" ::: "memory"); __hip_atomic_fetch_add(cnt, 1u, __ATOMIC_RELAXED, __HIP_MEMORY_SCOPE_AGENT); }
}
__device__ __forceinline__ void counter_wait(unsigned* cnt, unsigned want) {
    if (threadIdx.x == 0) { unsigned sp = 0; while (__hip_atomic_load(cnt, __ATOMIC_RELAXED, __HIP_MEMORY_SCOPE_AGENT) < want) { __builtin_amdgcn_s_sleep(2); if (++sp > (1u << 22)) break; }
        __builtin_amdgcn_fence(__ATOMIC_ACQUIRE, "agent"); asm volatile("s_waitcnt vmcnt(0)" ::: "memory"); }
    __syncthreads();
}

__device__ __forceinline__ void final_row(Frame& F, int row) {
    const bf16_t* XBp = (const bf16_t*)(F.ws + WS_XB); const float* SSX = (const float*)(F.ws + WS_SSX); const float* fg = GIN(9); const int lane = F.lane;
    float s = lane < 16 ? SSX[(size_t)row * 16 + lane] : 0.f; s = wave_sum(s);
    const float r = __builtin_amdgcn_rsqf(s * (1.f / DM) + EPS);
    float* o = row < MP ? F.out + O_YP + (size_t)row * DM : F.out + O_YS + (size_t)(row - MP) * DM;
#pragma unroll
    for (int j = 0; j < 4; ++j) { const u32x2 w = *((const u32x2*)(XBp + (size_t)row * DM) + lane + 64 * j); const f32x4 v = (f32x4){bflo(w.x), bfhi(w.x), bflo(w.y), bfhi(w.y)}; const f32x4 gq = *((const f32x4*)fg + lane + 64 * j); *((f32x4*)o + lane + 64 * j) = v * r * gq; }
}
__device__ __forceinline__ void final_phase(Frame& F) {
    const int gw = F.bid * NWAVES + F.wave, NGW = F.G * NWAVES;
    asm volatile("s_waitcnt vmcnt(0)" ::: "memory"); for (int r = F.bid * NWAVES + F.wave; r < MS; r += F.G * NWAVES) final_row(F, MP + r);
#pragma unroll 2
    for (int row = gw; row < MP; row += NGW) final_row(F, row);
}

#define XB_TMO      128
#define XB_XCNT(j)  (256  + 64 * (j))
#define XB_XSUB(j)  (1280 + 64 * (j))
#define XB_XGEN(j)  (2304 + 64 * (j))
#define XB_TOP      3328
#define XB_TOPGEN   3392
#define XCD_BAR_WORDS 3456
#define XB_SPIN_CAP (1u << 20)
__device__ __forceinline__ unsigned xb_ld(unsigned* p)              { return __hip_atomic_load(p, __ATOMIC_RELAXED, __HIP_MEMORY_SCOPE_AGENT); }
__device__ __forceinline__ unsigned xb_add(unsigned* p, unsigned v) { return __hip_atomic_fetch_add(p, v, __ATOMIC_RELAXED, __HIP_MEMORY_SCOPE_AGENT); }
__device__ __forceinline__ unsigned xb_xcc_id() { return (unsigned)__builtin_amdgcn_s_getreg((3 << 11) | 20) & 0xFu; }
#define XB_SPIN(cond, bar) do { unsigned _sp = 0; while (cond) { __builtin_amdgcn_s_sleep(1); \
    if ((++_sp & 255u) == 0u) { if (xb_ld(&(bar)[XB_TMO])) break; if (_sp > XB_SPIN_CAP) { atomicAdd(&(bar)[XB_TMO], 1u); break; } } } } while (0)
struct XcdBarrier { unsigned* bar; unsigned x; volatile LAS unsigned* st; };
__device__ __forceinline__ XcdBarrier xcd_barrier_post(unsigned* bar, volatile LAS unsigned* st) {
    XcdBarrier b; b.bar = bar; b.x = xb_xcc_id(); b.st = st;
    if (threadIdx.x == 0) (void)xb_add(&bar[XB_XCNT(b.x)], 1u);
    return b;
}
__device__ __forceinline__ void xcd_barrier_complete(unsigned* bar, unsigned x, unsigned& nloc, unsigned& nx) {
    const unsigned G = gridDim.x * gridDim.y * gridDim.z;
    unsigned sum, cnt, mine, sp = 0u;
    for (;;) {
        sum = 0u; cnt = 0u; mine = 0u;
#pragma unroll
        for (unsigned j = 0; j < 16; ++j) { const unsigned c = xb_ld(&bar[XB_XCNT(j)]); sum += c; cnt += (c > 0u) ? 1u : 0u; mine = (j == x) ? c : mine; }
        if (sum == G) break;
        __builtin_amdgcn_s_sleep(1);
        if ((++sp & 255u) == 0u) { if (xb_ld(&bar[XB_TMO])) break; if (sp > XB_SPIN_CAP) { atomicAdd(&bar[XB_TMO], 1u); break; } }
    }
    nloc = mine > 0u ? mine : 1u; nx = cnt > 0u ? cnt : 1u;
}
__device__ __forceinline__ void xcd_barrier(const XcdBarrier& b) {
    asm volatile("s_waitcnt vmcnt(0)" ::: "memory");
    __syncthreads();
    if (threadIdx.x == 0) {
        unsigned* bar = b.bar;
        __builtin_amdgcn_s_waitcnt(0);
        unsigned nloc = b.st[0], nx = b.st[1];
        if (nloc == 0u) { xcd_barrier_complete(bar, b.x, nloc, nx); b.st[0] = nloc; b.st[1] = nx; }
        const unsigned old = xb_add(&bar[XB_XSUB(b.x)], 1u);
        const unsigned gen = old / nloc;
        if (old + 1u == (gen + 1u) * nloc) {
            __builtin_amdgcn_fence(__ATOMIC_RELEASE, "agent");
            asm volatile("s_waitcnt vmcnt(0)" ::: "memory");
            const unsigned og = xb_add(&bar[XB_TOP], 1u);
            const unsigned tg = og / nx;
            if (og + 1u == (tg + 1u) * nx) xb_add(&bar[XB_TOPGEN], 1u);
            else XB_SPIN(xb_ld(&bar[XB_TOPGEN]) == tg, bar);
            __builtin_amdgcn_fence(__ATOMIC_ACQUIRE, "agent");
            xb_add(&bar[XB_XGEN(b.x)], 1u);
            asm volatile("s_waitcnt vmcnt(0)" ::: "memory");
        } else {
            XB_SPIN(xb_ld(&bar[XB_XGEN(b.x)]) == gen, bar);
            __builtin_amdgcn_fence(__ATOMIC_ACQUIRE, "agent");
            asm volatile("s_waitcnt vmcnt(0)" ::: "memory");
        }
    }
    __syncthreads();
}

constexpr int NPHASE = 15;
__global__ void __launch_bounds__(NTHR, 2) fwd_kernel(Args args) {
    extern __shared__ __attribute__((aligned(16))) unsigned char lds_raw[];
    Frame F; F.lds = (LAS unsigned char*)lds_raw; F.G = gridDim.x; F.bid = blockIdx.x;
    F.in = args.in; F.out = (float*)(GAS float*)args.out; F.ws = (unsigned char*)(GAS unsigned char*)args.ws;
    unsigned char* ws = F.ws;
#define REFRESH() do { int t_ = threadIdx.x; asm volatile("" : "+v"(t_)); F.tid = t_; F.lane = t_ & 63; F.wave = __builtin_amdgcn_readfirstlane(t_ >> 6); \
        GAS unsigned char* wsg_ = (GAS unsigned char*)args.ws; asm volatile("" : "+s"(wsg_)); ws = (unsigned char*)wsg_; F.ws = ws; } while (0)
    const int lo = args.ph_lo, hi = args.ph_hi;
#if MK_ONE_LAUNCH
    cg::grid_group grid = cg::this_grid();
    if (lo < 0) grid.sync();
    { volatile LAS unsigned* st0 = (volatile LAS unsigned*)(F.lds + LDS_BYTES - 64); if (threadIdx.x < 16) st0[threadIdx.x] = 0u; }
    __syncthreads();
    const XcdBarrier xbar = xcd_barrier_post((unsigned*)(args.ws + WS_CTL), (volatile LAS unsigned*)(F.lds + LDS_BYTES - 64));
#define SEAM(k) do { if (lo <= (k) && (k) + 1 < hi) xcd_barrier(xbar); } while (0)
#else
#define SEAM(k) do { } while (0)
#endif
#ifndef PHASE_MASK
#define PHASE_MASK 0x7fff
#endif
#define REP(k) for (int rep_ = 0; rep_ <= (((PROBE_REP_MASK) >> (k)) & 1); ++rep_)
#define WSSEL(bit) do { if ((FLAT_FN_MASK >> (bit)) & 1) { unsigned char* w_ = args.ws; asm volatile("" : "+s"(w_)); F.ws = w_; } else { GAS unsigned char* g_ = (GAS unsigned char*)args.ws; asm volatile("" : "+s"(g_)); F.ws = (unsigned char*)g_; } } while (0)
#define IN(k) ((((PHASE_MASK) >> (k)) & 1) && lo <= (k) && (k) < hi)
#define XB ((bf16_t*)(ws + WS_XB))
#define X ((float*)(ws + WS_X))
#define SSX ((float*)(ws + WS_SSX))
#define SSV ((float*)(ws + WS_SSV))
#define B0 ((bf16_t*)(ws + WS_B0))
#define B1 ((bf16_t*)(ws + WS_B1))
#define QBp ((bf16_t*)(ws + WS_QB))
#define A2 ((bf16_t*)(ws + WS_A2))
#define GBp ((bf16_t*)(ws + WS_GB))
    const int G = F.G, bid = F.bid;

    if (IN(0)) REP(0) { REFRESH(); WSSEL(0); p0_prologue(F); __syncthreads(); } SEAM(0);
#define CNT(k) ((unsigned*)(ws + WS_CTL) + 4096 + 64 * (k))
#define WOUT(l) ((const bf16_t*)(ws + WS_WOUT) + (size_t)(l) * DM * KOUT)
#define INPROJ(EpiT, E, W, N, cnt, want) do { \
        pg8::Gemm g{XB, (W), M, (N), DM, DM}; pg8::StaticOrder S; S.init(MP, (N), G, bid); pg8::gemm_phase<EpiT, pg8::StaticOrder, true, true>(F.lds, g, S, E); \
        if (cnt) counter_wait(cnt, (unsigned)(want)); \
        const int rem = ((MP / 256) * ((N) / 256)) % G; pg8::StaticOrder S2; S2.init(MS, (N), G, (bid + G - rem) % G, MP / 256); pg8::gemm_phase<EpiT, pg8::StaticOrder, true, true>(F.lds, g, S2, E); } while (0)
#define OUTPROJ_PROMPT(l, bp) do { pg8::Gemm g{A2, WOUT(l), M, DM, KOUT, KOUT}; pg8::StaticOrder S; S.init(MP, DM, G, bid); EpiOut E{(bp), XB, SSX}; pg8::gemm_phase<EpiOut, pg8::StaticOrder, true, true>(F.lds, g, S, E); } while (0)
#define OUTPROJ_SLICES(l, c, nb) do { pg8::Gemm g{A2, WOUT(l), M, DM, 256, KOUT}; typedef pg8::SliceOrder<MS / 256, DM / 256, NK_OUT> SO; SO S; S.init((nb), (c), MP / 256); \
        EpiSlab E{(float*)(ws + WS_SLAB), DM, MP, (size_t)MS * DM}; pg8::gemm_phase<EpiSlab, SO, true, true>(F.lds, g, S, E); } while (0)
#define SLICEFIX(l, sb0, basef, cA, cB) do { if (bid >= (sb0)) { const int nsb_ = G - (sb0); OUTPROJ_SLICES(l, bid - (sb0), nsb_); counter_signal(cA); counter_wait(cA, (unsigned)nsb_); \
        fixup_out_rows(F, (basef), bid - (sb0), nsb_); counter_signal(cB); } } while (0)
#define KVPROJ(l, c0) do { pg8::Gemm g{(const bf16_t*)(ws + WS_MEMB), (const bf16_t*)(ws + WS_WKV) + (size_t)(l) * DM * DM, PB * MEML, DM, DM, DM}; pg8::StaticOrder S; S.init(g.M, g.N, G, (bid + G - (c0)) % G); \
        EpiKV E{(const float*)(ws + WS_RSTDM), F.out + O_MK, F.out + O_MV, (bf16_t*)(ws + WS_KB), (bf16_t*)(ws + WS_VT), (l)}; pg8::gemm_phase<EpiKV, pg8::StaticOrder, true, true>(F.lds, g, S, E); } while (0)
    if (IN(1)) REP(1) { REFRESH();
        { EpiInA E{SSX, B0, B1, QBp, SSV}; INPROJ(EpiInA, E, (const bf16_t*)(ws + WS_WINA), NIN_A, (unsigned*)nullptr, 0); }
        KVPROJ(0, 180); KVPROJ(1, 212);
    } SEAM(1);
    if (IN(2)) REP(2) { REFRESH(); WSSEL(1);
        sgu_phase_mfma(F, 0); sgu_sample_phase(F, 0); attn_prompt_phase(F, 0); attn_sample_phase(F, 0); } SEAM(2);
    if (IN(3)) REP(3) { REFRESH(); OUTPROJ_PROMPT(0, GIN(0)); } SEAM(3);
    if (IN(4)) REP(4) { REFRESH(); SLICEFIX(0, 196, GIN(1), CNT(0), CNT(4));
        EpiInB E{SSX, B0, B1, QBp, F.out + O_CP, F.out + O_CS}; INPROJ(EpiInB, E, (const bf16_t*)(ws + WS_WINB), NIN_B, CNT(4), G - 196); } SEAM(4);
    if (IN(5)) REP(5) { REFRESH(); WSSEL(3);
        conv_phase(F); attn_prompt_phase(F, 1); attn_sample_phase(F, 1); } SEAM(5);
    if (IN(6)) REP(6) { REFRESH(); OUTPROJ_PROMPT(1, (const float*)nullptr); } SEAM(6);
    if (IN(7)) REP(7) { REFRESH(); SLICEFIX(1, 196, (const float*)nullptr, CNT(1), CNT(5));
        EpiInC E{SSX, B0, B1, QBp}; INPROJ(EpiInC, E, (const bf16_t*)(ws + WS_WINC), NIN_C, CNT(5), G - 196); KVPROJ(2, 164); } SEAM(7);
    if (IN(8)) REP(8) { REFRESH();
        const int half = G / 2;
        if (bid < half) { F.G = half; WSSEL(4); s5_prompt_mfma(F); if (PROBE_SUB_MASK & 8) s5_prompt_mfma(F); }
        else { F.bid = bid - half; F.G = G - half; for (int r2 = 0; r2 <= ((PROBE_SUB_MASK >> 4) & 1); ++r2) { WSSEL(6); attn_prompt_phase(F, 2); WSSEL(7); attn_sample_phase(F, 2); WSSEL(5); s5_sample_phase(F); } }
        F.bid = bid; F.G = G; } SEAM(8);
    if (IN(9)) REP(9) { REFRESH();
        { pg8::Gemm g{GBp, (const bf16_t*)(ws + WS_WGLU), M, E_, E_, E_}; pg8::StaticOrder S; S.init(MP, E_, G, bid); EpiGlu E{GBp, B1, GIN(29), A2}; pg8::gemm_phase<EpiGlu, pg8::StaticOrder, true, true>(F.lds, g, S, E); }
        { pg8::Gemm g{GBp, (const bf16_t*)(ws + WS_WGLU), M, E_, 256, E_}; typedef pg8::SliceOrder<MS / 256, E_ / 256, NK_GLU> SG; SG S; S.init(G, bid, MP / 256); EpiSlab E{(float*)(ws + WS_SLAB), E_, MP, (size_t)MS * E_}; pg8::gemm_phase<EpiSlab, SG, true, true>(F.lds, g, S, E); } } SEAM(9);
    if (IN(10)) REP(10) { REFRESH(); fixup_glu_rows(F);
        OUTPROJ_PROMPT(2, (const float*)nullptr); } SEAM(10);
    if (IN(11)) REP(11) { REFRESH(); SLICEFIX(2, 212, (const float*)nullptr, CNT(3), CNT(6));
        EpiInA E{SSX, B0, B1, QBp, SSV}; INPROJ(EpiInA, E, (const bf16_t*)(ws + WS_WINA) + (size_t)NIN_A * DM, NIN_A, CNT(6), G - 212); KVPROJ(3, 180); } SEAM(11);
    if (IN(12)) REP(12) { REFRESH(); WSSEL(1);
        sgu_phase_mfma(F, 1); sgu_sample_phase(F, 1); attn_prompt_phase(F, 3); attn_sample_phase(F, 3); } SEAM(12);
    if (IN(13)) REP(13) { REFRESH(); OUTPROJ_PROMPT(3, (const float*)nullptr); OUTPROJ_SLICES(3, bid, G); } SEAM(13);
    if (IN(14)) REP(14) { REFRESH(); WSSEL(8); fixup_out_rows(F, (const float*)nullptr, bid, G); final_phase(F); }
#undef CNT
#undef WOUT
#undef KVPROJ
#undef INPROJ
#undef OUTPROJ_PROMPT
#undef OUTPROJ_SLICES
#undef SLICEFIX
#undef IN
#undef REP
#undef SEAM
#undef XB
#undef X
#undef SSX
#undef SSV
#undef B0
#undef B1
#undef QBp
#undef A2
#undef GBp
#undef REFRESH
}

extern "C" void kernel_launch(void* const* d_in, const int* in_sizes, int n_in, void* d_out, int out_size, void* d_ws, size_t ws_size, hipStream_t stream) {
    static int grid = 0;
    if (grid == 0) {
        if (n_in != 30 || out_size != (int)O_END || ws_size < WS_END) { fprintf(stderr, "kernel_launch: unexpected shapes (n_in %d out %d ws %zu)\n", n_in, out_size, ws_size); grid = -1; return; }
        int dev = 0, cus = 0, per_cu = 0;
        (void)hipGetDevice(&dev); (void)hipDeviceGetAttribute(&cus, hipDeviceAttributeMultiprocessorCount, dev);
        if (hipFuncSetAttribute((const void*)fwd_kernel, hipFuncAttributeMaxDynamicSharedMemorySize, LDS_BYTES) != hipSuccess) { fprintf(stderr, "kernel_launch: hipFuncSetAttribute failed\n"); grid = -1; return; }
        if (hipOccupancyMaxActiveBlocksPerMultiprocessor(&per_cu, (const void*)fwd_kernel, NTHR, LDS_BYTES) != hipSuccess || per_cu < 1) { fprintf(stderr, "kernel_launch: occupancy query says %d\n", per_cu); (void)hipGetLastError(); per_cu = 1; }
        grid = cus;
    }
    if (grid < 0) return;
    Args a{};
    for (int i = 0; i < 30; ++i) a.in[i] = (const float*)d_in[i];
    a.out = (float*)d_out; a.ws = (unsigned char*)d_ws;
#if MK_ONE_LAUNCH
    (void)hipMemsetAsync((char*)d_ws + WS_CTL, 0, 65536, stream);
    a.ph_lo = 0; a.ph_hi = NPHASE;
    void* kargs[] = {&a};
    hipError_t e = hipLaunchCooperativeKernel((const void*)fwd_kernel, dim3(grid), dim3(NTHR), kargs, LDS_BYTES, stream);
    if (e != hipSuccess) fprintf(stderr, "cooperative launch failed: %s (grid %d)\n", hipGetErrorString(e), grid);
#else
    for (int p = 0; p < NPHASE; ++p) { a.ph_lo = p; a.ph_hi = p + 1; hipLaunchKernelGGL(fwd_kernel, dim3(grid), dim3(NTHR), LDS_BYTES, stream, a); }
#endif
}
```

```cpp
#include <hip/hip_runtime.h>
#include <hip/hip_cooperative_groups.h>
#include <cstdio>
#include <cstdint>
namespace cg = cooperative_groups;

#ifndef MK_ONE_LAUNCH
#define MK_ONE_LAUNCH 1
#endif
#ifndef XHALF_SHFL
#define XHALF_SHFL 0
#endif
#ifndef EPI_DRAIN
#define EPI_DRAIN 1
#endif
#ifndef FLAT_FN_MASK
#define FLAT_FN_MASK 0x00
#endif
#ifndef PROBE_SUB_MASK
#define PROBE_SUB_MASK 0
#endif
#ifndef PROBE_REP_MASK
#define PROBE_REP_MASK 0
#endif

namespace pg8 {
#define PG8_LAS __attribute__((address_space(3)))
typedef unsigned short bf16_t;
typedef short bf16x8 __attribute__((ext_vector_type(8)));
typedef float f32x4 __attribute__((ext_vector_type(4)));
typedef unsigned u32x4 __attribute__((ext_vector_type(4)));
typedef unsigned u32x2 __attribute__((ext_vector_type(2)));
constexpr int BM = 256, BK = 64, HALF = 128, HTB = HALF * BK * 2, STAGE_BYTES = 8 * HTB, NXCD = 8, WGM = 8;

__host__ __device__ __forceinline__ int lds_byte(int r, int c) { const int st = (r >> 4) * 2 + (c >> 5), rr = r & 15, cc = c & 31, ob = rr * 64 + cc * 2; return st * 1024 + (ob ^ (((ob >> 9) & 1) << 5)); }
__host__ __device__ __forceinline__ void stage_rc(int b, int& R, int& C) { const int st = b / 1024, sb = b % 1024, swz = sb ^ (((sb >> 9) & 1) << 5); R = (st >> 1) * 16 + swz / 64; C = (st & 1) * 32 + (swz % 64) / 2; }
__host__ __device__ __forceinline__ int perm32(int rho) { const int n = rho >> 4, i = rho & 15; return 8 * (i >> 2) + 4 * n + (i & 3); }

struct Unit { int pm, pn, ks; };
struct Gemm { const bf16_t* A; const bf16_t* Bt; int M, N, K, ld; };

struct StaticOrder {
    int nM, nN, nwg, G, c, pm0;
    __host__ __device__ void init(int M, int N, int G_, int c_, int pm0_ = 0) { nM = M / BM; nN = N / BM; nwg = nM * nN; G = G_; c = c_; pm0 = pm0_; }
    __host__ __device__ bool next(int i, Unit& u) const {
        const long L = (long)i * G + c; if (L >= nwg) return false;
        int wgid = (int)L; { const int q = nwg / NXCD, r = nwg % NXCD, xcd = wgid % NXCD, off = wgid / NXCD; wgid = (xcd < r ? xcd * (q + 1) : r * (q + 1) + (xcd - r) * q) + off; }
        const int nig = WGM * nN, gid = wgid / nig, fm = gid * WGM, gsz = (nM - fm) < WGM ? (nM - fm) : WGM;
        u.pm = pm0 + fm + ((wgid % nig) % gsz); u.pn = (wgid % nig) / gsz; u.ks = 0; return true;
    }
    __device__ __forceinline__ void a_ready(const Unit&) const {}
    __device__ __forceinline__ void done(const Unit&) const {}
};
template <int NM_, int NN_, int NK_> struct SliceOrder {
    int G, c, pm0;
    __host__ __device__ void init(int G_, int c_, int pm0_) { G = G_; c = c_; pm0 = pm0_; }
    __host__ __device__ bool next(int i, Unit& u) const {
        const int L = i * G + c; if (L >= NM_ * NN_ * NK_) return false;
        const int t = L / NK_; u.ks = L % NK_; u.pn = t % NN_; u.pm = pm0 + t / NN_; return true;
    }
    __device__ __forceinline__ void a_ready(const Unit&) const {}
    __device__ __forceinline__ void done(const Unit&) const {}
};

template <class Epi, class Sched, bool ALIGN_EPI = false, bool SP2 = false>
__device__ __forceinline__ void gemm_phase(PG8_LAS unsigned char* lds, const Gemm g, const Sched& S, const Epi& E) {
    int tid = threadIdx.x; asm volatile("" : "+v"(tid));
    const int wid = __builtin_amdgcn_readfirstlane(tid >> 6), lane = tid & 63, wr = wid >> 2, wc = wid & 3, fr = lane & 15, fq = lane >> 4;
    const int K = g.K, ld = g.ld, nt = K / BK;
    unsigned voffA[2], voffB[2];
#pragma unroll
    for (int i = 0; i < 2; ++i) { int R, C; stage_rc(tid * 16 + i * 8192, R, C); const int Rb = Epi::PERM ? ((R & ~31) + perm32(R & 31)) : R;
        voffA[i] = (unsigned)(R * ld + C) * 2u; voffB[i] = (unsigned)(Rb * ld + C) * 2u; }
    const size_t kstep = (size_t)(BK * 2);
    const size_t hstep = (size_t)HALF * ld * 2;
    const size_t sstep = (size_t)K * 2;
    const size_t tstep = 2 * hstep;
    const unsigned ldsw = (unsigned)wid * 1024u;
    const int aoff = lds_byte(wr * 64 + fr, fq * 8), boff = lds_byte(wc * 32 + fr, fq * 8);
#define PG8_SA(b, h) (((b) * 2 + (h)) * HTB)
#define PG8_SB(b, h) ((4 + (b) * 2 + (h)) * HTB)
#define PG8_STAGE(bufoff, gbase, voff) do { _Pragma("unroll") for (int _i = 0; _i < 2; ++_i) \
        __builtin_amdgcn_global_load_lds((const unsigned*)((const char*)(gbase) + (voff)[_i]), (PG8_LAS unsigned*)(lds + (bufoff) + ldsw + _i * 8192), 16, 0, 0); } while (0)
#define PG8_LDA(dst, b, h) do { _Pragma("unroll") for (int m = 0; m < 4; ++m) _Pragma("unroll") for (int k = 0; k < 2; ++k) dst[m][k] = *(const PG8_LAS bf16x8*)(lds + PG8_SA(b, h) + aoff + m * 2048 + k * 1024); } while (0)
#define PG8_LDB(dst, b, h) do { _Pragma("unroll") for (int n = 0; n < 2; ++n) _Pragma("unroll") for (int k = 0; k < 2; ++k) dst[n][k] = *(const PG8_LAS bf16x8*)(lds + PG8_SB(b, h) + boff + n * 2048 + k * 1024); } while (0)
#define PG8_MMA(ai, bj, At, Bt) do { __builtin_amdgcn_s_setprio(1); _Pragma("unroll") for (int m = 0; m < 4; ++m) _Pragma("unroll") for (int n = 0; n < 2; ++n) _Pragma("unroll") for (int k = 0; k < 2; ++k) \
        acc[ai][bj][m][n] = __builtin_amdgcn_mfma_f32_16x16x32_bf16(Bt[n][k], At[m][k], acc[ai][bj][m][n], 0, 0, 0); __builtin_amdgcn_s_setprio(0); } while (0)
#define PG8_WAIT_V(n) asm volatile("s_waitcnt vmcnt(" #n ")" ::: "memory")
#define PG8_WAIT_L(n) asm volatile("s_waitcnt lgkmcnt(" #n ")" ::: "memory")
#define PG8_BAR __builtin_amdgcn_s_barrier()
#define PG8_SCHED __builtin_amdgcn_sched_barrier(0)
    Unit cur, nxt; int ui = 0;
    if (!S.next(0, cur)) return;
    f32x4 acc[2][2][4][2];
#pragma unroll
    for (int a = 0; a < 2; ++a)
#pragma unroll
        for (int b = 0; b < 2; ++b)
#pragma unroll
            for (int m = 0; m < 4; ++m)
#pragma unroll
                for (int n = 0; n < 2; ++n) acc[a][b][m][n] = (f32x4){0.f, 0.f, 0.f, 0.f};
    bf16x8 At[4][2], B0[2][2], B1[2][2];
    const char* cA = (const char*)g.A + (size_t)cur.pm * tstep + (size_t)cur.ks * sstep; const char* cB = (const char*)g.Bt + (size_t)cur.pn * tstep + (size_t)cur.ks * sstep;
    S.a_ready(cur);
    if constexpr (SP2) {
        PG8_STAGE(PG8_SB(0, 0), cB, voffB); PG8_STAGE(PG8_SB(0, 1), cB + hstep, voffB); PG8_STAGE(PG8_SA(0, 0), cA, voffA); PG8_STAGE(PG8_SA(0, 1), cA + hstep, voffA);
        if (wr == 1) PG8_BAR;
        PG8_WAIT_V(2); PG8_BAR;
        PG8_STAGE(PG8_SB(1, 0), cB + kstep, voffB); PG8_STAGE(PG8_SA(1, 0), cA + kstep, voffA); PG8_STAGE(PG8_SB(1, 1), cB + hstep + kstep, voffB);
        PG8_WAIT_V(6); PG8_BAR;
    } else {
        PG8_STAGE(PG8_SB(0, 0), cB, voffB); PG8_STAGE(PG8_SA(0, 0), cA, voffA); PG8_STAGE(PG8_SB(0, 1), cB + hstep, voffB); PG8_STAGE(PG8_SA(0, 1), cA + hstep, voffA);
        if (wr == 1) PG8_BAR;
        PG8_WAIT_V(4); PG8_BAR;
        PG8_STAGE(PG8_SB(1, 0), cB + kstep, voffB); PG8_STAGE(PG8_SA(1, 0), cA + kstep, voffA); PG8_STAGE(PG8_SB(1, 1), cB + hstep + kstep, voffB);
        PG8_WAIT_V(6); PG8_BAR;
    }
    for (;;) {
        const bool has_next = S.next(ui + 1, nxt);
        const char* nA = has_next ? (const char*)g.A + (size_t)nxt.pm * tstep + (size_t)nxt.ks * sstep : cA; const char* nB = has_next ? (const char*)g.Bt + (size_t)nxt.pn * tstep + (size_t)nxt.ks * sstep : cB;
        for (int t = 0; t < nt; t += 2) {
            const bool last = (t == nt - 2);
            const char* a1 = cA + (size_t)(t + 1) * kstep;
            const char* a2 = last ? nA : cA + (size_t)(t + 2) * kstep; const char* b2 = last ? nB : cB + (size_t)(t + 2) * kstep;
            const char* a3 = a2 + kstep; const char* b3 = b2 + kstep;
            if (last && has_next) S.a_ready(nxt);
            if constexpr (SP2) {
            PG8_LDB(B0, 0, 0); PG8_LDB(B1, 0, 1); PG8_SCHED; PG8_LDA(At, 0, 0); PG8_STAGE(PG8_SA(1, 1), a1 + hstep, voffA);
            PG8_WAIT_V(8); PG8_WAIT_L(0); PG8_BAR; PG8_MMA(0, 0, At, B0); PG8_MMA(0, 1, At, B1); PG8_BAR; PG8_SCHED;
            PG8_LDA(At, 0, 1); PG8_STAGE(PG8_SB(0, 0), b2, voffB); PG8_STAGE(PG8_SB(0, 1), b2 + hstep, voffB); PG8_STAGE(PG8_SA(0, 0), a2, voffA);
            PG8_WAIT_V(8); PG8_WAIT_L(0); PG8_BAR; PG8_MMA(1, 0, At, B0); PG8_MMA(1, 1, At, B1); PG8_BAR; PG8_SCHED;
            PG8_LDB(B0, 1, 0); PG8_LDB(B1, 1, 1); PG8_SCHED; PG8_LDA(At, 1, 0); PG8_STAGE(PG8_SA(0, 1), a2 + hstep, voffA);
            PG8_WAIT_V(8); PG8_WAIT_L(0); PG8_BAR; PG8_MMA(0, 0, At, B0); PG8_MMA(0, 1, At, B1); PG8_BAR; PG8_SCHED;
            PG8_LDA(At, 1, 1); PG8_STAGE(PG8_SB(1, 0), b3, voffB); PG8_STAGE(PG8_SB(1, 1), b3 + hstep, voffB); PG8_STAGE(PG8_SA(1, 0), a3, voffA);
            PG8_WAIT_V(8); PG8_WAIT_L(0); PG8_BAR; PG8_MMA(1, 0, At, B0); PG8_MMA(1, 1, At, B1); PG8_BAR; PG8_SCHED;
            } else {
            PG8_LDB(B0, 0, 0); PG8_SCHED; PG8_LDA(At, 0, 0); PG8_STAGE(PG8_SA(1, 1), a1 + hstep, voffA);
            PG8_WAIT_L(8); PG8_BAR; PG8_WAIT_L(0); PG8_MMA(0, 0, At, B0); PG8_BAR; PG8_SCHED;
            PG8_LDB(B1, 0, 1); PG8_STAGE(PG8_SB(0, 0), b2, voffB);
            PG8_BAR; PG8_WAIT_L(0); PG8_MMA(0, 1, At, B1); PG8_BAR;
            PG8_LDA(At, 0, 1); PG8_STAGE(PG8_SA(0, 0), a2, voffA);
            PG8_BAR; PG8_WAIT_L(0); PG8_MMA(1, 0, At, B0); PG8_BAR; PG8_SCHED;
            PG8_STAGE(PG8_SB(0, 1), b2 + hstep, voffB);
            PG8_WAIT_V(6); PG8_BAR; PG8_MMA(1, 1, At, B1); PG8_BAR;
            PG8_LDB(B0, 1, 0); PG8_SCHED; PG8_LDA(At, 1, 0); PG8_STAGE(PG8_SA(0, 1), a2 + hstep, voffA);
            PG8_WAIT_L(8); PG8_BAR; PG8_WAIT_L(0); PG8_MMA(0, 0, At, B0); PG8_BAR; PG8_SCHED;
            PG8_LDB(B1, 1, 1); PG8_STAGE(PG8_SB(1, 0), b3, voffB);
            PG8_BAR; PG8_WAIT_L(0); PG8_MMA(0, 1, At, B1); PG8_BAR;
            PG8_LDA(At, 1, 1); PG8_STAGE(PG8_SA(1, 0), a3, voffA);
            PG8_BAR; PG8_WAIT_L(0); PG8_MMA(1, 0, At, B0); PG8_BAR; PG8_SCHED;
            PG8_STAGE(PG8_SB(1, 1), b3 + hstep, voffB);
            PG8_WAIT_V(6); PG8_BAR; PG8_MMA(1, 1, At, B1); PG8_BAR;
            }
        }
        if constexpr (ALIGN_EPI) { if (wr == 0) PG8_BAR; }
        if constexpr (!Epi::AFTER_DRAIN) { E(acc, cur, wr, wc, fr, fq); S.done(cur); }
#if EPI_DRAIN
        PG8_WAIT_V(0);
#endif
        if (!has_next) break;
#pragma unroll
        for (int a = 0; a < 2; ++a)
#pragma unroll
            for (int b = 0; b < 2; ++b)
#pragma unroll
                for (int m = 0; m < 4; ++m)
#pragma unroll
                    for (int n = 0; n < 2; ++n) acc[a][b][m][n] = (f32x4){0.f, 0.f, 0.f, 0.f};
        cur = nxt; cA = nA; cB = nB; ++ui;
        if constexpr (ALIGN_EPI) { if (wr == 1) PG8_BAR; }
    }
    PG8_WAIT_V(0);
    if constexpr (!ALIGN_EPI) { if (wr == 0) PG8_BAR; }
    PG8_BAR;
#undef PG8_SA
#undef PG8_SB
#undef PG8_STAGE
#undef PG8_LDA
#undef PG8_LDB
#undef PG8_MMA
#undef PG8_WAIT_V
#undef PG8_WAIT_L
#undef PG8_BAR
#undef PG8_SCHED
}
}

using pg8::bf16_t; using pg8::f32x4; using pg8::u32x4; using pg8::u32x2; using pg8::bf16x8; using pg8::Unit;
#define LAS __attribute__((address_space(3)))
#define GAS __attribute__((address_space(1)))
#define GIN(k) ((const float*)(const GAS float*)F.in[k])
typedef float f32x2 __attribute__((ext_vector_type(2)));
typedef __bf16 bf16x2_t __attribute__((ext_vector_type(2)));
typedef float f32x16 __attribute__((ext_vector_type(16)));

constexpr int DM = 1024, E_ = 2048, XA = 512, NH = 4, HD = 128, MEML = 256;
constexpr int PB = 8, PSEQ = 2048, MP = PB * PSEQ;
constexpr int SBT = 128, SSEQ = 4, MS = SBT * SSEQ;
constexpr int M = MP + MS;
constexpr int NIN_A = 3 * E_ + XA, NIN_B = 4 * E_ + XA, NIN_C = 2 * E_ + XA, KOUT = E_ + XA;
constexpr int S5G = 128, S5P = 64, S5I = 16;
constexpr float EPS = 1e-6f;
constexpr int NWAVES = 8, NTHR = 512;

constexpr size_t O_YP = 0, O_YS = O_YP + (size_t)MP * DM, O_MK = O_YS + (size_t)MS * DM, O_MV = O_MK + 4ull * PB * MEML * XA, O_CP = O_MV + 4ull * PB * MEML * XA,
                 O_CS = O_CP + (size_t)PB * 2 * E_, O_SRP = O_CS + (size_t)SBT * 2 * E_, O_SIP = O_SRP + (size_t)PB * S5G * S5P, O_SRS = O_SIP + (size_t)PB * S5G * S5P,
                 O_SIS = O_SRS + (size_t)SBT * S5G * S5P, O_CV = O_SIS + (size_t)SBT * S5G * S5P, O_END = O_CV + 2ull * SBT * SSEQ * E_;
static_assert(O_END == 30572544ull, "output size");

constexpr size_t MiB = 1u << 20;
constexpr size_t WS_CTL = 0, WS_TAB = 1 * MiB, WS_RSTDM = 3 * MiB, WS_SGUW = 4 * MiB, WS_SSX = 5 * MiB, WS_SSV = 7 * MiB, WS_WKV = 10 * MiB, WS_WGLU = 18 * MiB, WS_WOUT = 26 * MiB,
                 WS_WINA = 46 * MiB, WS_WINB = 72 * MiB, WS_WINC = 89 * MiB, WS_MEMB = 98 * MiB, WS_KB = 102 * MiB, WS_VT = 110 * MiB, WS_XB = 118 * MiB, WS_X = 151 * MiB,
                 WS_B0 = 217 * MiB, WS_B1 = 283 * MiB, WS_QB = 349 * MiB, WS_A2 = 366 * MiB, WS_GB = 449 * MiB, WS_SLAB = 515 * MiB  , WS_END = 548 * MiB;
constexpr size_t T_AR = 0, T_AI = 8192, T_BBR = 16384, T_BBI = 16384 + 131072;

constexpr int RING_BYTES = 131072, LDS_BYTES = 147456;

struct Args { const float* in[30]; float* out; unsigned char* ws; int ph_lo, ph_hi; };

__device__ __forceinline__ unsigned pk2(float lo, float hi) { f32x2 v = {lo, hi}; return __builtin_bit_cast(unsigned, __builtin_convertvector(v, bf16x2_t)); }
__device__ __forceinline__ bf16_t f2bf(float f) { return (bf16_t)(pk2(f, 0.f) & 0xffffu); }
__device__ __forceinline__ float bf2f(unsigned short h) { return __uint_as_float((unsigned)h << 16); }
__device__ __forceinline__ float bflo(unsigned w) { return __uint_as_float(w << 16); }
__device__ __forceinline__ float bfhi(unsigned w) { return __uint_as_float(w & 0xffff0000u); }
__device__ __forceinline__ float sigmoidf_(float x) { return __builtin_amdgcn_rcpf(1.f + __expf(-x)); }
__device__ __forceinline__ float siluf_(float x) { return x * sigmoidf_(x); }
__device__ __forceinline__ float gelu_tanh(float x) { const float y = 0.7978845608028654f * (x + 0.044715f * x * x * x); return x * sigmoidf_(2.f * y); }
__device__ __forceinline__ float wave_sum(float v) {
#pragma unroll
    for (int o = 1; o < 64; o <<= 1) v += __shfl_xor(v, o);
    return v;
}
__device__ __forceinline__ float wave_max(float v) {
#pragma unroll
    for (int o = 1; o < 64; o <<= 1) v = fmaxf(v, __shfl_xor(v, o));
    return v;
}
__device__ __forceinline__ u32x4 pack8(f32x4 a, f32x4 b) { u32x4 w; w.x = pk2(a[0], a[1]); w.y = pk2(a[2], a[3]); w.z = pk2(b[0], b[1]); w.w = pk2(b[2], b[3]); return w; }
__device__ __forceinline__ void unpack8(u32x4 w, float (&f)[8]) { f[0] = bflo(w.x); f[1] = bfhi(w.x); f[2] = bflo(w.y); f[3] = bfhi(w.y); f[4] = bflo(w.z); f[5] = bfhi(w.z); f[6] = bflo(w.w); f[7] = bfhi(w.w); }

__device__ __forceinline__ int src_col(int kind, int np) {
    const int pn = np >> 8, p = np & 255, pos = (p & ~31) + pg8::perm32(p & 31);
    if (kind == 0) {
        if (pn < 16) return pos < 128 ? 128 * pn + pos : 2 * E_ + 128 * pn + (pos - 128);
        if (pn < 24) return E_ + 256 * (pn - 16) + pos;
        return 3 * E_ + 256 * (pn - 24) + pos;
    }
    if (kind == 1) {
        if (pn < 32) { const int qs = 2 * (p >> 7) + ((p >> 4) & 1), ch = 64 * pn + 16 * ((p >> 5) & 3) + (p & 15); return qs * E_ + ch; }
        return 4 * E_ + 256 * (pn - 32) + pos;
    }
    return 256 * pn + pos;
}

__device__ __forceinline__ float sum_rows4(float x) {
    auto a = __builtin_amdgcn_permlane16_swap(__float_as_uint(x), __float_as_uint(x), false, false); const float y = __uint_as_float(a[0]) + __uint_as_float(a[1]);
    auto b = __builtin_amdgcn_permlane32_swap(__float_as_uint(y), __float_as_uint(y), false, false); return __uint_as_float(b[0]) + __uint_as_float(b[1]);
}
__device__ __forceinline__ void rows_rstd16(const float* ssx, int row0, int fq, float (&rs)[2][4]) {
#pragma unroll
    for (int ai = 0; ai < 2; ++ai)
#pragma unroll
        for (int m = 0; m < 4; ++m) {
            const f32x4 v = *(const f32x4*)(ssx + (size_t)(row0 + ai * 128 + m * 16) * 16 + fq * 4);
            const float s = sum_rows4((v[0] + v[1]) + (v[2] + v[3]));
            rs[ai][m] = __builtin_amdgcn_rsqf(s * (1.f / DM) + EPS);
        }
}

struct EpiKV {
    static constexpr bool PERM = false, AFTER_DRAIN = false;
    const float* rstdm; float* outk; float* outv; bf16_t* KB; bf16_t* VT; int layer;
    __device__ __forceinline__ void operator()(const f32x4 (&acc)[2][2][4][2], const Unit& u, int wr, int wc, int fr, int fq) const {
        const int sub = u.pn & 3, isv = sub >> 1, b = u.pm;
        const int key0 = wr * 64 + fr, d0 = 32 * wc + 8 * fq;
        const float* rsp = rstdm + b * 256 + key0;
        float* of = (isv ? outv : outk) + (((size_t)(layer * PB + b) * MEML + key0) * NH + (sub & 1) * 2) * HD + d0;
        const size_t bh0 = (size_t)((layer * PB + b) * NH + (sub & 1) * 2);
        if (!isv) {
            bf16_t* kb = KB + (bh0 * MEML + key0) * HD + d0;
#pragma unroll
            for (int ai = 0; ai < 2; ++ai)
#pragma unroll
                for (int m = 0; m < 4; ++m) { const int kk = ai * 128 + m * 16; const float rs = rsp[kk];
#pragma unroll
                    for (int bj = 0; bj < 2; ++bj) { const f32x4 v0 = acc[ai][bj][m][0] * rs, v1 = acc[ai][bj][m][1] * rs;
                        float* o = of + (size_t)kk * XA + bj * HD; *(f32x4*)o = v0; *(f32x4*)(o + 4) = v1;
                        *(u32x4*)(kb + (size_t)bj * MEML * HD + (size_t)kk * HD) = pack8(v0, v1); }
                    asm volatile("" ::: "memory"); }
        } else {
            bf16_t* vt = VT + (bh0 * HD + d0) * MEML + key0;
#pragma unroll
            for (int ai = 0; ai < 2; ++ai)
#pragma unroll
                for (int m = 0; m < 4; ++m) { const int kk = ai * 128 + m * 16; const float rs = rsp[kk];
#pragma unroll
                    for (int bj = 0; bj < 2; ++bj) { const f32x4 v0 = acc[ai][bj][m][0] * rs, v1 = acc[ai][bj][m][1] * rs;
                        float* o = of + (size_t)kk * XA + bj * HD; *(f32x4*)o = v0; *(f32x4*)(o + 4) = v1;
                        bf16_t* q = vt + (size_t)bj * HD * MEML + kk;
#pragma unroll
                        for (int e = 0; e < 4; ++e) { q[e * MEML] = f2bf(v0[e]); q[(e + 4) * MEML] = f2bf(v1[e]); }
                        asm volatile("" ::: "memory"); } }
        }
    }
};

struct EpiInA {
    static constexpr bool PERM = false, AFTER_DRAIN = false;
    const float* ssx; bf16_t* UZ; bf16_t* VR; bf16_t* QB; float* SSV;
    __device__ __forceinline__ void operator()(const f32x4 (&acc)[2][2][4][2], const Unit& u, int wr, int wc, int fr, int fq) const {
        const int row0 = u.pm * 256 + wr * 64 + fr; float rs[2][4]; rows_rstd16(ssx, row0, fq, rs);
        if (u.pn < 16) {
#pragma unroll
            for (int ai = 0; ai < 2; ++ai)
#pragma unroll
                for (int m = 0; m < 4; ++m) { const int row = row0 + ai * 128 + m * 16; const float r = rs[ai][m]; f32x4 o[2];
#pragma unroll
                    for (int n = 0; n < 2; ++n)
#pragma unroll
                        for (int e = 0; e < 4; ++e) o[n][e] = acc[ai][0][m][n][e] * r * siluf_(acc[ai][1][m][n][e] * r);
                    *(u32x4*)(UZ + (size_t)row * E_ + 128 * u.pn + 32 * wc + 8 * fq) = pack8(o[0], o[1]); }
        } else if (u.pn < 24) {
#pragma unroll
            for (int ai = 0; ai < 2; ++ai)
#pragma unroll
                for (int m = 0; m < 4; ++m) { const int row = row0 + ai * 128 + m * 16; const float r = rs[ai][m]; float ss = 0.f;
#pragma unroll
                    for (int bj = 0; bj < 2; ++bj) { const f32x4 v0 = acc[ai][bj][m][0] * r, v1 = acc[ai][bj][m][1] * r;
                        ss += (v0[0] * v0[0] + v0[1] * v0[1]) + (v0[2] * v0[2] + v0[3] * v0[3]) + (v1[0] * v1[0] + v1[1] * v1[1]) + (v1[2] * v1[2] + v1[3] * v1[3]);
                        *(u32x4*)(VR + (size_t)row * E_ + 256 * (u.pn - 16) + 128 * bj + 32 * wc + 8 * fq) = pack8(v0, v1); }
                    ss = sum_rows4(ss);
                    if (fq == 0) SSV[(size_t)row * 32 + (u.pn - 16) * 4 + wc] = ss; }
        } else {
#pragma unroll
            for (int ai = 0; ai < 2; ++ai)
#pragma unroll
                for (int m = 0; m < 4; ++m) { const int row = row0 + ai * 128 + m * 16; const float r = rs[ai][m] * 0.08838834764831845f;
#pragma unroll
                    for (int bj = 0; bj < 2; ++bj) *(u32x4*)(QB + (size_t)row * XA + 256 * (u.pn - 24) + 128 * bj + 32 * wc + 8 * fq) = pack8(acc[ai][bj][m][0] * r, acc[ai][bj][m][1] * r); }
        }
    }
};

struct EpiInB {
    static constexpr bool PERM = false, AFTER_DRAIN = false;
    const float* ssx; bf16_t* P; bf16_t* G; bf16_t* QB; float* convp; float* convs;
    __device__ __forceinline__ void operator()(const f32x4 (&acc)[2][2][4][2], const Unit& u, int wr, int wc, int fr, int fq) const {
        const int row0 = u.pm * 256 + wr * 64 + fr; float rs[2][4]; rows_rstd16(ssx, row0, fq, rs);
        if (u.pn < 32) {
            const int ch0 = 64 * u.pn + 16 * wc + 4 * fq;
#pragma unroll
            for (int ai = 0; ai < 2; ++ai)
#pragma unroll
                for (int m = 0; m < 4; ++m) { const int row = row0 + ai * 128 + m * 16; const float r = rs[ai][m];
                    const f32x4 bg = acc[ai][0][m][0] * r, cgv = acc[ai][0][m][1] * r, hv = acc[ai][1][m][0] * r, z = acc[ai][1][m][1] * r;
                    f32x4 p = cgv * hv, gg;
#pragma unroll
                    for (int e = 0; e < 4; ++e) gg[e] = bg[e] * siluf_(z[e]);
                    u32x2 wp, wg; wp.x = pk2(p[0], p[1]); wp.y = pk2(p[2], p[3]); wg.x = pk2(gg[0], gg[1]); wg.y = pk2(gg[2], gg[3]);
                    *(u32x2*)(P + (size_t)row * E_ + ch0) = wp; *(u32x2*)(G + (size_t)row * E_ + ch0) = wg;
                    if (row < MP) { const int t = row & (PSEQ - 1); if (t >= PSEQ - 2) *(f32x4*)(convp + ((size_t)(row >> 11) * 2 + (t - (PSEQ - 2))) * E_ + ch0) = p; }
                    else { const int s = row - MP, t = s & 3; if (t >= 2) *(f32x4*)(convs + ((size_t)(s >> 2) * 2 + (t - 2)) * E_ + ch0) = p; } }
        } else {
#pragma unroll
            for (int ai = 0; ai < 2; ++ai)
#pragma unroll
                for (int m = 0; m < 4; ++m) { const int row = row0 + ai * 128 + m * 16; const float r = rs[ai][m] * 0.08838834764831845f;
#pragma unroll
                    for (int bj = 0; bj < 2; ++bj) *(u32x4*)(QB + (size_t)row * XA + 256 * (u.pn - 32) + 128 * bj + 32 * wc + 8 * fq) = pack8(acc[ai][bj][m][0] * r, acc[ai][bj][m][1] * r); }
        }
    }
};

struct EpiInC {
    static constexpr bool PERM = false, AFTER_DRAIN = false;
    const float* ssx; bf16_t* U; bf16_t* SZ; bf16_t* QB;
    __device__ __forceinline__ void operator()(const f32x4 (&acc)[2][2][4][2], const Unit& u, int wr, int wc, int fr, int fq) const {
        const int row0 = u.pm * 256 + wr * 64 + fr; float rs[2][4]; rows_rstd16(ssx, row0, fq, rs);
#pragma unroll
        for (int ai = 0; ai < 2; ++ai)
#pragma unroll
            for (int m = 0; m < 4; ++m) { const int row = row0 + ai * 128 + m * 16; const float r = rs[ai][m];
#pragma unroll
                for (int bj = 0; bj < 2; ++bj) { const int cc = 128 * bj + 32 * wc + 8 * fq;
                    if (u.pn < 8) *(u32x4*)(U + (size_t)row * E_ + 256 * u.pn + cc) = pack8(acc[ai][bj][m][0] * r, acc[ai][bj][m][1] * r);
                    else if (u.pn < 16) { f32x4 a, b2;
#pragma unroll
                        for (int e = 0; e < 4; ++e) { a[e] = siluf_(acc[ai][bj][m][0][e] * r); b2[e] = siluf_(acc[ai][bj][m][1][e] * r); }
                        *(u32x4*)(SZ + (size_t)row * E_ + 256 * (u.pn - 8) + cc) = pack8(a, b2); }
                    else { const float rq = r * 0.08838834764831845f; *(u32x4*)(QB + (size_t)row * XA + 256 * (u.pn - 16) + cc) = pack8(acc[ai][bj][m][0] * rq, acc[ai][bj][m][1] * rq); } } }
    }
};

struct EpiOut {
    static constexpr bool PERM = false, AFTER_DRAIN = false;
    const float* basef; bf16_t* XB; float* SSX;
    __device__ __forceinline__ void operator()(const f32x4 (&acc)[2][2][4][2], const Unit& u, int wr, int wc, int fr, int fq) const {
        const int row0 = u.pm * 256 + wr * 64 + fr;
#pragma unroll
        for (int ai = 0; ai < 2; ++ai)
#pragma unroll
            for (int m = 0; m < 4; ++m) { const int row = row0 + ai * 128 + m * 16; float ss = 0.f;
#pragma unroll
                for (int bj = 0; bj < 2; ++bj) { const int col = 256 * u.pn + 128 * bj + 32 * wc + 8 * fq; f32x4 x0, x1;
                    if (basef) { x0 = *(const f32x4*)(basef + (size_t)row * DM + col); x1 = *(const f32x4*)(basef + (size_t)row * DM + col + 4); }
                    else { float r[8]; unpack8(*(const u32x4*)(XB + (size_t)row * DM + col), r); x0 = (f32x4){r[0], r[1], r[2], r[3]}; x1 = (f32x4){r[4], r[5], r[6], r[7]}; }
                    x0 += acc[ai][bj][m][0]; x1 += acc[ai][bj][m][1];
                    *(u32x4*)(XB + (size_t)row * DM + col) = pack8(x0, x1);
                    ss += (x0[0] * x0[0] + x0[1] * x0[1]) + (x0[2] * x0[2] + x0[3] * x0[3]) + (x1[0] * x1[0] + x1[1] * x1[1]) + (x1[2] * x1[2] + x1[3] * x1[3]); }
                ss = sum_rows4(ss);
                if (fq == 0) SSX[(size_t)row * 16 + u.pn * 4 + wc] = ss; }
    }
};

struct EpiGlu {
    static constexpr bool PERM = false, AFTER_DRAIN = false;
    const bf16_t* GB; const bf16_t* SZ; const float* bias; bf16_t* A2;
    __device__ __forceinline__ void operator()(const f32x4 (&acc)[2][2][4][2], const Unit& u, int wr, int wc, int fr, int fq) const {
        const int row0 = u.pm * 256 + wr * 64 + fr;
#pragma unroll
        for (int ai = 0; ai < 2; ++ai)
#pragma unroll
            for (int m = 0; m < 4; ++m) { const int row = row0 + ai * 128 + m * 16;
#pragma unroll
                for (int bj = 0; bj < 2; ++bj) { const int col = 256 * u.pn + 128 * bj + 32 * wc + 8 * fq;
                    const f32x4 b0 = *(const f32x4*)(bias + col), b1 = *(const f32x4*)(bias + col + 4);
                    float gv[8], sz[8]; unpack8(*(const u32x4*)(GB + (size_t)row * E_ + col), gv); unpack8(*(const u32x4*)(SZ + (size_t)row * E_ + col), sz);
                    f32x4 o0, o1;
#pragma unroll
                    for (int e = 0; e < 4; ++e) { o0[e] = gv[e] * sigmoidf_(acc[ai][bj][m][0][e] + b0[e]) * sz[e]; o1[e] = gv[4 + e] * sigmoidf_(acc[ai][bj][m][1][e] + b1[e]) * sz[4 + e]; }
                    *(u32x4*)(A2 + (size_t)row * KOUT + col) = pack8(o0, o1); } }
    }
};

struct EpiSlab {
    static constexpr bool PERM = false, AFTER_DRAIN = false;
    float* S; int ldc; int row0; size_t kstride;
    __device__ __forceinline__ void operator()(const f32x4 (&acc)[2][2][4][2], const Unit& u, int wr, int wc, int fr, int fq) const {
        float* base = S + (size_t)u.ks * kstride + (size_t)(u.pm * 256 + wr * 64 + fr - row0) * ldc + 256 * u.pn + 32 * wc + 8 * fq;
#pragma unroll
        for (int ai = 0; ai < 2; ++ai)
#pragma unroll
            for (int m = 0; m < 4; ++m)
                { float* o = base + (size_t)(ai * 128 + m * 16) * ldc; *(f32x4*)o = acc[ai][0][m][0]; *(f32x4*)(o + 4) = acc[ai][0][m][1]; *(f32x4*)(o + 128) = acc[ai][1][m][0]; *(f32x4*)(o + 132) = acc[ai][1][m][1];
                  asm volatile("" ::: "memory"); }
    }
};

#ifndef PROBE_EPI2
#define PROBE_EPI2 0
#endif
template <class E_> struct EpiTwice { static constexpr bool PERM = false, AFTER_DRAIN = false; E_ e;
    __device__ __forceinline__ void operator()(const f32x4 (&acc)[2][2][4][2], const Unit& u, int wr, int wc, int fr, int fq) const { e(acc, u, wr, wc, fr, fq); asm volatile("" ::: "memory"); e(acc, u, wr, wc, fr, fq); } };

struct Frame {
    LAS unsigned char* lds; int tid, lane, wave, G, bid;
    const float* const* in; float* out; unsigned char* ws;
};

struct WItem { const float* W; const float* gs; bf16_t* WT; int K, N, kind, r; };
__device__ __forceinline__ WItem witem(Frame& F, int it) {
    constexpr int I_A = 16 * (NIN_A / 32), I_B = 16 * (NIN_B / 32), I_C = 16 * (NIN_C / 32), I_O = (KOUT / 64) * (DM / 32), I_KV = 16 * (DM / 32);
    unsigned char* ws = F.ws; int r = it; WItem w;
    if (r < 2 * I_A) { const int j = r / I_A; r -= j * I_A; w = WItem{GIN(13) + (size_t)j * DM * NIN_A, GIN(8) + (j == 0 ? 0 : 3) * DM, (bf16_t*)(ws + WS_WINA) + (size_t)j * NIN_A * DM, DM, NIN_A, 0, r}; return w; } r -= 2 * I_A;
    if (r < I_B) { w = WItem{GIN(17), GIN(8) + 1 * DM, (bf16_t*)(ws + WS_WINB), DM, NIN_B, 1, r}; return w; } r -= I_B;
    if (r < I_C) { w = WItem{GIN(19), GIN(8) + 2 * DM, (bf16_t*)(ws + WS_WINC), DM, NIN_C, 2, r}; return w; } r -= I_C;
    if (r < 4 * I_O) { const int j = r / I_O; r -= j * I_O; w = WItem{GIN(12) + (size_t)j * KOUT * DM, nullptr, (bf16_t*)(ws + WS_WOUT) + (size_t)j * DM * KOUT, KOUT, DM, 2, r}; return w; } r -= 4 * I_O;
    if (r < 4 * I_KV) { const int j = r / I_KV; r -= j * I_KV; w = WItem{GIN(11) + (size_t)j * DM * DM, GIN(10) + j * DM, (bf16_t*)(ws + WS_WKV) + (size_t)j * DM * DM, DM, DM, 2, r}; return w; } r -= 4 * I_KV;
    w = WItem{GIN(28), nullptr, (bf16_t*)(ws + WS_WGLU), E_, E_, 2, r}; return w;
}
__device__ __forceinline__ void witem_load(const WItem& w, int lane, f32x4 (&x)[8]) {
    const int nblk = w.N / 32, kb = w.r / nblk, nb = w.r % nblk, k0 = 64 * kb, n0 = 32 * nb, n4 = lane & 7, kr = lane >> 3;
    const int sc = src_col(w.kind, n0 + 4 * n4);
#pragma unroll
    for (int i = 0; i < 8; ++i) x[i] = *(const f32x4*)(w.W + (size_t)(k0 + kr + 8 * i) * w.N + sc);
}
__device__ __forceinline__ void witem_finish(const WItem& w, int lane, const f32x4 (&x)[8], LAS float* scr) {
    const int nblk = w.N / 32, kb = w.r / nblk, nb = w.r % nblk, k0 = 64 * kb, n0 = 32 * nb, n4 = lane & 7, kr = lane >> 3;
    asm volatile("s_waitcnt vmcnt(8)" ::: "memory");
#pragma unroll
    for (int i = 0; i < 8; ++i) { const int kk = kr + 8 * i; const float g = w.gs ? w.gs[k0 + kk] : 1.f; LAS float* d = scr + kk * 33 + 4 * n4; d[0] = x[i][0] * g; d[1] = x[i][1] * g; d[2] = x[i][2] * g; d[3] = x[i][3] * g; }
    asm volatile("s_waitcnt lgkmcnt(0)" ::: "memory");
    const int c = lane & 7;
#pragma unroll
    for (int j = 0; j < 4; ++j) { const int n = (lane >> 3) + 8 * j; const LAS float* sp = scr + (8 * c) * 33 + n;
        u32x4 o; o.x = pk2(sp[0 * 33], sp[1 * 33]); o.y = pk2(sp[2 * 33], sp[3 * 33]); o.z = pk2(sp[4 * 33], sp[5 * 33]); o.w = pk2(sp[6 * 33], sp[7 * 33]);
        *(u32x4*)(w.WT + (size_t)(n0 + n) * w.K + k0 + 8 * c) = o; }
    asm volatile("s_waitcnt lgkmcnt(0)" ::: "memory");
}

__device__ __forceinline__ void p0_prologue(Frame& F) {
    LAS float* scr = (LAS float*)(F.lds + F.wave * 16384);
    const int gw = F.bid * NWAVES + F.wave, NGW = F.G * NWAVES, lane = F.lane;
    unsigned char* ws = F.ws;
    constexpr int NITEMS = 2 * 16 * (NIN_A / 32) + 16 * (NIN_B / 32) + 16 * (NIN_C / 32) + 4 * (KOUT / 64) * (DM / 32) + 4 * 16 * (DM / 32) + (E_ / 64) * (E_ / 32);
    if (gw < NITEMS) {
        WItem wc = witem(F, gw); f32x4 xa[8]; witem_load(wc, lane, xa);
        for (int it = gw; it < NITEMS; it += NGW) {
            const int nit = it + NGW < NITEMS ? it + NGW : it; const WItem wn = witem(F, nit); f32x4 xb[8]; witem_load(wn, lane, xb);
            witem_finish(wc, lane, xa, scr);
            wc = wn;
#pragma unroll
            for (int i = 0; i < 8; ++i) xa[i] = xb[i];
        }
    }
    {
        bf16_t* XB = (bf16_t*)(ws + WS_XB); float* SSX = (float*)(ws + WS_SSX);
        for (int row = gw; row < M; row += 2 * NGW) {
            const int row2 = row + NGW < M ? row + NGW : row;
            const float* xr = row < MP ? GIN(0) + (size_t)row * DM : GIN(1) + (size_t)(row - MP) * DM;
            const float* xr2 = row2 < MP ? GIN(0) + (size_t)row2 * DM : GIN(1) + (size_t)(row2 - MP) * DM;
            f32x4 v[4], v2[4];
#pragma unroll
            for (int j = 0; j < 4; ++j) { v[j] = *((const f32x4*)xr + lane + 64 * j); v2[j] = *((const f32x4*)xr2 + lane + 64 * j); }
            float ss = 0.f, ss2 = 0.f;
#pragma unroll
            for (int j = 0; j < 4; ++j) { ss += (v[j][0] * v[j][0] + v[j][1] * v[j][1]) + (v[j][2] * v[j][2] + v[j][3] * v[j][3]); ss2 += (v2[j][0] * v2[j][0] + v2[j][1] * v2[j][1]) + (v2[j][2] * v2[j][2] + v2[j][3] * v2[j][3]);
                u32x2 w; w.x = pk2(v[j][0], v[j][1]); w.y = pk2(v[j][2], v[j][3]); *((u32x2*)(XB + (size_t)row * DM) + lane + 64 * j) = w;
                u32x2 w2; w2.x = pk2(v2[j][0], v2[j][1]); w2.y = pk2(v2[j][2], v2[j][3]); *((u32x2*)(XB + (size_t)row2 * DM) + lane + 64 * j) = w2; }
            asm volatile("s_waitcnt vmcnt(0)" ::: "memory");
            ss = wave_sum(ss); ss2 = wave_sum(ss2);
            if (lane < 16) { SSX[(size_t)row * 16 + lane] = lane == 0 ? ss : 0.f; SSX[(size_t)row2 * 16 + lane] = lane == 0 ? ss2 : 0.f; }
        }
    }
    {
        bf16_t* MB = (bf16_t*)(ws + WS_MEMB); float* RM = (float*)(ws + WS_RSTDM);
        for (int row = gw; row < PB * MEML; row += NGW) {
            const float* xr = GIN(2) + (size_t)row * DM; float ss = 0.f;
#pragma unroll
            for (int j = 0; j < 4; ++j) { const f32x4 v = *((const f32x4*)xr + lane + 64 * j); ss += (v[0] * v[0] + v[1] * v[1]) + (v[2] * v[2] + v[3] * v[3]);
                u32x2 w; w.x = pk2(v[0], v[1]); w.y = pk2(v[2], v[3]); *((u32x2*)(MB + (size_t)row * DM) + lane + 64 * j) = w; }
            asm volatile("s_waitcnt vmcnt(0)" ::: "memory");
            ss = wave_sum(ss);
            if (lane == 0) RM[row] = 1.0f / sqrtf(ss * (1.f / DM) + EPS);
        }
    }
    {
        float* TAB = (float*)(ws + WS_TAB);
        for (int g = gw; g < S5G; g += NGW) {
            const int gp = g * S5P + lane;
            const float lr = GIN(20)[gp], li = GIN(21)[gp], dt = expf(GIN(22)[g]);
            const float th = li * dt, em1 = expm1f(lr * dt), mag = em1 + 1.f, cs = cosf(th), sn = sinf(th), sh = sinf(0.5f * th);
            const float ar = mag * cs, ai = mag * sn;
            const float nr = em1 * cs - 2.f * sh * sh, ni = ai;
            const float den = lr * lr + li * li, cr = (nr * lr + ni * li) / den, ci = (ni * lr - nr * li) / den;
            TAB[T_AR + gp] = ar; TAB[T_AI + gp] = ai;
#pragma unroll
            for (int i = 0; i < S5I; ++i) { const float br = GIN(23)[(size_t)gp * S5I + i], bi = GIN(24)[(size_t)gp * S5I + i];
                TAB[T_BBR + (size_t)gp * S5I + i] = cr * br - ci * bi; TAB[T_BBI + (size_t)gp * S5I + i] = cr * bi + ci * br; }
        }
    }
    {
        bf16_t* SW = (bf16_t*)(ws + WS_SGUW);
        for (int i = (F.bid * NTHR + F.tid); i < 2 * 8 * 128 * 128; i += F.G * NTHR) { const int t = (i >> 7) & 127, s = i & 127; SW[i] = f2bf(s <= t ? GIN(15)[i] : 0.f); }
    }
}

typedef short v4i16_t __attribute__((ext_vector_type(4)));
constexpr int SG_VSTR = 576, SG_WSTR = 272, SG_WOFF = 128 * SG_VSTR, SG_ROFF = SG_WOFF + 128 * SG_WSTR;
static_assert(SG_ROFF + 1024 <= RING_BYTES, "sgu LDS");
__device__ __forceinline__ void sgu_phase_mfma(Frame& F, int j) {
    const bf16_t* UZ = (const bf16_t*)(F.ws + WS_B0); const bf16_t* VR = (const bf16_t*)(F.ws + WS_B1); const float* SSV = (const float*)(F.ws + WS_SSV);
    const bf16_t* SW = (const bf16_t*)(F.ws + WS_SGUW) + (size_t)j * 8 * 128 * 128; bf16_t* A2 = (bf16_t*)(F.ws + WS_A2);
    const float* gn = GIN(14) + (size_t)j * E_; const float* bsv = GIN(16) + (size_t)j * 8 * 128;
    LAS unsigned char* lds = F.lds; LAS float* rsl = (LAS float*)(lds + SG_ROFF);
    const int tid = F.tid, lane = F.lane, wid = F.wave, c = lane & 31, hh = lane >> 5;
    const bool same_g = (F.G & 7) == 0; int gld = -1, cur = 0;
    u32x4 vr[8];
    { const int un = F.bid; if (un < 128 * 8) { const int rbase = (un >> 3) * 128, g = un & 7;
#pragma unroll
        for (int i = 0; i < 8; ++i) { const int chn = tid + NTHR * i; vr[i] = *(const u32x4*)(VR + (size_t)(rbase + (chn >> 5)) * E_ + 256 * g + 8 * (chn & 31)); }
        __syncthreads();
        if (tid < 128) { const float* p = SSV + (size_t)(rbase + tid) * 32; float sq = 0.f;
#pragma unroll
            for (int k = 0; k < 8; ++k) { const f32x4 v = *((const f32x4*)p + k); sq += (v[0] + v[1]) + (v[2] + v[3]); }
            rsl[tid] = __builtin_amdgcn_rsqf(sq * (1.f / E_) + EPS); } } }
    for (int un = F.bid; un < 128 * 8; un += F.G) {
        const int ch = un >> 3, g = un & 7, rbase = ch * 128; const int nun = un + F.G < 128 * 8 ? un + F.G : un, nrb = (nun >> 3) * 128, ng = nun & 7;
        asm volatile("s_waitcnt vmcnt(0)" ::: "memory");
        __syncthreads();
        if (!same_g || gld != g) { gld = g;
#pragma unroll
            for (int i = 0; i < 4; ++i) { const int chn = tid + NTHR * i, row = chn >> 4, c16 = chn & 15;
                *(LAS u32x4*)(lds + SG_WOFF + row * SG_WSTR + c16 * 16) = *(const u32x4*)(SW + (size_t)g * 128 * 128 + row * 128 + c16 * 8); } }
#pragma unroll
        for (int i = 0; i < 8; ++i) { const int chn = tid + NTHR * i, sr = chn >> 5, c8 = chn & 31; float v[8]; unpack8(vr[i], v);
            const float r = rsl[cur * 128 + sr]; const f32x4 g0 = *(const f32x4*)(gn + 256 * g + 8 * c8), g1 = *(const f32x4*)(gn + 256 * g + 8 * c8 + 4); f32x4 a, b2;
#pragma unroll
            for (int e = 0; e < 4; ++e) { a[e] = v[e] * r * g0[e]; b2[e] = v[4 + e] * r * g1[e]; }
            *(LAS u32x4*)(lds + sr * SG_VSTR + c8 * 16) = pack8(a, b2); }
#pragma unroll
        for (int i = 0; i < 8; ++i) { const int chn = tid + NTHR * i; vr[i] = *(const u32x4*)(VR + (size_t)(nrb + (chn >> 5)) * E_ + 256 * ng + 8 * (chn & 31)); }
        if (tid < 128) { const float* p = SSV + (size_t)(nrb + tid) * 32; float sq = 0.f;
#pragma unroll
            for (int k = 0; k < 8; ++k) { const f32x4 v = *((const f32x4*)p + k); sq += (v[0] + v[1]) + (v[2] + v[3]); }
            rsl[(cur ^ 1) * 128 + tid] = __builtin_amdgcn_rsqf(sq * (1.f / E_) + EPS); }
        u32x2 uzr[4][4];
#pragma unroll
        for (int ti = 0; ti < 4; ++ti)
#pragma unroll
            for (int g4 = 0; g4 < 4; ++g4) uzr[ti][g4] = *(const u32x2*)(UZ + (size_t)(rbase + 32 * ti + c) * E_ + 256 * g + 32 * wid + 8 * g4 + 4 * hh);
        __syncthreads();
        f32x16 acc[4];
#pragma unroll
        for (int ti = 0; ti < 4; ++ti) acc[ti] = (f32x16){};
        const LAS unsigned char* abase = lds + (8 * hh + ((lane & 15) >> 2)) * SG_VSTR + (32 * wid + 16 * ((lane >> 4) & 1) + 4 * (lane & 3)) * 2;
#pragma unroll
        for (int s2 = 0; s2 < 8; ++s2) {
            const v4i16_t lo = __builtin_amdgcn_ds_read_tr16_b64_v4i16((LAS v4i16_t*)(abase + (16 * s2) * SG_VSTR));
            const v4i16_t hi = __builtin_amdgcn_ds_read_tr16_b64_v4i16((LAS v4i16_t*)(abase + (16 * s2 + 4) * SG_VSTR));
            const bf16x8 a = (bf16x8){lo[0], lo[1], lo[2], lo[3], hi[0], hi[1], hi[2], hi[3]};
#pragma unroll
            for (int ti = s2 >> 1; ti < 4; ++ti) { const bf16x8 b = *(const LAS bf16x8*)(lds + SG_WOFF + (32 * ti + c) * SG_WSTR + (16 * s2 + 8 * hh) * 2);
                acc[ti] = __builtin_amdgcn_mfma_f32_32x32x16_bf16(a, b, acc[ti], 0, 0, 0); }
        }
#pragma unroll
        for (int ti = 0; ti < 4; ++ti) { const int t = 32 * ti + c; const size_t row = (size_t)(rbase + t); const float bias = bsv[g * 128 + t];
#pragma unroll
            for (int g4 = 0; g4 < 4; ++g4) { const int d = 256 * g + 32 * wid + 8 * g4 + 4 * hh; const u32x2 uz = uzr[ti][g4];
                u32x2 w; w.x = pk2(bflo(uz.x) * (acc[ti][4 * g4] + bias), bfhi(uz.x) * (acc[ti][4 * g4 + 1] + bias)); w.y = pk2(bflo(uz.y) * (acc[ti][4 * g4 + 2] + bias), bfhi(uz.y) * (acc[ti][4 * g4 + 3] + bias));
                *(u32x2*)(A2 + row * KOUT + d) = w; } }
        cur ^= 1;
    }
}

__device__ __forceinline__ void sgu_sample_phase(Frame& F, int j) {
    const bf16_t* UZ = (const bf16_t*)(F.ws + WS_B0); const bf16_t* VR = (const bf16_t*)(F.ws + WS_B1); const float* SSV = (const float*)(F.ws + WS_SSV);
    const bf16_t* SW = (const bf16_t*)(F.ws + WS_SGUW) + (size_t)j * 8 * 128 * 128; bf16_t* A2 = (bf16_t*)(F.ws + WS_A2);
    const float* gn = GIN(14) + (size_t)j * E_; const float* bsv = GIN(16) + (size_t)j * 8 * 128; float* cvout = F.out + O_CV + (size_t)j * SBT * SSEQ * E_;
    const int gw = F.bid * NWAVES + F.wave, NGW = F.G * NWAVES, lane = F.lane;
    for (int task = gw; task < SBT * 8; task += NGW) {
        const int b = task >> 3, g = task & 7; const size_t r0 = (size_t)MP + b * SSEQ; const int ch = 256 * g + 4 * lane;
        float rs[SSEQ];
#pragma unroll
        for (int t = 0; t < SSEQ; ++t) { float v = lane < 32 ? SSV[(r0 + t) * 32 + lane] : 0.f; v = wave_sum(v); rs[t] = __builtin_amdgcn_rsqf(v * (1.f / E_) + EPS); }
        const f32x4 g4 = *(const f32x4*)(gn + ch);
        f32x4 vn[SSEQ];
#pragma unroll
        for (int t = 0; t < SSEQ; ++t) { const u32x2 w = *(const u32x2*)(VR + (r0 + t) * E_ + ch); const f32x4 v = (f32x4){bflo(w.x), bfhi(w.x), bflo(w.y), bfhi(w.y)}; vn[t] = v * rs[t] * g4;
            *(f32x4*)(cvout + (size_t)(b * SSEQ + t) * E_ + ch) = vn[t];
            u32x2 q; q.x = pk2(vn[t][0], vn[t][1]); q.y = pk2(vn[t][2], vn[t][3]); vn[t] = (f32x4){bflo(q.x), bfhi(q.x), bflo(q.y), bfhi(q.y)}; }
#pragma unroll
        for (int t = 0; t < SSEQ; ++t) { f32x4 a = {0.f, 0.f, 0.f, 0.f};
#pragma unroll
            for (int sq = 0; sq <= t; ++sq) a += vn[sq] * bf2f(SW[(size_t)g * 128 * 128 + t * 128 + sq]);
            a += bsv[g * 128 + t];
            const u32x2 uz = *(const u32x2*)(UZ + (r0 + t) * E_ + ch);
            u32x2 w; w.x = pk2(bflo(uz.x) * a[0], bfhi(uz.x) * a[1]); w.y = pk2(bflo(uz.y) * a[2], bfhi(uz.y) * a[3]);
            *(u32x2*)(A2 + (r0 + t) * KOUT + ch) = w; }
    }
}

__device__ __forceinline__ void conv_phase(Frame& F) {
    const bf16_t* P = (const bf16_t*)(F.ws + WS_B0); const bf16_t* G = (const bf16_t*)(F.ws + WS_B1); bf16_t* A2 = (bf16_t*)(F.ws + WS_A2);
    const float* cw = GIN(18); const float* st = GIN(5);
    for (int i = F.bid * NTHR + F.tid; i < (M / 32) * 256; i += F.G * NTHR) {
        const int seg = i >> 8, c0 = (i & 255) * 8, r0 = seg * 32;
        float w0[8], w1[8], w2[8];
#pragma unroll
        for (int e = 0; e < 8; ++e) { w0[e] = cw[c0 + e]; w1[e] = cw[E_ + c0 + e]; w2[e] = cw[2 * E_ + c0 + e]; }
        float x1[8], x2[8];
        if (r0 < MP) { if ((r0 & (PSEQ - 1)) == 0) { for (int e = 0; e < 8; ++e) { x1[e] = 0.f; x2[e] = 0.f; } }
                       else { unpack8(*(const u32x4*)(P + (size_t)(r0 - 1) * E_ + c0), x1); unpack8(*(const u32x4*)(P + (size_t)(r0 - 2) * E_ + c0), x2); } }
#pragma unroll 4
        for (int rr = 0; rr < 32; ++rr) {
            const int row = r0 + rr;
            if (row >= MP && ((row - MP) & 3) == 0) { const float* buf = st + (size_t)((row - MP) >> 2) * 2 * E_ + c0;
                for (int e = 0; e < 8; ++e) { x2[e] = buf[e]; x1[e] = buf[E_ + e]; } }
            float x0[8], gg[8]; unpack8(*(const u32x4*)(P + (size_t)row * E_ + c0), x0); unpack8(*(const u32x4*)(G + (size_t)row * E_ + c0), gg);
            f32x4 o0, o1;
#pragma unroll
            for (int e = 0; e < 8; ++e) { const float y = w0[e] * x2[e] + w1[e] * x1[e] + w2[e] * x0[e]; const float r = y * gg[e]; if (e < 4) o0[e] = r; else o1[e - 4] = r; x2[e] = x1[e]; x1[e] = x0[e]; }
            *(u32x4*)(A2 + (size_t)row * KOUT + c0) = pack8(o0, o1);
        }
    }
}

__device__ __forceinline__ void s5_sample_phase(Frame& F) {
    const bf16_t* U = (const bf16_t*)(F.ws + WS_B0); bf16_t* GBo = (bf16_t*)(F.ws + WS_GB); const float* TAB = (const float*)(F.ws + WS_TAB);
    const float* cre = GIN(25); const float* cim = GIN(26); const float* dsk = GIN(27);
    const int gw = F.bid * NWAVES + F.wave, NGW = F.G * NWAVES, lane = F.lane;
    for (int task = gw; task < S5G * (SBT / 16); task += NGW) {
        const int g = task & (S5G - 1), bc = task >> 7, gp = g * S5P + lane;
        const float ar = TAB[T_AR + gp], ai = TAB[T_AI + gp];
        float bbr[16], bbi[16], cr[16], ci[16];
#pragma unroll
        for (int i = 0; i < 16; ++i) { bbr[i] = TAB[T_BBR + (size_t)gp * 16 + i]; bbi[i] = TAB[T_BBI + (size_t)gp * 16 + i]; cr[i] = cre[((size_t)g * 16 + i) * S5P + lane]; ci[i] = cim[((size_t)g * 16 + i) * S5P + lane]; }
        const float dmine = dsk[g * 16 + (lane >> 2)];
        for (int bi = 0; bi < 16; ++bi) {
            const int sq = bc * 16 + bi; const size_t rbase = (size_t)MP + sq * SSEQ; const size_t so = ((size_t)sq * S5G + g) * S5P + lane;
            float hr = GIN(6)[so], hi = GIN(7)[so];
            u32x4 ur[SSEQ][2];
#pragma unroll
            for (int t = 0; t < SSEQ; ++t) { const bf16_t* up = U + (rbase + t) * E_ + g * 16; ur[t][0] = *(const u32x4*)up; ur[t][1] = *(const u32x4*)(up + 8); }
#pragma unroll
            for (int t = 0; t < SSEQ; ++t) {
                float u[16]; { float a[8], b[8]; unpack8(ur[t][0], a); unpack8(ur[t][1], b);
#pragma unroll
                    for (int i = 0; i < 8; ++i) { u[i] = a[i]; u[8 + i] = b[i]; } }
                float br = 0.f, bi2 = 0.f;
#pragma unroll
                for (int i = 0; i < 16; ++i) { br += bbr[i] * u[i]; bi2 += bbi[i] * u[i]; }
                const float nhr = ar * hr - ai * hi + br, nhi = ar * hi + ai * hr + bi2; hr = nhr; hi = nhi;
                float v[16];
#pragma unroll
                for (int i = 0; i < 16; ++i) v[i] = cr[i] * hr - ci[i] * hi;
                float w8[8];
                { const bool up5 = (lane & 32) != 0;
#pragma unroll
                  for (int i = 0; i < 8; ++i) { const float keep = up5 ? v[8 + i] : v[i], send = up5 ? v[i] : v[8 + i]; w8[i] = keep + __shfl_xor(send, 32); } }
                float w4[4];
                { const bool upb = (lane & 16) != 0;
#pragma unroll
                  for (int i = 0; i < 4; ++i) { const float keep = upb ? w8[4 + i] : w8[i], send = upb ? w8[i] : w8[4 + i]; w4[i] = keep + __shfl_xor(send, 16); } }
                float w2[2];
                { const bool upb = (lane & 8) != 0;
#pragma unroll
                  for (int i = 0; i < 2; ++i) { const float keep = upb ? w4[2 + i] : w4[i], send = upb ? w4[i] : w4[2 + i]; w2[i] = keep + __shfl_xor(send, 8); } }
                float w1;
                { const bool upb = (lane & 4) != 0; const float keep = upb ? w2[1] : w2[0], send = upb ? w2[0] : w2[1]; w1 = keep + __shfl_xor(send, 4); }
                w1 += __shfl_xor(w1, 2); w1 += __shfl_xor(w1, 1);
                float umine = 0.f;
#pragma unroll
                for (int i = 0; i < 16; ++i) umine = ((lane >> 2) == i) ? u[i] : umine;
                const float y = w1 + dmine * umine;
                if ((lane & 3) == 0) GBo[(rbase + t) * E_ + g * 16 + (lane >> 2)] = f2bf(gelu_tanh(y));
                asm volatile("s_waitcnt vmcnt(0)" ::: "memory");
            }
            F.out[O_SRS + so] = hr; F.out[O_SIS + so] = hi;
        }
    }
}

#if XHALF_SHFL
__device__ __forceinline__ void xhalf(float v, float& lo, float& hi) { const int l_ = threadIdx.x & 31; lo = __shfl(v, l_); hi = __shfl(v, l_ + 32); }
#else
__device__ __forceinline__ void xhalf(float v, float& lo, float& hi) { auto rr = __builtin_amdgcn_permlane32_swap(__float_as_uint(v), __float_as_uint(v), false, false); lo = __uint_as_float(rr[0]); hi = __uint_as_float(rr[1]);
 }
#endif
__device__ __forceinline__ void cmuladd(float& xr, float& xi, float ar, float ai, float pr, float pi) { float t = fmaf(-ai, pi, xr); asm("" : "+v"(t)); xr = fmaf(ar, pr, t); xi = fmaf(ar, pi, fmaf(ai, pr, xi)); }
constexpr int S5_HSTR = 272, S5_UOFF = 32 * S5_HSTR, S5_OOFF = S5_UOFF + 1024, S5_HT = S5_OOFF + 4096;
__device__ __forceinline__ void s5_prompt_mfma(Frame& F) {
    const bf16_t* U = (const bf16_t*)(F.ws + WS_B0); bf16_t* GBo = (bf16_t*)(F.ws + WS_GB); const float* TAB = (const float*)(F.ws + WS_TAB);
    const float* cre = GIN(25); const float* cim = GIN(26); const float* dsk = GIN(27);
    const int lane = F.lane, wid = F.wave, c = lane & 31, hh = lane >> 5, col = lane & 15, fq = lane >> 4;
    LAS unsigned char* ht = F.lds + wid * S5_HT;
    for (int task = F.bid * NWAVES + wid; task < PB * S5G; task += F.G * NWAVES) {
        const int b = task >> 7, g = task & 127;
        bf16x8 bfr[2], bfi[2]; float p_r[2][4], p_i[2][4];
#pragma unroll
        for (int st = 0; st < 2; ++st) { const int gp = g * S5P + 32 * st + c;
            const float* pr = TAB + T_BBR + (size_t)gp * 16 + 8 * hh; const float* pi = TAB + T_BBI + (size_t)gp * 16 + 8 * hh;
            bfr[st] = __builtin_bit_cast(bf16x8, pack8(*(const f32x4*)pr, *(const f32x4*)(pr + 4))); bfi[st] = __builtin_bit_cast(bf16x8, pack8(*(const f32x4*)pi, *(const f32x4*)(pi + 4)));
            const float ar = TAB[T_AR + gp], ai = TAB[T_AI + gp]; p_r[st][0] = ar; p_i[st][0] = ai;
#pragma unroll
            for (int n = 1; n < 4; ++n) { p_r[st][n] = p_r[st][n - 1] * ar - p_i[st][n - 1] * ai; p_i[st][n] = p_r[st][n - 1] * ai + p_i[st][n - 1] * ar; } }
        bf16x8 cf[4];
#pragma unroll
        for (int s4 = 0; s4 < 4; ++s4) { const size_t o = ((size_t)g * 16 + col) * S5P + 16 * s4 + 4 * fq; const f32x4 cr4 = *(const f32x4*)(cre + o), ci4 = *(const f32x4*)(cim + o);
            u32x4 w; w.x = pk2(cr4[0], -ci4[0]); w.y = pk2(cr4[1], -ci4[1]); w.z = pk2(cr4[2], -ci4[2]); w.w = pk2(cr4[3], -ci4[3]); cf[s4] = __builtin_bit_cast(bf16x8, w); }
        const f32x4 d4 = *(const f32x4*)(dsk + 16 * g + 4 * fq);
        float car_r[2] = {0.f, 0.f}, car_i[2] = {0.f, 0.f};
        const bf16_t* up = U + ((size_t)b * PSEQ + c) * E_ + 16 * g + 8 * hh;
        bf16x8 ub[4];
#pragma unroll
        for (int q = 0; q < 4; ++q) ub[q] = *(const GAS bf16x8*)(up + (size_t)q * 32 * E_);
        for (int tg = 0; tg < PSEQ / 128; ++tg) {
          bf16x8 nb[4];
#pragma unroll
          for (int q = 0; q < 4; ++q) nb[q] = *(const GAS bf16x8*)(up + (size_t)(4 * (tg + 1 < PSEQ / 128 ? tg + 1 : tg) + q) * 32 * E_);
#pragma unroll
          for (int q = 0; q < 4; ++q) {
            const int ti = 4 * tg + q; const bf16x8 ua = ub[q];
            *(LAS bf16x8*)(ht + S5_UOFF + c * 32 + hh * 16) = ua;
#pragma unroll
            for (int st = 0; st < 2; ++st) {
                f32x16 xr = __builtin_amdgcn_mfma_f32_32x32x16_bf16(ua, bfr[st], (f32x16){}, 0, 0, 0);
                f32x16 xi = __builtin_amdgcn_mfma_f32_32x32x16_bf16(ua, bfi[st], (f32x16){}, 0, 0, 0);
                const float a1r = p_r[st][0], a1i = p_i[st][0], a4r = p_r[st][3], a4i = p_i[st][3];
#pragma unroll
                for (int k = 0; k < 4; ++k)
#pragma unroll
                    for (int jj = 1; jj < 4; ++jj) { float tr = xr[4 * k + jj], tq = xi[4 * k + jj]; cmuladd(tr, tq, a1r, a1i, xr[4 * k + jj - 1], xi[4 * k + jj - 1]); xr[4 * k + jj] = tr; xi[4 * k + jj] = tq; }
                float er = car_r[st], ei = car_i[st], cin_r[4], cin_i[4];
#pragma unroll
                for (int k = 0; k < 4; ++k) {
                    float lor, hir, loi, hii; xhalf(xr[4 * k + 3], lor, hir); xhalf(xi[4 * k + 3], loi, hii);
                    const float c0r = er, c0i = ei;
                    float nr = lor, ni = loi; cmuladd(nr, ni, a4r, a4i, er, ei); er = nr; ei = ni;
                    const float c1r = er, c1i = ei;
                    nr = hir; ni = hii; cmuladd(nr, ni, a4r, a4i, er, ei); er = nr; ei = ni;
                    cin_r[k] = hh ? c1r : c0r; cin_i[k] = hh ? c1i : c0i;
                }
                car_r[st] = er; car_i[st] = ei;
#pragma unroll
                for (int k = 0; k < 4; ++k)
#pragma unroll
                    for (int jj = 0; jj < 4; ++jj) { float tr = xr[4 * k + jj], tq = xi[4 * k + jj]; cmuladd(tr, tq, p_r[st][jj], p_i[st][jj], cin_r[k], cin_i[k]);
                        *(LAS unsigned*)(ht + (8 * k + 4 * hh + jj) * S5_HSTR + 128 * st + 4 * c) = pk2(tr, tq); }
            }
            asm volatile("" ::: "memory");
#pragma unroll
            for (int tt = 0; tt < 2; ++tt) {
                f32x4 y = {0.f, 0.f, 0.f, 0.f};
#pragma unroll
                for (int s4 = 0; s4 < 4; ++s4) { const bf16x8 hb = *(const LAS bf16x8*)(ht + (16 * tt + col) * S5_HSTR + (32 * s4 + 8 * fq) * 2); y = __builtin_amdgcn_mfma_f32_16x16x32_bf16(cf[s4], hb, y, 0, 0, 0); }
                const size_t row = (size_t)b * PSEQ + 32 * ti + 16 * tt + col; const u32x2 uw = *(const LAS u32x2*)(ht + S5_UOFF + (16 * tt + col) * 32 + fq * 8);
                u32x2 w; w.x = pk2(gelu_tanh(y[0] + d4[0] * bflo(uw.x)), gelu_tanh(y[1] + d4[1] * bfhi(uw.x))); w.y = pk2(gelu_tanh(y[2] + d4[2] * bflo(uw.y)), gelu_tanh(y[3] + d4[3] * bfhi(uw.y)));
                *(LAS u32x2*)(ht + S5_OOFF + q * 1024 + (16 * tt + col) * 32 + fq * 8) = w;
            }
            asm volatile("" ::: "memory");
          }
#pragma unroll
          for (int q = 0; q < 4; ++q)
#pragma unroll
            for (int tt = 0; tt < 2; ++tt) *(GAS u32x2*)(GBo + ((size_t)b * PSEQ + 32 * (4 * tg + q) + 16 * tt + col) * E_ + 16 * g + 4 * fq) = *(const LAS u32x2*)(ht + S5_OOFF + q * 1024 + (16 * tt + col) * 32 + fq * 8);
          asm volatile("s_waitcnt vmcnt(0)" ::: "memory");
#pragma unroll
          for (int q = 0; q < 4; ++q) ub[q] = nb[q];
        }
        const size_t so = ((size_t)b * S5G + g) * S5P + 32 * hh + c;
        F.out[O_SRP + so] = hh ? car_r[1] : car_r[0]; F.out[O_SIP + so] = hh ? car_i[1] : car_i[0];
    }
}

constexpr int AK_STR = 272, AV_STR = 520, AV_OFF = 256 * AK_STR;
static_assert(AV_OFF + 128 * AV_STR <= RING_BYTES + 8192, "attention LDS");
__device__ __forceinline__ void attn_prompt_phase(Frame& F, int layer) {
    const bf16_t* QB = (const bf16_t*)(F.ws + WS_QB); const bf16_t* KBp = (const bf16_t*)(F.ws + WS_KB); const bf16_t* VTp = (const bf16_t*)(F.ws + WS_VT); bf16_t* A2 = (bf16_t*)(F.ws + WS_A2);
    const int tid = F.tid, lane = F.lane, wid = F.wave, c = lane & 31, hh = lane >> 5;
    LAS unsigned char* lds = F.lds;
    for (int un = F.bid; un < PB * NH * 8; un += F.G) {
        const int bh = un >> 3, qb = un & 7, b = bh >> 2, h = bh & 3;
        const bf16_t* Kg = KBp + (size_t)((layer * PB + b) * NH + h) * MEML * HD; const bf16_t* Vg = VTp + (size_t)((layer * PB + b) * NH + h) * MEML * HD;
        __syncthreads();
        { u32x4 kr[8], vr[8];
#pragma unroll
          for (int i = 0; i < 8; ++i) { const int chn = tid + NTHR * i; kr[i] = *(const u32x4*)(Kg + (chn >> 4) * HD + (chn & 15) * 8); vr[i] = *(const u32x4*)(Vg + (chn >> 5) * MEML + (chn & 31) * 8); }
#pragma unroll
          for (int i = 0; i < 8; ++i) { const int chn = tid + NTHR * i, row = chn >> 4, c16 = chn & 15; *(LAS u32x4*)(lds + row * AK_STR + c16 * 16) = kr[i]; }
#pragma unroll
          for (int i = 0; i < 8; ++i) { const int chn = tid + NTHR * i, row = chn >> 5, c16 = chn & 31; const u32x4 v = vr[i];
            LAS u32x2* p = (LAS u32x2*)(lds + AV_OFF + row * AV_STR + c16 * 16); u32x2 lo, hi; lo.x = v.x; lo.y = v.y; hi.x = v.z; hi.y = v.w; p[0] = lo; p[1] = hi; } }
        __syncthreads();
        const size_t qrow = (size_t)b * PSEQ + qb * 256 + wid * 32 + c;
        f32x16 S[8];
#pragma unroll
        for (int kt = 0; kt < 8; ++kt) S[kt] = (f32x16){};
#pragma unroll
        for (int s = 0; s < 8; ++s) {
            const bf16x8 qf = *(const bf16x8*)(QB + qrow * XA + h * HD + 16 * s + 8 * hh);
#pragma unroll
            for (int kt = 0; kt < 8; ++kt) { const bf16x8 kf = *(const LAS bf16x8*)(lds + (32 * kt + c) * AK_STR + (16 * s + 8 * hh) * 2); S[kt] = __builtin_amdgcn_mfma_f32_32x32x16_bf16(kf, qf, S[kt], 0, 0, 0); }
        }
        float mx = -3.0e38f;
#pragma unroll
        for (int kt = 0; kt < 8; ++kt)
#pragma unroll
            for (int r = 0; r < 16; ++r) mx = fmaxf(mx, S[kt][r]);
        mx = fmaxf(mx, __shfl_xor(mx, 32));
        float sum = 0.f; bf16x8 pf[8][2];
#pragma unroll
        for (int kt = 0; kt < 8; ++kt) {
            float p[16];
#pragma unroll
            for (int r = 0; r < 16; ++r) { p[r] = __expf(S[kt][r] - mx); sum += p[r]; }
#pragma unroll
            for (int s2 = 0; s2 < 2; ++s2) { u32x4 w; w.x = pk2(p[8 * s2], p[8 * s2 + 1]); w.y = pk2(p[8 * s2 + 2], p[8 * s2 + 3]); w.z = pk2(p[8 * s2 + 4], p[8 * s2 + 5]); w.w = pk2(p[8 * s2 + 6], p[8 * s2 + 7]);
                pf[kt][s2] = __builtin_bit_cast(bf16x8, w); }
        }
        sum += __shfl_xor(sum, 32);
        const float inv = 1.f / sum;
        bf16_t* orow = A2 + qrow * KOUT + E_ + h * HD;
#pragma unroll
        for (int dt = 0; dt < 4; ++dt) {
            f32x16 o = {};
#pragma unroll
            for (int kt = 0; kt < 8; ++kt)
#pragma unroll
                for (int s2 = 0; s2 < 2; ++s2) {
                    const LAS unsigned char* vb = lds + AV_OFF + (32 * dt + c) * AV_STR + (32 * kt + 16 * s2 + 4 * hh) * 2;
                    const u32x2 lo = *(const LAS u32x2*)vb, hi = *(const LAS u32x2*)(vb + 16);
                    u32x4 w; w.x = lo.x; w.y = lo.y; w.z = hi.x; w.w = hi.y;
                    o = __builtin_amdgcn_mfma_f32_32x32x16_bf16(__builtin_bit_cast(bf16x8, w), pf[kt][s2], o, 0, 0, 0);
                }
#pragma unroll
            for (int g4 = 0; g4 < 4; ++g4) { u32x2 w; w.x = pk2(o[4 * g4] * inv, o[4 * g4 + 1] * inv); w.y = pk2(o[4 * g4 + 2] * inv, o[4 * g4 + 3] * inv);
                *(u32x2*)(orow + 32 * dt + 8 * g4 + 4 * hh) = w; }
        }
    }
}

__device__ __forceinline__ void attn_sample_phase(Frame& F, int layer) {
    const bf16_t* QB = (const bf16_t*)(F.ws + WS_QB); bf16_t* A2 = (bf16_t*)(F.ws + WS_A2);
    const float* CK = GIN(3) + (size_t)layer * SBT * MEML * XA; const float* CV = GIN(4) + (size_t)layer * SBT * MEML * XA;
    LAS float* sl = (LAS float*)F.lds;
    LAS float* pt = (LAS float*)(F.lds + 4096);
    LAS float* ol = (LAS float*)(F.lds + 8192);
    const int tid = F.tid, lane = F.lane, wid = F.wave, par = lane >> 5, d4 = lane & 31;
    const size_t lane_off = ((size_t)(32 * wid + par) * NH) * HD + 4 * d4;
    const bool b4 = (lane & 16) != 0, b3 = (lane & 8) != 0;
#define AS_Q(q4, b_, h_) do { _Pragma("unroll") for (int qi = 0; qi < 4; ++qi) { const u32x2 w = *(const u32x2*)(QB + (size_t)(MP + (b_) * 4 + qi) * XA + (h_) * HD + 4 * d4); q4[qi] = (f32x4){bflo(w.x), bfhi(w.x), bflo(w.y), bfhi(w.y)}; } } while (0)
#define AS_LOADROWS(dst, base, b_, h_) do { const size_t o_ = (size_t)(b_) * MEML * XA + (size_t)(h_) * HD + lane_off; _Pragma("unroll") for (int j = 0; j < 16; ++j) dst[j] = *(const f32x4*)((base) + o_ + (size_t)j * 2 * XA); } while (0)
#define AS_SCORES(q4) do { _Pragma("unroll") for (int j = 0; j < 16; ++j) { float v[4]; \
            _Pragma("unroll") for (int qi = 0; qi < 4; ++qi) v[qi] = (kr[j][0] * q4[qi][0] + kr[j][1] * q4[qi][1]) + (kr[j][2] * q4[qi][2] + kr[j][3] * q4[qi][3]); \
            const float w0 = (b4 ? v[2] : v[0]) + __shfl_xor(b4 ? v[0] : v[2], 16), w1 = (b4 ? v[3] : v[1]) + __shfl_xor(b4 ? v[1] : v[3], 16); \
            float z = (b3 ? w1 : w0) + __shfl_xor(b3 ? w0 : w1, 8); \
            z += __shfl_xor(z, 4); z += __shfl_xor(z, 2); z += __shfl_xor(z, 1); \
            if ((lane & 7) == 0) sl[(2 * (int)b4 + (int)b3) * 256 + 32 * wid + 2 * j + par] = z; } } while (0)
#define AS_SOFTMAX() do { if (wid < 4) { float v[4], mx = -3.0e38f; \
            _Pragma("unroll") for (int j = 0; j < 4; ++j) { v[j] = sl[wid * 256 + lane + 64 * j]; mx = fmaxf(mx, v[j]); } \
            mx = wave_max(mx); float sm = 0.f; \
            _Pragma("unroll") for (int j = 0; j < 4; ++j) { v[j] = __expf(v[j] - mx); sm += v[j]; } \
            sm = wave_sum(sm); const float inv = 1.f / sm; \
            _Pragma("unroll") for (int j = 0; j < 4; ++j) pt[(lane + 64 * j) * 4 + wid] = v[j] * inv; } } while (0)
#define AS_PV() do { f32x4 o[4]; _Pragma("unroll") for (int qi = 0; qi < 4; ++qi) o[qi] = (f32x4){0.f, 0.f, 0.f, 0.f}; \
            _Pragma("unroll") for (int j = 0; j < 16; ++j) { const f32x4 p = *(const LAS f32x4*)(pt + (32 * wid + 2 * j + par) * 4); \
                _Pragma("unroll") for (int qi = 0; qi < 4; ++qi) o[qi] += vr[j] * p[qi]; } \
            _Pragma("unroll") for (int qi = 0; qi < 4; ++qi) { _Pragma("unroll") for (int e = 0; e < 4; ++e) o[qi][e] += __shfl_xor(o[qi][e], 32); \
                if (par == 0) *(LAS f32x4*)(ol + (wid * 4 + qi) * 128 + 4 * d4) = o[qi]; } } while (0)
#define AS_OUT(b_, h_) do { const int qi = tid >> 7, d = tid & 127; float acc = 0.f; _Pragma("unroll") for (int w = 0; w < 8; ++w) acc += ol[(w * 4 + qi) * 128 + d]; \
            A2[(size_t)(MP + (b_) * 4 + qi) * KOUT + E_ + (h_) * HD + d] = f2bf(acc); } while (0)
    for (int un = F.bid; un < SBT * NH; un += 2 * F.G) {
        const int unb = un + F.G < SBT * NH ? un + F.G : un; const int ba = un >> 2, ha = un & 3, bb = unb >> 2, hb = unb & 3;
        asm volatile("s_waitcnt vmcnt(0)" ::: "memory");
        f32x4 kr[16], vr[16], q4[4];
        AS_LOADROWS(kr, CK, ba, ha); AS_LOADROWS(vr, CV, ba, ha); AS_Q(q4, ba, ha);
        __syncthreads();
        AS_SCORES(q4);
        AS_LOADROWS(kr, CK, bb, hb);
        __syncthreads();
        AS_SOFTMAX();
        __syncthreads();
        AS_PV();
        __syncthreads();
        AS_Q(q4, bb, hb);
        AS_OUT(ba, ha);
        AS_LOADROWS(vr, CV, bb, hb);
        asm volatile("s_waitcnt vmcnt(16)" ::: "memory");
        AS_SCORES(q4);
        __syncthreads();
        AS_SOFTMAX();
        __syncthreads();
        AS_PV();
        __syncthreads();
        AS_OUT(bb, hb);
    }
#undef AS_Q
#undef AS_LOADROWS
#undef AS_SCORES
#undef AS_SOFTMAX
#undef AS_PV
#undef AS_OUT
}

constexpr int NK_OUT = 10, NK_GLU = 8;
__device__ __forceinline__ void fixup_out_rows(Frame& F, const float* basef  , int vb, int nvb  ) {
    for (int r = vb * NWAVES + F.wave; r < MS; r += nvb * NWAVES) {
        const int lane = F.lane; const float* slab = (const float*)(F.ws + WS_SLAB);
        bf16_t* XB = (bf16_t*)(F.ws + WS_XB) + (size_t)(MP + r) * DM; float ss = 0.f;
#pragma unroll
        for (int j = 0; j < 4; ++j) { f32x4 v;
            if (basef) v = *((const f32x4*)(basef + (size_t)r * DM) + lane + 64 * j);
            else { const u32x2 w = *((const u32x2*)XB + lane + 64 * j); v = (f32x4){bflo(w.x), bfhi(w.x), bflo(w.y), bfhi(w.y)}; }
#pragma unroll
            for (int ks = 0; ks < NK_OUT; ++ks) v += *((const f32x4*)(slab + ((size_t)ks * MS + r) * DM) + lane + 64 * j);
            u32x2 w; w.x = pk2(v[0], v[1]); w.y = pk2(v[2], v[3]); *((u32x2*)XB + lane + 64 * j) = w;
            ss += (v[0] * v[0] + v[1] * v[1]) + (v[2] * v[2] + v[3] * v[3]); }
        asm volatile("s_waitcnt vmcnt(0)" ::: "memory");
        ss = wave_sum(ss);
        if (lane < 16) ((float*)(F.ws + WS_SSX))[(size_t)(MP + r) * 16 + lane] = lane == 0 ? ss : 0.f;
    }
}
__device__ __forceinline__ void fixup_glu_rows(Frame& F) {
    if (F.wave < 2) for (int r = F.bid * 2 + F.wave; r < MS; r += F.G * 2) {
        const int lane = F.lane; const float* slab = (const float*)(F.ws + WS_SLAB); const float* bias = GIN(29);
        const bf16_t* GBp = (const bf16_t*)(F.ws + WS_GB) + (size_t)(MP + r) * E_; const bf16_t* SZ = (const bf16_t*)(F.ws + WS_B1) + (size_t)(MP + r) * E_; bf16_t* A2 = (bf16_t*)(F.ws + WS_A2) + (size_t)(MP + r) * KOUT;
#pragma unroll
        for (int j = 0; j < 4; ++j) { const int c0 = 8 * (lane + 64 * j); f32x4 t0 = *(const f32x4*)(bias + c0), t1 = *(const f32x4*)(bias + c0 + 4);
#pragma unroll
            for (int ks = 0; ks < NK_GLU; ++ks) { const float* sp = slab + ((size_t)ks * MS + r) * E_ + c0; t0 += *(const f32x4*)sp; t1 += *(const f32x4*)(sp + 4); }
            float gv[8], sz[8]; unpack8(*(const u32x4*)(GBp + c0), gv); unpack8(*(const u32x4*)(SZ + c0), sz); f32x4 o0, o1;
#pragma unroll
            for (int e = 0; e < 4; ++e) { o0[e] = gv[e] * sigmoidf_(t0[e]) * sz[e]; o1[e] = gv[4 + e] * sigmoidf_(t1[e]) * sz[4 + e]; }
            *(u32x4*)(A2 + c0) = pack8(o0, o1); }
    }
}
__device__ __forceinline__ void counter_signal(unsigned* cnt) {
    asm volatile("s_waitcnt vmcnt(0)" ::: "memory"); __syncthreads();
    if (threadIdx.x == 0) { __builtin_amdgcn_fence(__ATOMIC_RELEASE, "agent"); asm volatile("s_waitcnt vmcnt(0)" ::: "memory"); __hip_atomic_fetch_add(cnt, 1u, __ATOMIC_RELAXED, __HIP_MEMORY_SCOPE_AGENT); }
}
__device__ __forceinline__ void counter_wait(unsigned* cnt, unsigned want) {
    if (threadIdx.x == 0) { unsigned sp = 0; while (__hip_atomic_load(cnt, __ATOMIC_RELAXED, __HIP_MEMORY_SCOPE_AGENT) < want) { __builtin_amdgcn_s_sleep(2); if (++sp > (1u << 22)) break; }
        __builtin_amdgcn_fence(__ATOMIC_ACQUIRE, "agent"); asm volatile("s_waitcnt vmcnt(0)" ::: "memory"); }
    __syncthreads();
}

__device__ __forceinline__ void final_row(Frame& F, int row) {
    const bf16_t* XBp = (const bf16_t*)(F.ws + WS_XB); const float* SSX = (const float*)(F.ws + WS_SSX); const float* fg = GIN(9); const int lane = F.lane;
    float s = lane < 16 ? SSX[(size_t)row * 16 + lane] : 0.f; s = wave_sum(s);
    const float r = __builtin_amdgcn_rsqf(s * (1.f / DM) + EPS);
    float* o = row < MP ? F.out + O_YP + (size_t)row * DM : F.out + O_YS + (size_t)(row - MP) * DM;
#pragma unroll
    for (int j = 0; j < 4; ++j) { const u32x2 w = *((const u32x2*)(XBp + (size_t)row * DM) + lane + 64 * j); const f32x4 v = (f32x4){bflo(w.x), bfhi(w.x), bflo(w.y), bfhi(w.y)}; const f32x4 gq = *((const f32x4*)fg + lane + 64 * j); *((f32x4*)o + lane + 64 * j) = v * r * gq; }
}
__device__ __forceinline__ void final_phase(Frame& F) {
    const int gw = F.bid * NWAVES + F.wave, NGW = F.G * NWAVES;
    asm volatile("s_waitcnt vmcnt(0)" ::: "memory"); for (int r = F.bid * NWAVES + F.wave; r < MS; r += F.G * NWAVES) final_row(F, MP + r);
#pragma unroll 2
    for (int row = gw; row < MP; row += NGW) final_row(F, row);
}

#define XB_TMO      128
#define XB_XCNT(j)  (256  + 64 * (j))
#define XB_XSUB(j)  (1280 + 64 * (j))
#define XB_XGEN(j)  (2304 + 64 * (j))
#define XB_TOP      3328
#define XB_TOPGEN   3392
#define XCD_BAR_WORDS 3456
#define XB_SPIN_CAP (1u << 20)
__device__ __forceinline__ unsigned xb_ld(unsigned* p)              { return __hip_atomic_load(p, __ATOMIC_RELAXED, __HIP_MEMORY_SCOPE_AGENT); }
__device__ __forceinline__ unsigned xb_add(unsigned* p, unsigned v) { return __hip_atomic_fetch_add(p, v, __ATOMIC_RELAXED, __HIP_MEMORY_SCOPE_AGENT); }
__device__ __forceinline__ unsigned xb_xcc_id() { return (unsigned)__builtin_amdgcn_s_getreg((3 << 11) | 20) & 0xFu; }
#define XB_SPIN(cond, bar) do { unsigned _sp = 0; while (cond) { __builtin_amdgcn_s_sleep(1); \
    if ((++_sp & 255u) == 0u) { if (xb_ld(&(bar)[XB_TMO])) break; if (_sp > XB_SPIN_CAP) { atomicAdd(&(bar)[XB_TMO], 1u); break; } } } } while (0)
struct XcdBarrier { unsigned* bar; unsigned x; volatile LAS unsigned* st; };
__device__ __forceinline__ XcdBarrier xcd_barrier_post(unsigned* bar, volatile LAS unsigned* st) {
    XcdBarrier b; b.bar = bar; b.x = xb_xcc_id(); b.st = st;
    if (threadIdx.x == 0) (void)xb_add(&bar[XB_XCNT(b.x)], 1u);
    return b;
}
__device__ __forceinline__ void xcd_barrier_complete(unsigned* bar, unsigned x, unsigned& nloc, unsigned& nx) {
    const unsigned G = gridDim.x * gridDim.y * gridDim.z;
    unsigned sum, cnt, mine, sp = 0u;
    for (;;) {
        sum = 0u; cnt = 0u; mine = 0u;
#pragma unroll
        for (unsigned j = 0; j < 16; ++j) { const unsigned c = xb_ld(&bar[XB_XCNT(j)]); sum += c; cnt += (c > 0u) ? 1u : 0u; mine = (j == x) ? c : mine; }
        if (sum == G) break;
        __builtin_amdgcn_s_sleep(1);
        if ((++sp & 255u) == 0u) { if (xb_ld(&bar[XB_TMO])) break; if (sp > XB_SPIN_CAP) { atomicAdd(&bar[XB_TMO], 1u); break; } }
    }
    nloc = mine > 0u ? mine : 1u; nx = cnt > 0u ? cnt : 1u;
}
__device__ __forceinline__ void xcd_barrier(const XcdBarrier& b) {
    asm volatile("s_waitcnt vmcnt(0)" ::: "memory");
    __syncthreads();
    if (threadIdx.x == 0) {
        unsigned* bar = b.bar;
        __builtin_amdgcn_s_waitcnt(0);
        unsigned nloc = b.st[0], nx = b.st[1];
        if (nloc == 0u) { xcd_barrier_complete(bar, b.x, nloc, nx); b.st[0] = nloc; b.st[1] = nx; }
        const unsigned old = xb_add(&bar[XB_XSUB(b.x)], 1u);
        const unsigned gen = old / nloc;
        if (old + 1u == (gen + 1u) * nloc) {
            __builtin_amdgcn_fence(__ATOMIC_RELEASE, "agent");
            asm volatile("s_waitcnt vmcnt(0)" ::: "memory");
            const unsigned og = xb_add(&bar[XB_TOP], 1u);
            const unsigned tg = og / nx;
            if (og + 1u == (tg + 1u) * nx) xb_add(&bar[XB_TOPGEN], 1u);
            else XB_SPIN(xb_ld(&bar[XB_TOPGEN]) == tg, bar);
            __builtin_amdgcn_fence(__ATOMIC_ACQUIRE, "agent");
            xb_add(&bar[XB_XGEN(b.x)], 1u);
            asm volatile("s_waitcnt vmcnt(0)" ::: "memory");
        } else {
            XB_SPIN(xb_ld(&bar[XB_XGEN(b.x)]) == gen, bar);
            __builtin_amdgcn_fence(__ATOMIC_ACQUIRE, "agent");
            asm volatile("s_waitcnt vmcnt(0)" ::: "memory");
        }
    }
    __syncthreads();
}

constexpr int NPHASE = 15;
__global__ void __launch_bounds__(NTHR, 2) fwd_kernel(Args args) {
    extern __shared__ __attribute__((aligned(16))) unsigned char lds_raw[];
    Frame F; F.lds = (LAS unsigned char*)lds_raw; F.G = gridDim.x; F.bid = blockIdx.x;
    F.in = args.in; F.out = (float*)(GAS float*)args.out; F.ws = (unsigned char*)(GAS unsigned char*)args.ws;
    unsigned char* ws = F.ws;
#define REFRESH() do { int t_ = threadIdx.x; asm volatile("" : "+v"(t_)); F.tid = t_; F.lane = t_ & 63; F.wave = __builtin_amdgcn_readfirstlane(t_ >> 6); \
        GAS unsigned char* wsg_ = (GAS unsigned char*)args.ws; asm volatile("" : "+s"(wsg_)); ws = (unsigned char*)wsg_; F.ws = ws; } while (0)
    const int lo = args.ph_lo, hi = args.ph_hi;
#if MK_ONE_LAUNCH
    cg::grid_group grid = cg::this_grid();
    if (lo < 0) grid.sync();
    { volatile LAS unsigned* st0 = (volatile LAS unsigned*)(F.lds + LDS_BYTES - 64); if (threadIdx.x < 16) st0[threadIdx.x] = 0u; }
    __syncthreads();
    const XcdBarrier xbar = xcd_barrier_post((unsigned*)(args.ws + WS_CTL), (volatile LAS unsigned*)(F.lds + LDS_BYTES - 64));
#define SEAM(k) do { if (lo <= (k) && (k) + 1 < hi) xcd_barrier(xbar); } while (0)
#else
#define SEAM(k) do { } while (0)
#endif
#ifndef PHASE_MASK
#define PHASE_MASK 0x7fff
#endif
#define REP(k) for (int rep_ = 0; rep_ <= (((PROBE_REP_MASK) >> (k)) & 1); ++rep_)
#define WSSEL(bit) do { if ((FLAT_FN_MASK >> (bit)) & 1) { unsigned char* w_ = args.ws; asm volatile("" : "+s"(w_)); F.ws = w_; } else { GAS unsigned char* g_ = (GAS unsigned char*)args.ws; asm volatile("" : "+s"(g_)); F.ws = (unsigned char*)g_; } } while (0)
#define IN(k) ((((PHASE_MASK) >> (k)) & 1) && lo <= (k) && (k) < hi)
#define XB ((bf16_t*)(ws + WS_XB))
#define X ((float*)(ws + WS_X))
#define SSX ((float*)(ws + WS_SSX))
#define SSV ((float*)(ws + WS_SSV))
#define B0 ((bf16_t*)(ws + WS_B0))
#define B1 ((bf16_t*)(ws + WS_B1))
#define QBp ((bf16_t*)(ws + WS_QB))
#define A2 ((bf16_t*)(ws + WS_A2))
#define GBp ((bf16_t*)(ws + WS_GB))
    const int G = F.G, bid = F.bid;

    if (IN(0)) REP(0) { REFRESH(); WSSEL(0); p0_prologue(F); __syncthreads(); } SEAM(0);
#define CNT(k) ((unsigned*)(ws + WS_CTL) + 4096 + 64 * (k))
#define WOUT(l) ((const bf16_t*)(ws + WS_WOUT) + (size_t)(l) * DM * KOUT)
#define INPROJ(EpiT, E, W, N, cnt, want) do { \
        pg8::Gemm g{XB, (W), M, (N), DM, DM}; pg8::StaticOrder S; S.init(MP, (N), G, bid); pg8::gemm_phase<EpiT, pg8::StaticOrder, true, true>(F.lds, g, S, E); \
        if (cnt) counter_wait(cnt, (unsigned)(want)); \
        const int rem = ((MP / 256) * ((N) / 256)) % G; pg8::StaticOrder S2; S2.init(MS, (N), G, (bid + G - rem) % G, MP / 256); pg8::gemm_phase<EpiT, pg8::StaticOrder, true, true>(F.lds, g, S2, E); } while (0)
#define OUTPROJ_PROMPT(l, bp) do { pg8::Gemm g{A2, WOUT(l), M, DM, KOUT, KOUT}; pg8::StaticOrder S; S.init(MP, DM, G, bid); EpiOut E{(bp), XB, SSX}; pg8::gemm_phase<EpiOut, pg8::StaticOrder, true, true>(F.lds, g, S, E); } while (0)
#define OUTPROJ_SLICES(l, c, nb) do { pg8::Gemm g{A2, WOUT(l), M, DM, 256, KOUT}; typedef pg8::SliceOrder<MS / 256, DM / 256, NK_OUT> SO; SO S; S.init((nb), (c), MP / 256); \
        EpiSlab E{(float*)(ws + WS_SLAB), DM, MP, (size_t)MS * DM}; pg8::gemm_phase<EpiSlab, SO, true, true>(F.lds, g, S, E); } while (0)
#define SLICEFIX(l, sb0, basef, cA, cB) do { if (bid >= (sb0)) { const int nsb_ = G - (sb0); OUTPROJ_SLICES(l, bid - (sb0), nsb_); counter_signal(cA); counter_wait(cA, (unsigned)nsb_); \
        fixup_out_rows(F, (basef), bid - (sb0), nsb_); counter_signal(cB); } } while (0)
#define KVPROJ(l, c0) do { pg8::Gemm g{(const bf16_t*)(ws + WS_MEMB), (const bf16_t*)(ws + WS_WKV) + (size_t)(l) * DM * DM, PB * MEML, DM, DM, DM}; pg8::StaticOrder S; S.init(g.M, g.N, G, (bid + G - (c0)) % G); \
        EpiKV E{(const float*)(ws + WS_RSTDM), F.out + O_MK, F.out + O_MV, (bf16_t*)(ws + WS_KB), (bf16_t*)(ws + WS_VT), (l)}; pg8::gemm_phase<EpiKV, pg8::StaticOrder, true, true>(F.lds, g, S, E); } while (0)
    if (IN(1)) REP(1) { REFRESH();
        { EpiInA E{SSX, B0, B1, QBp, SSV}; INPROJ(EpiInA, E, (const bf16_t*)(ws + WS_WINA), NIN_A, (unsigned*)nullptr, 0); }
        KVPROJ(0, 180); KVPROJ(1, 212);
    } SEAM(1);
    if (IN(2)) REP(2) { REFRESH(); WSSEL(1);
        sgu_phase_mfma(F, 0); sgu_sample_phase(F, 0); attn_prompt_phase(F, 0); attn_sample_phase(F, 0); } SEAM(2);
    if (IN(3)) REP(3) { REFRESH(); OUTPROJ_PROMPT(0, GIN(0)); } SEAM(3);
    if (IN(4)) REP(4) { REFRESH(); SLICEFIX(0, 196, GIN(1), CNT(0), CNT(4));
        EpiInB E{SSX, B0, B1, QBp, F.out + O_CP, F.out + O_CS}; INPROJ(EpiInB, E, (const bf16_t*)(ws + WS_WINB), NIN_B, CNT(4), G - 196); } SEAM(4);
    if (IN(5)) REP(5) { REFRESH(); WSSEL(3);
        conv_phase(F); attn_prompt_phase(F, 1); attn_sample_phase(F, 1); } SEAM(5);
    if (IN(6)) REP(6) { REFRESH(); OUTPROJ_PROMPT(1, (const float*)nullptr); } SEAM(6);
    if (IN(7)) REP(7) { REFRESH(); SLICEFIX(1, 196, (const float*)nullptr, CNT(1), CNT(5));
        EpiInC E{SSX, B0, B1, QBp}; INPROJ(EpiInC, E, (const bf16_t*)(ws + WS_WINC), NIN_C, CNT(5), G - 196); KVPROJ(2, 164); } SEAM(7);
    if (IN(8)) REP(8) { REFRESH();
        const int half = G / 2;
        if (bid < half) { F.G = half; WSSEL(4); s5_prompt_mfma(F); if (PROBE_SUB_MASK & 8) s5_prompt_mfma(F); }
        else { F.bid = bid - half; F.G = G - half; for (int r2 = 0; r2 <= ((PROBE_SUB_MASK >> 4) & 1); ++r2) { WSSEL(6); attn_prompt_phase(F, 2); WSSEL(7); attn_sample_phase(F, 2); WSSEL(5); s5_sample_phase(F); } }
        F.bid = bid; F.G = G; } SEAM(8);
    if (IN(9)) REP(9) { REFRESH();
        { pg8::Gemm g{GBp, (const bf16_t*)(ws + WS_WGLU), M, E_, E_, E_}; pg8::StaticOrder S; S.init(MP, E_, G, bid); EpiGlu E{GBp, B1, GIN(29), A2}; pg8::gemm_phase<EpiGlu, pg8::StaticOrder, true, true>(F.lds, g, S, E); }
        { pg8::Gemm g{GBp, (const bf16_t*)(ws + WS_WGLU), M, E_, 256, E_}; typedef pg8::SliceOrder<MS / 256, E_ / 256, NK_GLU> SG; SG S; S.init(G, bid, MP / 256); EpiSlab E{(float*)(ws + WS_SLAB), E_, MP, (size_t)MS * E_}; pg8::gemm_phase<EpiSlab, SG, true, true>(F.lds, g, S, E); } } SEAM(9);
    if (IN(10)) REP(10) { REFRESH(); fixup_glu_rows(F);
        OUTPROJ_PROMPT(2, (const float*)nullptr); } SEAM(10);
    if (IN(11)) REP(11) { REFRESH(); SLICEFIX(2, 212, (const float*)nullptr, CNT(3), CNT(6));
        EpiInA E{SSX, B0, B1, QBp, SSV}; INPROJ(EpiInA, E, (const bf16_t*)(ws + WS_WINA) + (size_t)NIN_A * DM, NIN_A, CNT(6), G - 212); KVPROJ(3, 180); } SEAM(11);
    if (IN(12)) REP(12) { REFRESH(); WSSEL(1);
        sgu_phase_mfma(F, 1); sgu_sample_phase(F, 1); attn_prompt_phase(F, 3); attn_sample_phase(F, 3); } SEAM(12);
    if (IN(13)) REP(13) { REFRESH(); OUTPROJ_PROMPT(3, (const float*)nullptr); OUTPROJ_SLICES(3, bid, G); } SEAM(13);
    if (IN(14)) REP(14) { REFRESH(); WSSEL(8); fixup_out_rows(F, (const float*)nullptr, bid, G); final_phase(F); }
#undef CNT
#undef WOUT
#undef KVPROJ
#undef INPROJ
#undef OUTPROJ_PROMPT
#undef OUTPROJ_SLICES
#undef SLICEFIX
#undef IN
#undef REP
#undef SEAM
#undef XB
#undef X
#undef SSX
#undef SSV
#undef B0
#undef B1
#undef QBp
#undef A2
#undef GBp
#undef REFRESH
}

extern "C" void kernel_launch(void* const* d_in, const int* in_sizes, int n_in, void* d_out, int out_size, void* d_ws, size_t ws_size, hipStream_t stream) {
    static int grid = 0;
    if (grid == 0) {
        if (n_in != 30 || out_size != (int)O_END || ws_size < WS_END) { fprintf(stderr, "kernel_launch: unexpected shapes (n_in %d out %d ws %zu)\n", n_in, out_size, ws_size); grid = -1; return; }
        int dev = 0, cus = 0, per_cu = 0;
        (void)hipGetDevice(&dev); (void)hipDeviceGetAttribute(&cus, hipDeviceAttributeMultiprocessorCount, dev);
        if (hipFuncSetAttribute((const void*)fwd_kernel, hipFuncAttributeMaxDynamicSharedMemorySize, LDS_BYTES) != hipSuccess) { fprintf(stderr, "kernel_launch: hipFuncSetAttribute failed\n"); grid = -1; return; }
        if (hipOccupancyMaxActiveBlocksPerMultiprocessor(&per_cu, (const void*)fwd_kernel, NTHR, LDS_BYTES) != hipSuccess || per_cu < 1) { fprintf(stderr, "kernel_launch: occupancy query says %d\n", per_cu); (void)hipGetLastError(); per_cu = 1; }
        grid = cus;
    }
    if (grid < 0) return;
    Args a{};
    for (int i = 0; i < 30; ++i) a.in[i] = (const float*)d_in[i];
    a.out = (float*)d_out; a.ws = (unsigned char*)d_ws;
#if MK_ONE_LAUNCH
    (void)hipMemsetAsync((char*)d_ws + WS_CTL, 0, 65536, stream);
    a.ph_lo = 0; a.ph_hi = NPHASE;
    void* kargs[] = {&a};
    hipError_t e = hipLaunchCooperativeKernel((const void*)fwd_kernel, dim3(grid), dim3(NTHR), kargs, LDS_BYTES, stream);
    if (e != hipSuccess) fprintf(stderr, "cooperative launch failed: %s (grid %d)\n", hipGetErrorString(e), grid);
#else
    for (int p = 0; p < NPHASE; ++p) { a.ph_lo = p; a.ph_hi = p + 1; hipLaunchKernelGGL(fwd_kernel, dim3(grid), dim3(NTHR), LDS_BYTES, stream, a); }
#endif
}
```

```cpp
#include <hip/hip_runtime.h>
#include <hip/hip_cooperative_groups.h>
#include <cstdio>
#include <cstdint>
namespace cg = cooperative_groups;

#ifndef MK_ONE_LAUNCH
#define MK_ONE_LAUNCH 1
#endif
#ifndef XHALF_SHFL
#define XHALF_SHFL 0
#endif
#ifndef EPI_DRAIN
#define EPI_DRAIN 1
#endif
#ifndef FLAT_FN_MASK
#define FLAT_FN_MASK 0x00
#endif
#ifndef PROBE_SUB_MASK
#define PROBE_SUB_MASK 0
#endif
#ifndef PROBE_REP_MASK
#define PROBE_REP_MASK 0
#endif

namespace pg8 {
#define PG8_LAS __attribute__((address_space(3)))
typedef unsigned short bf16_t;
typedef short bf16x8 __attribute__((ext_vector_type(8)));
typedef float f32x4 __attribute__((ext_vector_type(4)));
typedef unsigned u32x4 __attribute__((ext_vector_type(4)));
typedef unsigned u32x2 __attribute__((ext_vector_type(2)));
constexpr int BM = 256, BK = 64, HALF = 128, HTB = HALF * BK * 2, STAGE_BYTES = 8 * HTB, NXCD = 8, WGM = 8;

__host__ __device__ __forceinline__ int lds_byte(int r, int c) { const int st = (r >> 4) * 2 + (c >> 5), rr = r & 15, cc = c & 31, ob = rr * 64 + cc * 2; return st * 1024 + (ob ^ (((ob >> 9) & 1) << 5)); }
__host__ __device__ __forceinline__ void stage_rc(int b, int& R, int& C) { const int st = b / 1024, sb = b % 1024, swz = sb ^ (((sb >> 9) & 1) << 5); R = (st >> 1) * 16 + swz / 64; C = (st & 1) * 32 + (swz % 64) / 2; }
__host__ __device__ __forceinline__ int perm32(int rho) { const int n = rho >> 4, i = rho & 15; return 8 * (i >> 2) + 4 * n + (i & 3); }

struct Unit { int pm, pn, ks; };
struct Gemm { const bf16_t* A; const bf16_t* Bt; int M, N, K, ld; };

struct StaticOrder {
    int nM, nN, nwg, G, c, pm0;
    __host__ __device__ void init(int M, int N, int G_, int c_, int pm0_ = 0) { nM = M / BM; nN = N / BM; nwg = nM * nN; G = G_; c = c_; pm0 = pm0_; }
    __host__ __device__ bool next(int i, Unit& u) const {
        const long L = (long)i * G + c; if (L >= nwg) return false;
        int wgid = (int)L; { const int q = nwg / NXCD, r = nwg % NXCD, xcd = wgid % NXCD, off = wgid / NXCD; wgid = (xcd < r ? xcd * (q + 1) : r * (q + 1) + (xcd - r) * q) + off; }
        const int nig = WGM * nN, gid = wgid / nig, fm = gid * WGM, gsz = (nM - fm) < WGM ? (nM - fm) : WGM;
        u.pm = pm0 + fm + ((wgid % nig) % gsz); u.pn = (wgid % nig) / gsz; u.ks = 0; return true;
    }
    __device__ __forceinline__ void a_ready(const Unit&) const {}
    __device__ __forceinline__ void done(const Unit&) const {}
};
template <int NM_, int NN_, int NK_> struct SliceOrder {
    int G, c, pm0;
    __host__ __device__ void init(int G_, int c_, int pm0_) { G = G_; c = c_; pm0 = pm0_; }
    __host__ __device__ bool next(int i, Unit& u) const {
        const int L = i * G + c; if (L >= NM_ * NN_ * NK_) return false;
        const int t = L / NK_; u.ks = L % NK_; u.pn = t % NN_; u.pm = pm0 + t / NN_; return true;
    }
    __device__ __forceinline__ void a_ready(const Unit&) const {}
    __device__ __forceinline__ void done(const Unit&) const {}
};

template <class Epi, class Sched, bool ALIGN_EPI = false, bool SP2 = false>
__device__ __forceinline__ void gemm_phase(PG8_LAS unsigned char* lds, const Gemm g, const Sched& S, const Epi& E) {
    int tid = threadIdx.x; asm volatile("" : "+v"(tid));
    const int wid = __builtin_amdgcn_readfirstlane(tid >> 6), lane = tid & 63, wr = wid >> 2, wc = wid & 3, fr = lane & 15, fq = lane >> 4;
    const int K = g.K, ld = g.ld, nt = K / BK;
    unsigned voffA[2], voffB[2];
#pragma unroll
    for (int i = 0; i < 2; ++i) { int R, C; stage_rc(tid * 16 + i * 8192, R, C); const int Rb = Epi::PERM ? ((R & ~31) + perm32(R & 31)) : R;
        voffA[i] = (unsigned)(R * ld + C) * 2u; voffB[i] = (unsigned)(Rb * ld + C) * 2u; }
    const size_t kstep = (size_t)(BK * 2);
    const size_t hstep = (size_t)HALF * ld * 2;
    const size_t sstep = (size_t)K * 2;
    const size_t tstep = 2 * hstep;
    const unsigned ldsw = (unsigned)wid * 1024u;
    const int aoff = lds_byte(wr * 64 + fr, fq * 8), boff = lds_byte(wc * 32 + fr, fq * 8);
#define PG8_SA(b, h) (((b) * 2 + (h)) * HTB)
#define PG8_SB(b, h) ((4 + (b) * 2 + (h)) * HTB)
#define PG8_STAGE(bufoff, gbase, voff) do { _Pragma("unroll") for (int _i = 0; _i < 2; ++_i) \
        __builtin_amdgcn_global_load_lds((const unsigned*)((const char*)(gbase) + (voff)[_i]), (PG8_LAS unsigned*)(lds + (bufoff) + ldsw + _i * 8192), 16, 0, 0); } while (0)
#define PG8_LDA(dst, b, h) do { _Pragma("unroll") for (int m = 0; m < 4; ++m) _Pragma("unroll") for (int k = 0; k < 2; ++k) dst[m][k] = *(const PG8_LAS bf16x8*)(lds + PG8_SA(b, h) + aoff + m * 2048 + k * 1024); } while (0)
#define PG8_LDB(dst, b, h) do { _Pragma("unroll") for (int n = 0; n < 2; ++n) _Pragma("unroll") for (int k = 0; k < 2; ++k) dst[n][k] = *(const PG8_LAS bf16x8*)(lds + PG8_SB(b, h) + boff + n * 2048 + k * 1024); } while (0)
#define PG8_MMA(ai, bj, At, Bt) do { __builtin_amdgcn_s_setprio(1); _Pragma("unroll") for (int m = 0; m < 4; ++m) _Pragma("unroll") for (int n = 0; n < 2; ++n) _Pragma("unroll") for (int k = 0; k < 2; ++k) \
        acc[ai][bj][m][n] = __builtin_amdgcn_mfma_f32_16x16x32_bf16(Bt[n][k], At[m][k], acc[ai][bj][m][n], 0, 0, 0); __builtin_amdgcn_s_setprio(0); } while (0)
#define PG8_WAIT_V(n) asm volatile("s_waitcnt vmcnt(" #n ")" ::: "memory")
#define PG8_WAIT_L(n) asm volatile("s_waitcnt lgkmcnt(" #n ")" ::: "memory")
#define PG8_BAR __builtin_amdgcn_s_barrier()
#define PG8_SCHED __builtin_amdgcn_sched_barrier(0)
    Unit cur, nxt; int ui = 0;
    if (!S.next(0, cur)) return;
    f32x4 acc[2][2][4][2];
#pragma unroll
    for (int a = 0; a < 2; ++a)
#pragma unroll
        for (int b = 0; b < 2; ++b)
#pragma unroll
            for (int m = 0; m < 4; ++m)
#pragma unroll
                for (int n = 0; n < 2; ++n) acc[a][b][m][n] = (f32x4){0.f, 0.f, 0.f, 0.f};
    bf16x8 At[4][2], B0[2][2], B1[2][2];
    const char* cA = (const char*)g.A + (size_t)cur.pm * tstep + (size_t)cur.ks * sstep; const char* cB = (const char*)g.Bt + (size_t)cur.pn * tstep + (size_t)cur.ks * sstep;
    S.a_ready(cur);
    if constexpr (SP2) {
        PG8_STAGE(PG8_SB(0, 0), cB, voffB); PG8_STAGE(PG8_SB(0, 1), cB + hstep, voffB); PG8_STAGE(PG8_SA(0, 0), cA, voffA); PG8_STAGE(PG8_SA(0, 1), cA + hstep, voffA);
        if (wr == 1) PG8_BAR;
        PG8_WAIT_V(2); PG8_BAR;
        PG8_STAGE(PG8_SB(1, 0), cB + kstep, voffB); PG8_STAGE(PG8_SA(1, 0), cA + kstep, voffA); PG8_STAGE(PG8_SB(1, 1), cB + hstep + kstep, voffB);
        PG8_WAIT_V(6); PG8_BAR;
    } else {
        PG8_STAGE(PG8_SB(0, 0), cB, voffB); PG8_STAGE(PG8_SA(0, 0), cA, voffA); PG8_STAGE(PG8_SB(0, 1), cB + hstep, voffB); PG8_STAGE(PG8_SA(0, 1), cA + hstep, voffA);
        if (wr == 1) PG8_BAR;
        PG8_WAIT_V(4); PG8_BAR;
        PG8_STAGE(PG8_SB(1, 0), cB + kstep, voffB); PG8_STAGE(PG8_SA(1, 0), cA + kstep, voffA); PG8_STAGE(PG8_SB(1, 1), cB + hstep + kstep, voffB);
        PG8_WAIT_V(6); PG8_BAR;
    }
    for (;;) {
        const bool has_next = S.next(ui + 1, nxt);
        const char* nA = has_next ? (const char*)g.A + (size_t)nxt.pm * tstep + (size_t)nxt.ks * sstep : cA; const char* nB = has_next ? (const char*)g.Bt + (size_t)nxt.pn * tstep + (size_t)nxt.ks * sstep : cB;
        for (int t = 0; t < nt; t += 2) {
            const bool last = (t == nt - 2);
            const char* a1 = cA + (size_t)(t + 1) * kstep;
            const char* a2 = last ? nA : cA + (size_t)(t + 2) * kstep; const char* b2 = last ? nB : cB + (size_t)(t + 2) * kstep;
            const char* a3 = a2 + kstep; const char* b3 = b2 + kstep;
            if (last && has_next) S.a_ready(nxt);
            if constexpr (SP2) {
            PG8_LDB(B0, 0, 0); PG8_LDB(B1, 0, 1); PG8_SCHED; PG8_LDA(At, 0, 0); PG8_STAGE(PG8_SA(1, 1), a1 + hstep, voffA);
            PG8_WAIT_V(8); PG8_WAIT_L(0); PG8_BAR; PG8_MMA(0, 0, At, B0); PG8_MMA(0, 1, At, B1); PG8_BAR; PG8_SCHED;
            PG8_LDA(At, 0, 1); PG8_STAGE(PG8_SB(0, 0), b2, voffB); PG8_STAGE(PG8_SB(0, 1), b2 + hstep, voffB); PG8_STAGE(PG8_SA(0, 0), a2, voffA);
            PG8_WAIT_V(8); PG8_WAIT_L(0); PG8_BAR; PG8_MMA(1, 0, At, B0); PG8_MMA(1, 1, At, B1); PG8_BAR; PG8_SCHED;
            PG8_LDB(B0, 1, 0); PG8_LDB(B1, 1, 1); PG8_SCHED; PG8_LDA(At, 1, 0); PG8_STAGE(PG8_SA(0, 1), a2 + hstep, voffA);
            PG8_WAIT_V(8); PG8_WAIT_L(0); PG8_BAR; PG8_MMA(0, 0, At, B0); PG8_MMA(0, 1, At, B1); PG8_BAR; PG8_SCHED;
            PG8_LDA(At, 1, 1); PG8_STAGE(PG8_SB(1, 0), b3, voffB); PG8_STAGE(PG8_SB(1, 1), b3 + hstep, voffB); PG8_STAGE(PG8_SA(1, 0), a3, voffA);
            PG8_WAIT_V(8); PG8_WAIT_L(0); PG8_BAR; PG8_MMA(1, 0, At, B0); PG8_MMA(1, 1, At, B1); PG8_BAR; PG8_SCHED;
            } else {
            PG8_LDB(B0, 0, 0); PG8_SCHED; PG8_LDA(At, 0, 0); PG8_STAGE(PG8_SA(1, 1), a1 + hstep, voffA);
            PG8_WAIT_L(8); PG8_BAR; PG8_WAIT_L(0); PG8_MMA(0, 0, At, B0); PG8_BAR; PG8_SCHED;
            PG8_LDB(B1, 0, 1); PG8_STAGE(PG8_SB(0, 0), b2, voffB);
            PG8_BAR; PG8_WAIT_L(0); PG8_MMA(0, 1, At, B1); PG8_BAR;
            PG8_LDA(At, 0, 1); PG8_STAGE(PG8_SA(0, 0), a2, voffA);
            PG8_BAR; PG8_WAIT_L(0); PG8_MMA(1, 0, At, B0); PG8_BAR; PG8_SCHED;
            PG8_STAGE(PG8_SB(0, 1), b2 + hstep, voffB);
            PG8_WAIT_V(6); PG8_BAR; PG8_MMA(1, 1, At, B1); PG8_BAR;
            PG8_LDB(B0, 1, 0); PG8_SCHED; PG8_LDA(At, 1, 0); PG8_STAGE(PG8_SA(0, 1), a2 + hstep, voffA);
            PG8_WAIT_L(8); PG8_BAR; PG8_WAIT_L(0); PG8_MMA(0, 0, At, B0); PG8_BAR; PG8_SCHED;
            PG8_LDB(B1, 1, 1); PG8_STAGE(PG8_SB(1, 0), b3, voffB);
            PG8_BAR; PG8_WAIT_L(0); PG8_MMA(0, 1, At, B1); PG8_BAR;
            PG8_LDA(At, 1, 1); PG8_STAGE(PG8_SA(1, 0), a3, voffA);
            PG8_BAR; PG8_WAIT_L(0); PG8_MMA(1, 0, At, B0); PG8_BAR; PG8_SCHED;
            PG8_STAGE(PG8_SB(1, 1), b3 + hstep, voffB);
            PG8_WAIT_V(6); PG8_BAR; PG8_MMA(1, 1, At, B1); PG8_BAR;
            }
        }
        if constexpr (ALIGN_EPI) { if (wr == 0) PG8_BAR; }
        if constexpr (!Epi::AFTER_DRAIN) { E(acc, cur, wr, wc, fr, fq); S.done(cur); }
#if EPI_DRAIN
        PG8_WAIT_V(0);
#endif
        if (!has_next) break;
#pragma unroll
        for (int a = 0; a < 2; ++a)
#pragma unroll
            for (int b = 0; b < 2; ++b)
#pragma unroll
                for (int m = 0; m < 4; ++m)
#pragma unroll
                    for (int n = 0; n < 2; ++n) acc[a][b][m][n] = (f32x4){0.f, 0.f, 0.f, 0.f};
        cur = nxt; cA = nA; cB = nB; ++ui;
        if constexpr (ALIGN_EPI) { if (wr == 1) PG8_BAR; }
    }
    PG8_WAIT_V(0);
    if constexpr (!ALIGN_EPI) { if (wr == 0) PG8_BAR; }
    PG8_BAR;
#undef PG8_SA
#undef PG8_SB
#undef PG8_STAGE
#undef PG8_LDA
#undef PG8_LDB
#undef PG8_MMA
#undef PG8_WAIT_V
#undef PG8_WAIT_L
#undef PG8_BAR
#undef PG8_SCHED
}
}

using pg8::bf16_t; using pg8::f32x4; using pg8::u32x4; using pg8::u32x2; using pg8::bf16x8; using pg8::Unit;
#define LAS __attribute__((address_space(3)))
#define GAS __attribute__((address_space(1)))
#define GIN(k) ((const float*)(const GAS float*)F.in[k])
typedef float f32x2 __attribute__((ext_vector_type(2)));
typedef __bf16 bf16x2_t __attribute__((ext_vector_type(2)));
typedef float f32x16 __attribute__((ext_vector_type(16)));

constexpr int DM = 1024, E_ = 2048, XA = 512, NH = 4, HD = 128, MEML = 256;
constexpr int PB = 8, PSEQ = 2048, MP = PB * PSEQ;
constexpr int SBT = 128, SSEQ = 4, MS = SBT * SSEQ;
constexpr int M = MP + MS;
constexpr int NIN_A = 3 * E_ + XA, NIN_B = 4 * E_ + XA, NIN_C = 2 * E_ + XA, KOUT = E_ + XA;
constexpr int S5G = 128, S5P = 64, S5I = 16;
constexpr float EPS = 1e-6f;
constexpr int NWAVES = 8, NTHR = 512;

constexpr size_t O_YP = 0, O_YS = O_YP + (size_t)MP * DM, O_MK = O_YS + (size_t)MS * DM, O_MV = O_MK + 4ull * PB * MEML * XA, O_CP = O_MV + 4ull * PB * MEML * XA,
                 O_CS = O_CP + (size_t)PB * 2 * E_, O_SRP = O_CS + (size_t)SBT * 2 * E_, O_SIP = O_SRP + (size_t)PB * S5G * S5P, O_SRS = O_SIP + (size_t)PB * S5G * S5P,
                 O_SIS = O_SRS + (size_t)SBT * S5G * S5P, O_CV = O_SIS + (size_t)SBT * S5G * S5P, O_END = O_CV + 2ull * SBT * SSEQ * E_;
static_assert(O_END == 30572544ull, "output size");

constexpr size_t MiB = 1u << 20;
constexpr size_t WS_CTL = 0, WS_TAB = 1 * MiB, WS_RSTDM = 3 * MiB, WS_SGUW = 4 * MiB, WS_SSX = 5 * MiB, WS_SSV = 7 * MiB, WS_WKV = 10 * MiB, WS_WGLU = 18 * MiB, WS_WOUT = 26 * MiB,
                 WS_WINA = 46 * MiB, WS_WINB = 72 * MiB, WS_WINC = 89 * MiB, WS_MEMB = 98 * MiB, WS_KB = 102 * MiB, WS_VT = 110 * MiB, WS_XB = 118 * MiB, WS_X = 151 * MiB,
                 WS_B0 = 217 * MiB, WS_B1 = 283 * MiB, WS_QB = 349 * MiB, WS_A2 = 366 * MiB, WS_GB = 449 * MiB, WS_SLAB = 515 * MiB  , WS_END = 548 * MiB;
constexpr size_t T_AR = 0, T_AI = 8192, T_BBR = 16384, T_BBI = 16384 + 131072;

constexpr int RING_BYTES = 131072, LDS_BYTES = 147456;

struct Args { const float* in[30]; float* out; unsigned char* ws; int ph_lo, ph_hi; };

__device__ __forceinline__ unsigned pk2(float lo, float hi) { f32x2 v = {lo, hi}; return __builtin_bit_cast(unsigned, __builtin_convertvector(v, bf16x2_t)); }
__device__ __forceinline__ bf16_t f2bf(float f) { return (bf16_t)(pk2(f, 0.f) & 0xffffu); }
__device__ __forceinline__ float bf2f(unsigned short h) { return __uint_as_float((unsigned)h << 16); }
__device__ __forceinline__ float bflo(unsigned w) { return __uint_as_float(w << 16); }
__device__ __forceinline__ float bfhi(unsigned w) { return __uint_as_float(w & 0xffff0000u); }
__device__ __forceinline__ float sigmoidf_(float x) { return __builtin_amdgcn_rcpf(1.f + __expf(-x)); }
__device__ __forceinline__ float siluf_(float x) { return x * sigmoidf_(x); }
__device__ __forceinline__ float gelu_tanh(float x) { const float y = 0.7978845608028654f * (x + 0.044715f * x * x * x); return x * sigmoidf_(2.f * y); }
__device__ __forceinline__ float wave_sum(float v) {
#pragma unroll
    for (int o = 1; o < 64; o <<= 1) v += __shfl_xor(v, o);
    return v;
}
__device__ __forceinline__ float wave_max(float v) {
#pragma unroll
    for (int o = 1; o < 64; o <<= 1) v = fmaxf(v, __shfl_xor(v, o));
    return v;
}
__device__ __forceinline__ u32x4 pack8(f32x4 a, f32x4 b) { u32x4 w; w.x = pk2(a[0], a[1]); w.y = pk2(a[2], a[3]); w.z = pk2(b[0], b[1]); w.w = pk2(b[2], b[3]); return w; }
__device__ __forceinline__ void unpack8(u32x4 w, float (&f)[8]) { f[0] = bflo(w.x); f[1] = bfhi(w.x); f[2] = bflo(w.y); f[3] = bfhi(w.y); f[4] = bflo(w.z); f[5] = bfhi(w.z); f[6] = bflo(w.w); f[7] = bfhi(w.w); }

__device__ __forceinline__ int src_col(int kind, int np) {
    const int pn = np >> 8, p = np & 255, pos = (p & ~31) + pg8::perm32(p & 31);
    if (kind == 0) {
        if (pn < 16) return pos < 128 ? 128 * pn + pos : 2 * E_ + 128 * pn + (pos - 128);
        if (pn < 24) return E_ + 256 * (pn - 16) + pos;
        return 3 * E_ + 256 * (pn - 24) + pos;
    }
    if (kind == 1) {
        if (pn < 32) { const int qs = 2 * (p >> 7) + ((p >> 4) & 1), ch = 64 * pn + 16 * ((p >> 5) & 3) + (p & 15); return qs * E_ + ch; }
        return 4 * E_ + 256 * (pn - 32) + pos;
    }
    return 256 * pn + pos;
}

__device__ __forceinline__ float sum_rows4(float x) {
    auto a = __builtin_amdgcn_permlane16_swap(__float_as_uint(x), __float_as_uint(x), false, false); const float y = __uint_as_float(a[0]) + __uint_as_float(a[1]);
    auto b = __builtin_amdgcn_permlane32_swap(__float_as_uint(y), __float_as_uint(y), false, false); return __uint_as_float(b[0]) + __uint_as_float(b[1]);
}
__device__ __forceinline__ void rows_rstd16(const float* ssx, int row0, int fq, float (&rs)[2][4]) {
#pragma unroll
    for (int ai = 0; ai < 2; ++ai)
#pragma unroll
        for (int m = 0; m < 4; ++m) {
            const f32x4 v = *(const f32x4*)(ssx + (size_t)(row0 + ai * 128 + m * 16) * 16 + fq * 4);
            const float s = sum_rows4((v[0] + v[1]) + (v[2] + v[3]));
            rs[ai][m] = __builtin_amdgcn_rsqf(s * (1.f / DM) + EPS);
        }
}

struct EpiKV {
    static constexpr bool PERM = false, AFTER_DRAIN = false;
    const float* rstdm; float* outk; float* outv; bf16_t* KB; bf16_t* VT; int layer;
    __device__ __forceinline__ void operator()(const f32x4 (&acc)[2][2][4][2], const Unit& u, int wr, int wc, int fr, int fq) const {
        const int sub = u.pn & 3, isv = sub >> 1, b = u.pm;
        const int key0 = wr * 64 + fr, d0 = 32 * wc + 8 * fq;
        const float* rsp = rstdm + b * 256 + key0;
        float* of = (isv ? outv : outk) + (((size_t)(layer * PB + b) * MEML + key0) * NH + (sub & 1) * 2) * HD + d0;
        const size_t bh0 = (size_t)((layer * PB + b) * NH + (sub & 1) * 2);
        if (!isv) {
            bf16_t* kb = KB + (bh0 * MEML + key0) * HD + d0;
#pragma unroll
            for (int ai = 0; ai < 2; ++ai)
#pragma unroll
                for (int m = 0; m < 4; ++m) { const int kk = ai * 128 + m * 16; const float rs = rsp[kk];
#pragma unroll
                    for (int bj = 0; bj < 2; ++bj) { const f32x4 v0 = acc[ai][bj][m][0] * rs, v1 = acc[ai][bj][m][1] * rs;
                        float* o = of + (size_t)kk * XA + bj * HD; *(f32x4*)o = v0; *(f32x4*)(o + 4) = v1;
                        *(u32x4*)(kb + (size_t)bj * MEML * HD + (size_t)kk * HD) = pack8(v0, v1); }
                    asm volatile("" ::: "memory"); }
        } else {
            bf16_t* vt = VT + (bh0 * HD + d0) * MEML + key0;
#pragma unroll
            for (int ai = 0; ai < 2; ++ai)
#pragma unroll
                for (int m = 0; m < 4; ++m) { const int kk = ai * 128 + m * 16; const float rs = rsp[kk];
#pragma unroll
                    for (int bj = 0; bj < 2; ++bj) { const f32x4 v0 = acc[ai][bj][m][0] * rs, v1 = acc[ai][bj][m][1] * rs;
                        float* o = of + (size_t)kk * XA + bj * HD; *(f32x4*)o = v0; *(f32x4*)(o + 4) = v1;
                        bf16_t* q = vt + (size_t)bj * HD * MEML + kk;
#pragma unroll
                        for (int e = 0; e < 4; ++e) { q[e * MEML] = f2bf(v0[e]); q[(e + 4) * MEML] = f2bf(v1[e]); }
                        asm volatile("" ::: "memory"); } }
        }
    }
};

struct EpiInA {
    static constexpr bool PERM = false, AFTER_DRAIN = false;
    const float* ssx; bf16_t* UZ; bf16_t* VR; bf16_t* QB; float* SSV;
    __device__ __forceinline__ void operator()(const f32x4 (&acc)[2][2][4][2], const Unit& u, int wr, int wc, int fr, int fq) const {
        const int row0 = u.pm * 256 + wr * 64 + fr; float rs[2][4]; rows_rstd16(ssx, row0, fq, rs);
        if (u.pn < 16) {
#pragma unroll
            for (int ai = 0; ai < 2; ++ai)
#pragma unroll
                for (int m = 0; m < 4; ++m) { const int row = row0 + ai * 128 + m * 16; const float r = rs[ai][m]; f32x4 o[2];
#pragma unroll
                    for (int n = 0; n < 2; ++n)
#pragma unroll
                        for (int e = 0; e < 4; ++e) o[n][e] = acc[ai][0][m][n][e] * r * siluf_(acc[ai][1][m][n][e] * r);
                    *(u32x4*)(UZ + (size_t)row * E_ + 128 * u.pn + 32 * wc + 8 * fq) = pack8(o[0], o[1]); }
        } else if (u.pn < 24) {
#pragma unroll
            for (int ai = 0; ai < 2; ++ai)
#pragma unroll
                for (int m = 0; m < 4; ++m) { const int row = row0 + ai * 128 + m * 16; const float r = rs[ai][m]; float ss = 0.f;
#pragma unroll
                    for (int bj = 0; bj < 2; ++bj) { const f32x4 v0 = acc[ai][bj][m][0] * r, v1 = acc[ai][bj][m][1] * r;
                        ss += (v0[0] * v0[0] + v0[1] * v0[1]) + (v0[2] * v0[2] + v0[3] * v0[3]) + (v1[0] * v1[0] + v1[1] * v1[1]) + (v1[2] * v1[2] + v1[3] * v1[3]);
                        *(u32x4*)(VR + (size_t)row * E_ + 256 * (u.pn - 16) + 128 * bj + 32 * wc + 8 * fq) = pack8(v0, v1); }
                    ss = sum_rows4(ss);
                    if (fq == 0) SSV[(size_t)row * 32 + (u.pn - 16) * 4 + wc] = ss; }
        } else {
#pragma unroll
            for (int ai = 0; ai < 2; ++ai)
#pragma unroll
                for (int m = 0; m < 4; ++m) { const int row = row0 + ai * 128 + m * 16; const float r = rs[ai][m] * 0.08838834764831845f;
#pragma unroll
                    for (int bj = 0; bj < 2; ++bj) *(u32x4*)(QB + (size_t)row * XA + 256 * (u.pn - 24) + 128 * bj + 32 * wc + 8 * fq) = pack8(acc[ai][bj][m][0] * r, acc[ai][bj][m][1] * r); }
        }
    }
};

struct EpiInB {
    static constexpr bool PERM = false, AFTER_DRAIN = false;
    const float* ssx; bf16_t* P; bf16_t* G; bf16_t* QB; float* convp; float* convs;
    __device__ __forceinline__ void operator()(const f32x4 (&acc)[2][2][4][2], const Unit& u, int wr, int wc, int fr, int fq) const {
        const int row0 = u.pm * 256 + wr * 64 + fr; float rs[2][4]; rows_rstd16(ssx, row0, fq, rs);
        if (u.pn < 32) {
            const int ch0 = 64 * u.pn + 16 * wc + 4 * fq;
#pragma unroll
            for (int ai = 0; ai < 2; ++ai)
#pragma unroll
                for (int m = 0; m < 4; ++m) { const int row = row0 + ai * 128 + m * 16; const float r = rs[ai][m];
                    const f32x4 bg = acc[ai][0][m][0] * r, cgv = acc[ai][0][m][1] * r, hv = acc[ai][1][m][0] * r, z = acc[ai][1][m][1] * r;
                    f32x4 p = cgv * hv, gg;
#pragma unroll
                    for (int e = 0; e < 4; ++e) gg[e] = bg[e] * siluf_(z[e]);
                    u32x2 wp, wg; wp.x = pk2(p[0], p[1]); wp.y = pk2(p[2], p[3]); wg.x = pk2(gg[0], gg[1]); wg.y = pk2(gg[2], gg[3]);
                    *(u32x2*)(P + (size_t)row * E_ + ch0) = wp; *(u32x2*)(G + (size_t)row * E_ + ch0) = wg;
                    if (row < MP) { const int t = row & (PSEQ - 1); if (t >= PSEQ - 2) *(f32x4*)(convp + ((size_t)(row >> 11) * 2 + (t - (PSEQ - 2))) * E_ + ch0) = p; }
                    else { const int s = row - MP, t = s & 3; if (t >= 2) *(f32x4*)(convs + ((size_t)(s >> 2) * 2 + (t - 2)) * E_ + ch0) = p; } }
        } else {
#pragma unroll
            for (int ai = 0; ai < 2; ++ai)
#pragma unroll
                for (int m = 0; m < 4; ++m) { const int row = row0 + ai * 128 + m * 16; const float r = rs[ai][m] * 0.08838834764831845f;
#pragma unroll
                    for (int bj = 0; bj < 2; ++bj) *(u32x4*)(QB + (size_t)row * XA + 256 * (u.pn - 32) + 128 * bj + 32 * wc + 8 * fq) = pack8(acc[ai][bj][m][0] * r, acc[ai][bj][m][1] * r); }
        }
    }
};

struct EpiInC {
    static constexpr bool PERM = false, AFTER_DRAIN = false;
    const float* ssx; bf16_t* U; bf16_t* SZ; bf16_t* QB;
    __device__ __forceinline__ void operator()(const f32x4 (&acc)[2][2][4][2], const Unit& u, int wr, int wc, int fr, int fq) const {
        const int row0 = u.pm * 256 + wr * 64 + fr; float rs[2][4]; rows_rstd16(ssx, row0, fq, rs);
#pragma unroll
        for (int ai = 0; ai < 2; ++ai)
#pragma unroll
            for (int m = 0; m < 4; ++m) { const int row = row0 + ai * 128 + m * 16; const float r = rs[ai][m];
#pragma unroll
                for (int bj = 0; bj < 2; ++bj) { const int cc = 128 * bj + 32 * wc + 8 * fq;
                    if (u.pn < 8) *(u32x4*)(U + (size_t)row * E_ + 256 * u.pn + cc) = pack8(acc[ai][bj][m][0] * r, acc[ai][bj][m][1] * r);
                    else if (u.pn < 16) { f32x4 a, b2;
#pragma unroll
                        for (int e = 0; e < 4; ++e) { a[e] = siluf_(acc[ai][bj][m][0][e] * r); b2[e] = siluf_(acc[ai][bj][m][1][e] * r); }
                        *(u32x4*)(SZ + (size_t)row * E_ + 256 * (u.pn - 8) + cc) = pack8(a, b2); }
                    else { const float rq = r * 0.08838834764831845f; *(u32x4*)(QB + (size_t)row * XA + 256 * (u.pn - 16) + cc) = pack8(acc[ai][bj][m][0] * rq, acc[ai][bj][m][1] * rq); } } }
    }
};

struct EpiOut {
    static constexpr bool PERM = false, AFTER_DRAIN = false;
    const float* basef; bf16_t* XB; float* SSX;
    __device__ __forceinline__ void operator()(const f32x4 (&acc)[2][2][4][2], const Unit& u, int wr, int wc, int fr, int fq) const {
        const int row0 = u.pm * 256 + wr * 64 + fr;
#pragma unroll
        for (int ai = 0; ai < 2; ++ai)
#pragma unroll
            for (int m = 0; m < 4; ++m) { const int row = row0 + ai * 128 + m * 16; float ss = 0.f;
#pragma unroll
                for (int bj = 0; bj < 2; ++bj) { const int col = 256 * u.pn + 128 * bj + 32 * wc + 8 * fq; f32x4 x0, x1;
                    if (basef) { x0 = *(const f32x4*)(basef + (size_t)row * DM + col); x1 = *(const f32x4*)(basef + (size_t)row * DM + col + 4); }
                    else { float r[8]; unpack8(*(const u32x4*)(XB + (size_t)row * DM + col), r); x0 = (f32x4){r[0], r[1], r[2], r[3]}; x1 = (f32x4){r[4], r[5], r[6], r[7]}; }
                    x0 += acc[ai][bj][m][0]; x1 += acc[ai][bj][m][1];
                    *(u32x4*)(XB + (size_t)row * DM + col) = pack8(x0, x1);
                    ss += (x0[0] * x0[0] + x0[1] * x0[1]) + (x0[2] * x0[2] + x0[3] * x0[3]) + (x1[0] * x1[0] + x1[1] * x1[1]) + (x1[2] * x1[2] + x1[3] * x1[3]); }
                ss = sum_rows4(ss);
                if (fq == 0) SSX[(size_t)row * 16 + u.pn * 4 + wc] = ss; }
    }
};

struct EpiGlu {
    static constexpr bool PERM = false, AFTER_DRAIN = false;
    const bf16_t* GB; const bf16_t* SZ; const float* bias; bf16_t* A2;
    __device__ __forceinline__ void operator()(const f32x4 (&acc)[2][2][4][2], const Unit& u, int wr, int wc, int fr, int fq) const {
        const int row0 = u.pm * 256 + wr * 64 + fr;
#pragma unroll
        for (int ai = 0; ai < 2; ++ai)
#pragma unroll
            for (int m = 0; m < 4; ++m) { const int row = row0 + ai * 128 + m * 16;
#pragma unroll
                for (int bj = 0; bj < 2; ++bj) { const int col = 256 * u.pn + 128 * bj + 32 * wc + 8 * fq;
                    const f32x4 b0 = *(const f32x4*)(bias + col), b1 = *(const f32x4*)(bias + col + 4);
                    float gv[8], sz[8]; unpack8(*(const u32x4*)(GB + (size_t)row * E_ + col), gv); unpack8(*(const u32x4*)(SZ + (size_t)row * E_ + col), sz);
                    f32x4 o0, o1;
#pragma unroll
                    for (int e = 0; e < 4; ++e) { o0[e] = gv[e] * sigmoidf_(acc[ai][bj][m][0][e] + b0[e]) * sz[e]; o1[e] = gv[4 + e] * sigmoidf_(acc[ai][bj][m][1][e] + b1[e]) * sz[4 + e]; }
                    *(u32x4*)(A2 + (size_t)row * KOUT + col) = pack8(o0, o1); } }
    }
};

struct EpiSlab {
    static constexpr bool PERM = false, AFTER_DRAIN = false;
    float* S; int ldc; int row0; size_t kstride;
    __device__ __forceinline__ void operator()(const f32x4 (&acc)[2][2][4][2], const Unit& u, int wr, int wc, int fr, int fq) const {
        float* base = S + (size_t)u.ks * kstride + (size_t)(u.pm * 256 + wr * 64 + fr - row0) * ldc + 256 * u.pn + 32 * wc + 8 * fq;
#pragma unroll
        for (int ai = 0; ai < 2; ++ai)
#pragma unroll
            for (int m = 0; m < 4; ++m)
                { float* o = base + (size_t)(ai * 128 + m * 16) * ldc; *(f32x4*)o = acc[ai][0][m][0]; *(f32x4*)(o + 4) = acc[ai][0][m][1]; *(f32x4*)(o + 128) = acc[ai][1][m][0]; *(f32x4*)(o + 132) = acc[ai][1][m][1];
                  asm volatile("" ::: "memory"); }
    }
};

#ifndef PROBE_EPI2
#define PROBE_EPI2 0
#endif
template <class E_> struct EpiTwice { static constexpr bool PERM = false, AFTER_DRAIN = false; E_ e;
    __device__ __forceinline__ void operator()(const f32x4 (&acc)[2][2][4][2], const Unit& u, int wr, int wc, int fr, int fq) const { e(acc, u, wr, wc, fr, fq); asm volatile("" ::: "memory"); e(acc, u, wr, wc, fr, fq); } };

struct Frame {
    LAS unsigned char* lds; int tid, lane, wave, G, bid;
    const float* const* in; float* out; unsigned char* ws;
};

struct WItem { const float* W; const float* gs; bf16_t* WT; int K, N, kind, r; };
__device__ __forceinline__ WItem witem(Frame& F, int it) {
    constexpr int I_A = 16 * (NIN_A / 32), I_B = 16 * (NIN_B / 32), I_C = 16 * (NIN_C / 32), I_O = (KOUT / 64) * (DM / 32), I_KV = 16 * (DM / 32);
    unsigned char* ws = F.ws; int r = it; WItem w;
    if (r < 2 * I_A) { const int j = r / I_A; r -= j * I_A; w = WItem{GIN(13) + (size_t)j * DM * NIN_A, GIN(8) + (j == 0 ? 0 : 3) * DM, (bf16_t*)(ws + WS_WINA) + (size_t)j * NIN_A * DM, DM, NIN_A, 0, r}; return w; } r -= 2 * I_A;
    if (r < I_B) { w = WItem{GIN(17), GIN(8) + 1 * DM, (bf16_t*)(ws + WS_WINB), DM, NIN_B, 1, r}; return w; } r -= I_B;
    if (r < I_C) { w = WItem{GIN(19), GIN(8) + 2 * DM, (bf16_t*)(ws + WS_WINC), DM, NIN_C, 2, r}; return w; } r -= I_C;
    if (r < 4 * I_O) { const int j = r / I_O; r -= j * I_O; w = WItem{GIN(12) + (size_t)j * KOUT * DM, nullptr, (bf16_t*)(ws + WS_WOUT) + (size_t)j * DM * KOUT, KOUT, DM, 2, r}; return w; } r -= 4 * I_O;
    if (r < 4 * I_KV) { const int j = r / I_KV; r -= j * I_KV; w = WItem{GIN(11) + (size_t)j * DM * DM, GIN(10) + j * DM, (bf16_t*)(ws + WS_WKV) + (size_t)j * DM * DM, DM, DM, 2, r}; return w; } r -= 4 * I_KV;
    w = WItem{GIN(28), nullptr, (bf16_t*)(ws + WS_WGLU), E_, E_, 2, r}; return w;
}
__device__ __forceinline__ void witem_load(const WItem& w, int lane, f32x4 (&x)[8]) {
    const int nblk = w.N / 32, kb = w.r / nblk, nb = w.r % nblk, k0 = 64 * kb, n0 = 32 * nb, n4 = lane & 7, kr = lane >> 3;
    const int sc = src_col(w.kind, n0 + 4 * n4);
#pragma unroll
    for (int i = 0; i < 8; ++i) x[i] = *(const f32x4*)(w.W + (size_t)(k0 + kr + 8 * i) * w.N + sc);
}
__device__ __forceinline__ void witem_finish(const WItem& w, int lane, const f32x4 (&x)[8], LAS float* scr) {
    const int nblk = w.N / 32, kb = w.r / nblk, nb = w.r % nblk, k0 = 64 * kb, n0 = 32 * nb, n4 = lane & 7, kr = lane >> 3;
    asm volatile("s_waitcnt vmcnt(8)" ::: "memory");
#pragma unroll
    for (int i = 0; i < 8; ++i) { const int kk = kr + 8 * i; const float g = w.gs ? w.gs[k0 + kk] : 1.f; LAS float* d = scr + kk * 33 + 4 * n4; d[0] = x[i][0] * g; d[1] = x[i][1] * g; d[2] = x[i][2] * g; d[3] = x[i][3] * g; }
    asm volatile("s_waitcnt lgkmcnt(0)" ::: "memory");
    const int c = lane & 7;
#pragma unroll
    for (int j = 0; j < 4; ++j) { const int n = (lane >> 3) + 8 * j; const LAS float* sp = scr + (8 * c) * 33 + n;
        u32x4 o; o.x = pk2(sp[0 * 33], sp[1 * 33]); o.y = pk2(sp[2 * 33], sp[3 * 33]); o.z = pk2(sp[4 * 33], sp[5 * 33]); o.w = pk2(sp[6 * 33], sp[7 * 33]);
        *(u32x4*)(w.WT + (size_t)(n0 + n) * w.K + k0 + 8 * c) = o; }
    asm volatile("s_waitcnt lgkmcnt(0)" ::: "memory");
}

__device__ __forceinline__ void p0_prologue(Frame& F) {
    LAS float* scr = (LAS float*)(F.lds + F.wave * 16384);
    const int gw = F.bid * NWAVES + F.wave, NGW = F.G * NWAVES, lane = F.lane;
    unsigned char* ws = F.ws;
    constexpr int NITEMS = 2 * 16 * (NIN_A / 32) + 16 * (NIN_B / 32) + 16 * (NIN_C / 32) + 4 * (KOUT / 64) * (DM / 32) + 4 * 16 * (DM / 32) + (E_ / 64) * (E_ / 32);
    if (gw < NITEMS) {
        WItem wc = witem(F, gw); f32x4 xa[8]; witem_load(wc, lane, xa);
        for (int it = gw; it < NITEMS; it += NGW) {
            const int nit = it + NGW < NITEMS ? it + NGW : it; const WItem wn = witem(F, nit); f32x4 xb[8]; witem_load(wn, lane, xb);
            witem_finish(wc, lane, xa, scr);
            wc = wn;
#pragma unroll
            for (int i = 0; i < 8; ++i) xa[i] = xb[i];
        }
    }
    {
        bf16_t* XB = (bf16_t*)(ws + WS_XB); float* SSX = (float*)(ws + WS_SSX);
        for (int row = gw; row < M; row += 2 * NGW) {
            const int row2 = row + NGW < M ? row + NGW : row;
            const float* xr = row < MP ? GIN(0) + (size_t)row * DM : GIN(1) + (size_t)(row - MP) * DM;
            const float* xr2 = row2 < MP ? GIN(0) + (size_t)row2 * DM : GIN(1) + (size_t)(row2 - MP) * DM;
            f32x4 v[4], v2[4];
#pragma unroll
            for (int j = 0; j < 4; ++j) { v[j] = *((const f32x4*)xr + lane + 64 * j); v2[j] = *((const f32x4*)xr2 + lane + 64 * j); }
            float ss = 0.f, ss2 = 0.f;
#pragma unroll
            for (int j = 0; j < 4; ++j) { ss += (v[j][0] * v[j][0] + v[j][1] * v[j][1]) + (v[j][2] * v[j][2] + v[j][3] * v[j][3]); ss2 += (v2[j][0] * v2[j][0] + v2[j][1] * v2[j][1]) + (v2[j][2] * v2[j][2] + v2[j][3] * v2[j][3]);
                u32x2 w; w.x = pk2(v[j][0], v[j][1]); w.y = pk2(v[j][2], v[j][3]); *((u32x2*)(XB + (size_t)row * DM) + lane + 64 * j) = w;
                u32x2 w2; w2.x = pk2(v2[j][0], v2[j][1]); w2.y = pk2(v2[j][2], v2[j][3]); *((u32x2*)(XB + (size_t)row2 * DM) + lane + 64 * j) = w2; }
            asm volatile("s_waitcnt vmcnt(0)" ::: "memory");
            ss = wave_sum(ss); ss2 = wave_sum(ss2);
            if (lane < 16) { SSX[(size_t)row * 16 + lane] = lane == 0 ? ss : 0.f; SSX[(size_t)row2 * 16 + lane] = lane == 0 ? ss2 : 0.f; }
        }
    }
    {
        bf16_t* MB = (bf16_t*)(ws + WS_MEMB); float* RM = (float*)(ws + WS_RSTDM);
        for (int row = gw; row < PB * MEML; row += NGW) {
            const float* xr = GIN(2) + (size_t)row * DM; float ss = 0.f;
#pragma unroll
            for (int j = 0; j < 4; ++j) { const f32x4 v = *((const f32x4*)xr + lane + 64 * j); ss += (v[0] * v[0] + v[1] * v[1]) + (v[2] * v[2] + v[3] * v[3]);
                u32x2 w; w.x = pk2(v[0], v[1]); w.y = pk2(v[2], v[3]); *((u32x2*)(MB + (size_t)row * DM) + lane + 64 * j) = w; }
            asm volatile("s_waitcnt vmcnt(0)" ::: "memory");
            ss = wave_sum(ss);
            if (lane == 0) RM[row] = 1.0f / sqrtf(ss * (1.f / DM) + EPS);
        }
    }
    {
        float* TAB = (float*)(ws + WS_TAB);
        for (int g = gw; g < S5G; g += NGW) {
            const int gp = g * S5P + lane;
            const float lr = GIN(20)[gp], li = GIN(21)[gp], dt = expf(GIN(22)[g]);
            const float th = li * dt, em1 = expm1f(lr * dt), mag = em1 + 1.f, cs = cosf(th), sn = sinf(th), sh = sinf(0.5f * th);
            const float ar = mag * cs, ai = mag * sn;
            const float nr = em1 * cs - 2.f * sh * sh, ni = ai;
            const float den = lr * lr + li * li, cr = (nr * lr + ni * li) / den, ci = (ni * lr - nr * li) / den;
            TAB[T_AR + gp] = ar; TAB[T_AI + gp] = ai;
#pragma unroll
            for (int i = 0; i < S5I; ++i) { const float br = GIN(23)[(size_t)gp * S5I + i], bi = GIN(24)[(size_t)gp * S5I + i];
                TAB[T_BBR + (size_t)gp * S5I + i] = cr * br - ci * bi; TAB[T_BBI + (size_t)gp * S5I + i] = cr * bi + ci * br; }
        }
    }
    {
        bf16_t* SW = (bf16_t*)(ws + WS_SGUW);
        for (int i = (F.bid * NTHR + F.tid); i < 2 * 8 * 128 * 128; i += F.G * NTHR) { const int t = (i >> 7) & 127, s = i & 127; SW[i] = f2bf(s <= t ? GIN(15)[i] : 0.f); }
    }
}

typedef short v4i16_t __attribute__((ext_vector_type(4)));
constexpr int SG_VSTR = 576, SG_WSTR = 272, SG_WOFF = 128 * SG_VSTR, SG_ROFF = SG_WOFF + 128 * SG_WSTR;
static_assert(SG_ROFF + 1024 <= RING_BYTES, "sgu LDS");
__device__ __forceinline__ void sgu_phase_mfma(Frame& F, int j) {
    const bf16_t* UZ = (const bf16_t*)(F.ws + WS_B0); const bf16_t* VR = (const bf16_t*)(F.ws + WS_B1); const float* SSV = (const float*)(F.ws + WS_SSV);
    const bf16_t* SW = (const bf16_t*)(F.ws + WS_SGUW) + (size_t)j * 8 * 128 * 128; bf16_t* A2 = (bf16_t*)(F.ws + WS_A2);
    const float* gn = GIN(14) + (size_t)j * E_; const float* bsv = GIN(16) + (size_t)j * 8 * 128;
    LAS unsigned char* lds = F.lds; LAS float* rsl = (LAS float*)(lds + SG_ROFF);
    const int tid = F.tid, lane = F.lane, wid = F.wave, c = lane & 31, hh = lane >> 5;
    const bool same_g = (F.G & 7) == 0; int gld = -1, cur = 0;
    u32x4 vr[8];
    { const int un = F.bid; if (un < 128 * 8) { const int rbase = (un >> 3) * 128, g = un & 7;
#pragma unroll
        for (int i = 0; i < 8; ++i) { const int chn = tid + NTHR * i; vr[i] = *(const u32x4*)(VR + (size_t)(rbase + (chn >> 5)) * E_ + 256 * g + 8 * (chn & 31)); }
        __syncthreads();
        if (tid < 128) { const float* p = SSV + (size_t)(rbase + tid) * 32; float sq = 0.f;
#pragma unroll
            for (int k = 0; k < 8; ++k) { const f32x4 v = *((const f32x4*)p + k); sq += (v[0] + v[1]) + (v[2] + v[3]); }
            rsl[tid] = __builtin_amdgcn_rsqf(sq * (1.f / E_) + EPS); } } }
    for (int un = F.bid; un < 128 * 8; un += F.G) {
        const int ch = un >> 3, g = un & 7, rbase = ch * 128; const int nun = un + F.G < 128 * 8 ? un + F.G : un, nrb = (nun >> 3) * 128, ng = nun & 7;
        asm volatile("s_waitcnt vmcnt(0)" ::: "memory");
        __syncthreads();
        if (!same_g || gld != g) { gld = g;
#pragma unroll
            for (int i = 0; i < 4; ++i) { const int chn = tid + NTHR * i, row = chn >> 4, c16 = chn & 15;
                *(LAS u32x4*)(lds + SG_WOFF + row * SG_WSTR + c16 * 16) = *(const u32x4*)(SW + (size_t)g * 128 * 128 + row * 128 + c16 * 8); } }
#pragma unroll
        for (int i = 0; i < 8; ++i) { const int chn = tid + NTHR * i, sr = chn >> 5, c8 = chn & 31; float v[8]; unpack8(vr[i], v);
            const float r = rsl[cur * 128 + sr]; const f32x4 g0 = *(const f32x4*)(gn + 256 * g + 8 * c8), g1 = *(const f32x4*)(gn + 256 * g + 8 * c8 + 4); f32x4 a, b2;
#pragma unroll
            for (int e = 0; e < 4; ++e) { a[e] = v[e] * r * g0[e]; b2[e] = v[4 + e] * r * g1[e]; }
            *(LAS u32x4*)(lds + sr * SG_VSTR + c8 * 16) = pack8(a, b2); }
#pragma unroll
        for (int i = 0; i < 8; ++i) { const int chn = tid + NTHR * i; vr[i] = *(const u32x4*)(VR + (size_t)(nrb + (chn >> 5)) * E_ + 256 * ng + 8 * (chn & 31)); }
        if (tid < 128) { const float* p = SSV + (size_t)(nrb + tid) * 32; float sq = 0.f;
#pragma unroll
            for (int k = 0; k < 8; ++k) { const f32x4 v = *((const f32x4*)p + k); sq += (v[0] + v[1]) + (v[2] + v[3]); }
            rsl[(cur ^ 1) * 128 + tid] = __builtin_amdgcn_rsqf(sq * (1.f / E_) + EPS); }
        u32x2 uzr[4][4];
#pragma unroll
        for (int ti = 0; ti < 4; ++ti)
#pragma unroll
            for (int g4 = 0; g4 < 4; ++g4) uzr[ti][g4] = *(const u32x2*)(UZ + (size_t)(rbase + 32 * ti + c) * E_ + 256 * g + 32 * wid + 8 * g4 + 4 * hh);
        __syncthreads();
        f32x16 acc[4];
#pragma unroll
        for (int ti = 0; ti < 4; ++ti) acc[ti] = (f32x16){};
        const LAS unsigned char* abase = lds + (8 * hh + ((lane & 15) >> 2)) * SG_VSTR + (32 * wid + 16 * ((lane >> 4) & 1) + 4 * (lane & 3)) * 2;
#pragma unroll
        for (int s2 = 0; s2 < 8; ++s2) {
            const v4i16_t lo = __builtin_amdgcn_ds_read_tr16_b64_v4i16((LAS v4i16_t*)(abase + (16 * s2) * SG_VSTR));
            const v4i16_t hi = __builtin_amdgcn_ds_read_tr16_b64_v4i16((LAS v4i16_t*)(abase + (16 * s2 + 4) * SG_VSTR));
            const bf16x8 a = (bf16x8){lo[0], lo[1], lo[2], lo[3], hi[0], hi[1], hi[2], hi[3]};
#pragma unroll
            for (int ti = s2 >> 1; ti < 4; ++ti) { const bf16x8 b = *(const LAS bf16x8*)(lds + SG_WOFF + (32 * ti + c) * SG_WSTR + (16 * s2 + 8 * hh) * 2);
                acc[ti] = __builtin_amdgcn_mfma_f32_32x32x16_bf16(a, b, acc[ti], 0, 0, 0); }
        }
#pragma unroll
        for (int ti = 0; ti < 4; ++ti) { const int t = 32 * ti + c; const size_t row = (size_t)(rbase + t); const float bias = bsv[g * 128 + t];
#pragma unroll
            for (int g4 = 0; g4 < 4; ++g4) { const int d = 256 * g + 32 * wid + 8 * g4 + 4 * hh; const u32x2 uz = uzr[ti][g4];
                u32x2 w; w.x = pk2(bflo(uz.x) * (acc[ti][4 * g4] + bias), bfhi(uz.x) * (acc[ti][4 * g4 + 1] + bias)); w.y = pk2(bflo(uz.y) * (acc[ti][4 * g4 + 2] + bias), bfhi(uz.y) * (acc[ti][4 * g4 + 3] + bias));
                *(u32x2*)(A2 + row * KOUT + d) = w; } }
        cur ^= 1;
    }
}

__device__ __forceinline__ void sgu_sample_phase(Frame& F, int j) {
    const bf16_t* UZ = (const bf16_t*)(F.ws + WS_B0); const bf16_t* VR = (const bf16_t*)(F.ws + WS_B1); const float* SSV = (const float*)(F.ws + WS_SSV);
    const bf16_t* SW = (const bf16_t*)(F.ws + WS_SGUW) + (size_t)j * 8 * 128 * 128; bf16_t* A2 = (bf16_t*)(F.ws + WS_A2);
    const float* gn = GIN(14) + (size_t)j * E_; const float* bsv = GIN(16) + (size_t)j * 8 * 128; float* cvout = F.out + O_CV + (size_t)j * SBT * SSEQ * E_;
    const int gw = F.bid * NWAVES + F.wave, NGW = F.G * NWAVES, lane = F.lane;
    for (int task = gw; task < SBT * 8; task += NGW) {
        const int b = task >> 3, g = task & 7; const size_t r0 = (size_t)MP + b * SSEQ; const int ch = 256 * g + 4 * lane;
        float rs[SSEQ];
#pragma unroll
        for (int t = 0; t < SSEQ; ++t) { float v = lane < 32 ? SSV[(r0 + t) * 32 + lane] : 0.f; v = wave_sum(v); rs[t] = __builtin_amdgcn_rsqf(v * (1.f / E_) + EPS); }
        const f32x4 g4 = *(const f32x4*)(gn + ch);
        f32x4 vn[SSEQ];
#pragma unroll
        for (int t = 0; t < SSEQ; ++t) { const u32x2 w = *(const u32x2*)(VR + (r0 + t) * E_ + ch); const f32x4 v = (f32x4){bflo(w.x), bfhi(w.x), bflo(w.y), bfhi(w.y)}; vn[t] = v * rs[t] * g4;
            *(f32x4*)(cvout + (size_t)(b * SSEQ + t) * E_ + ch) = vn[t];
            u32x2 q; q.x = pk2(vn[t][0], vn[t][1]); q.y = pk2(vn[t][2], vn[t][3]); vn[t] = (f32x4){bflo(q.x), bfhi(q.x), bflo(q.y), bfhi(q.y)}; }
#pragma unroll
        for (int t = 0; t < SSEQ; ++t) { f32x4 a = {0.f, 0.f, 0.f, 0.f};
#pragma unroll
            for (int sq = 0; sq <= t; ++sq) a += vn[sq] * bf2f(SW[(size_t)g * 128 * 128 + t * 128 + sq]);
            a += bsv[g * 128 + t];
            const u32x2 uz = *(const u32x2*)(UZ + (r0 + t) * E_ + ch);
            u32x2 w; w.x = pk2(bflo(uz.x) * a[0], bfhi(uz.x) * a[1]); w.y = pk2(bflo(uz.y) * a[2], bfhi(uz.y) * a[3]);
            *(u32x2*)(A2 + (r0 + t) * KOUT + ch) = w; }
    }
}

__device__ __forceinline__ void conv_phase(Frame& F) {
    const bf16_t* P = (const bf16_t*)(F.ws + WS_B0); const bf16_t* G = (const bf16_t*)(F.ws + WS_B1); bf16_t* A2 = (bf16_t*)(F.ws + WS_A2);
    const float* cw = GIN(18); const float* st = GIN(5);
    for (int i = F.bid * NTHR + F.tid; i < (M / 32) * 256; i += F.G * NTHR) {
        const int seg = i >> 8, c0 = (i & 255) * 8, r0 = seg * 32;
        float w0[8], w1[8], w2[8];
#pragma unroll
        for (int e = 0; e < 8; ++e) { w0[e] = cw[c0 + e]; w1[e] = cw[E_ + c0 + e]; w2[e] = cw[2 * E_ + c0 + e]; }
        float x1[8], x2[8];
        if (r0 < MP) { if ((r0 & (PSEQ - 1)) == 0) { for (int e = 0; e < 8; ++e) { x1[e] = 0.f; x2[e] = 0.f; } }
                       else { unpack8(*(const u32x4*)(P + (size_t)(r0 - 1) * E_ + c0), x1); unpack8(*(const u32x4*)(P + (size_t)(r0 - 2) * E_ + c0), x2); } }
#pragma unroll 4
        for (int rr = 0; rr < 32; ++rr) {
            const int row = r0 + rr;
            if (row >= MP && ((row - MP) & 3) == 0) { const float* buf = st + (size_t)((row - MP) >> 2) * 2 * E_ + c0;
                for (int e = 0; e < 8; ++e) { x2[e] = buf[e]; x1[e] = buf[E_ + e]; } }
            float x0[8], gg[8]; unpack8(*(const u32x4*)(P + (size_t)row * E_ + c0), x0); unpack8(*(const u32x4*)(G + (size_t)row * E_ + c0), gg);
            f32x4 o0, o1;
#pragma unroll
            for (int e = 0; e < 8; ++e) { const float y = w0[e] * x2[e] + w1[e] * x1[e] + w2[e] * x0[e]; const float r = y * gg[e]; if (e < 4) o0[e] = r; else o1[e - 4] = r; x2[e] = x1[e]; x1[e] = x0[e]; }
            *(u32x4*)(A2 + (size_t)row * KOUT + c0) = pack8(o0, o1);
        }
    }
}

__device__ __forceinline__ void s5_sample_phase(Frame& F) {
    const bf16_t* U = (const bf16_t*)(F.ws + WS_B0); bf16_t* GBo = (bf16_t*)(F.ws + WS_GB); const float* TAB = (const float*)(F.ws + WS_TAB);
    const float* cre = GIN(25); const float* cim = GIN(26); const float* dsk = GIN(27);
    const int gw = F.bid * NWAVES + F.wave, NGW = F.G * NWAVES, lane = F.lane;
    for (int task = gw; task < S5G * (SBT / 16); task += NGW) {
        const int g = task & (S5G - 1), bc = task >> 7, gp = g * S5P + lane;
        const float ar = TAB[T_AR + gp], ai = TAB[T_AI + gp];
        float bbr[16], bbi[16], cr[16], ci[16];
#pragma unroll
        for (int i = 0; i < 16; ++i) { bbr[i] = TAB[T_BBR + (size_t)gp * 16 + i]; bbi[i] = TAB[T_BBI + (size_t)gp * 16 + i]; cr[i] = cre[((size_t)g * 16 + i) * S5P + lane]; ci[i] = cim[((size_t)g * 16 + i) * S5P + lane]; }
        const float dmine = dsk[g * 16 + (lane >> 2)];
        for (int bi = 0; bi < 16; ++bi) {
            const int sq = bc * 16 + bi; const size_t rbase = (size_t)MP + sq * SSEQ; const size_t so = ((size_t)sq * S5G + g) * S5P + lane;
            float hr = GIN(6)[so], hi = GIN(7)[so];
            u32x4 ur[SSEQ][2];
#pragma unroll
            for (int t = 0; t < SSEQ; ++t) { const bf16_t* up = U + (rbase + t) * E_ + g * 16; ur[t][0] = *(const u32x4*)up; ur[t][1] = *(const u32x4*)(up + 8); }
#pragma unroll
            for (int t = 0; t < SSEQ; ++t) {
                float u[16]; { float a[8], b[8]; unpack8(ur[t][0], a); unpack8(ur[t][1], b);
#pragma unroll
                    for (int i = 0; i < 8; ++i) { u[i] = a[i]; u[8 + i] = b[i]; } }
                float br = 0.f, bi2 = 0.f;
#pragma unroll
                for (int i = 0; i < 16; ++i) { br += bbr[i] * u[i]; bi2 += bbi[i] * u[i]; }
                const float nhr = ar * hr - ai * hi + br, nhi = ar * hi + ai * hr + bi2; hr = nhr; hi = nhi;
                float v[16];
#pragma unroll
                for (int i = 0; i < 16; ++i) v[i] = cr[i] * hr - ci[i] * hi;
                float w8[8];
                { const bool up5 = (lane & 32) != 0;
#pragma unroll
                  for (int i = 0; i < 8; ++i) { const float keep = up5 ? v[8 + i] : v[i], send = up5 ? v[i] : v[8 + i]; w8[i] = keep + __shfl_xor(send, 32); } }
                float w4[4];
                { const bool upb = (lane & 16) != 0;
#pragma unroll
                  for (int i = 0; i < 4; ++i) { const float keep = upb ? w8[4 + i] : w8[i], send = upb ? w8[i] : w8[4 + i]; w4[i] = keep + __shfl_xor(send, 16); } }
                float w2[2];
                { const bool upb = (lane & 8) != 0;
#pragma unroll
                  for (int i = 0; i < 2; ++i) { const float keep = upb ? w4[2 + i] : w4[i], send = upb ? w4[i] : w4[2 + i]; w2[i] = keep + __shfl_xor(send, 8); } }
                float w1;
                { const bool upb = (lane & 4) != 0; const float keep = upb ? w2[1] : w2[0], send = upb ? w2[0] : w2[1]; w1 = keep + __shfl_xor(send, 4); }
                w1 += __shfl_xor(w1, 2); w1 += __shfl_xor(w1, 1);
                float umine = 0.f;
#pragma unroll
                for (int i = 0; i < 16; ++i) umine = ((lane >> 2) == i) ? u[i] : umine;
                const float y = w1 + dmine * umine;
                if ((lane & 3) == 0) GBo[(rbase + t) * E_ + g * 16 + (lane >> 2)] = f2bf(gelu_tanh(y));
                asm volatile("s_waitcnt vmcnt(0)" ::: "memory");
            }
            F.out[O_SRS + so] = hr; F.out[O_SIS + so] = hi;
        }
    }
}

#if XHALF_SHFL
__device__ __forceinline__ void xhalf(float v, float& lo, float& hi) { const int l_ = threadIdx.x & 31; lo = __shfl(v, l_); hi = __shfl(v, l_ + 32); }
#else
__device__ __forceinline__ void xhalf(float v, float& lo, float& hi) { auto rr = __builtin_amdgcn_permlane32_swap(__float_as_uint(v), __float_as_uint(v), false, false); lo = __uint_as_float(rr[0]); hi = __uint_as_float(rr[1]);
 }
#endif
__device__ __forceinline__ void cmuladd(float& xr, float& xi, float ar, float ai, float pr, float pi) { float t = fmaf(-ai, pi, xr); asm("" : "+v"(t)); xr = fmaf(ar, pr, t); xi = fmaf(ar, pi, fmaf(ai, pr, xi)); }
constexpr int S5_HSTR = 272, S5_UOFF = 32 * S5_HSTR, S5_OOFF = S5_UOFF + 1024, S5_HT = S5_OOFF + 4096;
__device__ __forceinline__ void s5_prompt_mfma(Frame& F) {
    const bf16_t* U = (const bf16_t*)(F.ws + WS_B0); bf16_t* GBo = (bf16_t*)(F.ws + WS_GB); const float* TAB = (const float*)(F.ws + WS_TAB);
    const float* cre = GIN(25); const float* cim = GIN(26); const float* dsk = GIN(27);
    const int lane = F.lane, wid = F.wave, c = lane & 31, hh = lane >> 5, col = lane & 15, fq = lane >> 4;
    LAS unsigned char* ht = F.lds + wid * S5_HT;
    for (int task = F.bid * NWAVES + wid; task < PB * S5G; task += F.G * NWAVES) {
        const int b = task >> 7, g = task & 127;
        bf16x8 bfr[2], bfi[2]; float p_r[2][4], p_i[2][4];
#pragma unroll
        for (int st = 0; st < 2; ++st) { const int gp = g * S5P + 32 * st + c;
            const float* pr = TAB + T_BBR + (size_t)gp * 16 + 8 * hh; const float* pi = TAB + T_BBI + (size_t)gp * 16 + 8 * hh;
            bfr[st] = __builtin_bit_cast(bf16x8, pack8(*(const f32x4*)pr, *(const f32x4*)(pr + 4))); bfi[st] = __builtin_bit_cast(bf16x8, pack8(*(const f32x4*)pi, *(const f32x4*)(pi + 4)));
            const float ar = TAB[T_AR + gp], ai = TAB[T_AI + gp]; p_r[st][0] = ar; p_i[st][0] = ai;
#pragma unroll
            for (int n = 1; n < 4; ++n) { p_r[st][n] = p_r[st][n - 1] * ar - p_i[st][n - 1] * ai; p_i[st][n] = p_r[st][n - 1] * ai + p_i[st][n - 1] * ar; } }
        bf16x8 cf[4];
#pragma unroll
        for (int s4 = 0; s4 < 4; ++s4) { const size_t o = ((size_t)g * 16 + col) * S5P + 16 * s4 + 4 * fq; const f32x4 cr4 = *(const f32x4*)(cre + o), ci4 = *(const f32x4*)(cim + o);
            u32x4 w; w.x = pk2(cr4[0], -ci4[0]); w.y = pk2(cr4[1], -ci4[1]); w.z = pk2(cr4[2], -ci4[2]); w.w = pk2(cr4[3], -ci4[3]); cf[s4] = __builtin_bit_cast(bf16x8, w); }
        const f32x4 d4 = *(const f32x4*)(dsk + 16 * g + 4 * fq);
        float car_r[2] = {0.f, 0.f}, car_i[2] = {0.f, 0.f};
        const bf16_t* up = U + ((size_t)b * PSEQ + c) * E_ + 16 * g + 8 * hh;
        bf16x8 ub[4];
#pragma unroll
        for (int q = 0; q < 4; ++q) ub[q] = *(const GAS bf16x8*)(up + (size_t)q * 32 * E_);
        for (int tg = 0; tg < PSEQ / 128; ++tg) {
          bf16x8 nb[4];
#pragma unroll
          for (int q = 0; q < 4; ++q) nb[q] = *(const GAS bf16x8*)(up + (size_t)(4 * (tg + 1 < PSEQ / 128 ? tg + 1 : tg) + q) * 32 * E_);
#pragma unroll
          for (int q = 0; q < 4; ++q) {
            const int ti = 4 * tg + q; const bf16x8 ua = ub[q];
            *(LAS bf16x8*)(ht + S5_UOFF + c * 32 + hh * 16) = ua;
#pragma unroll
            for (int st = 0; st < 2; ++st) {
                f32x16 xr = __builtin_amdgcn_mfma_f32_32x32x16_bf16(ua, bfr[st], (f32x16){}, 0, 0, 0);
                f32x16 xi = __builtin_amdgcn_mfma_f32_32x32x16_bf16(ua, bfi[st], (f32x16){}, 0, 0, 0);
                const float a1r = p_r[st][0], a1i = p_i[st][0], a4r = p_r[st][3], a4i = p_i[st][3];
#pragma unroll
                for (int k = 0; k < 4; ++k)
#pragma unroll
                    for (int jj = 1; jj < 4; ++jj) { float tr = xr[4 * k + jj], tq = xi[4 * k + jj]; cmuladd(tr, tq, a1r, a1i, xr[4 * k + jj - 1], xi[4 * k + jj - 1]); xr[4 * k + jj] = tr; xi[4 * k + jj] = tq; }
                float er = car_r[st], ei = car_i[st], cin_r[4], cin_i[4];
#pragma unroll
                for (int k = 0; k < 4; ++k) {
                    float lor, hir, loi, hii; xhalf(xr[4 * k + 3], lor, hir); xhalf(xi[4 * k + 3], loi, hii);
                    const float c0r = er, c0i = ei;
                    float nr = lor, ni = loi; cmuladd(nr, ni, a4r, a4i, er, ei); er = nr; ei = ni;
                    const float c1r = er, c1i = ei;
                    nr = hir; ni = hii; cmuladd(nr, ni, a4r, a4i, er, ei); er = nr; ei = ni;
                    cin_r[k] = hh ? c1r : c0r; cin_i[k] = hh ? c1i : c0i;
                }
                car_r[st] = er; car_i[st] = ei;
#pragma unroll
                for (int k = 0; k < 4; ++k)
#pragma unroll
                    for (int jj = 0; jj < 4; ++jj) { float tr = xr[4 * k + jj], tq = xi[4 * k + jj]; cmuladd(tr, tq, p_r[st][jj], p_i[st][jj], cin_r[k], cin_i[k]);
                        *(LAS unsigned*)(ht + (8 * k + 4 * hh + jj) * S5_HSTR + 128 * st + 4 * c) = pk2(tr, tq); }
            }
            asm volatile("" ::: "memory");
#pragma unroll
            for (int tt = 0; tt < 2; ++tt) {
                f32x4 y = {0.f, 0.f, 0.f, 0.f};
#pragma unroll
                for (int s4 = 0; s4 < 4; ++s4) { const bf16x8 hb = *(const LAS bf16x8*)(ht + (16 * tt + col) * S5_HSTR + (32 * s4 + 8 * fq) * 2); y = __builtin_amdgcn_mfma_f32_16x16x32_bf16(cf[s4], hb, y, 0, 0, 0); }
                const size_t row = (size_t)b * PSEQ + 32 * ti + 16 * tt + col; const u32x2 uw = *(const LAS u32x2*)(ht + S5_UOFF + (16 * tt + col) * 32 + fq * 8);
                u32x2 w; w.x = pk2(gelu_tanh(y[0] + d4[0] * bflo(uw.x)), gelu_tanh(y[1] + d4[1] * bfhi(uw.x))); w.y = pk2(gelu_tanh(y[2] + d4[2] * bflo(uw.y)), gelu_tanh(y[3] + d4[3] * bfhi(uw.y)));
                *(LAS u32x2*)(ht + S5_OOFF + q * 1024 + (16 * tt + col) * 32 + fq * 8) = w;
            }
            asm volatile("" ::: "memory");
          }
#pragma unroll
          for (int q = 0; q < 4; ++q)
#pragma unroll
            for (int tt = 0; tt < 2; ++tt) *(GAS u32x2*)(GBo + ((size_t)b * PSEQ + 32 * (4 * tg + q) + 16 * tt + col) * E_ + 16 * g + 4 * fq) = *(const LAS u32x2*)(ht + S5_OOFF + q * 1024 + (16 * tt + col) * 32 + fq * 8);
          asm volatile("s_waitcnt vmcnt(0)" ::: "memory");
#pragma unroll
          for (int q = 0; q < 4; ++q) ub[q] = nb[q];
        }
        const size_t so = ((size_t)b * S5G + g) * S5P + 32 * hh + c;
        F.out[O_SRP + so] = hh ? car_r[1] : car_r[0]; F.out[O_SIP + so] = hh ? car_i[1] : car_i[0];
    }
}

constexpr int AK_STR = 272, AV_STR = 520, AV_OFF = 256 * AK_STR;
static_assert(AV_OFF + 128 * AV_STR <= RING_BYTES + 8192, "attention LDS");
__device__ __forceinline__ void attn_prompt_phase(Frame& F, int layer) {
    const bf16_t* QB = (const bf16_t*)(F.ws + WS_QB); const bf16_t* KBp = (const bf16_t*)(F.ws + WS_KB); const bf16_t* VTp = (const bf16_t*)(F.ws + WS_VT); bf16_t* A2 = (bf16_t*)(F.ws + WS_A2);
    const int tid = F.tid, lane = F.lane, wid = F.wave, c = lane & 31, hh = lane >> 5;
    LAS unsigned char* lds = F.lds;
    for (int un = F.bid; un < PB * NH * 8; un += F.G) {
        const int bh = un >> 3, qb = un & 7, b = bh >> 2, h = bh & 3;
        const bf16_t* Kg = KBp + (size_t)((layer * PB + b) * NH + h) * MEML * HD; const bf16_t* Vg = VTp + (size_t)((layer * PB + b) * NH + h) * MEML * HD;
        __syncthreads();
        { u32x4 kr[8], vr[8];
#pragma unroll
          for (int i = 0; i < 8; ++i) { const int chn = tid + NTHR * i; kr[i] = *(const u32x4*)(Kg + (chn >> 4) * HD + (chn & 15) * 8); vr[i] = *(const u32x4*)(Vg + (chn >> 5) * MEML + (chn & 31) * 8); }
#pragma unroll
          for (int i = 0; i < 8; ++i) { const int chn = tid + NTHR * i, row = chn >> 4, c16 = chn & 15; *(LAS u32x4*)(lds + row * AK_STR + c16 * 16) = kr[i]; }
#pragma unroll
          for (int i = 0; i < 8; ++i) { const int chn = tid + NTHR * i, row = chn >> 5, c16 = chn & 31; const u32x4 v = vr[i];
            LAS u32x2* p = (LAS u32x2*)(lds + AV_OFF + row * AV_STR + c16 * 16); u32x2 lo, hi; lo.x = v.x; lo.y = v.y; hi.x = v.z; hi.y = v.w; p[0] = lo; p[1] = hi; } }
        __syncthreads();
        const size_t qrow = (size_t)b * PSEQ + qb * 256 + wid * 32 + c;
        f32x16 S[8];
#pragma unroll
        for (int kt = 0; kt < 8; ++kt) S[kt] = (f32x16){};
#pragma unroll
        for (int s = 0; s < 8; ++s) {
            const bf16x8 qf = *(const bf16x8*)(QB + qrow * XA + h * HD + 16 * s + 8 * hh);
#pragma unroll
            for (int kt = 0; kt < 8; ++kt) { const bf16x8 kf = *(const LAS bf16x8*)(lds + (32 * kt + c) * AK_STR + (16 * s + 8 * hh) * 2); S[kt] = __builtin_amdgcn_mfma_f32_32x32x16_bf16(kf, qf, S[kt], 0, 0, 0); }
        }
        float mx = -3.0e38f;
#pragma unroll
        for (int kt = 0; kt < 8; ++kt)
#pragma unroll
            for (int r = 0; r < 16; ++r) mx = fmaxf(mx, S[kt][r]);
        mx = fmaxf(mx, __shfl_xor(mx, 32));
        float sum = 0.f; bf16x8 pf[8][2];
#pragma unroll
        for (int kt = 0; kt < 8; ++kt) {
            float p[16];
#pragma unroll
            for (int r = 0; r < 16; ++r) { p[r] = __expf(S[kt][r] - mx); sum += p[r]; }
#pragma unroll
            for (int s2 = 0; s2 < 2; ++s2) { u32x4 w; w.x = pk2(p[8 * s2], p[8 * s2 + 1]); w.y = pk2(p[8 * s2 + 2], p[8 * s2 + 3]); w.z = pk2(p[8 * s2 + 4], p[8 * s2 + 5]); w.w = pk2(p[8 * s2 + 6], p[8 * s2 + 7]);
                pf[kt][s2] = __builtin_bit_cast(bf16x8, w); }
        }
        sum += __shfl_xor(sum, 32);
        const float inv = 1.f / sum;
        bf16_t* orow = A2 + qrow * KOUT + E_ + h * HD;
#pragma unroll
        for (int dt = 0; dt < 4; ++dt) {
            f32x16 o = {};
#pragma unroll
            for (int kt = 0; kt < 8; ++kt)
#pragma unroll
                for (int s2 = 0; s2 < 2; ++s2) {
                    const LAS unsigned char* vb = lds + AV_OFF + (32 * dt + c) * AV_STR + (32 * kt + 16 * s2 + 4 * hh) * 2;
                    const u32x2 lo = *(const LAS u32x2*)vb, hi = *(const LAS u32x2*)(vb + 16);
                    u32x4 w; w.x = lo.x; w.y = lo.y; w.z = hi.x; w.w = hi.y;
                    o = __builtin_amdgcn_mfma_f32_32x32x16_bf16(__builtin_bit_cast(bf16x8, w), pf[kt][s2], o, 0, 0, 0);
                }
#pragma unroll
            for (int g4 = 0; g4 < 4; ++g4) { u32x2 w; w.x = pk2(o[4 * g4] * inv, o[4 * g4 + 1] * inv); w.y = pk2(o[4 * g4 + 2] * inv, o[4 * g4 + 3] * inv);
                *(u32x2*)(orow + 32 * dt + 8 * g4 + 4 * hh) = w; }
        }
    }
}

__device__ __forceinline__ void attn_sample_phase(Frame& F, int layer) {
    const bf16_t* QB = (const bf16_t*)(F.ws + WS_QB); bf16_t* A2 = (bf16_t*)(F.ws + WS_A2);
    const float* CK = GIN(3) + (size_t)layer * SBT * MEML * XA; const float* CV = GIN(4) + (size_t)layer * SBT * MEML * XA;
    LAS float* sl = (LAS float*)F.lds;
    LAS float* pt = (LAS float*)(F.lds + 4096);
    LAS float* ol = (LAS float*)(F.lds + 8192);
    const int tid = F.tid, lane = F.lane, wid = F.wave, par = lane >> 5, d4 = lane & 31;
    const size_t lane_off = ((size_t)(32 * wid + par) * NH) * HD + 4 * d4;
    const bool b4 = (lane & 16) != 0, b3 = (lane & 8) != 0;
#define AS_Q(q4, b_, h_) do { _Pragma("unroll") for (int qi = 0; qi < 4; ++qi) { const u32x2 w = *(const u32x2*)(QB + (size_t)(MP + (b_) * 4 + qi) * XA + (h_) * HD + 4 * d4); q4[qi] = (f32x4){bflo(w.x), bfhi(w.x), bflo(w.y), bfhi(w.y)}; } } while (0)
#define AS_LOADROWS(dst, base, b_, h_) do { const size_t o_ = (size_t)(b_) * MEML * XA + (size_t)(h_) * HD + lane_off; _Pragma("unroll") for (int j = 0; j < 16; ++j) dst[j] = *(const f32x4*)((base) + o_ + (size_t)j * 2 * XA); } while (0)
#define AS_SCORES(q4) do { _Pragma("unroll") for (int j = 0; j < 16; ++j) { float v[4]; \
            _Pragma("unroll") for (int qi = 0; qi < 4; ++qi) v[qi] = (kr[j][0] * q4[qi][0] + kr[j][1] * q4[qi][1]) + (kr[j][2] * q4[qi][2] + kr[j][3] * q4[qi][3]); \
            const float w0 = (b4 ? v[2] : v[0]) + __shfl_xor(b4 ? v[0] : v[2], 16), w1 = (b4 ? v[3] : v[1]) + __shfl_xor(b4 ? v[1] : v[3], 16); \
            float z = (b3 ? w1 : w0) + __shfl_xor(b3 ? w0 : w1, 8); \
            z += __shfl_xor(z, 4); z += __shfl_xor(z, 2); z += __shfl_xor(z, 1); \
            if ((lane & 7) == 0) sl[(2 * (int)b4 + (int)b3) * 256 + 32 * wid + 2 * j + par] = z; } } while (0)
#define AS_SOFTMAX() do { if (wid < 4) { float v[4], mx = -3.0e38f; \
            _Pragma("unroll") for (int j = 0; j < 4; ++j) { v[j] = sl[wid * 256 + lane + 64 * j]; mx = fmaxf(mx, v[j]); } \
            mx = wave_max(mx); float sm = 0.f; \
            _Pragma("unroll") for (int j = 0; j < 4; ++j) { v[j] = __expf(v[j] - mx); sm += v[j]; } \
            sm = wave_sum(sm); const float inv = 1.f / sm; \
            _Pragma("unroll") for (int j = 0; j < 4; ++j) pt[(lane + 64 * j) * 4 + wid] = v[j] * inv; } } while (0)
#define AS_PV() do { f32x4 o[4]; _Pragma("unroll") for (int qi = 0; qi < 4; ++qi) o[qi] = (f32x4){0.f, 0.f, 0.f, 0.f}; \
            _Pragma("unroll") for (int j = 0; j < 16; ++j) { const f32x4 p = *(const LAS f32x4*)(pt + (32 * wid + 2 * j + par) * 4); \
                _Pragma("unroll") for (int qi = 0; qi < 4; ++qi) o[qi] += vr[j] * p[qi]; } \
            _Pragma("unroll") for (int qi = 0; qi < 4; ++qi) { _Pragma("unroll") for (int e = 0; e < 4; ++e) o[qi][e] += __shfl_xor(o[qi][e], 32); \
                if (par == 0) *(LAS f32x4*)(ol + (wid * 4 + qi) * 128 + 4 * d4) = o[qi]; } } while (0)
#define AS_OUT(b_, h_) do { const int qi = tid >> 7, d = tid & 127; float acc = 0.f; _Pragma("unroll") for (int w = 0; w < 8; ++w) acc += ol[(w * 4 + qi) * 128 + d]; \
            A2[(size_t)(MP + (b_) * 4 + qi) * KOUT + E_ + (h_) * HD + d] = f2bf(acc); } while (0)
    for (int un = F.bid; un < SBT * NH; un += 2 * F.G) {
        const int unb = un + F.G < SBT * NH ? un + F.G : un; const int ba = un >> 2, ha = un & 3, bb = unb >> 2, hb = unb & 3;
        asm volatile("s_waitcnt vmcnt(0)" ::: "memory");
        f32x4 kr[16], vr[16], q4[4];
        AS_LOADROWS(kr, CK, ba, ha); AS_LOADROWS(vr, CV, ba, ha); AS_Q(q4, ba, ha);
        __syncthreads();
        AS_SCORES(q4);
        AS_LOADROWS(kr, CK, bb, hb);
        __syncthreads();
        AS_SOFTMAX();
        __syncthreads();
        AS_PV();
        __syncthreads();
        AS_Q(q4, bb, hb);
        AS_OUT(ba, ha);
        AS_LOADROWS(vr, CV, bb, hb);
        asm volatile("s_waitcnt vmcnt(16)" ::: "memory");
        AS_SCORES(q4);
        __syncthreads();
        AS_SOFTMAX();
        __syncthreads();
        AS_PV();
        __syncthreads();
        AS_OUT(bb, hb);
    }
#undef AS_Q
#undef AS_LOADROWS
#undef AS_SCORES
#undef AS_SOFTMAX
#undef AS_PV
#undef AS_OUT
}

constexpr int NK_OUT = 5, NK_OUT_LAST = 10, NK_GLU = 8;
__device__ __forceinline__ void fixup_out_rows(Frame& F, const float* basef  , int vb, int nvb  , int nk  ) {
    for (int r = vb * NWAVES + F.wave; r < MS; r += nvb * NWAVES) {
        const int lane = F.lane; const float* slab = (const float*)(F.ws + WS_SLAB);
        bf16_t* XB = (bf16_t*)(F.ws + WS_XB) + (size_t)(MP + r) * DM; float ss = 0.f;
#pragma unroll
        for (int j = 0; j < 4; ++j) { f32x4 v;
            if (basef) v = *((const f32x4*)(basef + (size_t)r * DM) + lane + 64 * j);
            else { const u32x2 w = *((const u32x2*)XB + lane + 64 * j); v = (f32x4){bflo(w.x), bfhi(w.x), bflo(w.y), bfhi(w.y)}; }
            for (int ks = 0; ks < nk; ++ks) v += *((const f32x4*)(slab + ((size_t)ks * MS + r) * DM) + lane + 64 * j);
            u32x2 w; w.x = pk2(v[0], v[1]); w.y = pk2(v[2], v[3]); *((u32x2*)XB + lane + 64 * j) = w;
            ss += (v[0] * v[0] + v[1] * v[1]) + (v[2] * v[2] + v[3] * v[3]); }
        asm volatile("s_waitcnt vmcnt(0)" ::: "memory");
        ss = wave_sum(ss);
        if (lane < 16) ((float*)(F.ws + WS_SSX))[(size_t)(MP + r) * 16 + lane] = lane == 0 ? ss : 0.f;
    }
}
__device__ __forceinline__ void fixup_glu_rows(Frame& F) {
    if (F.wave < 2) for (int r = F.bid * 2 + F.wave; r < MS; r += F.G * 2) {
        const int lane = F.lane; const float* slab = (const float*)(F.ws + WS_SLAB); const float* bias = GIN(29);
        const bf16_t* GBp = (const bf16_t*)(F.ws + WS_GB) + (size_t)(MP + r) * E_; const bf16_t* SZ = (const bf16_t*)(F.ws + WS_B1) + (size_t)(MP + r) * E_; bf16_t* A2 = (bf16_t*)(F.ws + WS_A2) + (size_t)(MP + r) * KOUT;
#pragma unroll
        for (int j = 0; j < 4; ++j) { const int c0 = 8 * (lane + 64 * j); f32x4 t0 = *(const f32x4*)(bias + c0), t1 = *(const f32x4*)(bias + c0 + 4);
#pragma unroll
            for (int ks = 0; ks < NK_GLU; ++ks) { const float* sp = slab + ((size_t)ks * MS + r) * E_ + c0; t0 += *(const f32x4*)sp; t1 += *(const f32x4*)(sp + 4); }
            float gv[8], sz[8]; unpack8(*(const u32x4*)(GBp + c0), gv); unpack8(*(const u32x4*)(SZ + c0), sz); f32x4 o0, o1;
#pragma unroll
            for (int e = 0; e < 4; ++e) { o0[e] = gv[e] * sigmoidf_(t0[e]) * sz[e]; o1[e] = gv[4 + e] * sigmoidf_(t1[e]) * sz[4 + e]; }
            *(u32x4*)(A2 + c0) = pack8(o0, o1); }
    }
}
__device__ __forceinline__ void counter_signal(unsigned* cnt) {
    asm volatile("s_waitcnt vmcnt(0)" ::: "memory"); __syncthreads();
    if (threadIdx.x == 0) { __builtin_amdgcn_fence(__ATOMIC_RELEASE, "agent"); asm volatile("s_waitcnt vmcnt(0)" ::: "memory"); __hip_atomic_fetch_add(cnt, 1u, __ATOMIC_RELAXED, __HIP_MEMORY_SCOPE_AGENT); }
}
__device__ __forceinline__ void counter_wait(unsigned* cnt, unsigned want) {
    if (threadIdx.x == 0) { unsigned sp = 0; while (__hip_atomic_load(cnt, __ATOMIC_RELAXED, __HIP_MEMORY_SCOPE_AGENT) < want) { __builtin_amdgcn_s_sleep(2); if (++sp > (1u << 22)) break; }
        __builtin_amdgcn_fence(__ATOMIC_ACQUIRE, "agent"); asm volatile("s_waitcnt vmcnt(0)" ::: "memory"); }
    __syncthreads();
}

__device__ __forceinline__ void final_row(Frame& F, int row) {
    const bf16_t* XBp = (const bf16_t*)(F.ws + WS_XB); const float* SSX = (const float*)(F.ws + WS_SSX); const float* fg = GIN(9); const int lane = F.lane;
    float s = lane < 16 ? SSX[(size_t)row * 16 + lane] : 0.f; s = wave_sum(s);
    const float r = __builtin_amdgcn_rsqf(s * (1.f / DM) + EPS);
    float* o = row < MP ? F.out + O_YP + (size_t)row * DM : F.out + O_YS + (size_t)(row - MP) * DM;
#pragma unroll
    for (int j = 0; j < 4; ++j) { const u32x2 w = *((const u32x2*)(XBp + (size_t)row * DM) + lane + 64 * j); const f32x4 v = (f32x4){bflo(w.x), bfhi(w.x), bflo(w.y), bfhi(w.y)}; const f32x4 gq = *((const f32x4*)fg + lane + 64 * j); *((f32x4*)o + lane + 64 * j) = v * r * gq; }
}
__device__ __forceinline__ void final_phase(Frame& F) {
    const int gw = F.bid * NWAVES + F.wave, NGW = F.G * NWAVES;
    asm volatile("s_waitcnt vmcnt(0)" ::: "memory"); for (int r = F.bid * NWAVES + F.wave; r < MS; r += F.G * NWAVES) final_row(F, MP + r);
#pragma unroll 2
    for (int row = gw; row < MP; row += NGW) final_row(F, row);
}

#define XB_TMO      128
#define XB_XCNT(j)  (256  + 64 * (j))
#define XB_XSUB(j)  (1280 + 64 * (j))
#define XB_XGEN(j)  (2304 + 64 * (j))
#define XB_TOP      3328
#define XB_TOPGEN   3392
#define XCD_BAR_WORDS 3456
#define XB_SPIN_CAP (1u << 20)
__device__ __forceinline__ unsigned xb_ld(unsigned* p)              { return __hip_atomic_load(p, __ATOMIC_RELAXED, __HIP_MEMORY_SCOPE_AGENT); }
__device__ __forceinline__ unsigned xb_add(unsigned* p, unsigned v) { return __hip_atomic_fetch_add(p, v, __ATOMIC_RELAXED, __HIP_MEMORY_SCOPE_AGENT); }
__device__ __forceinline__ unsigned xb_xcc_id() { return (unsigned)__builtin_amdgcn_s_getreg((3 << 11) | 20) & 0xFu; }
#define XB_SPIN(cond, bar) do { unsigned _sp = 0; while (cond) { __builtin_amdgcn_s_sleep(1); \
    if ((++_sp & 255u) == 0u) { if (xb_ld(&(bar)[XB_TMO])) break; if (_sp > XB_SPIN_CAP) { atomicAdd(&(bar)[XB_TMO], 1u); break; } } } } while (0)
struct XcdBarrier { unsigned* bar; unsigned x; volatile LAS unsigned* st; };
__device__ __forceinline__ XcdBarrier xcd_barrier_post(unsigned* bar, volatile LAS unsigned* st) {
    XcdBarrier b; b.bar = bar; b.x = xb_xcc_id(); b.st = st;
    if (threadIdx.x == 0) (void)xb_add(&bar[XB_XCNT(b.x)], 1u);
    return b;
}
__device__ __forceinline__ void xcd_barrier_complete(unsigned* bar, unsigned x, unsigned& nloc, unsigned& nx) {
    const unsigned G = gridDim.x * gridDim.y * gridDim.z;
    unsigned sum, cnt, mine, sp = 0u;
    for (;;) {
        sum = 0u; cnt = 0u; mine = 0u;
#pragma unroll
        for (unsigned j = 0; j < 16; ++j) { const unsigned c = xb_ld(&bar[XB_XCNT(j)]); sum += c; cnt += (c > 0u) ? 1u : 0u; mine = (j == x) ? c : mine; }
        if (sum == G) break;
        __builtin_amdgcn_s_sleep(1);
        if ((++sp & 255u) == 0u) { if (xb_ld(&bar[XB_TMO])) break; if (sp > XB_SPIN_CAP) { atomicAdd(&bar[XB_TMO], 1u); break; } }
    }
    nloc = mine > 0u ? mine : 1u; nx = cnt > 0u ? cnt : 1u;
}
__device__ __forceinline__ void xcd_barrier(const XcdBarrier& b) {
    asm volatile("s_waitcnt vmcnt(0)" ::: "memory");
    __syncthreads();
    if (threadIdx.x == 0) {
        unsigned* bar = b.bar;
        __builtin_amdgcn_s_waitcnt(0);
        unsigned nloc = b.st[0], nx = b.st[1];
        if (nloc == 0u) { xcd_barrier_complete(bar, b.x, nloc, nx); b.st[0] = nloc; b.st[1] = nx; }
        const unsigned old = xb_add(&bar[XB_XSUB(b.x)], 1u);
        const unsigned gen = old / nloc;
        if (old + 1u == (gen + 1u) * nloc) {
            __builtin_amdgcn_fence(__ATOMIC_RELEASE, "agent");
            asm volatile("s_waitcnt vmcnt(0)" ::: "memory");
            const unsigned og = xb_add(&bar[XB_TOP], 1u);
            const unsigned tg = og / nx;
            if (og + 1u == (tg + 1u) * nx) xb_add(&bar[XB_TOPGEN], 1u);
            else XB_SPIN(xb_ld(&bar[XB_TOPGEN]) == tg, bar);
            __builtin_amdgcn_fence(__ATOMIC_ACQUIRE, "agent");
            xb_add(&bar[XB_XGEN(b.x)], 1u);
            asm volatile("s_waitcnt vmcnt(0)" ::: "memory");
        } else {
            XB_SPIN(xb_ld(&bar[XB_XGEN(b.x)]) == gen, bar);
            __builtin_amdgcn_fence(__ATOMIC_ACQUIRE, "agent");
            asm volatile("s_waitcnt vmcnt(0)" ::: "memory");
        }
    }
    __syncthreads();
}

constexpr int NPHASE = 15;
__global__ void __launch_bounds__(NTHR, 2) fwd_kernel(Args args) {
    extern __shared__ __attribute__((aligned(16))) unsigned char lds_raw[];
    Frame F; F.lds = (LAS unsigned char*)lds_raw; F.G = gridDim.x; F.bid = blockIdx.x;
    F.in = args.in; F.out = (float*)(GAS float*)args.out; F.ws = (unsigned char*)(GAS unsigned char*)args.ws;
    unsigned char* ws = F.ws;
#define REFRESH() do { int t_ = threadIdx.x; asm volatile("" : "+v"(t_)); F.tid = t_; F.lane = t_ & 63; F.wave = __builtin_amdgcn_readfirstlane(t_ >> 6); \
        GAS unsigned char* wsg_ = (GAS unsigned char*)args.ws; asm volatile("" : "+s"(wsg_)); ws = (unsigned char*)wsg_; F.ws = ws; } while (0)
    const int lo = args.ph_lo, hi = args.ph_hi;
#if MK_ONE_LAUNCH
    cg::grid_group grid = cg::this_grid();
    if (lo < 0) grid.sync();
    { volatile LAS unsigned* st0 = (volatile LAS unsigned*)(F.lds + LDS_BYTES - 64); if (threadIdx.x < 16) st0[threadIdx.x] = 0u; }
    __syncthreads();
    const XcdBarrier xbar = xcd_barrier_post((unsigned*)(args.ws + WS_CTL), (volatile LAS unsigned*)(F.lds + LDS_BYTES - 64));
#define SEAM(k) do { if (lo <= (k) && (k) + 1 < hi) xcd_barrier(xbar); } while (0)
#else
#define SEAM(k) do { } while (0)
#endif
#ifndef PHASE_MASK
#define PHASE_MASK 0x7fff
#endif
#define REP(k) for (int rep_ = 0; rep_ <= (((PROBE_REP_MASK) >> (k)) & 1); ++rep_)
#define WSSEL(bit) do { if ((FLAT_FN_MASK >> (bit)) & 1) { unsigned char* w_ = args.ws; asm volatile("" : "+s"(w_)); F.ws = w_; } else { GAS unsigned char* g_ = (GAS unsigned char*)args.ws; asm volatile("" : "+s"(g_)); F.ws = (unsigned char*)g_; } } while (0)
#define IN(k) ((((PHASE_MASK) >> (k)) & 1) && lo <= (k) && (k) < hi)
#define XB ((bf16_t*)(ws + WS_XB))
#define X ((float*)(ws + WS_X))
#define SSX ((float*)(ws + WS_SSX))
#define SSV ((float*)(ws + WS_SSV))
#define B0 ((bf16_t*)(ws + WS_B0))
#define B1 ((bf16_t*)(ws + WS_B1))
#define QBp ((bf16_t*)(ws + WS_QB))
#define A2 ((bf16_t*)(ws + WS_A2))
#define GBp ((bf16_t*)(ws + WS_GB))
    const int G = F.G, bid = F.bid;

    if (IN(0)) REP(0) { REFRESH(); WSSEL(0); p0_prologue(F); __syncthreads(); } SEAM(0);
#define CNT(k) ((unsigned*)(ws + WS_CTL) + 4096 + 64 * (k))
#define WOUT(l) ((const bf16_t*)(ws + WS_WOUT) + (size_t)(l) * DM * KOUT)
#define INPROJ(EpiT, E, W, N, cnt, want) do { \
        pg8::Gemm g{XB, (W), M, (N), DM, DM}; pg8::StaticOrder S; S.init(MP, (N), G, bid); pg8::gemm_phase<EpiT, pg8::StaticOrder, true, true>(F.lds, g, S, E); \
        if (cnt) counter_wait(cnt, (unsigned)(want)); \
        const int rem = ((MP / 256) * ((N) / 256)) % G; pg8::StaticOrder S2; S2.init(MS, (N), G, (bid + G - rem) % G, MP / 256); pg8::gemm_phase<EpiT, pg8::StaticOrder, true, true>(F.lds, g, S2, E); } while (0)
#define OUTPROJ_PROMPT(l, bp) do { pg8::Gemm g{A2, WOUT(l), M, DM, KOUT, KOUT}; pg8::StaticOrder S; S.init(MP, DM, G, bid); EpiOut E{(bp), XB, SSX}; pg8::gemm_phase<EpiOut, pg8::StaticOrder, true, true>(F.lds, g, S, E); } while (0)
#define OUTPROJ_SLICES(l, c, nb, NK) do { pg8::Gemm g{A2, WOUT(l), M, DM, KOUT / (NK), KOUT}; typedef pg8::SliceOrder<MS / 256, DM / 256, (NK)> SO; SO S; S.init((nb), (c), MP / 256); \
        EpiSlab E{(float*)(ws + WS_SLAB), DM, MP, (size_t)MS * DM}; pg8::gemm_phase<EpiSlab, SO, true, true>(F.lds, g, S, E); } while (0)
#define SLICEFIX(l, sb0, basef, cA, cB) do { if (bid >= (sb0)) { const int nsb_ = G - (sb0); OUTPROJ_SLICES(l, bid - (sb0), nsb_, NK_OUT); counter_signal(cA); counter_wait(cA, (unsigned)nsb_); \
        fixup_out_rows(F, (basef), bid - (sb0), nsb_, NK_OUT); counter_signal(cB); } } while (0)
#define KVPROJ(l, c0) do { pg8::Gemm g{(const bf16_t*)(ws + WS_MEMB), (const bf16_t*)(ws + WS_WKV) + (size_t)(l) * DM * DM, PB * MEML, DM, DM, DM}; pg8::StaticOrder S; S.init(g.M, g.N, G, (bid + G - (c0)) % G); \
        EpiKV E{(const float*)(ws + WS_RSTDM), F.out + O_MK, F.out + O_MV, (bf16_t*)(ws + WS_KB), (bf16_t*)(ws + WS_VT), (l)}; pg8::gemm_phase<EpiKV, pg8::StaticOrder, true, true>(F.lds, g, S, E); } while (0)
    if (IN(1)) REP(1) { REFRESH();
        { EpiInA E{SSX, B0, B1, QBp, SSV}; INPROJ(EpiInA, E, (const bf16_t*)(ws + WS_WINA), NIN_A, (unsigned*)nullptr, 0); }
        KVPROJ(0, 180); KVPROJ(1, 212);
    } SEAM(1);
    if (IN(2)) REP(2) { REFRESH(); WSSEL(1);
        sgu_phase_mfma(F, 0); sgu_sample_phase(F, 0); attn_prompt_phase(F, 0); attn_sample_phase(F, 0); } SEAM(2);
    if (IN(3)) REP(3) { REFRESH(); OUTPROJ_PROMPT(0, GIN(0)); } SEAM(3);
    if (IN(4)) REP(4) { REFRESH(); SLICEFIX(0, 196, GIN(1), CNT(0), CNT(4));
        EpiInB E{SSX, B0, B1, QBp, F.out + O_CP, F.out + O_CS}; INPROJ(EpiInB, E, (const bf16_t*)(ws + WS_WINB), NIN_B, CNT(4), G - 196); } SEAM(4);
    if (IN(5)) REP(5) { REFRESH(); WSSEL(3);
        conv_phase(F); attn_prompt_phase(F, 1); attn_sample_phase(F, 1); } SEAM(5);
    if (IN(6)) REP(6) { REFRESH(); OUTPROJ_PROMPT(1, (const float*)nullptr); } SEAM(6);
    if (IN(7)) REP(7) { REFRESH(); SLICEFIX(1, 196, (const float*)nullptr, CNT(1), CNT(5));
        EpiInC E{SSX, B0, B1, QBp}; INPROJ(EpiInC, E, (const bf16_t*)(ws + WS_WINC), NIN_C, CNT(5), G - 196); KVPROJ(2, 164); } SEAM(7);
    if (IN(8)) REP(8) { REFRESH();
        const int half = G / 2;
        if (bid < half) { F.G = half; WSSEL(4); s5_prompt_mfma(F); if (PROBE_SUB_MASK & 8) s5_prompt_mfma(F); }
        else { F.bid = bid - half; F.G = G - half; for (int r2 = 0; r2 <= ((PROBE_SUB_MASK >> 4) & 1); ++r2) { WSSEL(6); attn_prompt_phase(F, 2); WSSEL(7); attn_sample_phase(F, 2); WSSEL(5); s5_sample_phase(F); } }
        F.bid = bid; F.G = G; } SEAM(8);
    if (IN(9)) REP(9) { REFRESH();
        { pg8::Gemm g{GBp, (const bf16_t*)(ws + WS_WGLU), M, E_, E_, E_}; pg8::StaticOrder S; S.init(MP, E_, G, bid); EpiGlu E{GBp, B1, GIN(29), A2}; pg8::gemm_phase<EpiGlu, pg8::StaticOrder, true, true>(F.lds, g, S, E); }
        { pg8::Gemm g{GBp, (const bf16_t*)(ws + WS_WGLU), M, E_, 256, E_}; typedef pg8::SliceOrder<MS / 256, E_ / 256, NK_GLU> SG; SG S; S.init(G, bid, MP / 256); EpiSlab E{(float*)(ws + WS_SLAB), E_, MP, (size_t)MS * E_}; pg8::gemm_phase<EpiSlab, SG, true, true>(F.lds, g, S, E); } } SEAM(9);
    if (IN(10)) REP(10) { REFRESH(); fixup_glu_rows(F);
        OUTPROJ_PROMPT(2, (const float*)nullptr); } SEAM(10);
    if (IN(11)) REP(11) { REFRESH(); SLICEFIX(2, 212, (const float*)nullptr, CNT(3), CNT(6));
        EpiInA E{SSX, B0, B1, QBp, SSV}; INPROJ(EpiInA, E, (const bf16_t*)(ws + WS_WINA) + (size_t)NIN_A * DM, NIN_A, CNT(6), G - 212); KVPROJ(3, 180); } SEAM(11);
    if (IN(12)) REP(12) { REFRESH(); WSSEL(1);
        sgu_phase_mfma(F, 1); sgu_sample_phase(F, 1); attn_prompt_phase(F, 3); attn_sample_phase(F, 3); } SEAM(12);
    if (IN(13)) REP(13) { REFRESH(); OUTPROJ_PROMPT(3, (const float*)nullptr); OUTPROJ_SLICES(3, bid, G, NK_OUT_LAST); } SEAM(13);
    if (IN(14)) REP(14) { REFRESH(); WSSEL(8); fixup_out_rows(F, (const float*)nullptr, bid, G, NK_OUT_LAST); final_phase(F); }
#undef CNT
#undef WOUT
#undef KVPROJ
#undef INPROJ
#undef OUTPROJ_PROMPT
#undef OUTPROJ_SLICES
#undef SLICEFIX
#undef IN
#undef REP
#undef SEAM
#undef XB
#undef X
#undef SSX
#undef SSV
#undef B0
#undef B1
#undef QBp
#undef A2
#undef GBp
#undef REFRESH
}

extern "C" void kernel_launch(void* const* d_in, const int* in_sizes, int n_in, void* d_out, int out_size, void* d_ws, size_t ws_size, hipStream_t stream) {
    static int grid = 0;
    if (grid == 0) {
        if (n_in != 30 || out_size != (int)O_END || ws_size < WS_END) { fprintf(stderr, "kernel_launch: unexpected shapes (n_in %d out %d ws %zu)\n", n_in, out_size, ws_size); grid = -1; return; }
        int dev = 0, cus = 0, per_cu = 0;
        (void)hipGetDevice(&dev); (void)hipDeviceGetAttribute(&cus, hipDeviceAttributeMultiprocessorCount, dev);
        if (hipFuncSetAttribute((const void*)fwd_kernel, hipFuncAttributeMaxDynamicSharedMemorySize, LDS_BYTES) != hipSuccess) { fprintf(stderr, "kernel_launch: hipFuncSetAttribute failed\n"); grid = -1; return; }
        if (hipOccupancyMaxActiveBlocksPerMultiprocessor(&per_cu, (const void*)fwd_kernel, NTHR, LDS_BYTES) != hipSuccess || per_cu < 1) { fprintf(stderr, "kernel_launch: occupancy query says %d\n", per_cu); (void)hipGetLastError(); per_cu = 1; }
        grid = cus;
    }
    if (grid < 0) return;
    Args a{};
    for (int i = 0; i < 30; ++i) a.in[i] = (const float*)d_in[i];
    a.out = (float*)d_out; a.ws = (unsigned char*)d_ws;
#if MK_ONE_LAUNCH
    (void)hipMemsetAsync((char*)d_ws + WS_CTL, 0, 65536, stream);
    a.ph_lo = 0; a.ph_hi = NPHASE;
    void* kargs[] = {&a};
    hipError_t e = hipLaunchCooperativeKernel((const void*)fwd_kernel, dim3(grid), dim3(NTHR), kargs, LDS_BYTES, stream);
    if (e != hipSuccess) fprintf(stderr, "cooperative launch failed: %s (grid %d)\n", hipGetErrorString(e), grid);
#else
    for (int p = 0; p < NPHASE; ++p) { a.ph_lo = p; a.ph_hi = p + 1; hipLaunchKernelGGL(fwd_kernel, dim3(grid), dim3(NTHR), LDS_BYTES, stream, a); }
#endif
}
```

```cpp
#include <hip/hip_runtime.h>
#include <hip/hip_cooperative_groups.h>
#include <cstdio>
#include <cstdint>
namespace cg = cooperative_groups;

#ifndef MK_ONE_LAUNCH
#define MK_ONE_LAUNCH 1
#endif
#ifndef XHALF_SHFL
#define XHALF_SHFL 0
#endif
#ifndef EPI_DRAIN
#define EPI_DRAIN 1
#endif
#ifndef FLAT_FN_MASK
#define FLAT_FN_MASK 0x00
#endif
#ifndef PROBE_SUB_MASK
#define PROBE_SUB_MASK 0
#endif
#ifndef PROBE_REP_MASK
#define PROBE_REP_MASK 0
#endif

namespace pg8 {
#define PG8_LAS __attribute__((address_space(3)))
typedef unsigned short bf16_t;
typedef short bf16x8 __attribute__((ext_vector_type(8)));
typedef float f32x4 __attribute__((ext_vector_type(4)));
typedef unsigned u32x4 __attribute__((ext_vector_type(4)));
typedef unsigned u32x2 __attribute__((ext_vector_type(2)));
constexpr int BM = 256, BK = 64, HALF = 128, HTB = HALF * BK * 2, STAGE_BYTES = 8 * HTB, NXCD = 8, WGM = 8;

__host__ __device__ __forceinline__ int lds_byte(int r, int c) { const int st = (r >> 4) * 2 + (c >> 5), rr = r & 15, cc = c & 31, ob = rr * 64 + cc * 2; return st * 1024 + (ob ^ (((ob >> 9) & 1) << 5)); }
__host__ __device__ __forceinline__ void stage_rc(int b, int& R, int& C) { const int st = b / 1024, sb = b % 1024, swz = sb ^ (((sb >> 9) & 1) << 5); R = (st >> 1) * 16 + swz / 64; C = (st & 1) * 32 + (swz % 64) / 2; }
__host__ __device__ __forceinline__ int perm32(int rho) { const int n = rho >> 4, i = rho & 15; return 8 * (i >> 2) + 4 * n + (i & 3); }

struct Unit { int pm, pn, ks; };
struct Gemm { const bf16_t* A; const bf16_t* Bt; int M, N, K, ld; };

struct StaticOrder {
    int nM, nN, nwg, G, c, pm0;
    __host__ __device__ void init(int M, int N, int G_, int c_, int pm0_ = 0) { nM = M / BM; nN = N / BM; nwg = nM * nN; G = G_; c = c_; pm0 = pm0_; }
    __host__ __device__ bool next(int i, Unit& u) const {
        const long L = (long)i * G + c; if (L >= nwg) return false;
        int wgid = (int)L; { const int q = nwg / NXCD, r = nwg % NXCD, xcd = wgid % NXCD, off = wgid / NXCD; wgid = (xcd < r ? xcd * (q + 1) : r * (q + 1) + (xcd - r) * q) + off; }
        const int nig = WGM * nN, gid = wgid / nig, fm = gid * WGM, gsz = (nM - fm) < WGM ? (nM - fm) : WGM;
        u.pm = pm0 + fm + ((wgid % nig) % gsz); u.pn = (wgid % nig) / gsz; u.ks = 0; return true;
    }
    __device__ __forceinline__ void a_ready(const Unit&) const {}
    __device__ __forceinline__ void done(const Unit&) const {}
};
template <int NM_, int NN_, int NK_> struct SliceOrder {
    int G, c, pm0;
    __host__ __device__ void init(int G_, int c_, int pm0_) { G = G_; c = c_; pm0 = pm0_; }
    __host__ __device__ bool next(int i, Unit& u) const {
        const int L = i * G + c; if (L >= NM_ * NN_ * NK_) return false;
        const int t = L / NK_; u.ks = L % NK_; u.pn = t % NN_; u.pm = pm0 + t / NN_; return true;
    }
    __device__ __forceinline__ void a_ready(const Unit&) const {}
    __device__ __forceinline__ void done(const Unit&) const {}
};

template <class Epi, class Sched, bool ALIGN_EPI = false, bool SP2 = false>
__device__ __forceinline__ void gemm_phase(PG8_LAS unsigned char* lds, const Gemm g, const Sched& S, const Epi& E) {
    int tid = threadIdx.x; asm volatile("" : "+v"(tid));
    const int wid = __builtin_amdgcn_readfirstlane(tid >> 6), lane = tid & 63, wr = wid >> 2, wc = wid & 3, fr = lane & 15, fq = lane >> 4;
    const int K = g.K, ld = g.ld, nt = K / BK;
    unsigned voffA[2], voffB[2];
#pragma unroll
    for (int i = 0; i < 2; ++i) { int R, C; stage_rc(tid * 16 + i * 8192, R, C); const int Rb = Epi::PERM ? ((R & ~31) + perm32(R & 31)) : R;
        voffA[i] = (unsigned)(R * ld + C) * 2u; voffB[i] = (unsigned)(Rb * ld + C) * 2u; }
    const size_t kstep = (size_t)(BK * 2);
    const size_t hstep = (size_t)HALF * ld * 2;
    const size_t sstep = (size_t)K * 2;
    const size_t tstep = 2 * hstep;
    const unsigned ldsw = (unsigned)wid * 1024u;
    const int aoff = lds_byte(wr * 64 + fr, fq * 8), boff = lds_byte(wc * 32 + fr, fq * 8);
#define PG8_SA(b, h) (((b) * 2 + (h)) * HTB)
#define PG8_SB(b, h) ((4 + (b) * 2 + (h)) * HTB)
#define PG8_STAGE(bufoff, gbase, voff) do { _Pragma("unroll") for (int _i = 0; _i < 2; ++_i) \
        __builtin_amdgcn_global_load_lds((const unsigned*)((const char*)(gbase) + (voff)[_i]), (PG8_LAS unsigned*)(lds + (bufoff) + ldsw + _i * 8192), 16, 0, 0); } while (0)
#define PG8_LDA(dst, b, h) do { _Pragma("unroll") for (int m = 0; m < 4; ++m) _Pragma("unroll") for (int k = 0; k < 2; ++k) dst[m][k] = *(const PG8_LAS bf16x8*)(lds + PG8_SA(b, h) + aoff + m * 2048 + k * 1024); } while (0)
#define PG8_LDB(dst, b, h) do { _Pragma("unroll") for (int n = 0; n < 2; ++n) _Pragma("unroll") for (int k = 0; k < 2; ++k) dst[n][k] = *(const PG8_LAS bf16x8*)(lds + PG8_SB(b, h) + boff + n * 2048 + k * 1024); } while (0)
#define PG8_MMA(ai, bj, At, Bt) do { __builtin_amdgcn_s_setprio(1); _Pragma("unroll") for (int m = 0; m < 4; ++m) _Pragma("unroll") for (int n = 0; n < 2; ++n) _Pragma("unroll") for (int k = 0; k < 2; ++k) \
        acc[ai][bj][m][n] = __builtin_amdgcn_mfma_f32_16x16x32_bf16(Bt[n][k], At[m][k], acc[ai][bj][m][n], 0, 0, 0); __builtin_amdgcn_s_setprio(0); } while (0)
#define PG8_WAIT_V(n) asm volatile("s_waitcnt vmcnt(" #n ")" ::: "memory")
#define PG8_WAIT_L(n) asm volatile("s_waitcnt lgkmcnt(" #n ")" ::: "memory")
#define PG8_BAR __builtin_amdgcn_s_barrier()
#define PG8_SCHED __builtin_amdgcn_sched_barrier(0)
    Unit cur, nxt; int ui = 0;
    if (!S.next(0, cur)) return;
    f32x4 acc[2][2][4][2];
#pragma unroll
    for (int a = 0; a < 2; ++a)
#pragma unroll
        for (int b = 0; b < 2; ++b)
#pragma unroll
            for (int m = 0; m < 4; ++m)
#pragma unroll
                for (int n = 0; n < 2; ++n) acc[a][b][m][n] = (f32x4){0.f, 0.f, 0.f, 0.f};
    bf16x8 At[4][2], B0[2][2], B1[2][2];
    const char* cA = (const char*)g.A + (size_t)cur.pm * tstep + (size_t)cur.ks * sstep; const char* cB = (const char*)g.Bt + (size_t)cur.pn * tstep + (size_t)cur.ks * sstep;
    S.a_ready(cur);
    if constexpr (SP2) {
        PG8_STAGE(PG8_SB(0, 0), cB, voffB); PG8_STAGE(PG8_SB(0, 1), cB + hstep, voffB); PG8_STAGE(PG8_SA(0, 0), cA, voffA); PG8_STAGE(PG8_SA(0, 1), cA + hstep, voffA);
        if (wr == 1) PG8_BAR;
        PG8_WAIT_V(2); PG8_BAR;
        PG8_STAGE(PG8_SB(1, 0), cB + kstep, voffB); PG8_STAGE(PG8_SA(1, 0), cA + kstep, voffA); PG8_STAGE(PG8_SB(1, 1), cB + hstep + kstep, voffB);
        PG8_WAIT_V(6); PG8_BAR;
    } else {
        PG8_STAGE(PG8_SB(0, 0), cB, voffB); PG8_STAGE(PG8_SA(0, 0), cA, voffA); PG8_STAGE(PG8_SB(0, 1), cB + hstep, voffB); PG8_STAGE(PG8_SA(0, 1), cA + hstep, voffA);
        if (wr == 1) PG8_BAR;
        PG8_WAIT_V(4); PG8_BAR;
        PG8_STAGE(PG8_SB(1, 0), cB + kstep, voffB); PG8_STAGE(PG8_SA(1, 0), cA + kstep, voffA); PG8_STAGE(PG8_SB(1, 1), cB + hstep + kstep, voffB);
        PG8_WAIT_V(6); PG8_BAR;
    }
    for (;;) {
        const bool has_next = S.next(ui + 1, nxt);
        const char* nA = has_next ? (const char*)g.A + (size_t)nxt.pm * tstep + (size_t)nxt.ks * sstep : cA; const char* nB = has_next ? (const char*)g.Bt + (size_t)nxt.pn * tstep + (size_t)nxt.ks * sstep : cB;
        for (int t = 0; t < nt; t += 2) {
            const bool last = (t == nt - 2);
            const char* a1 = cA + (size_t)(t + 1) * kstep;
            const char* a2 = last ? nA : cA + (size_t)(t + 2) * kstep; const char* b2 = last ? nB : cB + (size_t)(t + 2) * kstep;
            const char* a3 = a2 + kstep; const char* b3 = b2 + kstep;
            if (last && has_next) S.a_ready(nxt);
            if constexpr (SP2) {
            PG8_LDB(B0, 0, 0); PG8_LDB(B1, 0, 1); PG8_SCHED; PG8_LDA(At, 0, 0); PG8_STAGE(PG8_SA(1, 1), a1 + hstep, voffA);
            PG8_WAIT_V(8); PG8_WAIT_L(0); PG8_BAR; PG8_MMA(0, 0, At, B0); PG8_MMA(0, 1, At, B1); PG8_BAR; PG8_SCHED;
            PG8_LDA(At, 0, 1); PG8_STAGE(PG8_SB(0, 0), b2, voffB); PG8_STAGE(PG8_SB(0, 1), b2 + hstep, voffB); PG8_STAGE(PG8_SA(0, 0), a2, voffA);
            PG8_WAIT_V(8); PG8_WAIT_L(0); PG8_BAR; PG8_MMA(1, 0, At, B0); PG8_MMA(1, 1, At, B1); PG8_BAR; PG8_SCHED;
            PG8_LDB(B0, 1, 0); PG8_LDB(B1, 1, 1); PG8_SCHED; PG8_LDA(At, 1, 0); PG8_STAGE(PG8_SA(0, 1), a2 + hstep, voffA);
            PG8_WAIT_V(8); PG8_WAIT_L(0); PG8_BAR; PG8_MMA(0, 0, At, B0); PG8_MMA(0, 1, At, B1); PG8_BAR; PG8_SCHED;
            PG8_LDA(At, 1, 1); PG8_STAGE(PG8_SB(1, 0), b3, voffB); PG8_STAGE(PG8_SB(1, 1), b3 + hstep, voffB); PG8_STAGE(PG8_SA(1, 0), a3, voffA);
            PG8_WAIT_V(8); PG8_WAIT_L(0); PG8_BAR; PG8_MMA(1, 0, At, B0); PG8_MMA(1, 1, At, B1); PG8_BAR; PG8_SCHED;
            } else {
            PG8_LDB(B0, 0, 0); PG8_SCHED; PG8_LDA(At, 0, 0); PG8_STAGE(PG8_SA(1, 1), a1 + hstep, voffA);
            PG8_WAIT_L(8); PG8_BAR; PG8_WAIT_L(0); PG8_MMA(0, 0, At, B0); PG8_BAR; PG8_SCHED;
            PG8_LDB(B1, 0, 1); PG8_STAGE(PG8_SB(0, 0), b2, voffB);
            PG8_BAR; PG8_WAIT_L(0); PG8_MMA(0, 1, At, B1); PG8_BAR;
            PG8_LDA(At, 0, 1); PG8_STAGE(PG8_SA(0, 0), a2, voffA);
            PG8_BAR; PG8_WAIT_L(0); PG8_MMA(1, 0, At, B0); PG8_BAR; PG8_SCHED;
            PG8_STAGE(PG8_SB(0, 1), b2 + hstep, voffB);
            PG8_WAIT_V(6); PG8_BAR; PG8_MMA(1, 1, At, B1); PG8_BAR;
            PG8_LDB(B0, 1, 0); PG8_SCHED; PG8_LDA(At, 1, 0); PG8_STAGE(PG8_SA(0, 1), a2 + hstep, voffA);
            PG8_WAIT_L(8); PG8_BAR; PG8_WAIT_L(0); PG8_MMA(0, 0, At, B0); PG8_BAR; PG8_SCHED;
            PG8_LDB(B1, 1, 1); PG8_STAGE(PG8_SB(1, 0), b3, voffB);
            PG8_BAR; PG8_WAIT_L(0); PG8_MMA(0, 1, At, B1); PG8_BAR;
            PG8_LDA(At, 1, 1); PG8_STAGE(PG8_SA(1, 0), a3, voffA);
            PG8_BAR; PG8_WAIT_L(0); PG8_MMA(1, 0, At, B0); PG8_BAR; PG8_SCHED;
            PG8_STAGE(PG8_SB(1, 1), b3 + hstep, voffB);
            PG8_WAIT_V(6); PG8_BAR; PG8_MMA(1, 1, At, B1); PG8_BAR;
            }
        }
        if constexpr (ALIGN_EPI) { if (wr == 0) PG8_BAR; }
        if constexpr (!Epi::AFTER_DRAIN) { E(acc, cur, wr, wc, fr, fq); S.done(cur); }
#if EPI_DRAIN
        PG8_WAIT_V(0);
#endif
        if (!has_next) break;
#pragma unroll
        for (int a = 0; a < 2; ++a)
#pragma unroll
            for (int b = 0; b < 2; ++b)
#pragma unroll
                for (int m = 0; m < 4; ++m)
#pragma unroll
                    for (int n = 0; n < 2; ++n) acc[a][b][m][n] = (f32x4){0.f, 0.f, 0.f, 0.f};
        cur = nxt; cA = nA; cB = nB; ++ui;
        if constexpr (ALIGN_EPI) { if (wr == 1) PG8_BAR; }
    }
    PG8_WAIT_V(0);
    if constexpr (!ALIGN_EPI) { if (wr == 0) PG8_BAR; }
    PG8_BAR;
#undef PG8_SA
#undef PG8_SB
#undef PG8_STAGE
#undef PG8_LDA
#undef PG8_LDB
#undef PG8_MMA
#undef PG8_WAIT_V
#undef PG8_WAIT_L
#undef PG8_BAR
#undef PG8_SCHED
}
}

using pg8::bf16_t; using pg8::f32x4; using pg8::u32x4; using pg8::u32x2; using pg8::bf16x8; using pg8::Unit;
#define LAS __attribute__((address_space(3)))
#define GAS __attribute__((address_space(1)))
#define GIN(k) ((const float*)(const GAS float*)F.in[k])
typedef float f32x2 __attribute__((ext_vector_type(2)));
typedef __bf16 bf16x2_t __attribute__((ext_vector_type(2)));
typedef float f32x16 __attribute__((ext_vector_type(16)));

constexpr int DM = 1024, E_ = 2048, XA = 512, NH = 4, HD = 128, MEML = 256;
constexpr int PB = 8, PSEQ = 2048, MP = PB * PSEQ;
constexpr int SBT = 128, SSEQ = 4, MS = SBT * SSEQ;
constexpr int M = MP + MS;
constexpr int NIN_A = 3 * E_ + XA, NIN_B = 4 * E_ + XA, NIN_C = 2 * E_ + XA, KOUT = E_ + XA;
constexpr int S5G = 128, S5P = 64, S5I = 16;
constexpr float EPS = 1e-6f;
constexpr int NWAVES = 8, NTHR = 512;

constexpr size_t O_YP = 0, O_YS = O_YP + (size_t)MP * DM, O_MK = O_YS + (size_t)MS * DM, O_MV = O_MK + 4ull * PB * MEML * XA, O_CP = O_MV + 4ull * PB * MEML * XA,
                 O_CS = O_CP + (size_t)PB * 2 * E_, O_SRP = O_CS + (size_t)SBT * 2 * E_, O_SIP = O_SRP + (size_t)PB * S5G * S5P, O_SRS = O_SIP + (size_t)PB * S5G * S5P,
                 O_SIS = O_SRS + (size_t)SBT * S5G * S5P, O_CV = O_SIS + (size_t)SBT * S5G * S5P, O_END = O_CV + 2ull * SBT * SSEQ * E_;
static_assert(O_END == 30572544ull, "output size");

constexpr size_t MiB = 1u << 20;
constexpr size_t WS_CTL = 0, WS_TAB = 1 * MiB, WS_RSTDM = 3 * MiB, WS_SGUW = 4 * MiB, WS_SSX = 5 * MiB, WS_SSV = 7 * MiB, WS_WKV = 10 * MiB, WS_WGLU = 18 * MiB, WS_WOUT = 26 * MiB,
                 WS_WINA = 46 * MiB, WS_WINB = 72 * MiB, WS_WINC = 89 * MiB, WS_MEMB = 98 * MiB, WS_KB = 102 * MiB, WS_VT = 110 * MiB, WS_XB = 118 * MiB, WS_X = 151 * MiB,
                 WS_B0 = 217 * MiB, WS_B1 = 283 * MiB, WS_QB = 349 * MiB, WS_A2 = 366 * MiB, WS_GB = 449 * MiB, WS_SLAB = 515 * MiB  , WS_END = 548 * MiB;
constexpr size_t T_AR = 0, T_AI = 8192, T_BBR = 16384, T_BBI = 16384 + 131072;

constexpr int RING_BYTES = 131072, LDS_BYTES = 147456;

struct Args { const float* in[30]; float* out; unsigned char* ws; int ph_lo, ph_hi; };

__device__ __forceinline__ unsigned pk2(float lo, float hi) { f32x2 v = {lo, hi}; return __builtin_bit_cast(unsigned, __builtin_convertvector(v, bf16x2_t)); }
__device__ __forceinline__ bf16_t f2bf(float f) { return (bf16_t)(pk2(f, 0.f) & 0xffffu); }
__device__ __forceinline__ float bf2f(unsigned short h) { return __uint_as_float((unsigned)h << 16); }
__device__ __forceinline__ float bflo(unsigned w) { return __uint_as_float(w << 16); }
__device__ __forceinline__ float bfhi(unsigned w) { return __uint_as_float(w & 0xffff0000u); }
__device__ __forceinline__ float sigmoidf_(float x) { return __builtin_amdgcn_rcpf(1.f + __expf(-x)); }
__device__ __forceinline__ float siluf_(float x) { return x * sigmoidf_(x); }
__device__ __forceinline__ float gelu_tanh(float x) { const float y = 0.7978845608028654f * (x + 0.044715f * x * x * x); return x * sigmoidf_(2.f * y); }
__device__ __forceinline__ float wave_sum(float v) {
#pragma unroll
    for (int o = 1; o < 64; o <<= 1) v += __shfl_xor(v, o);
    return v;
}
__device__ __forceinline__ float wave_max(float v) {
#pragma unroll
    for (int o = 1; o < 64; o <<= 1) v = fmaxf(v, __shfl_xor(v, o));
    return v;
}
__device__ __forceinline__ u32x4 pack8(f32x4 a, f32x4 b) { u32x4 w; w.x = pk2(a[0], a[1]); w.y = pk2(a[2], a[3]); w.z = pk2(b[0], b[1]); w.w = pk2(b[2], b[3]); return w; }
__device__ __forceinline__ void unpack8(u32x4 w, float (&f)[8]) { f[0] = bflo(w.x); f[1] = bfhi(w.x); f[2] = bflo(w.y); f[3] = bfhi(w.y); f[4] = bflo(w.z); f[5] = bfhi(w.z); f[6] = bflo(w.w); f[7] = bfhi(w.w); }

__device__ __forceinline__ int src_col(int kind, int np) {
    const int pn = np >> 8, p = np & 255, pos = (p & ~31) + pg8::perm32(p & 31);
    if (kind == 0) {
        if (pn < 16) return pos < 128 ? 128 * pn + pos : 2 * E_ + 128 * pn + (pos - 128);
        if (pn < 24) return E_ + 256 * (pn - 16) + pos;
        return 3 * E_ + 256 * (pn - 24) + pos;
    }
    if (kind == 1) {
        if (pn < 32) { const int qs = 2 * (p >> 7) + ((p >> 4) & 1), ch = 64 * pn + 16 * ((p >> 5) & 3) + (p & 15); return qs * E_ + ch; }
        return 4 * E_ + 256 * (pn - 32) + pos;
    }
    return 256 * pn + pos;
}

__device__ __forceinline__ float sum_rows4(float x) {
    auto a = __builtin_amdgcn_permlane16_swap(__float_as_uint(x), __float_as_uint(x), false, false); const float y = __uint_as_float(a[0]) + __uint_as_float(a[1]);
    auto b = __builtin_amdgcn_permlane32_swap(__float_as_uint(y), __float_as_uint(y), false, false); return __uint_as_float(b[0]) + __uint_as_float(b[1]);
}
__device__ __forceinline__ void rows_rstd16(const float* ssx, int row0, int fq, float (&rs)[2][4]) {
#pragma unroll
    for (int ai = 0; ai < 2; ++ai)
#pragma unroll
        for (int m = 0; m < 4; ++m) {
            const f32x4 v = *(const f32x4*)(ssx + (size_t)(row0 + ai * 128 + m * 16) * 16 + fq * 4);
            const float s = sum_rows4((v[0] + v[1]) + (v[2] + v[3]));
            rs[ai][m] = __builtin_amdgcn_rsqf(s * (1.f / DM) + EPS);
        }
}

struct EpiKV {
    static constexpr bool PERM = false, AFTER_DRAIN = false;
    const float* rstdm; float* outk; float* outv; bf16_t* KB; bf16_t* VT; int layer;
    __device__ __forceinline__ void operator()(const f32x4 (&acc)[2][2][4][2], const Unit& u, int wr, int wc, int fr, int fq) const {
        const int sub = u.pn & 3, isv = sub >> 1, b = u.pm;
        const int key0 = wr * 64 + fr, d0 = 32 * wc + 8 * fq;
        const float* rsp = rstdm + b * 256 + key0;
        float* of = (isv ? outv : outk) + (((size_t)(layer * PB + b) * MEML + key0) * NH + (sub & 1) * 2) * HD + d0;
        const size_t bh0 = (size_t)((layer * PB + b) * NH + (sub & 1) * 2);
        if (!isv) {
            bf16_t* kb = KB + (bh0 * MEML + key0) * HD + d0;
#pragma unroll
            for (int ai = 0; ai < 2; ++ai)
#pragma unroll
                for (int m = 0; m < 4; ++m) { const int kk = ai * 128 + m * 16; const float rs = rsp[kk];
#pragma unroll
                    for (int bj = 0; bj < 2; ++bj) { const f32x4 v0 = acc[ai][bj][m][0] * rs, v1 = acc[ai][bj][m][1] * rs;
                        float* o = of + (size_t)kk * XA + bj * HD; *(f32x4*)o = v0; *(f32x4*)(o + 4) = v1;
                        *(u32x4*)(kb + (size_t)bj * MEML * HD + (size_t)kk * HD) = pack8(v0, v1); }
                    asm volatile("" ::: "memory"); }
        } else {
            bf16_t* vt = VT + (bh0 * HD + d0) * MEML + key0;
#pragma unroll
            for (int ai = 0; ai < 2; ++ai)
#pragma unroll
                for (int m = 0; m < 4; ++m) { const int kk = ai * 128 + m * 16; const float rs = rsp[kk];
#pragma unroll
                    for (int bj = 0; bj < 2; ++bj) { const f32x4 v0 = acc[ai][bj][m][0] * rs, v1 = acc[ai][bj][m][1] * rs;
                        float* o = of + (size_t)kk * XA + bj * HD; *(f32x4*)o = v0; *(f32x4*)(o + 4) = v1;
                        bf16_t* q = vt + (size_t)bj * HD * MEML + kk;
#pragma unroll
                        for (int e = 0; e < 4; ++e) { q[e * MEML] = f2bf(v0[e]); q[(e + 4) * MEML] = f2bf(v1[e]); }
                        asm volatile("" ::: "memory"); } }
        }
    }
};

struct EpiInA {
    static constexpr bool PERM = false, AFTER_DRAIN = false;
    const float* ssx; bf16_t* UZ; bf16_t* VR; bf16_t* QB; float* SSV;
    __device__ __forceinline__ void operator()(const f32x4 (&acc)[2][2][4][2], const Unit& u, int wr, int wc, int fr, int fq) const {
        const int row0 = u.pm * 256 + wr * 64 + fr; float rs[2][4]; rows_rstd16(ssx, row0, fq, rs);
        if (u.pn < 16) {
#pragma unroll
            for (int ai = 0; ai < 2; ++ai)
#pragma unroll
                for (int m = 0; m < 4; ++m) { const int row = row0 + ai * 128 + m * 16; const float r = rs[ai][m]; f32x4 o[2];
#pragma unroll
                    for (int n = 0; n < 2; ++n)
#pragma unroll
                        for (int e = 0; e < 4; ++e) o[n][e] = acc[ai][0][m][n][e] * r * siluf_(acc[ai][1][m][n][e] * r);
                    *(u32x4*)(UZ + (size_t)row * E_ + 128 * u.pn + 32 * wc + 8 * fq) = pack8(o[0], o[1]); }
        } else if (u.pn < 24) {
#pragma unroll
            for (int ai = 0; ai < 2; ++ai)
#pragma unroll
                for (int m = 0; m < 4; ++m) { const int row = row0 + ai * 128 + m * 16; const float r = rs[ai][m]; float ss = 0.f;
#pragma unroll
                    for (int bj = 0; bj < 2; ++bj) { const f32x4 v0 = acc[ai][bj][m][0] * r, v1 = acc[ai][bj][m][1] * r;
                        ss += (v0[0] * v0[0] + v0[1] * v0[1]) + (v0[2] * v0[2] + v0[3] * v0[3]) + (v1[0] * v1[0] + v1[1] * v1[1]) + (v1[2] * v1[2] + v1[3] * v1[3]);
                        *(u32x4*)(VR + (size_t)row * E_ + 256 * (u.pn - 16) + 128 * bj + 32 * wc + 8 * fq) = pack8(v0, v1); }
                    ss = sum_rows4(ss);
                    if (fq == 0) SSV[(size_t)row * 32 + (u.pn - 16) * 4 + wc] = ss; }
        } else {
#pragma unroll
            for (int ai = 0; ai < 2; ++ai)
#pragma unroll
                for (int m = 0; m < 4; ++m) { const int row = row0 + ai * 128 + m * 16; const float r = rs[ai][m] * 0.08838834764831845f;
#pragma unroll
                    for (int bj = 0; bj < 2; ++bj) *(u32x4*)(QB + (size_t)row * XA + 256 * (u.pn - 24) + 128 * bj + 32 * wc + 8 * fq) = pack8(acc[ai][bj][m][0] * r, acc[ai][bj][m][1] * r); }
        }
    }
};

struct EpiInB {
    static constexpr bool PERM = false, AFTER_DRAIN = false;
    const float* ssx; bf16_t* P; bf16_t* G; bf16_t* QB; float* convp; float* convs;
    __device__ __forceinline__ void operator()(const f32x4 (&acc)[2][2][4][2], const Unit& u, int wr, int wc, int fr, int fq) const {
        const int row0 = u.pm * 256 + wr * 64 + fr; float rs[2][4]; rows_rstd16(ssx, row0, fq, rs);
        if (u.pn < 32) {
            const int ch0 = 64 * u.pn + 16 * wc + 4 * fq;
#pragma unroll
            for (int ai = 0; ai < 2; ++ai)
#pragma unroll
                for (int m = 0; m < 4; ++m) { const int row = row0 + ai * 128 + m * 16; const float r = rs[ai][m];
                    const f32x4 bg = acc[ai][0][m][0] * r, cgv = acc[ai][0][m][1] * r, hv = acc[ai][1][m][0] * r, z = acc[ai][1][m][1] * r;
                    f32x4 p = cgv * hv, gg;
#pragma unroll
                    for (int e = 0; e < 4; ++e) gg[e] = bg[e] * siluf_(z[e]);
                    u32x2 wp, wg; wp.x = pk2(p[0], p[1]); wp.y = pk2(p[2], p[3]); wg.x = pk2(gg[0], gg[1]); wg.y = pk2(gg[2], gg[3]);
                    *(u32x2*)(P + (size_t)row * E_ + ch0) = wp; *(u32x2*)(G + (size_t)row * E_ + ch0) = wg;
                    if (row < MP) { const int t = row & (PSEQ - 1); if (t >= PSEQ - 2) *(f32x4*)(convp + ((size_t)(row >> 11) * 2 + (t - (PSEQ - 2))) * E_ + ch0) = p; }
                    else { const int s = row - MP, t = s & 3; if (t >= 2) *(f32x4*)(convs + ((size_t)(s >> 2) * 2 + (t - 2)) * E_ + ch0) = p; } }
        } else {
#pragma unroll
            for (int ai = 0; ai < 2; ++ai)
#pragma unroll
                for (int m = 0; m < 4; ++m) { const int row = row0 + ai * 128 + m * 16; const float r = rs[ai][m] * 0.08838834764831845f;
#pragma unroll
                    for (int bj = 0; bj < 2; ++bj) *(u32x4*)(QB + (size_t)row * XA + 256 * (u.pn - 32) + 128 * bj + 32 * wc + 8 * fq) = pack8(acc[ai][bj][m][0] * r, acc[ai][bj][m][1] * r); }
        }
    }
};

struct EpiInC {
    static constexpr bool PERM = false, AFTER_DRAIN = false;
    const float* ssx; bf16_t* U; bf16_t* SZ; bf16_t* QB;
    __device__ __forceinline__ void operator()(const f32x4 (&acc)[2][2][4][2], const Unit& u, int wr, int wc, int fr, int fq) const {
        const int row0 = u.pm * 256 + wr * 64 + fr; float rs[2][4]; rows_rstd16(ssx, row0, fq, rs);
#pragma unroll
        for (int ai = 0; ai < 2; ++ai)
#pragma unroll
            for (int m = 0; m < 4; ++m) { const int row = row0 + ai * 128 + m * 16; const float r = rs[ai][m];
#pragma unroll
                for (int bj = 0; bj < 2; ++bj) { const int cc = 128 * bj + 32 * wc + 8 * fq;
                    if (u.pn < 8) *(u32x4*)(U + (size_t)row * E_ + 256 * u.pn + cc) = pack8(acc[ai][bj][m][0] * r, acc[ai][bj][m][1] * r);
                    else if (u.pn < 16) { f32x4 a, b2;
#pragma unroll
                        for (int e = 0; e < 4; ++e) { a[e] = siluf_(acc[ai][bj][m][0][e] * r); b2[e] = siluf_(acc[ai][bj][m][1][e] * r); }
                        *(u32x4*)(SZ + (size_t)row * E_ + 256 * (u.pn - 8) + cc) = pack8(a, b2); }
                    else { const float rq = r * 0.08838834764831845f; *(u32x4*)(QB + (size_t)row * XA + 256 * (u.pn - 16) + cc) = pack8(acc[ai][bj][m][0] * rq, acc[ai][bj][m][1] * rq); } } }
    }
};

struct EpiOut {
    static constexpr bool PERM = false, AFTER_DRAIN = false;
    const float* basef; bf16_t* XB; float* SSX;
    __device__ __forceinline__ void operator()(const f32x4 (&acc)[2][2][4][2], const Unit& u, int wr, int wc, int fr, int fq) const {
        const int row0 = u.pm * 256 + wr * 64 + fr;
#pragma unroll
        for (int ai = 0; ai < 2; ++ai)
#pragma unroll
            for (int m = 0; m < 4; ++m) { const int row = row0 + ai * 128 + m * 16; float ss = 0.f;
#pragma unroll
                for (int bj = 0; bj < 2; ++bj) { const int col = 256 * u.pn + 128 * bj + 32 * wc + 8 * fq; f32x4 x0, x1;
                    if (basef) { x0 = *(const f32x4*)(basef + (size_t)row * DM + col); x1 = *(const f32x4*)(basef + (size_t)row * DM + col + 4); }
                    else { float r[8]; unpack8(*(const u32x4*)(XB + (size_t)row * DM + col), r); x0 = (f32x4){r[0], r[1], r[2], r[3]}; x1 = (f32x4){r[4], r[5], r[6], r[7]}; }
                    x0 += acc[ai][bj][m][0]; x1 += acc[ai][bj][m][1];
                    *(u32x4*)(XB + (size_t)row * DM + col) = pack8(x0, x1);
                    ss += (x0[0] * x0[0] + x0[1] * x0[1]) + (x0[2] * x0[2] + x0[3] * x0[3]) + (x1[0] * x1[0] + x1[1] * x1[1]) + (x1[2] * x1[2] + x1[3] * x1[3]); }
                ss = sum_rows4(ss);
                if (fq == 0) SSX[(size_t)row * 16 + u.pn * 4 + wc] = ss; }
    }
};

struct EpiGlu {
    static constexpr bool PERM = false, AFTER_DRAIN = false;
    const bf16_t* GB; const bf16_t* SZ; const float* bias; bf16_t* A2;
    __device__ __forceinline__ void operator()(const f32x4 (&acc)[2][2][4][2], const Unit& u, int wr, int wc, int fr, int fq) const {
        const int row0 = u.pm * 256 + wr * 64 + fr;
#pragma unroll
        for (int ai = 0; ai < 2; ++ai)
#pragma unroll
            for (int m = 0; m < 4; ++m) { const int row = row0 + ai * 128 + m * 16;
#pragma unroll
                for (int bj = 0; bj < 2; ++bj) { const int col = 256 * u.pn + 128 * bj + 32 * wc + 8 * fq;
                    const f32x4 b0 = *(const f32x4*)(bias + col), b1 = *(const f32x4*)(bias + col + 4);
                    float gv[8], sz[8]; unpack8(*(const u32x4*)(GB + (size_t)row * E_ + col), gv); unpack8(*(const u32x4*)(SZ + (size_t)row * E_ + col), sz);
                    f32x4 o0, o1;
#pragma unroll
                    for (int e = 0; e < 4; ++e) { o0[e] = gv[e] * sigmoidf_(acc[ai][bj][m][0][e] + b0[e]) * sz[e]; o1[e] = gv[4 + e] * sigmoidf_(acc[ai][bj][m][1][e] + b1[e]) * sz[4 + e]; }
                    *(u32x4*)(A2 + (size_t)row * KOUT + col) = pack8(o0, o1); } }
    }
};

struct EpiSlab {
    static constexpr bool PERM = false, AFTER_DRAIN = false;
    float* S; int ldc; int row0; size_t kstride;
    __device__ __forceinline__ void operator()(const f32x4 (&acc)[2][2][4][2], const Unit& u, int wr, int wc, int fr, int fq) const {
        float* base = S + (size_t)u.ks * kstride + (size_t)(u.pm * 256 + wr * 64 + fr - row0) * ldc + 256 * u.pn + 32 * wc + 8 * fq;
#pragma unroll
        for (int ai = 0; ai < 2; ++ai)
#pragma unroll
            for (int m = 0; m < 4; ++m)
                { float* o = base + (size_t)(ai * 128 + m * 16) * ldc; *(f32x4*)o = acc[ai][0][m][0]; *(f32x4*)(o + 4) = acc[ai][0][m][1]; *(f32x4*)(o + 128) = acc[ai][1][m][0]; *(f32x4*)(o + 132) = acc[ai][1][m][1];
                  asm volatile("" ::: "memory"); }
    }
};

#ifndef PROBE_EPI2
#define PROBE_EPI2 0
#endif
template <class E_> struct EpiTwice { static constexpr bool PERM = false, AFTER_DRAIN = false; E_ e;
    __device__ __forceinline__ void operator()(const f32x4 (&acc)[2][2][4][2], const Unit& u, int wr, int wc, int fr, int fq) const { e(acc, u, wr, wc, fr, fq); asm volatile("" ::: "memory"); e(acc, u, wr, wc, fr, fq); } };

struct Frame {
    LAS unsigned char* lds; int tid, lane, wave, G, bid;
    const float* const* in; float* out; unsigned char* ws;
};

struct WItem { const float* W; const float* gs; bf16_t* WT; int K, N, kind, r; };
__device__ __forceinline__ WItem witem(Frame& F, int it) {
    constexpr int I_A = 16 * (NIN_A / 32), I_B = 16 * (NIN_B / 32), I_C = 16 * (NIN_C / 32), I_O = (KOUT / 64) * (DM / 32), I_KV = 16 * (DM / 32);
    unsigned char* ws = F.ws; int r = it; WItem w;
    if (r < 2 * I_A) { const int j = r / I_A; r -= j * I_A; w = WItem{GIN(13) + (size_t)j * DM * NIN_A, GIN(8) + (j == 0 ? 0 : 3) * DM, (bf16_t*)(ws + WS_WINA) + (size_t)j * NIN_A * DM, DM, NIN_A, 0, r}; return w; } r -= 2 * I_A;
    if (r < I_B) { w = WItem{GIN(17), GIN(8) + 1 * DM, (bf16_t*)(ws + WS_WINB), DM, NIN_B, 1, r}; return w; } r -= I_B;
    if (r < I_C) { w = WItem{GIN(19), GIN(8) + 2 * DM, (bf16_t*)(ws + WS_WINC), DM, NIN_C, 2, r}; return w; } r -= I_C;
    if (r < 4 * I_O) { const int j = r / I_O; r -= j * I_O; w = WItem{GIN(12) + (size_t)j * KOUT * DM, nullptr, (bf16_t*)(ws + WS_WOUT) + (size_t)j * DM * KOUT, KOUT, DM, 2, r}; return w; } r -= 4 * I_O;
    if (r < 4 * I_KV) { const int j = r / I_KV; r -= j * I_KV; w = WItem{GIN(11) + (size_t)j * DM * DM, GIN(10) + j * DM, (bf16_t*)(ws + WS_WKV) + (size_t)j * DM * DM, DM, DM, 2, r}; return w; } r -= 4 * I_KV;
    w = WItem{GIN(28), nullptr, (bf16_t*)(ws + WS_WGLU), E_, E_, 2, r}; return w;
}
__device__ __forceinline__ void witem_load(const WItem& w, int lane, f32x4 (&x)[8]) {
    const int nblk = w.N / 32, kb = w.r / nblk, nb = w.r % nblk, k0 = 64 * kb, n0 = 32 * nb, n4 = lane & 7, kr = lane >> 3;
    const int sc = src_col(w.kind, n0 + 4 * n4);
#pragma unroll
    for (int i = 0; i < 8; ++i) x[i] = *(const f32x4*)(w.W + (size_t)(k0 + kr + 8 * i) * w.N + sc);
}
__device__ __forceinline__ void witem_finish(const WItem& w, int lane, const f32x4 (&x)[8], LAS float* scr) {
    const int nblk = w.N / 32, kb = w.r / nblk, nb = w.r % nblk, k0 = 64 * kb, n0 = 32 * nb, n4 = lane & 7, kr = lane >> 3;
    asm volatile("s_waitcnt vmcnt(8)" ::: "memory");
#pragma unroll
    for (int i = 0; i < 8; ++i) { const int kk = kr + 8 * i; const float g = w.gs ? w.gs[k0 + kk] : 1.f; LAS float* d = scr + kk * 33 + 4 * n4; d[0] = x[i][0] * g; d[1] = x[i][1] * g; d[2] = x[i][2] * g; d[3] = x[i][3] * g; }
    asm volatile("s_waitcnt lgkmcnt(0)" ::: "memory");
    const int c = lane & 7;
#pragma unroll
    for (int j = 0; j < 4; ++j) { const int n = (lane >> 3) + 8 * j; const LAS float* sp = scr + (8 * c) * 33 + n;
        u32x4 o; o.x = pk2(sp[0 * 33], sp[1 * 33]); o.y = pk2(sp[2 * 33], sp[3 * 33]); o.z = pk2(sp[4 * 33], sp[5 * 33]); o.w = pk2(sp[6 * 33], sp[7 * 33]);
        *(u32x4*)(w.WT + (size_t)(n0 + n) * w.K + k0 + 8 * c) = o; }
    asm volatile("s_waitcnt lgkmcnt(0)" ::: "memory");
}

__device__ __forceinline__ void p0_prologue(Frame& F) {
    LAS float* scr = (LAS float*)(F.lds + F.wave * 16384);
    const int gw = F.bid * NWAVES + F.wave, NGW = F.G * NWAVES, lane = F.lane;
    unsigned char* ws = F.ws;
    constexpr int NITEMS = 2 * 16 * (NIN_A / 32) + 16 * (NIN_B / 32) + 16 * (NIN_C / 32) + 4 * (KOUT / 64) * (DM / 32) + 4 * 16 * (DM / 32) + (E_ / 64) * (E_ / 32);
    if (gw < NITEMS) {
        WItem wc = witem(F, gw); f32x4 xa[8]; witem_load(wc, lane, xa);
        for (int it = gw; it < NITEMS; it += NGW) {
            const int nit = it + NGW < NITEMS ? it + NGW : it; const WItem wn = witem(F, nit); f32x4 xb[8]; witem_load(wn, lane, xb);
            witem_finish(wc, lane, xa, scr);
            wc = wn;
#pragma unroll
            for (int i = 0; i < 8; ++i) xa[i] = xb[i];
        }
    }
    {
        bf16_t* XB = (bf16_t*)(ws + WS_XB); float* SSX = (float*)(ws + WS_SSX);
        for (int row = gw; row < M; row += 2 * NGW) {
            const int row2 = row + NGW < M ? row + NGW : row;
            const float* xr = row < MP ? GIN(0) + (size_t)row * DM : GIN(1) + (size_t)(row - MP) * DM;
            const float* xr2 = row2 < MP ? GIN(0) + (size_t)row2 * DM : GIN(1) + (size_t)(row2 - MP) * DM;
            f32x4 v[4], v2[4];
#pragma unroll
            for (int j = 0; j < 4; ++j) { v[j] = *((const f32x4*)xr + lane + 64 * j); v2[j] = *((const f32x4*)xr2 + lane + 64 * j); }
            float ss = 0.f, ss2 = 0.f;
#pragma unroll
            for (int j = 0; j < 4; ++j) { ss += (v[j][0] * v[j][0] + v[j][1] * v[j][1]) + (v[j][2] * v[j][2] + v[j][3] * v[j][3]); ss2 += (v2[j][0] * v2[j][0] + v2[j][1] * v2[j][1]) + (v2[j][2] * v2[j][2] + v2[j][3] * v2[j][3]);
                u32x2 w; w.x = pk2(v[j][0], v[j][1]); w.y = pk2(v[j][2], v[j][3]); *((u32x2*)(XB + (size_t)row * DM) + lane + 64 * j) = w;
                u32x2 w2; w2.x = pk2(v2[j][0], v2[j][1]); w2.y = pk2(v2[j][2], v2[j][3]); *((u32x2*)(XB + (size_t)row2 * DM) + lane + 64 * j) = w2; }
            asm volatile("s_waitcnt vmcnt(0)" ::: "memory");
            ss = wave_sum(ss); ss2 = wave_sum(ss2);
            if (lane < 16) { SSX[(size_t)row * 16 + lane] = lane == 0 ? ss : 0.f; SSX[(size_t)row2 * 16 + lane] = lane == 0 ? ss2 : 0.f; }
        }
    }
    {
        bf16_t* MB = (bf16_t*)(ws + WS_MEMB); float* RM = (float*)(ws + WS_RSTDM);
        for (int row = gw; row < PB * MEML; row += NGW) {
            const float* xr = GIN(2) + (size_t)row * DM; float ss = 0.f;
#pragma unroll
            for (int j = 0; j < 4; ++j) { const f32x4 v = *((const f32x4*)xr + lane + 64 * j); ss += (v[0] * v[0] + v[1] * v[1]) + (v[2] * v[2] + v[3] * v[3]);
                u32x2 w; w.x = pk2(v[0], v[1]); w.y = pk2(v[2], v[3]); *((u32x2*)(MB + (size_t)row * DM) + lane + 64 * j) = w; }
            asm volatile("s_waitcnt vmcnt(0)" ::: "memory");
            ss = wave_sum(ss);
            if (lane == 0) RM[row] = 1.0f / sqrtf(ss * (1.f / DM) + EPS);
        }
    }
    {
        float* TAB = (float*)(ws + WS_TAB);
        for (int g = gw; g < S5G; g += NGW) {
            const int gp = g * S5P + lane;
            const float lr = GIN(20)[gp], li = GIN(21)[gp], dt = expf(GIN(22)[g]);
            const float th = li * dt, em1 = expm1f(lr * dt), mag = em1 + 1.f, cs = cosf(th), sn = sinf(th), sh = sinf(0.5f * th);
            const float ar = mag * cs, ai = mag * sn;
            const float nr = em1 * cs - 2.f * sh * sh, ni = ai;
            const float den = lr * lr + li * li, cr = (nr * lr + ni * li) / den, ci = (ni * lr - nr * li) / den;
            TAB[T_AR + gp] = ar; TAB[T_AI + gp] = ai;
#pragma unroll
            for (int i = 0; i < S5I; ++i) { const float br = GIN(23)[(size_t)gp * S5I + i], bi = GIN(24)[(size_t)gp * S5I + i];
                TAB[T_BBR + (size_t)gp * S5I + i] = cr * br - ci * bi; TAB[T_BBI + (size_t)gp * S5I + i] = cr * bi + ci * br; }
        }
    }
    {
        bf16_t* SW = (bf16_t*)(ws + WS_SGUW);
        for (int i = (F.bid * NTHR + F.tid); i < 2 * 8 * 128 * 128; i += F.G * NTHR) { const int t = (i >> 7) & 127, s = i & 127; SW[i] = f2bf(s <= t ? GIN(15)[i] : 0.f); }
    }
}

typedef short v4i16_t __attribute__((ext_vector_type(4)));
constexpr int SG_VSTR = 576, SG_WSTR = 272, SG_WOFF = 128 * SG_VSTR, SG_ROFF = SG_WOFF + 128 * SG_WSTR;
static_assert(SG_ROFF + 1024 <= RING_BYTES, "sgu LDS");
__device__ __forceinline__ void sgu_phase_mfma(Frame& F, int j) {
    const bf16_t* UZ = (const bf16_t*)(F.ws + WS_B0); const bf16_t* VR = (const bf16_t*)(F.ws + WS_B1); const float* SSV = (const float*)(F.ws + WS_SSV);
    const bf16_t* SW = (const bf16_t*)(F.ws + WS_SGUW) + (size_t)j * 8 * 128 * 128; bf16_t* A2 = (bf16_t*)(F.ws + WS_A2);
    const float* gn = GIN(14) + (size_t)j * E_; const float* bsv = GIN(16) + (size_t)j * 8 * 128;
    LAS unsigned char* lds = F.lds; LAS float* rsl = (LAS float*)(lds + SG_ROFF);
    const int tid = F.tid, lane = F.lane, wid = F.wave, c = lane & 31, hh = lane >> 5;
    const bool same_g = (F.G & 7) == 0; int gld = -1, cur = 0;
    u32x4 vr[8];
    { const int un = F.bid; if (un < 128 * 8) { const int rbase = (un >> 3) * 128, g = un & 7;
#pragma unroll
        for (int i = 0; i < 8; ++i) { const int chn = tid + NTHR * i; vr[i] = *(const u32x4*)(VR + (size_t)(rbase + (chn >> 5)) * E_ + 256 * g + 8 * (chn & 31)); }
        __syncthreads();
        if (tid < 128) { const float* p = SSV + (size_t)(rbase + tid) * 32; float sq = 0.f;
#pragma unroll
            for (int k = 0; k < 8; ++k) { const f32x4 v = *((const f32x4*)p + k); sq += (v[0] + v[1]) + (v[2] + v[3]); }
            rsl[tid] = __builtin_amdgcn_rsqf(sq * (1.f / E_) + EPS); } } }
    for (int un = F.bid; un < 128 * 8; un += F.G) {
        const int ch = un >> 3, g = un & 7, rbase = ch * 128; const int nun = un + F.G < 128 * 8 ? un + F.G : un, nrb = (nun >> 3) * 128, ng = nun & 7;
        asm volatile("s_waitcnt vmcnt(0)" ::: "memory");
        __syncthreads();
        if (!same_g || gld != g) { gld = g;
#pragma unroll
            for (int i = 0; i < 4; ++i) { const int chn = tid + NTHR * i, row = chn >> 4, c16 = chn & 15;
                *(LAS u32x4*)(lds + SG_WOFF + row * SG_WSTR + c16 * 16) = *(const u32x4*)(SW + (size_t)g * 128 * 128 + row * 128 + c16 * 8); } }
#pragma unroll
        for (int i = 0; i < 8; ++i) { const int chn = tid + NTHR * i, sr = chn >> 5, c8 = chn & 31; float v[8]; unpack8(vr[i], v);
            const float r = rsl[cur * 128 + sr]; const f32x4 g0 = *(const f32x4*)(gn + 256 * g + 8 * c8), g1 = *(const f32x4*)(gn + 256 * g + 8 * c8 + 4); f32x4 a, b2;
#pragma unroll
            for (int e = 0; e < 4; ++e) { a[e] = v[e] * r * g0[e]; b2[e] = v[4 + e] * r * g1[e]; }
            *(LAS u32x4*)(lds + sr * SG_VSTR + c8 * 16) = pack8(a, b2); }
#pragma unroll
        for (int i = 0; i < 8; ++i) { const int chn = tid + NTHR * i; vr[i] = *(const u32x4*)(VR + (size_t)(nrb + (chn >> 5)) * E_ + 256 * ng + 8 * (chn & 31)); }
        if (tid < 128) { const float* p = SSV + (size_t)(nrb + tid) * 32; float sq = 0.f;
#pragma unroll
            for (int k = 0; k < 8; ++k) { const f32x4 v = *((const f32x4*)p + k); sq += (v[0] + v[1]) + (v[2] + v[3]); }
            rsl[(cur ^ 1) * 128 + tid] = __builtin_amdgcn_rsqf(sq * (1.f / E_) + EPS); }
        u32x2 uzr[4][4];
#pragma unroll
        for (int ti = 0; ti < 4; ++ti)
#pragma unroll
            for (int g4 = 0; g4 < 4; ++g4) uzr[ti][g4] = *(const u32x2*)(UZ + (size_t)(rbase + 32 * ti + c) * E_ + 256 * g + 32 * wid + 8 * g4 + 4 * hh);
        __syncthreads();
        f32x16 acc[4];
#pragma unroll
        for (int ti = 0; ti < 4; ++ti) acc[ti] = (f32x16){};
        const LAS unsigned char* abase = lds + (8 * hh + ((lane & 15) >> 2)) * SG_VSTR + (32 * wid + 16 * ((lane >> 4) & 1) + 4 * (lane & 3)) * 2;
#pragma unroll
        for (int s2 = 0; s2 < 8; ++s2) {
            const v4i16_t lo = __builtin_amdgcn_ds_read_tr16_b64_v4i16((LAS v4i16_t*)(abase + (16 * s2) * SG_VSTR));
            const v4i16_t hi = __builtin_amdgcn_ds_read_tr16_b64_v4i16((LAS v4i16_t*)(abase + (16 * s2 + 4) * SG_VSTR));
            const bf16x8 a = (bf16x8){lo[0], lo[1], lo[2], lo[3], hi[0], hi[1], hi[2], hi[3]};
#pragma unroll
            for (int ti = s2 >> 1; ti < 4; ++ti) { const bf16x8 b = *(const LAS bf16x8*)(lds + SG_WOFF + (32 * ti + c) * SG_WSTR + (16 * s2 + 8 * hh) * 2);
                acc[ti] = __builtin_amdgcn_mfma_f32_32x32x16_bf16(a, b, acc[ti], 0, 0, 0); }
        }
#pragma unroll
        for (int ti = 0; ti < 4; ++ti) { const int t = 32 * ti + c; const size_t row = (size_t)(rbase + t); const float bias = bsv[g * 128 + t];
#pragma unroll
            for (int g4 = 0; g4 < 4; ++g4) { const int d = 256 * g + 32 * wid + 8 * g4 + 4 * hh; const u32x2 uz = uzr[ti][g4];
                u32x2 w; w.x = pk2(bflo(uz.x) * (acc[ti][4 * g4] + bias), bfhi(uz.x) * (acc[ti][4 * g4 + 1] + bias)); w.y = pk2(bflo(uz.y) * (acc[ti][4 * g4 + 2] + bias), bfhi(uz.y) * (acc[ti][4 * g4 + 3] + bias));
                *(u32x2*)(A2 + row * KOUT + d) = w; } }
        cur ^= 1;
    }
}

__device__ __forceinline__ void sgu_sample_phase(Frame& F, int j) {
    const bf16_t* UZ = (const bf16_t*)(F.ws + WS_B0); const bf16_t* VR = (const bf16_t*)(F.ws + WS_B1); const float* SSV = (const float*)(F.ws + WS_SSV);
    const bf16_t* SW = (const bf16_t*)(F.ws + WS_SGUW) + (size_t)j * 8 * 128 * 128; bf16_t* A2 = (bf16_t*)(F.ws + WS_A2);
    const float* gn = GIN(14) + (size_t)j * E_; const float* bsv = GIN(16) + (size_t)j * 8 * 128; float* cvout = F.out + O_CV + (size_t)j * SBT * SSEQ * E_;
    const int gw = F.bid * NWAVES + F.wave, NGW = F.G * NWAVES, lane = F.lane;
    for (int task = gw; task < SBT * 8; task += NGW) {
        const int b = task >> 3, g = task & 7; const size_t r0 = (size_t)MP + b * SSEQ; const int ch = 256 * g + 4 * lane;
        float rs[SSEQ];
#pragma unroll
        for (int t = 0; t < SSEQ; ++t) { float v = lane < 32 ? SSV[(r0 + t) * 32 + lane] : 0.f; v = wave_sum(v); rs[t] = __builtin_amdgcn_rsqf(v * (1.f / E_) + EPS); }
        const f32x4 g4 = *(const f32x4*)(gn + ch);
        f32x4 vn[SSEQ];
#pragma unroll
        for (int t = 0; t < SSEQ; ++t) { const u32x2 w = *(const u32x2*)(VR + (r0 + t) * E_ + ch); const f32x4 v = (f32x4){bflo(w.x), bfhi(w.x), bflo(w.y), bfhi(w.y)}; vn[t] = v * rs[t] * g4;
            *(f32x4*)(cvout + (size_t)(b * SSEQ + t) * E_ + ch) = vn[t];
            u32x2 q; q.x = pk2(vn[t][0], vn[t][1]); q.y = pk2(vn[t][2], vn[t][3]); vn[t] = (f32x4){bflo(q.x), bfhi(q.x), bflo(q.y), bfhi(q.y)}; }
#pragma unroll
        for (int t = 0; t < SSEQ; ++t) { f32x4 a = {0.f, 0.f, 0.f, 0.f};
#pragma unroll
            for (int sq = 0; sq <= t; ++sq) a += vn[sq] * bf2f(SW[(size_t)g * 128 * 128 + t * 128 + sq]);
            a += bsv[g * 128 + t];
            const u32x2 uz = *(const u32x2*)(UZ + (r0 + t) * E_ + ch);
            u32x2 w; w.x = pk2(bflo(uz.x) * a[0], bfhi(uz.x) * a[1]); w.y = pk2(bflo(uz.y) * a[2], bfhi(uz.y) * a[3]);
            *(u32x2*)(A2 + (r0 + t) * KOUT + ch) = w; }
    }
}

__device__ __forceinline__ void conv_phase(Frame& F) {
    const bf16_t* P = (const bf16_t*)(F.ws + WS_B0); const bf16_t* G = (const bf16_t*)(F.ws + WS_B1); bf16_t* A2 = (bf16_t*)(F.ws + WS_A2);
    const float* cw = GIN(18); const float* st = GIN(5);
    for (int i = F.bid * NTHR + F.tid; i < (M / 32) * 256; i += F.G * NTHR) {
        const int seg = i >> 8, c0 = (i & 255) * 8, r0 = seg * 32;
        float w0[8], w1[8], w2[8];
#pragma unroll
        for (int e = 0; e < 8; ++e) { w0[e] = cw[c0 + e]; w1[e] = cw[E_ + c0 + e]; w2[e] = cw[2 * E_ + c0 + e]; }
        float x1[8], x2[8];
        if (r0 < MP) { if ((r0 & (PSEQ - 1)) == 0) { for (int e = 0; e < 8; ++e) { x1[e] = 0.f; x2[e] = 0.f; } }
                       else { unpack8(*(const u32x4*)(P + (size_t)(r0 - 1) * E_ + c0), x1); unpack8(*(const u32x4*)(P + (size_t)(r0 - 2) * E_ + c0), x2); } }
#pragma unroll 4
        for (int rr = 0; rr < 32; ++rr) {
            const int row = r0 + rr;
            if (row >= MP && ((row - MP) & 3) == 0) { const float* buf = st + (size_t)((row - MP) >> 2) * 2 * E_ + c0;
                for (int e = 0; e < 8; ++e) { x2[e] = buf[e]; x1[e] = buf[E_ + e]; } }
            float x0[8], gg[8]; unpack8(*(const u32x4*)(P + (size_t)row * E_ + c0), x0); unpack8(*(const u32x4*)(G + (size_t)row * E_ + c0), gg);
            f32x4 o0, o1;
#pragma unroll
            for (int e = 0; e < 8; ++e) { const float y = w0[e] * x2[e] + w1[e] * x1[e] + w2[e] * x0[e]; const float r = y * gg[e]; if (e < 4) o0[e] = r; else o1[e - 4] = r; x2[e] = x1[e]; x1[e] = x0[e]; }
            *(u32x4*)(A2 + (size_t)row * KOUT + c0) = pack8(o0, o1);
        }
    }
}

#if XHALF_SHFL
__device__ __forceinline__ void xhalf(float v, float& lo, float& hi) { const int l_ = threadIdx.x & 31; lo = __shfl(v, l_); hi = __shfl(v, l_ + 32); }
#else
__device__ __forceinline__ void xhalf(float v, float& lo, float& hi) { auto rr = __builtin_amdgcn_permlane32_swap(__float_as_uint(v), __float_as_uint(v), false, false); lo = __uint_as_float(rr[0]); hi = __uint_as_float(rr[1]);
 }
#endif
__device__ __forceinline__ void cmuladd(float& xr, float& xi, float ar, float ai, float pr, float pi) { float t = fmaf(-ai, pi, xr); asm("" : "+v"(t)); xr = fmaf(ar, pr, t); xi = fmaf(ar, pi, fmaf(ai, pr, xi)); }
constexpr int S5_HSTR = 272, S5_UOFF = 32 * S5_HSTR, S5_OOFF = S5_UOFF + 1024, S5_HT = S5_OOFF + 4096;
__device__ __forceinline__ void s5_prompt_mfma(Frame& F) {
    const bf16_t* U = (const bf16_t*)(F.ws + WS_B0); bf16_t* GBo = (bf16_t*)(F.ws + WS_GB); const float* TAB = (const float*)(F.ws + WS_TAB);
    const float* cre = GIN(25); const float* cim = GIN(26); const float* dsk = GIN(27);
    const int lane = F.lane, wid = F.wave, c = lane & 31, hh = lane >> 5, col = lane & 15, fq = lane >> 4;
    LAS unsigned char* ht = F.lds + wid * S5_HT;
    for (int task = F.bid * NWAVES + wid; task < PB * S5G; task += F.G * NWAVES) {
        const int b = task >> 7, g = task & 127;
        bf16x8 bfr[2], bfi[2];
#pragma unroll
        for (int st = 0; st < 2; ++st) { const int gp = g * S5P + 32 * st + c;
            const float* pr = TAB + T_BBR + (size_t)gp * 16 + 8 * hh; const float* pi = TAB + T_BBI + (size_t)gp * 16 + 8 * hh;
            bfr[st] = __builtin_bit_cast(bf16x8, pack8(*(const f32x4*)pr, *(const f32x4*)(pr + 4))); bfi[st] = __builtin_bit_cast(bf16x8, pack8(*(const f32x4*)pi, *(const f32x4*)(pi + 4))); }
        const float a1r = TAB[T_AR + g * S5P + lane], a1i = TAB[T_AI + g * S5P + lane];
        bf16x8 cf[4];
#pragma unroll
        for (int s4 = 0; s4 < 4; ++s4) { const size_t o = ((size_t)g * 16 + col) * S5P + 16 * s4 + 4 * fq; const f32x4 cr4 = *(const f32x4*)(cre + o), ci4 = *(const f32x4*)(cim + o);
            u32x4 w; w.x = pk2(cr4[0], -ci4[0]); w.y = pk2(cr4[1], -ci4[1]); w.z = pk2(cr4[2], -ci4[2]); w.w = pk2(cr4[3], -ci4[3]); cf[s4] = __builtin_bit_cast(bf16x8, w); }
        const f32x4 d4 = *(const f32x4*)(dsk + 16 * g + 4 * fq);
        float er = 0.f, ei = 0.f;
        const bf16_t* up = U + ((size_t)b * PSEQ + c) * E_ + 16 * g + 8 * hh;
        bf16x8 ub[4];
#pragma unroll
        for (int q = 0; q < 4; ++q) ub[q] = *(const GAS bf16x8*)(up + (size_t)q * 32 * E_);
        for (int tg = 0; tg < PSEQ / 128; ++tg) {
          bf16x8 nb[4];
#pragma unroll
          for (int q = 0; q < 4; ++q) nb[q] = *(const GAS bf16x8*)(up + (size_t)(4 * (tg + 1 < PSEQ / 128 ? tg + 1 : tg) + q) * 32 * E_);
#pragma unroll
          for (int q = 0; q < 4; ++q) {
            const int ti = 4 * tg + q; const bf16x8 ua = ub[q];
            *(LAS bf16x8*)(ht + S5_UOFF + c * 32 + hh * 16) = ua;
            {
                const f32x16 x0r = __builtin_amdgcn_mfma_f32_32x32x16_bf16(ua, bfr[0], (f32x16){}, 0, 0, 0);
                const f32x16 x1r = __builtin_amdgcn_mfma_f32_32x32x16_bf16(ua, bfr[1], (f32x16){}, 0, 0, 0);
                const f32x16 x0i = __builtin_amdgcn_mfma_f32_32x32x16_bf16(ua, bfi[0], (f32x16){}, 0, 0, 0);
                const f32x16 x1i = __builtin_amdgcn_mfma_f32_32x32x16_bf16(ua, bfi[1], (f32x16){}, 0, 0, 0);
#pragma unroll
                for (int k = 0; k < 4; ++k) {
                    float tr[8], tq[8];
#pragma unroll
                    for (int jj = 0; jj < 4; ++jj) {
                        auto sr = __builtin_amdgcn_permlane32_swap(__float_as_uint(x0r[4 * k + jj]), __float_as_uint(x1r[4 * k + jj]), false, false);
                        auto sq = __builtin_amdgcn_permlane32_swap(__float_as_uint(x0i[4 * k + jj]), __float_as_uint(x1i[4 * k + jj]), false, false);
                        tr[jj] = __uint_as_float(sr[0]); tr[4 + jj] = __uint_as_float(sr[1]); tq[jj] = __uint_as_float(sq[0]); tq[4 + jj] = __uint_as_float(sq[1]); }
#pragma unroll
                    for (int j = 0; j < 8; ++j) { float nr = tr[j], ni = tq[j]; cmuladd(nr, ni, a1r, a1i, er, ei); er = nr; ei = ni;
                        *(LAS unsigned*)(ht + (8 * k + j) * S5_HSTR + 4 * lane) = pk2(er, ei); }
                }
            }
            asm volatile("" ::: "memory");
#pragma unroll
            for (int tt = 0; tt < 2; ++tt) {
                f32x4 y = {0.f, 0.f, 0.f, 0.f};
#pragma unroll
                for (int s4 = 0; s4 < 4; ++s4) { const bf16x8 hb = *(const LAS bf16x8*)(ht + (16 * tt + col) * S5_HSTR + (32 * s4 + 8 * fq) * 2); y = __builtin_amdgcn_mfma_f32_16x16x32_bf16(cf[s4], hb, y, 0, 0, 0); }
                const size_t row = (size_t)b * PSEQ + 32 * ti + 16 * tt + col; const u32x2 uw = *(const LAS u32x2*)(ht + S5_UOFF + (16 * tt + col) * 32 + fq * 8);
                u32x2 w; w.x = pk2(gelu_tanh(y[0] + d4[0] * bflo(uw.x)), gelu_tanh(y[1] + d4[1] * bfhi(uw.x))); w.y = pk2(gelu_tanh(y[2] + d4[2] * bflo(uw.y)), gelu_tanh(y[3] + d4[3] * bfhi(uw.y)));
                *(LAS u32x2*)(ht + S5_OOFF + q * 1024 + (16 * tt + col) * 32 + fq * 8) = w;
            }
            asm volatile("" ::: "memory");
          }
#pragma unroll
          for (int q = 0; q < 4; ++q)
#pragma unroll
            for (int tt = 0; tt < 2; ++tt) *(GAS u32x2*)(GBo + ((size_t)b * PSEQ + 32 * (4 * tg + q) + 16 * tt + col) * E_ + 16 * g + 4 * fq) = *(const LAS u32x2*)(ht + S5_OOFF + q * 1024 + (16 * tt + col) * 32 + fq * 8);
          asm volatile("s_waitcnt vmcnt(0)" ::: "memory");
#pragma unroll
          for (int q = 0; q < 4; ++q) ub[q] = nb[q];
        }
        const size_t so = ((size_t)b * S5G + g) * S5P + lane;
        F.out[O_SRP + so] = er; F.out[O_SIP + so] = ei;
    }
}

__device__ __forceinline__ void s5_sample_mfma(Frame& F) {
    const bf16_t* U = (const bf16_t*)(F.ws + WS_B0); bf16_t* GBo = (bf16_t*)(F.ws + WS_GB); const float* TAB = (const float*)(F.ws + WS_TAB);
    const float* cre = GIN(25); const float* cim = GIN(26); const float* dsk = GIN(27); const float* h0re = GIN(6); const float* h0im = GIN(7);
    const int lane = F.lane, wid = F.wave, c = lane & 31, hh = lane >> 5, col = lane & 15, fq = lane >> 4;
    LAS unsigned char* ht = F.lds + wid * S5_HT;
    for (int task = F.bid * NWAVES + wid; task < S5G * (MS / 64); task += F.G * NWAVES) {
        const int g = task & (S5G - 1), tp = task >> 7;
        bf16x8 bfr[2], bfi[2];
#pragma unroll
        for (int st = 0; st < 2; ++st) { const int gp = g * S5P + 32 * st + c;
            const float* pr = TAB + T_BBR + (size_t)gp * 16 + 8 * hh; const float* pi = TAB + T_BBI + (size_t)gp * 16 + 8 * hh;
            bfr[st] = __builtin_bit_cast(bf16x8, pack8(*(const f32x4*)pr, *(const f32x4*)(pr + 4))); bfi[st] = __builtin_bit_cast(bf16x8, pack8(*(const f32x4*)pi, *(const f32x4*)(pi + 4))); }
        const float a1r = TAB[T_AR + g * S5P + lane], a1i = TAB[T_AI + g * S5P + lane];
        bf16x8 cf[4];
#pragma unroll
        for (int s4 = 0; s4 < 4; ++s4) { const size_t o = ((size_t)g * 16 + col) * S5P + 16 * s4 + 4 * fq; const f32x4 cr4 = *(const f32x4*)(cre + o), ci4 = *(const f32x4*)(cim + o);
            u32x4 w; w.x = pk2(cr4[0], -ci4[0]); w.y = pk2(cr4[1], -ci4[1]); w.z = pk2(cr4[2], -ci4[2]); w.w = pk2(cr4[3], -ci4[3]); cf[s4] = __builtin_bit_cast(bf16x8, w); }
        const f32x4 d4 = *(const f32x4*)(dsk + 16 * g + 4 * fq);
#pragma unroll 1
        for (int q = 0; q < 2; ++q) {
            const int tile = 2 * tp + q; const bf16x8 ua = *(const GAS bf16x8*)(U + ((size_t)MP + 32 * tile + c) * E_ + 16 * g + 8 * hh);
            float sr[8], sq[8];
#pragma unroll
            for (int rr = 0; rr < 8; ++rr) { const size_t so = ((size_t)(8 * tile + rr) * S5G + g) * S5P + lane; sr[rr] = *(const GAS float*)(h0re + so); sq[rr] = *(const GAS float*)(h0im + so); }
            *(LAS bf16x8*)(ht + S5_UOFF + c * 32 + hh * 16) = ua;
            {
                const f32x16 x0r = __builtin_amdgcn_mfma_f32_32x32x16_bf16(ua, bfr[0], (f32x16){}, 0, 0, 0);
                const f32x16 x1r = __builtin_amdgcn_mfma_f32_32x32x16_bf16(ua, bfr[1], (f32x16){}, 0, 0, 0);
                const f32x16 x0i = __builtin_amdgcn_mfma_f32_32x32x16_bf16(ua, bfi[0], (f32x16){}, 0, 0, 0);
                const f32x16 x1i = __builtin_amdgcn_mfma_f32_32x32x16_bf16(ua, bfi[1], (f32x16){}, 0, 0, 0);
#pragma unroll
                for (int k = 0; k < 4; ++k) {
                    float tr[8], tq[8];
#pragma unroll
                    for (int jj = 0; jj < 4; ++jj) {
                        auto s_r = __builtin_amdgcn_permlane32_swap(__float_as_uint(x0r[4 * k + jj]), __float_as_uint(x1r[4 * k + jj]), false, false);
                        auto s_q = __builtin_amdgcn_permlane32_swap(__float_as_uint(x0i[4 * k + jj]), __float_as_uint(x1i[4 * k + jj]), false, false);
                        tr[jj] = __uint_as_float(s_r[0]); tr[4 + jj] = __uint_as_float(s_r[1]); tq[jj] = __uint_as_float(s_q[0]); tq[4 + jj] = __uint_as_float(s_q[1]); }
#pragma unroll
                    for (int j = 0; j < 8; ++j) { const int rr = 2 * k + (j >> 2); float nr = tr[j], ni = tq[j]; cmuladd(nr, ni, a1r, a1i, sr[rr], sq[rr]); sr[rr] = nr; sq[rr] = ni;
                        *(LAS unsigned*)(ht + (8 * k + j) * S5_HSTR + 4 * lane) = pk2(nr, ni); }
                }
            }
            asm volatile("s_waitcnt vmcnt(0)" ::: "memory");
            u32x2 w[2];
#pragma unroll
            for (int tt = 0; tt < 2; ++tt) {
                f32x4 y = {0.f, 0.f, 0.f, 0.f};
#pragma unroll
                for (int s4 = 0; s4 < 4; ++s4) { const bf16x8 hb = *(const LAS bf16x8*)(ht + (16 * tt + col) * S5_HSTR + (32 * s4 + 8 * fq) * 2); y = __builtin_amdgcn_mfma_f32_16x16x32_bf16(cf[s4], hb, y, 0, 0, 0); }
                const u32x2 uw = *(const LAS u32x2*)(ht + S5_UOFF + (16 * tt + col) * 32 + fq * 8);
                w[tt].x = pk2(gelu_tanh(y[0] + d4[0] * bflo(uw.x)), gelu_tanh(y[1] + d4[1] * bfhi(uw.x))); w[tt].y = pk2(gelu_tanh(y[2] + d4[2] * bflo(uw.y)), gelu_tanh(y[3] + d4[3] * bfhi(uw.y)));
            }
            asm volatile("s_waitcnt lgkmcnt(0)" ::: "memory");
#pragma unroll
            for (int tt = 0; tt < 2; ++tt) *(GAS u32x2*)(GBo + ((size_t)MP + 32 * tile + 16 * tt + col) * E_ + 16 * g + 4 * fq) = w[tt];
#pragma unroll
            for (int rr = 0; rr < 8; ++rr) { const size_t so = ((size_t)(8 * tile + rr) * S5G + g) * S5P + lane; *(GAS float*)(F.out + O_SRS + so) = sr[rr]; *(GAS float*)(F.out + O_SIS + so) = sq[rr]; }
        }
        asm volatile("s_waitcnt vmcnt(0)" ::: "memory");
    }
}

constexpr int AK_STR = 272, AV_STR = 520, AV_OFF = 256 * AK_STR;
static_assert(AV_OFF + 128 * AV_STR <= RING_BYTES + 8192, "attention LDS");
__device__ __forceinline__ void attn_prompt_phase(Frame& F, int layer) {
    const bf16_t* QB = (const bf16_t*)(F.ws + WS_QB); const bf16_t* KBp = (const bf16_t*)(F.ws + WS_KB); const bf16_t* VTp = (const bf16_t*)(F.ws + WS_VT); bf16_t* A2 = (bf16_t*)(F.ws + WS_A2);
    const int tid = F.tid, lane = F.lane, wid = F.wave, c = lane & 31, hh = lane >> 5;
    LAS unsigned char* lds = F.lds;
    for (int un = F.bid; un < PB * NH * 8; un += F.G) {
        const int bh = un >> 3, qb = un & 7, b = bh >> 2, h = bh & 3;
        const bf16_t* Kg = KBp + (size_t)((layer * PB + b) * NH + h) * MEML * HD; const bf16_t* Vg = VTp + (size_t)((layer * PB + b) * NH + h) * MEML * HD;
        __syncthreads();
        { u32x4 kr[8], vr[8];
#pragma unroll
          for (int i = 0; i < 8; ++i) { const int chn = tid + NTHR * i; kr[i] = *(const u32x4*)(Kg + (chn >> 4) * HD + (chn & 15) * 8); vr[i] = *(const u32x4*)(Vg + (chn >> 5) * MEML + (chn & 31) * 8); }
#pragma unroll
          for (int i = 0; i < 8; ++i) { const int chn = tid + NTHR * i, row = chn >> 4, c16 = chn & 15; *(LAS u32x4*)(lds + row * AK_STR + c16 * 16) = kr[i]; }
#pragma unroll
          for (int i = 0; i < 8; ++i) { const int chn = tid + NTHR * i, row = chn >> 5, c16 = chn & 31; const u32x4 v = vr[i];
            LAS u32x2* p = (LAS u32x2*)(lds + AV_OFF + row * AV_STR + c16 * 16); u32x2 lo, hi; lo.x = v.x; lo.y = v.y; hi.x = v.z; hi.y = v.w; p[0] = lo; p[1] = hi; } }
        __syncthreads();
        const size_t qrow = (size_t)b * PSEQ + qb * 256 + wid * 32 + c;
        f32x16 S[8];
#pragma unroll
        for (int kt = 0; kt < 8; ++kt) S[kt] = (f32x16){};
#pragma unroll
        for (int s = 0; s < 8; ++s) {
            const bf16x8 qf = *(const bf16x8*)(QB + qrow * XA + h * HD + 16 * s + 8 * hh);
#pragma unroll
            for (int kt = 0; kt < 8; ++kt) { const bf16x8 kf = *(const LAS bf16x8*)(lds + (32 * kt + c) * AK_STR + (16 * s + 8 * hh) * 2); S[kt] = __builtin_amdgcn_mfma_f32_32x32x16_bf16(kf, qf, S[kt], 0, 0, 0); }
        }
        float mx = -3.0e38f;
#pragma unroll
        for (int kt = 0; kt < 8; ++kt)
#pragma unroll
            for (int r = 0; r < 16; ++r) mx = fmaxf(mx, S[kt][r]);
        mx = fmaxf(mx, __shfl_xor(mx, 32));
        float sum = 0.f; bf16x8 pf[8][2];
#pragma unroll
        for (int kt = 0; kt < 8; ++kt) {
            float p[16];
#pragma unroll
            for (int r = 0; r < 16; ++r) { p[r] = __expf(S[kt][r] - mx); sum += p[r]; }
#pragma unroll
            for (int s2 = 0; s2 < 2; ++s2) { u32x4 w; w.x = pk2(p[8 * s2], p[8 * s2 + 1]); w.y = pk2(p[8 * s2 + 2], p[8 * s2 + 3]); w.z = pk2(p[8 * s2 + 4], p[8 * s2 + 5]); w.w = pk2(p[8 * s2 + 6], p[8 * s2 + 7]);
                pf[kt][s2] = __builtin_bit_cast(bf16x8, w); }
        }
        sum += __shfl_xor(sum, 32);
        const float inv = 1.f / sum;
        bf16_t* orow = A2 + qrow * KOUT + E_ + h * HD;
#pragma unroll
        for (int dt = 0; dt < 4; ++dt) {
            f32x16 o = {};
#pragma unroll
            for (int kt = 0; kt < 8; ++kt)
#pragma unroll
                for (int s2 = 0; s2 < 2; ++s2) {
                    const LAS unsigned char* vb = lds + AV_OFF + (32 * dt + c) * AV_STR + (32 * kt + 16 * s2 + 4 * hh) * 2;
                    const u32x2 lo = *(const LAS u32x2*)vb, hi = *(const LAS u32x2*)(vb + 16);
                    u32x4 w; w.x = lo.x; w.y = lo.y; w.z = hi.x; w.w = hi.y;
                    o = __builtin_amdgcn_mfma_f32_32x32x16_bf16(__builtin_bit_cast(bf16x8, w), pf[kt][s2], o, 0, 0, 0);
                }
#pragma unroll
            for (int g4 = 0; g4 < 4; ++g4) { u32x2 w; w.x = pk2(o[4 * g4] * inv, o[4 * g4 + 1] * inv); w.y = pk2(o[4 * g4 + 2] * inv, o[4 * g4 + 3] * inv);
                *(u32x2*)(orow + 32 * dt + 8 * g4 + 4 * hh) = w; }
        }
    }
}

__device__ __forceinline__ void attn_sample_phase(Frame& F, int layer) {
    const bf16_t* QB = (const bf16_t*)(F.ws + WS_QB); bf16_t* A2 = (bf16_t*)(F.ws + WS_A2);
    const float* CK = GIN(3) + (size_t)layer * SBT * MEML * XA; const float* CV = GIN(4) + (size_t)layer * SBT * MEML * XA;
    LAS float* sl = (LAS float*)F.lds;
    LAS float* pt = (LAS float*)(F.lds + 4096);
    LAS float* ol = (LAS float*)(F.lds + 8192);
    const int tid = F.tid, lane = F.lane, wid = F.wave, par = lane >> 5, d4 = lane & 31;
    const size_t lane_off = ((size_t)(32 * wid + par) * NH) * HD + 4 * d4;
    const bool b4 = (lane & 16) != 0, b3 = (lane & 8) != 0;
#define AS_Q(q4, b_, h_) do { _Pragma("unroll") for (int qi = 0; qi < 4; ++qi) { const u32x2 w = *(const u32x2*)(QB + (size_t)(MP + (b_) * 4 + qi) * XA + (h_) * HD + 4 * d4); q4[qi] = (f32x4){bflo(w.x), bfhi(w.x), bflo(w.y), bfhi(w.y)}; } } while (0)
#define AS_LOADROWS(dst, base, b_, h_) do { const size_t o_ = (size_t)(b_) * MEML * XA + (size_t)(h_) * HD + lane_off; _Pragma("unroll") for (int j = 0; j < 16; ++j) dst[j] = *(const f32x4*)((base) + o_ + (size_t)j * 2 * XA); } while (0)
#define AS_SCORES(q4) do { _Pragma("unroll") for (int j = 0; j < 16; ++j) { float v[4]; \
            _Pragma("unroll") for (int qi = 0; qi < 4; ++qi) v[qi] = (kr[j][0] * q4[qi][0] + kr[j][1] * q4[qi][1]) + (kr[j][2] * q4[qi][2] + kr[j][3] * q4[qi][3]); \
            const float w0 = (b4 ? v[2] : v[0]) + __shfl_xor(b4 ? v[0] : v[2], 16), w1 = (b4 ? v[3] : v[1]) + __shfl_xor(b4 ? v[1] : v[3], 16); \
            float z = (b3 ? w1 : w0) + __shfl_xor(b3 ? w0 : w1, 8); \
            z += __shfl_xor(z, 4); z += __shfl_xor(z, 2); z += __shfl_xor(z, 1); \
            if ((lane & 7) == 0) sl[(2 * (int)b4 + (int)b3) * 256 + 32 * wid + 2 * j + par] = z; } } while (0)
#define AS_SOFTMAX() do { if (wid < 4) { float v[4], mx = -3.0e38f; \
            _Pragma("unroll") for (int j = 0; j < 4; ++j) { v[j] = sl[wid * 256 + lane + 64 * j]; mx = fmaxf(mx, v[j]); } \
            mx = wave_max(mx); float sm = 0.f; \
            _Pragma("unroll") for (int j = 0; j < 4; ++j) { v[j] = __expf(v[j] - mx); sm += v[j]; } \
            sm = wave_sum(sm); const float inv = 1.f / sm; \
            _Pragma("unroll") for (int j = 0; j < 4; ++j) pt[(lane + 64 * j) * 4 + wid] = v[j] * inv; } } while (0)
#define AS_PV() do { f32x4 o[4]; _Pragma("unroll") for (int qi = 0; qi < 4; ++qi) o[qi] = (f32x4){0.f, 0.f, 0.f, 0.f}; \
            _Pragma("unroll") for (int j = 0; j < 16; ++j) { const f32x4 p = *(const LAS f32x4*)(pt + (32 * wid + 2 * j + par) * 4); \
                _Pragma("unroll") for (int qi = 0; qi < 4; ++qi) o[qi] += vr[j] * p[qi]; } \
            _Pragma("unroll") for (int qi = 0; qi < 4; ++qi) { _Pragma("unroll") for (int e = 0; e < 4; ++e) o[qi][e] += __shfl_xor(o[qi][e], 32); \
                if (par == 0) *(LAS f32x4*)(ol + (wid * 4 + qi) * 128 + 4 * d4) = o[qi]; } } while (0)
#define AS_OUT(b_, h_) do { const int qi = tid >> 7, d = tid & 127; float acc = 0.f; _Pragma("unroll") for (int w = 0; w < 8; ++w) acc += ol[(w * 4 + qi) * 128 + d]; \
            A2[(size_t)(MP + (b_) * 4 + qi) * KOUT + E_ + (h_) * HD + d] = f2bf(acc); } while (0)
    for (int un = F.bid; un < SBT * NH; un += 2 * F.G) {
        const int unb = un + F.G < SBT * NH ? un + F.G : un; const int ba = un >> 2, ha = un & 3, bb = unb >> 2, hb = unb & 3;
        asm volatile("s_waitcnt vmcnt(0)" ::: "memory");
        f32x4 kr[16], vr[16], q4[4];
        AS_LOADROWS(kr, CK, ba, ha); AS_LOADROWS(vr, CV, ba, ha); AS_Q(q4, ba, ha);
        __syncthreads();
        AS_SCORES(q4);
        AS_LOADROWS(kr, CK, bb, hb);
        __syncthreads();
        AS_SOFTMAX();
        __syncthreads();
        AS_PV();
        __syncthreads();
        AS_Q(q4, bb, hb);
        AS_OUT(ba, ha);
        AS_LOADROWS(vr, CV, bb, hb);
        asm volatile("s_waitcnt vmcnt(16)" ::: "memory");
        AS_SCORES(q4);
        __syncthreads();
        AS_SOFTMAX();
        __syncthreads();
        AS_PV();
        __syncthreads();
        AS_OUT(bb, hb);
    }
#undef AS_Q
#undef AS_LOADROWS
#undef AS_SCORES
#undef AS_SOFTMAX
#undef AS_PV
#undef AS_OUT
}

constexpr int NK_OUT = 5, NK_OUT_LAST = 10, NK_GLU = 8;
__device__ __forceinline__ void fixup_out_rows(Frame& F, const float* basef  , int vb, int nvb  , int nk  ) {
    for (int r = vb * NWAVES + F.wave; r < MS; r += nvb * NWAVES) {
        const int lane = F.lane; const float* slab = (const float*)(F.ws + WS_SLAB);
        bf16_t* XB = (bf16_t*)(F.ws + WS_XB) + (size_t)(MP + r) * DM; float ss = 0.f;
#pragma unroll
        for (int j = 0; j < 4; ++j) { f32x4 v;
            if (basef) v = *((const f32x4*)(basef + (size_t)r * DM) + lane + 64 * j);
            else { const u32x2 w = *((const u32x2*)XB + lane + 64 * j); v = (f32x4){bflo(w.x), bfhi(w.x), bflo(w.y), bfhi(w.y)}; }
            for (int ks = 0; ks < nk; ++ks) v += *((const f32x4*)(slab + ((size_t)ks * MS + r) * DM) + lane + 64 * j);
            u32x2 w; w.x = pk2(v[0], v[1]); w.y = pk2(v[2], v[3]); *((u32x2*)XB + lane + 64 * j) = w;
            ss += (v[0] * v[0] + v[1] * v[1]) + (v[2] * v[2] + v[3] * v[3]); }
        asm volatile("s_waitcnt vmcnt(0)" ::: "memory");
        ss = wave_sum(ss);
        if (lane < 16) ((float*)(F.ws + WS_SSX))[(size_t)(MP + r) * 16 + lane] = lane == 0 ? ss : 0.f;
    }
}
__device__ __forceinline__ void fixup_glu_rows(Frame& F) {
    if (F.wave < 2) for (int r = F.bid * 2 + F.wave; r < MS; r += F.G * 2) {
        const int lane = F.lane; const float* slab = (const float*)(F.ws + WS_SLAB); const float* bias = GIN(29);
        const bf16_t* GBp = (const bf16_t*)(F.ws + WS_GB) + (size_t)(MP + r) * E_; const bf16_t* SZ = (const bf16_t*)(F.ws + WS_B1) + (size_t)(MP + r) * E_; bf16_t* A2 = (bf16_t*)(F.ws + WS_A2) + (size_t)(MP + r) * KOUT;
#pragma unroll
        for (int j = 0; j < 4; ++j) { const int c0 = 8 * (lane + 64 * j); f32x4 t0 = *(const f32x4*)(bias + c0), t1 = *(const f32x4*)(bias + c0 + 4);
#pragma unroll
            for (int ks = 0; ks < NK_GLU; ++ks) { const float* sp = slab + ((size_t)ks * MS + r) * E_ + c0; t0 += *(const f32x4*)sp; t1 += *(const f32x4*)(sp + 4); }
            float gv[8], sz[8]; unpack8(*(const u32x4*)(GBp + c0), gv); unpack8(*(const u32x4*)(SZ + c0), sz); f32x4 o0, o1;
#pragma unroll
            for (int e = 0; e < 4; ++e) { o0[e] = gv[e] * sigmoidf_(t0[e]) * sz[e]; o1[e] = gv[4 + e] * sigmoidf_(t1[e]) * sz[4 + e]; }
            *(u32x4*)(A2 + c0) = pack8(o0, o1); }
    }
}
__device__ __forceinline__ void counter_signal(unsigned* cnt) {
    asm volatile("s_waitcnt vmcnt(0)" ::: "memory"); __syncthreads();
    if (threadIdx.x == 0) { __builtin_amdgcn_fence(__ATOMIC_RELEASE, "agent"); asm volatile("s_waitcnt vmcnt(0)" ::: "memory"); __hip_atomic_fetch_add(cnt, 1u, __ATOMIC_RELAXED, __HIP_MEMORY_SCOPE_AGENT); }
}
__device__ __forceinline__ void counter_wait(unsigned* cnt, unsigned want) {
    if (threadIdx.x == 0) { unsigned sp = 0; while (__hip_atomic_load(cnt, __ATOMIC_RELAXED, __HIP_MEMORY_SCOPE_AGENT) < want) { __builtin_amdgcn_s_sleep(2); if (++sp > (1u << 22)) break; }
        __builtin_amdgcn_fence(__ATOMIC_ACQUIRE, "agent"); asm volatile("s_waitcnt vmcnt(0)" ::: "memory"); }
    __syncthreads();
}

__device__ __forceinline__ void final_row(Frame& F, int row) {
    const bf16_t* XBp = (const bf16_t*)(F.ws + WS_XB); const float* SSX = (const float*)(F.ws + WS_SSX); const float* fg = GIN(9); const int lane = F.lane;
    float s = lane < 16 ? SSX[(size_t)row * 16 + lane] : 0.f; s = wave_sum(s);
    const float r = __builtin_amdgcn_rsqf(s * (1.f / DM) + EPS);
    float* o = row < MP ? F.out + O_YP + (size_t)row * DM : F.out + O_YS + (size_t)(row - MP) * DM;
#pragma unroll
    for (int j = 0; j < 4; ++j) { const u32x2 w = *((const u32x2*)(XBp + (size_t)row * DM) + lane + 64 * j); const f32x4 v = (f32x4){bflo(w.x), bfhi(w.x), bflo(w.y), bfhi(w.y)}; const f32x4 gq = *((const f32x4*)fg + lane + 64 * j); *((f32x4*)o + lane + 64 * j) = v * r * gq; }
}
__device__ __forceinline__ void final_phase(Frame& F) {
    const int gw = F.bid * NWAVES + F.wave, NGW = F.G * NWAVES;
    asm volatile("s_waitcnt vmcnt(0)" ::: "memory"); for (int r = F.bid * NWAVES + F.wave; r < MS; r += F.G * NWAVES) final_row(F, MP + r);
#pragma unroll 2
    for (int row = gw; row < MP; row += NGW) final_row(F, row);
}

#define XB_TMO      128
#define XB_XCNT(j)  (256  + 64 * (j))
#define XB_XSUB(j)  (1280 + 64 * (j))
#define XB_XGEN(j)  (2304 + 64 * (j))
#define XB_TOP      3328
#define XB_TOPGEN   3392
#define XCD_BAR_WORDS 3456
#define XB_SPIN_CAP (1u << 20)
__device__ __forceinline__ unsigned xb_ld(unsigned* p)              { return __hip_atomic_load(p, __ATOMIC_RELAXED, __HIP_MEMORY_SCOPE_AGENT); }
__device__ __forceinline__ unsigned xb_add(unsigned* p, unsigned v) { return __hip_atomic_fetch_add(p, v, __ATOMIC_RELAXED, __HIP_MEMORY_SCOPE_AGENT); }
__device__ __forceinline__ unsigned xb_xcc_id() { return (unsigned)__builtin_amdgcn_s_getreg((3 << 11) | 20) & 0xFu; }
#define XB_SPIN(cond, bar) do { unsigned _sp = 0; while (cond) { __builtin_amdgcn_s_sleep(1); \
    if ((++_sp & 255u) == 0u) { if (xb_ld(&(bar)[XB_TMO])) break; if (_sp > XB_SPIN_CAP) { atomicAdd(&(bar)[XB_TMO], 1u); break; } } } } while (0)
struct XcdBarrier { unsigned* bar; unsigned x; volatile LAS unsigned* st; };
__device__ __forceinline__ XcdBarrier xcd_barrier_post(unsigned* bar, volatile LAS unsigned* st) {
    XcdBarrier b; b.bar = bar; b.x = xb_xcc_id(); b.st = st;
    if (threadIdx.x == 0) (void)xb_add(&bar[XB_XCNT(b.x)], 1u);
    return b;
}
__device__ __forceinline__ void xcd_barrier_complete(unsigned* bar, unsigned x, unsigned& nloc, unsigned& nx) {
    const unsigned G = gridDim.x * gridDim.y * gridDim.z;
    unsigned sum, cnt, mine, sp = 0u;
    for (;;) {
        sum = 0u; cnt = 0u; mine = 0u;
#pragma unroll
        for (unsigned j = 0; j < 16; ++j) { const unsigned c = xb_ld(&bar[XB_XCNT(j)]); sum += c; cnt += (c > 0u) ? 1u : 0u; mine = (j == x) ? c : mine; }
        if (sum == G) break;
        __builtin_amdgcn_s_sleep(1);
        if ((++sp & 255u) == 0u) { if (xb_ld(&bar[XB_TMO])) break; if (sp > XB_SPIN_CAP) { atomicAdd(&bar[XB_TMO], 1u); break; } }
    }
    nloc = mine > 0u ? mine : 1u; nx = cnt > 0u ? cnt : 1u;
}
__device__ __forceinline__ void xcd_barrier(const XcdBarrier& b) {
    asm volatile("s_waitcnt vmcnt(0)" ::: "memory");
    __syncthreads();
    if (threadIdx.x == 0) {
        unsigned* bar = b.bar;
        __builtin_amdgcn_s_waitcnt(0);
        unsigned nloc = b.st[0], nx = b.st[1];
        if (nloc == 0u) { xcd_barrier_complete(bar, b.x, nloc, nx); b.st[0] = nloc; b.st[1] = nx; }
        const unsigned old = xb_add(&bar[XB_XSUB(b.x)], 1u);
        const unsigned gen = old / nloc;
        if (old + 1u == (gen + 1u) * nloc) {
            __builtin_amdgcn_fence(__ATOMIC_RELEASE, "agent");
            asm volatile("s_waitcnt vmcnt(0)" ::: "memory");
            const unsigned og = xb_add(&bar[XB_TOP], 1u);
            const unsigned tg = og / nx;
            if (og + 1u == (tg + 1u) * nx) xb_add(&bar[XB_TOPGEN], 1u);
            else XB_SPIN(xb_ld(&bar[XB_TOPGEN]) == tg, bar);
            __builtin_amdgcn_fence(__ATOMIC_ACQUIRE, "agent");
            xb_add(&bar[XB_XGEN(b.x)], 1u);
            asm volatile("s_waitcnt vmcnt(0)" ::: "memory");
        } else {
            XB_SPIN(xb_ld(&bar[XB_XGEN(b.x)]) == gen, bar);
            __builtin_amdgcn_fence(__ATOMIC_ACQUIRE, "agent");
            asm volatile("s_waitcnt vmcnt(0)" ::: "memory");
        }
    }
    __syncthreads();
}

constexpr int NPHASE = 15;
__global__ void __launch_bounds__(NTHR, 2) fwd_kernel(Args args) {
    extern __shared__ __attribute__((aligned(16))) unsigned char lds_raw[];
    Frame F; F.lds = (LAS unsigned char*)lds_raw; F.G = gridDim.x; F.bid = blockIdx.x;
    F.in = args.in; F.out = (float*)(GAS float*)args.out; F.ws = (unsigned char*)(GAS unsigned char*)args.ws;
    unsigned char* ws = F.ws;
#define REFRESH() do { int t_ = threadIdx.x; asm volatile("" : "+v"(t_)); F.tid = t_; F.lane = t_ & 63; F.wave = __builtin_amdgcn_readfirstlane(t_ >> 6); \
        GAS unsigned char* wsg_ = (GAS unsigned char*)args.ws; asm volatile("" : "+s"(wsg_)); ws = (unsigned char*)wsg_; F.ws = ws; } while (0)
    const int lo = args.ph_lo, hi = args.ph_hi;
#if MK_ONE_LAUNCH
    cg::grid_group grid = cg::this_grid();
    if (lo < 0) grid.sync();
    { volatile LAS unsigned* st0 = (volatile LAS unsigned*)(F.lds + LDS_BYTES - 64); if (threadIdx.x < 16) st0[threadIdx.x] = 0u; }
    __syncthreads();
    const XcdBarrier xbar = xcd_barrier_post((unsigned*)(args.ws + WS_CTL), (volatile LAS unsigned*)(F.lds + LDS_BYTES - 64));
#define SEAM(k) do { if (lo <= (k) && (k) + 1 < hi) xcd_barrier(xbar); } while (0)
#else
#define SEAM(k) do { } while (0)
#endif
#ifndef PHASE_MASK
#define PHASE_MASK 0x7fff
#endif
#define REP(k) for (int rep_ = 0; rep_ <= (((PROBE_REP_MASK) >> (k)) & 1); ++rep_)
#define WSSEL(bit) do { if ((FLAT_FN_MASK >> (bit)) & 1) { unsigned char* w_ = args.ws; asm volatile("" : "+s"(w_)); F.ws = w_; } else { GAS unsigned char* g_ = (GAS unsigned char*)args.ws; asm volatile("" : "+s"(g_)); F.ws = (unsigned char*)g_; } } while (0)
#define IN(k) ((((PHASE_MASK) >> (k)) & 1) && lo <= (k) && (k) < hi)
#define XB ((bf16_t*)(ws + WS_XB))
#define X ((float*)(ws + WS_X))
#define SSX ((float*)(ws + WS_SSX))
#define SSV ((float*)(ws + WS_SSV))
#define B0 ((bf16_t*)(ws + WS_B0))
#define B1 ((bf16_t*)(ws + WS_B1))
#define QBp ((bf16_t*)(ws + WS_QB))
#define A2 ((bf16_t*)(ws + WS_A2))
#define GBp ((bf16_t*)(ws + WS_GB))
    const int G = F.G, bid = F.bid;

    if (IN(0)) REP(0) { REFRESH(); WSSEL(0); p0_prologue(F); __syncthreads(); } SEAM(0);
#define CNT(k) ((unsigned*)(ws + WS_CTL) + 4096 + 64 * (k))
#define WOUT(l) ((const bf16_t*)(ws + WS_WOUT) + (size_t)(l) * DM * KOUT)
#define INPROJ(EpiT, E, W, N, cnt, want) do { \
        pg8::Gemm g{XB, (W), M, (N), DM, DM}; pg8::StaticOrder S; S.init(MP, (N), G, bid); pg8::gemm_phase<EpiT, pg8::StaticOrder, true, true>(F.lds, g, S, E); \
        if (cnt) counter_wait(cnt, (unsigned)(want)); \
        const int rem = ((MP / 256) * ((N) / 256)) % G; pg8::StaticOrder S2; S2.init(MS, (N), G, (bid + G - rem) % G, MP / 256); pg8::gemm_phase<EpiT, pg8::StaticOrder, true, true>(F.lds, g, S2, E); } while (0)
#define OUTPROJ_PROMPT(l, bp) do { pg8::Gemm g{A2, WOUT(l), M, DM, KOUT, KOUT}; pg8::StaticOrder S; S.init(MP, DM, G, bid); EpiOut E{(bp), XB, SSX}; pg8::gemm_phase<EpiOut, pg8::StaticOrder, true, true>(F.lds, g, S, E); } while (0)
#define OUTPROJ_SLICES(l, c, nb, NK) do { pg8::Gemm g{A2, WOUT(l), M, DM, KOUT / (NK), KOUT}; typedef pg8::SliceOrder<MS / 256, DM / 256, (NK)> SO; SO S; S.init((nb), (c), MP / 256); \
        EpiSlab E{(float*)(ws + WS_SLAB), DM, MP, (size_t)MS * DM}; pg8::gemm_phase<EpiSlab, SO, true, true>(F.lds, g, S, E); } while (0)
#define SLICEFIX(l, sb0, basef, cA, cB) do { if (bid >= (sb0)) { const int nsb_ = G - (sb0); OUTPROJ_SLICES(l, bid - (sb0), nsb_, NK_OUT); counter_signal(cA); counter_wait(cA, (unsigned)nsb_); \
        fixup_out_rows(F, (basef), bid - (sb0), nsb_, NK_OUT); counter_signal(cB); } } while (0)
#define KVPROJ(l, c0) do { pg8::Gemm g{(const bf16_t*)(ws + WS_MEMB), (const bf16_t*)(ws + WS_WKV) + (size_t)(l) * DM * DM, PB * MEML, DM, DM, DM}; pg8::StaticOrder S; S.init(g.M, g.N, G, (bid + G - (c0)) % G); \
        EpiKV E{(const float*)(ws + WS_RSTDM), F.out + O_MK, F.out + O_MV, (bf16_t*)(ws + WS_KB), (bf16_t*)(ws + WS_VT), (l)}; pg8::gemm_phase<EpiKV, pg8::StaticOrder, true, true>(F.lds, g, S, E); } while (0)
    if (IN(1)) REP(1) { REFRESH();
        { EpiInA E{SSX, B0, B1, QBp, SSV}; INPROJ(EpiInA, E, (const bf16_t*)(ws + WS_WINA), NIN_A, (unsigned*)nullptr, 0); }
        KVPROJ(0, 180); KVPROJ(1, 212);
    } SEAM(1);
    if (IN(2)) REP(2) { REFRESH(); WSSEL(1);
        sgu_phase_mfma(F, 0); sgu_sample_phase(F, 0); attn_prompt_phase(F, 0); attn_sample_phase(F, 0); } SEAM(2);
    if (IN(3)) REP(3) { REFRESH(); OUTPROJ_PROMPT(0, GIN(0)); } SEAM(3);
    if (IN(4)) REP(4) { REFRESH(); SLICEFIX(0, 196, GIN(1), CNT(0), CNT(4));
        EpiInB E{SSX, B0, B1, QBp, F.out + O_CP, F.out + O_CS}; INPROJ(EpiInB, E, (const bf16_t*)(ws + WS_WINB), NIN_B, CNT(4), G - 196); } SEAM(4);
    if (IN(5)) REP(5) { REFRESH(); WSSEL(3);
        conv_phase(F); attn_prompt_phase(F, 1); attn_sample_phase(F, 1); } SEAM(5);
    if (IN(6)) REP(6) { REFRESH(); OUTPROJ_PROMPT(1, (const float*)nullptr); } SEAM(6);
    if (IN(7)) REP(7) { REFRESH(); SLICEFIX(1, 196, (const float*)nullptr, CNT(1), CNT(5));
        EpiInC E{SSX, B0, B1, QBp}; INPROJ(EpiInC, E, (const bf16_t*)(ws + WS_WINC), NIN_C, CNT(5), G - 196); KVPROJ(2, 164); } SEAM(7);
    if (IN(8)) REP(8) { REFRESH();
        const int half = G / 2; const bool s5h = bid < half;
        F.G = half; F.bid = s5h ? bid : (1 << 20);
        WSSEL(4); s5_prompt_mfma(F);
        F.G = G - half; F.bid = s5h ? (1 << 20) : bid - half;
        WSSEL(6); attn_prompt_phase(F, 2); WSSEL(7); attn_sample_phase(F, 2); WSSEL(5); s5_sample_mfma(F);
        F.bid = bid; F.G = G; } SEAM(8);
    if (IN(9)) REP(9) { REFRESH();
        { pg8::Gemm g{GBp, (const bf16_t*)(ws + WS_WGLU), M, E_, E_, E_}; pg8::StaticOrder S; S.init(MP, E_, G, bid); EpiGlu E{GBp, B1, GIN(29), A2}; pg8::gemm_phase<EpiGlu, pg8::StaticOrder, true, true>(F.lds, g, S, E); }
        { pg8::Gemm g{GBp, (const bf16_t*)(ws + WS_WGLU), M, E_, 256, E_}; typedef pg8::SliceOrder<MS / 256, E_ / 256, NK_GLU> SG; SG S; S.init(G, bid, MP / 256); EpiSlab E{(float*)(ws + WS_SLAB), E_, MP, (size_t)MS * E_}; pg8::gemm_phase<EpiSlab, SG, true, true>(F.lds, g, S, E); } } SEAM(9);
    if (IN(10)) REP(10) { REFRESH(); fixup_glu_rows(F);
        OUTPROJ_PROMPT(2, (const float*)nullptr); } SEAM(10);
    if (IN(11)) REP(11) { REFRESH(); SLICEFIX(2, 212, (const float*)nullptr, CNT(3), CNT(6));
        EpiInA E{SSX, B0, B1, QBp, SSV}; INPROJ(EpiInA, E, (const bf16_t*)(ws + WS_WINA) + (size_t)NIN_A * DM, NIN_A, CNT(6), G - 212); KVPROJ(3, 180); } SEAM(11);
    if (IN(12)) REP(12) { REFRESH(); WSSEL(1);
        sgu_phase_mfma(F, 1); sgu_sample_phase(F, 1); attn_prompt_phase(F, 3); attn_sample_phase(F, 3); } SEAM(12);
    if (IN(13)) REP(13) { REFRESH(); OUTPROJ_PROMPT(3, (const float*)nullptr); OUTPROJ_SLICES(3, bid, G, NK_OUT_LAST); } SEAM(13);
    if (IN(14)) REP(14) { REFRESH(); WSSEL(8); fixup_out_rows(F, (const float*)nullptr, bid, G, NK_OUT_LAST); final_phase(F); }
#undef CNT
#undef WOUT
#undef KVPROJ
#undef INPROJ
#undef OUTPROJ_PROMPT
#undef OUTPROJ_SLICES
#undef SLICEFIX
#undef IN
#undef REP
#undef SEAM
#undef XB
#undef X
#undef SSX
#undef SSV
#undef B0
#undef B1
#undef QBp
#undef A2
#undef GBp
#undef REFRESH
}

extern "C" void kernel_launch(void* const* d_in, const int* in_sizes, int n_in, void* d_out, int out_size, void* d_ws, size_t ws_size, hipStream_t stream) {
    static int grid = 0;
    if (grid == 0) {
        if (n_in != 30 || out_size != (int)O_END || ws_size < WS_END) { fprintf(stderr, "kernel_launch: unexpected shapes (n_in %d out %d ws %zu)\n", n_in, out_size, ws_size); grid = -1; return; }
        int dev = 0, cus = 0, per_cu = 0;
        (void)hipGetDevice(&dev); (void)hipDeviceGetAttribute(&cus, hipDeviceAttributeMultiprocessorCount, dev);
        if (hipFuncSetAttribute((const void*)fwd_kernel, hipFuncAttributeMaxDynamicSharedMemorySize, LDS_BYTES) != hipSuccess) { fprintf(stderr, "kernel_launch: hipFuncSetAttribute failed\n"); grid = -1; return; }
        if (hipOccupancyMaxActiveBlocksPerMultiprocessor(&per_cu, (const void*)fwd_kernel, NTHR, LDS_BYTES) != hipSuccess || per_cu < 1) { fprintf(stderr, "kernel_launch: occupancy query says %d\n", per_cu); (void)hipGetLastError(); per_cu = 1; }
        grid = cus;
    }
    if (grid < 0) return;
    Args a{};
    for (int i = 0; i < 30; ++i) a.in[i] = (const float*)d_in[i];
    a.out = (float*)d_out; a.ws = (unsigned char*)d_ws;
#if MK_ONE_LAUNCH
    (void)hipMemsetAsync((char*)d_ws + WS_CTL, 0, 65536, stream);
    a.ph_lo = 0; a.ph_hi = NPHASE;
    void* kargs[] = {&a};
    hipError_t e = hipLaunchCooperativeKernel((const void*)fwd_kernel, dim3(grid), dim3(NTHR), kargs, LDS_BYTES, stream);
    if (e != hipSuccess) fprintf(stderr, "cooperative launch failed: %s (grid %d)\n", hipGetErrorString(e), grid);
#else
    for (int p = 0; p < NPHASE; ++p) { a.ph_lo = p; a.ph_hi = p + 1; hipLaunchKernelGGL(fwd_kernel, dim3(grid), dim3(NTHR), LDS_BYTES, stream, a); }
#endif
}
```

```cpp
#include <hip/hip_runtime.h>
#include <hip/hip_cooperative_groups.h>
#include <cstdio>
#include <cstdint>
namespace cg = cooperative_groups;

#ifndef MK_ONE_LAUNCH
#define MK_ONE_LAUNCH 1
#endif
#ifndef XHALF_SHFL
#define XHALF_SHFL 0
#endif
#ifndef STAGGER_TICKS
#define STAGGER_TICKS 0
#endif
#ifndef PROBE_RSTD2
#define PROBE_RSTD2 0
#endif
#ifndef EPI_DRAIN
#define EPI_DRAIN 1
#endif
#ifndef FLAT_FN_MASK
#define FLAT_FN_MASK 0x00
#endif
#ifndef PROBE_SUB_MASK
#define PROBE_SUB_MASK 0
#endif
#ifndef PROBE_REP_MASK
#define PROBE_REP_MASK 0
#endif

namespace pg8 {
#define PG8_LAS __attribute__((address_space(3)))
typedef unsigned short bf16_t;
typedef short bf16x8 __attribute__((ext_vector_type(8)));
typedef float f32x4 __attribute__((ext_vector_type(4)));
typedef unsigned u32x4 __attribute__((ext_vector_type(4)));
typedef unsigned u32x2 __attribute__((ext_vector_type(2)));
constexpr int BM = 256, BK = 64, HALF = 128, HTB = HALF * BK * 2, STAGE_BYTES = 8 * HTB, NXCD = 8, WGM = 8;

__host__ __device__ __forceinline__ int lds_byte(int r, int c) { const int st = (r >> 4) * 2 + (c >> 5), rr = r & 15, cc = c & 31, ob = rr * 64 + cc * 2; return st * 1024 + (ob ^ (((ob >> 9) & 1) << 5)); }
__host__ __device__ __forceinline__ void stage_rc(int b, int& R, int& C) { const int st = b / 1024, sb = b % 1024, swz = sb ^ (((sb >> 9) & 1) << 5); R = (st >> 1) * 16 + swz / 64; C = (st & 1) * 32 + (swz % 64) / 2; }
__host__ __device__ __forceinline__ int perm32(int rho) { const int n = rho >> 4, i = rho & 15; return 8 * (i >> 2) + 4 * n + (i & 3); }

struct Unit { int pm, pn, ks; };
struct Gemm { const bf16_t* A; const bf16_t* Bt; int M, N, K, ld; };

struct StaticOrder {
    int nM, nN, nwg, G, c, pm0;
    __host__ __device__ void init(int M, int N, int G_, int c_, int pm0_ = 0) { nM = M / BM; nN = N / BM; nwg = nM * nN; G = G_; c = c_; pm0 = pm0_; }
    __host__ __device__ bool next(int i, Unit& u) const {
        const long L = (long)i * G + c; if (L >= nwg) return false;
        int wgid = (int)L; { const int q = nwg / NXCD, r = nwg % NXCD, xcd = wgid % NXCD, off = wgid / NXCD; wgid = (xcd < r ? xcd * (q + 1) : r * (q + 1) + (xcd - r) * q) + off; }
        const int nig = WGM * nN, gid = wgid / nig, fm = gid * WGM, gsz = (nM - fm) < WGM ? (nM - fm) : WGM;
        u.pm = pm0 + fm + ((wgid % nig) % gsz); u.pn = (wgid % nig) / gsz; u.ks = 0; return true;
    }
    __device__ __forceinline__ void a_ready(const Unit&) const {}
    __device__ __forceinline__ void done(const Unit&) const {}
};
template <int NM_, int NN_, int NK_> struct SliceOrder {
    int G, c, pm0;
    __host__ __device__ void init(int G_, int c_, int pm0_) { G = G_; c = c_; pm0 = pm0_; }
    __host__ __device__ bool next(int i, Unit& u) const {
        const int L = i * G + c; if (L >= NM_ * NN_ * NK_) return false;
        const int t = L / NK_; u.ks = L % NK_; u.pn = t % NN_; u.pm = pm0 + t / NN_; return true;
    }
    __device__ __forceinline__ void a_ready(const Unit&) const {}
    __device__ __forceinline__ void done(const Unit&) const {}
};

template <class Epi, class Sched, bool ALIGN_EPI = false, bool SP2 = false>
__device__ __forceinline__ void gemm_phase(PG8_LAS unsigned char* lds, const Gemm g, const Sched& S, const Epi& E) {
    int tid = threadIdx.x; asm volatile("" : "+v"(tid));
    const int wid = __builtin_amdgcn_readfirstlane(tid >> 6), lane = tid & 63, wr = wid >> 2, wc = wid & 3, fr = lane & 15, fq = lane >> 4;
    const int K = g.K, ld = g.ld, nt = K / BK;
    unsigned voffA[2], voffB[2];
#pragma unroll
    for (int i = 0; i < 2; ++i) { int R, C; stage_rc(tid * 16 + i * 8192, R, C); const int Rb = Epi::PERM ? ((R & ~31) + perm32(R & 31)) : R;
        voffA[i] = (unsigned)(R * ld + C) * 2u; voffB[i] = (unsigned)(Rb * ld + C) * 2u; }
    const size_t kstep = (size_t)(BK * 2);
    const size_t hstep = (size_t)HALF * ld * 2;
    const size_t sstep = (size_t)K * 2;
    const size_t tstep = 2 * hstep;
    const unsigned ldsw = (unsigned)wid * 1024u;
    const int aoff = lds_byte(wr * 64 + fr, fq * 8), boff = lds_byte(wc * 32 + fr, fq * 8);
#define PG8_SA(b, h) (((b) * 2 + (h)) * HTB)
#define PG8_SB(b, h) ((4 + (b) * 2 + (h)) * HTB)
#define PG8_STAGE(bufoff, gbase, voff) do { _Pragma("unroll") for (int _i = 0; _i < 2; ++_i) \
        __builtin_amdgcn_global_load_lds((const unsigned*)((const char*)(gbase) + (voff)[_i]), (PG8_LAS unsigned*)(lds + (bufoff) + ldsw + _i * 8192), 16, 0, 0); } while (0)
#define PG8_LDA(dst, b, h) do { _Pragma("unroll") for (int m = 0; m < 4; ++m) _Pragma("unroll") for (int k = 0; k < 2; ++k) dst[m][k] = *(const PG8_LAS bf16x8*)(lds + PG8_SA(b, h) + aoff + m * 2048 + k * 1024); } while (0)
#define PG8_LDB(dst, b, h) do { _Pragma("unroll") for (int n = 0; n < 2; ++n) _Pragma("unroll") for (int k = 0; k < 2; ++k) dst[n][k] = *(const PG8_LAS bf16x8*)(lds + PG8_SB(b, h) + boff + n * 2048 + k * 1024); } while (0)
#define PG8_MMA(ai, bj, At, Bt) do { __builtin_amdgcn_s_setprio(1); _Pragma("unroll") for (int m = 0; m < 4; ++m) _Pragma("unroll") for (int n = 0; n < 2; ++n) _Pragma("unroll") for (int k = 0; k < 2; ++k) \
        acc[ai][bj][m][n] = __builtin_amdgcn_mfma_f32_16x16x32_bf16(Bt[n][k], At[m][k], acc[ai][bj][m][n], 0, 0, 0); __builtin_amdgcn_s_setprio(0); } while (0)
#define PG8_WAIT_V(n) asm volatile("s_waitcnt vmcnt(" #n ")" ::: "memory")
#define PG8_WAIT_L(n) asm volatile("s_waitcnt lgkmcnt(" #n ")" ::: "memory")
#define PG8_BAR __builtin_amdgcn_s_barrier()
#define PG8_SCHED __builtin_amdgcn_sched_barrier(0)
    Unit cur, nxt; int ui = 0;
    if (!S.next(0, cur)) return;
    f32x4 acc[2][2][4][2];
#pragma unroll
    for (int a = 0; a < 2; ++a)
#pragma unroll
        for (int b = 0; b < 2; ++b)
#pragma unroll
            for (int m = 0; m < 4; ++m)
#pragma unroll
                for (int n = 0; n < 2; ++n) acc[a][b][m][n] = (f32x4){0.f, 0.f, 0.f, 0.f};
    bf16x8 At[4][2], B0[2][2], B1[2][2];
    const char* cA = (const char*)g.A + (size_t)cur.pm * tstep + (size_t)cur.ks * sstep; const char* cB = (const char*)g.Bt + (size_t)cur.pn * tstep + (size_t)cur.ks * sstep;
    S.a_ready(cur);
    if constexpr (SP2) {
        PG8_STAGE(PG8_SB(0, 0), cB, voffB); PG8_STAGE(PG8_SB(0, 1), cB + hstep, voffB); PG8_STAGE(PG8_SA(0, 0), cA, voffA); PG8_STAGE(PG8_SA(0, 1), cA + hstep, voffA);
        if (wr == 1) PG8_BAR;
        PG8_WAIT_V(2); PG8_BAR;
        PG8_STAGE(PG8_SB(1, 0), cB + kstep, voffB); PG8_STAGE(PG8_SA(1, 0), cA + kstep, voffA); PG8_STAGE(PG8_SB(1, 1), cB + hstep + kstep, voffB);
        PG8_WAIT_V(6); PG8_BAR;
    } else {
        PG8_STAGE(PG8_SB(0, 0), cB, voffB); PG8_STAGE(PG8_SA(0, 0), cA, voffA); PG8_STAGE(PG8_SB(0, 1), cB + hstep, voffB); PG8_STAGE(PG8_SA(0, 1), cA + hstep, voffA);
        if (wr == 1) PG8_BAR;
        PG8_WAIT_V(4); PG8_BAR;
        PG8_STAGE(PG8_SB(1, 0), cB + kstep, voffB); PG8_STAGE(PG8_SA(1, 0), cA + kstep, voffA); PG8_STAGE(PG8_SB(1, 1), cB + hstep + kstep, voffB);
        PG8_WAIT_V(6); PG8_BAR;
    }
    for (;;) {
        const bool has_next = S.next(ui + 1, nxt);
        const char* nA = has_next ? (const char*)g.A + (size_t)nxt.pm * tstep + (size_t)nxt.ks * sstep : cA; const char* nB = has_next ? (const char*)g.Bt + (size_t)nxt.pn * tstep + (size_t)nxt.ks * sstep : cB;
        for (int t = 0; t < nt; t += 2) {
            const bool last = (t == nt - 2);
            const char* a1 = cA + (size_t)(t + 1) * kstep;
            const char* a2 = last ? nA : cA + (size_t)(t + 2) * kstep; const char* b2 = last ? nB : cB + (size_t)(t + 2) * kstep;
            const char* a3 = a2 + kstep; const char* b3 = b2 + kstep;
            if (last && has_next) S.a_ready(nxt);
            if constexpr (SP2) {
            PG8_LDB(B0, 0, 0); PG8_LDB(B1, 0, 1); PG8_SCHED; PG8_LDA(At, 0, 0); PG8_STAGE(PG8_SA(1, 1), a1 + hstep, voffA);
            PG8_WAIT_V(8); PG8_WAIT_L(0); PG8_BAR; PG8_MMA(0, 0, At, B0); PG8_MMA(0, 1, At, B1); PG8_BAR; PG8_SCHED;
            PG8_LDA(At, 0, 1); PG8_STAGE(PG8_SB(0, 0), b2, voffB); PG8_STAGE(PG8_SB(0, 1), b2 + hstep, voffB); PG8_STAGE(PG8_SA(0, 0), a2, voffA);
            PG8_WAIT_V(8); PG8_WAIT_L(0); PG8_BAR; PG8_MMA(1, 0, At, B0); PG8_MMA(1, 1, At, B1); PG8_BAR; PG8_SCHED;
            PG8_LDB(B0, 1, 0); PG8_LDB(B1, 1, 1); PG8_SCHED; PG8_LDA(At, 1, 0); PG8_STAGE(PG8_SA(0, 1), a2 + hstep, voffA);
            PG8_WAIT_V(8); PG8_WAIT_L(0); PG8_BAR; PG8_MMA(0, 0, At, B0); PG8_MMA(0, 1, At, B1); PG8_BAR; PG8_SCHED;
            PG8_LDA(At, 1, 1); PG8_STAGE(PG8_SB(1, 0), b3, voffB); PG8_STAGE(PG8_SB(1, 1), b3 + hstep, voffB); PG8_STAGE(PG8_SA(1, 0), a3, voffA);
            PG8_WAIT_V(8); PG8_WAIT_L(0); PG8_BAR; PG8_MMA(1, 0, At, B0); PG8_MMA(1, 1, At, B1); PG8_BAR; PG8_SCHED;
            } else {
            PG8_LDB(B0, 0, 0); PG8_SCHED; PG8_LDA(At, 0, 0); PG8_STAGE(PG8_SA(1, 1), a1 + hstep, voffA);
            PG8_WAIT_L(8); PG8_BAR; PG8_WAIT_L(0); PG8_MMA(0, 0, At, B0); PG8_BAR; PG8_SCHED;
            PG8_LDB(B1, 0, 1); PG8_STAGE(PG8_SB(0, 0), b2, voffB);
            PG8_BAR; PG8_WAIT_L(0); PG8_MMA(0, 1, At, B1); PG8_BAR;
            PG8_LDA(At, 0, 1); PG8_STAGE(PG8_SA(0, 0), a2, voffA);
            PG8_BAR; PG8_WAIT_L(0); PG8_MMA(1, 0, At, B0); PG8_BAR; PG8_SCHED;
            PG8_STAGE(PG8_SB(0, 1), b2 + hstep, voffB);
            PG8_WAIT_V(6); PG8_BAR; PG8_MMA(1, 1, At, B1); PG8_BAR;
            PG8_LDB(B0, 1, 0); PG8_SCHED; PG8_LDA(At, 1, 0); PG8_STAGE(PG8_SA(0, 1), a2 + hstep, voffA);
            PG8_WAIT_L(8); PG8_BAR; PG8_WAIT_L(0); PG8_MMA(0, 0, At, B0); PG8_BAR; PG8_SCHED;
            PG8_LDB(B1, 1, 1); PG8_STAGE(PG8_SB(1, 0), b3, voffB);
            PG8_BAR; PG8_WAIT_L(0); PG8_MMA(0, 1, At, B1); PG8_BAR;
            PG8_LDA(At, 1, 1); PG8_STAGE(PG8_SA(1, 0), a3, voffA);
            PG8_BAR; PG8_WAIT_L(0); PG8_MMA(1, 0, At, B0); PG8_BAR; PG8_SCHED;
            PG8_STAGE(PG8_SB(1, 1), b3 + hstep, voffB);
            PG8_WAIT_V(6); PG8_BAR; PG8_MMA(1, 1, At, B1); PG8_BAR;
            }
        }
        if constexpr (ALIGN_EPI) { if (wr == 0) PG8_BAR; }
        if constexpr (!Epi::AFTER_DRAIN) { E(acc, cur, wr, wc, fr, fq); S.done(cur); }
#if EPI_DRAIN
        PG8_WAIT_V(0);
#endif
        if (!has_next) break;
#pragma unroll
        for (int a = 0; a < 2; ++a)
#pragma unroll
            for (int b = 0; b < 2; ++b)
#pragma unroll
                for (int m = 0; m < 4; ++m)
#pragma unroll
                    for (int n = 0; n < 2; ++n) acc[a][b][m][n] = (f32x4){0.f, 0.f, 0.f, 0.f};
        cur = nxt; cA = nA; cB = nB; ++ui;
        if constexpr (ALIGN_EPI) { if (wr == 1) PG8_BAR; }
    }
    PG8_WAIT_V(0);
    if constexpr (!ALIGN_EPI) { if (wr == 0) PG8_BAR; }
    PG8_BAR;
    if constexpr (Epi::AFTER_DRAIN) { E(acc, cur, wr, wc, fr, fq); S.done(cur); }
#undef PG8_SA
#undef PG8_SB
#undef PG8_STAGE
#undef PG8_LDA
#undef PG8_LDB
#undef PG8_MMA
#undef PG8_WAIT_V
#undef PG8_WAIT_L
#undef PG8_BAR
#undef PG8_SCHED
}
}

using pg8::bf16_t; using pg8::f32x4; using pg8::u32x4; using pg8::u32x2; using pg8::bf16x8; using pg8::Unit;
#define LAS __attribute__((address_space(3)))
#define GAS __attribute__((address_space(1)))
#define GIN(k) ((const float*)(const GAS float*)F.in[k])
typedef float f32x2 __attribute__((ext_vector_type(2)));
typedef __bf16 bf16x2_t __attribute__((ext_vector_type(2)));
typedef float f32x16 __attribute__((ext_vector_type(16)));

constexpr int DM = 1024, E_ = 2048, XA = 512, NH = 4, HD = 128, MEML = 256;
constexpr int PB = 8, PSEQ = 2048, MP = PB * PSEQ;
constexpr int SBT = 128, SSEQ = 4, MS = SBT * SSEQ;
constexpr int M = MP + MS;
constexpr int NIN_A = 3 * E_ + XA, NIN_B = 4 * E_ + XA, NIN_C = 2 * E_ + XA, KOUT = E_ + XA;
constexpr int S5G = 128, S5P = 64, S5I = 16;
constexpr float EPS = 1e-6f;
constexpr int NWAVES = 8, NTHR = 512;

constexpr size_t O_YP = 0, O_YS = O_YP + (size_t)MP * DM, O_MK = O_YS + (size_t)MS * DM, O_MV = O_MK + 4ull * PB * MEML * XA, O_CP = O_MV + 4ull * PB * MEML * XA,
                 O_CS = O_CP + (size_t)PB * 2 * E_, O_SRP = O_CS + (size_t)SBT * 2 * E_, O_SIP = O_SRP + (size_t)PB * S5G * S5P, O_SRS = O_SIP + (size_t)PB * S5G * S5P,
                 O_SIS = O_SRS + (size_t)SBT * S5G * S5P, O_CV = O_SIS + (size_t)SBT * S5G * S5P, O_END = O_CV + 2ull * SBT * SSEQ * E_;
static_assert(O_END == 30572544ull, "output size");

constexpr size_t MiB = 1u << 20;
constexpr size_t WS_CTL = 0, WS_TAB = 1 * MiB, WS_RSTDM = 3 * MiB, WS_SGUW = 4 * MiB, WS_SSX = 5 * MiB, WS_SSV = 7 * MiB, WS_WKV = 10 * MiB, WS_WGLU = 18 * MiB, WS_WOUT = 26 * MiB,
                 WS_WINA = 46 * MiB, WS_WINB = 72 * MiB, WS_WINC = 89 * MiB, WS_MEMB = 98 * MiB, WS_KB = 102 * MiB, WS_VT = 110 * MiB, WS_XB = 118 * MiB, WS_X = 151 * MiB,
                 WS_B0 = 217 * MiB, WS_B1 = 283 * MiB, WS_QB = 349 * MiB, WS_A2 = 366 * MiB, WS_GB = 449 * MiB, WS_SLAB = 515 * MiB  , WS_END = 548 * MiB;
constexpr size_t T_AR = 0, T_AI = 8192, T_BBR = 16384, T_BBI = 16384 + 131072;

constexpr int RING_BYTES = 131072, LDS_BYTES = 147456;

struct Args { const float* in[30]; float* out; unsigned char* ws; int ph_lo, ph_hi; };

__device__ __forceinline__ unsigned pk2(float lo, float hi) { f32x2 v = {lo, hi}; return __builtin_bit_cast(unsigned, __builtin_convertvector(v, bf16x2_t)); }
__device__ __forceinline__ bf16_t f2bf(float f) { return (bf16_t)(pk2(f, 0.f) & 0xffffu); }
__device__ __forceinline__ float bf2f(unsigned short h) { return __uint_as_float((unsigned)h << 16); }
__device__ __forceinline__ float bflo(unsigned w) { return __uint_as_float(w << 16); }
__device__ __forceinline__ float bfhi(unsigned w) { return __uint_as_float(w & 0xffff0000u); }
__device__ __forceinline__ float sigmoidf_(float x) { return __builtin_amdgcn_rcpf(1.f + __expf(-x)); }
__device__ __forceinline__ float siluf_(float x) { return x * sigmoidf_(x); }
__device__ __forceinline__ float gelu_tanh(float x) { const float y = 0.7978845608028654f * (x + 0.044715f * x * x * x); return x * sigmoidf_(2.f * y); }
__device__ __forceinline__ float wave_sum(float v) {
#pragma unroll
    for (int o = 1; o < 64; o <<= 1) v += __shfl_xor(v, o);
    return v;
}
__device__ __forceinline__ float wave_max(float v) {
#pragma unroll
    for (int o = 1; o < 64; o <<= 1) v = fmaxf(v, __shfl_xor(v, o));
    return v;
}
__device__ __forceinline__ u32x4 pack8(f32x4 a, f32x4 b) { u32x4 w; w.x = pk2(a[0], a[1]); w.y = pk2(a[2], a[3]); w.z = pk2(b[0], b[1]); w.w = pk2(b[2], b[3]); return w; }
__device__ __forceinline__ void unpack8(u32x4 w, float (&f)[8]) { f[0] = bflo(w.x); f[1] = bfhi(w.x); f[2] = bflo(w.y); f[3] = bfhi(w.y); f[4] = bflo(w.z); f[5] = bfhi(w.z); f[6] = bflo(w.w); f[7] = bfhi(w.w); }

__device__ __forceinline__ int src_col(int kind, int np) {
    const int pn = np >> 8, p = np & 255, pos = (p & ~31) + pg8::perm32(p & 31);
    if (kind == 0) {
        if (pn < 16) return pos < 128 ? 128 * pn + pos : 2 * E_ + 128 * pn + (pos - 128);
        if (pn < 24) return E_ + 256 * (pn - 16) + pos;
        return 3 * E_ + 256 * (pn - 24) + pos;
    }
    if (kind == 1) {
        if (pn < 32) { const int qs = 2 * (p >> 7) + ((p >> 4) & 1), ch = 64 * pn + 16 * ((p >> 5) & 3) + (p & 15); return qs * E_ + ch; }
        return 4 * E_ + 256 * (pn - 32) + pos;
    }
    return 256 * pn + pos;
}

__device__ __forceinline__ float sum_rows4(float x) {
    auto a = __builtin_amdgcn_permlane16_swap(__float_as_uint(x), __float_as_uint(x), false, false); const float y = __uint_as_float(a[0]) + __uint_as_float(a[1]);
    auto b = __builtin_amdgcn_permlane32_swap(__float_as_uint(y), __float_as_uint(y), false, false); return __uint_as_float(b[0]) + __uint_as_float(b[1]);
}
__device__ __forceinline__ void rows_rstd16(const float* ssx, int row0, int fq, float (&rs)[2][4]) {
#pragma unroll
    for (int ai = 0; ai < 2; ++ai)
#pragma unroll
        for (int m = 0; m < 4; ++m) {
            const f32x4 v = *(const f32x4*)(ssx + (size_t)(row0 + ai * 128 + m * 16) * 16 + fq * 4);
            const float s = sum_rows4((v[0] + v[1]) + (v[2] + v[3]));
            rs[ai][m] = __builtin_amdgcn_rsqf(s * (1.f / DM) + EPS);
        }
#if PROBE_RSTD2
    { const int dep = rs[1][3] == 12345.678f ? 1 : 0;
#pragma unroll
    for (int ai = 0; ai < 2; ++ai)
#pragma unroll
        for (int m = 0; m < 4; ++m) {
            const f32x4 v = *(const f32x4*)(ssx + (size_t)(row0 + dep + ai * 128 + m * 16) * 16 + fq * 4);
            const float s = sum_rows4((v[0] + v[1]) + (v[2] + v[3]));
            rs[ai][m] = fmaxf(rs[ai][m], __builtin_amdgcn_rsqf(s * (1.f / DM) + EPS));
        } }
#endif
}

struct EpiKV {
    static constexpr bool PERM = false, AFTER_DRAIN = false;
    const float* rstdm; float* outk; float* outv; bf16_t* KB; bf16_t* VT; int layer;
    __device__ __forceinline__ void operator()(const f32x4 (&acc)[2][2][4][2], const Unit& u, int wr, int wc, int fr, int fq) const {
        const int sub = u.pn & 3, isv = sub >> 1, b = u.pm;
        const int key0 = wr * 64 + fr, d0 = 32 * wc + 8 * fq;
        const float* rsp = rstdm + b * 256 + key0;
        float* of = (isv ? outv : outk) + (((size_t)(layer * PB + b) * MEML + key0) * NH + (sub & 1) * 2) * HD + d0;
        const size_t bh0 = (size_t)((layer * PB + b) * NH + (sub & 1) * 2);
        if (!isv) {
            bf16_t* kb = KB + (bh0 * MEML + key0) * HD + d0;
#pragma unroll
            for (int ai = 0; ai < 2; ++ai)
#pragma unroll
                for (int m = 0; m < 4; ++m) { const int kk = ai * 128 + m * 16; const float rs = rsp[kk];
#pragma unroll
                    for (int bj = 0; bj < 2; ++bj) { const f32x4 v0 = acc[ai][bj][m][0] * rs, v1 = acc[ai][bj][m][1] * rs;
                        float* o = of + (size_t)kk * XA + bj * HD; *(f32x4*)o = v0; *(f32x4*)(o + 4) = v1;
                        *(u32x4*)(kb + (size_t)bj * MEML * HD + (size_t)kk * HD) = pack8(v0, v1); }
                    asm volatile("" ::: "memory"); }
        } else {
            bf16_t* vt = VT + (bh0 * HD + d0) * MEML + key0;
#pragma unroll
            for (int ai = 0; ai < 2; ++ai)
#pragma unroll
                for (int m = 0; m < 4; ++m) { const int kk = ai * 128 + m * 16; const float rs = rsp[kk];
#pragma unroll
                    for (int bj = 0; bj < 2; ++bj) { const f32x4 v0 = acc[ai][bj][m][0] * rs, v1 = acc[ai][bj][m][1] * rs;
                        float* o = of + (size_t)kk * XA + bj * HD; *(f32x4*)o = v0; *(f32x4*)(o + 4) = v1;
                        bf16_t* q = vt + (size_t)bj * HD * MEML + kk;
#pragma unroll
                        for (int e = 0; e < 4; ++e) { q[e * MEML] = f2bf(v0[e]); q[(e + 4) * MEML] = f2bf(v1[e]); }
                        asm volatile("" ::: "memory"); } }
        }
    }
};

struct EpiInA {
    static constexpr bool PERM = false, AFTER_DRAIN = false;
    const float* ssx; bf16_t* UZ; bf16_t* VR; bf16_t* QB; float* SSV;
    __device__ __forceinline__ void operator()(const f32x4 (&acc)[2][2][4][2], const Unit& u, int wr, int wc, int fr, int fq) const {
        const int row0 = u.pm * 256 + wr * 64 + fr; float rs[2][4]; rows_rstd16(ssx, row0, fq, rs);
        if (u.pn < 16) {
#pragma unroll
            for (int ai = 0; ai < 2; ++ai)
#pragma unroll
                for (int m = 0; m < 4; ++m) { const int row = row0 + ai * 128 + m * 16; const float r = rs[ai][m]; f32x4 o[2];
#pragma unroll
                    for (int n = 0; n < 2; ++n)
#pragma unroll
                        for (int e = 0; e < 4; ++e) o[n][e] = acc[ai][0][m][n][e] * r * siluf_(acc[ai][1][m][n][e] * r);
                    *(u32x4*)(UZ + (size_t)row * E_ + 128 * u.pn + 32 * wc + 8 * fq) = pack8(o[0], o[1]); }
        } else if (u.pn < 24) {
#pragma unroll
            for (int ai = 0; ai < 2; ++ai)
#pragma unroll
                for (int m = 0; m < 4; ++m) { const int row = row0 + ai * 128 + m * 16; const float r = rs[ai][m]; float ss = 0.f;
#pragma unroll
                    for (int bj = 0; bj < 2; ++bj) { const f32x4 v0 = acc[ai][bj][m][0] * r, v1 = acc[ai][bj][m][1] * r;
                        ss += (v0[0] * v0[0] + v0[1] * v0[1]) + (v0[2] * v0[2] + v0[3] * v0[3]) + (v1[0] * v1[0] + v1[1] * v1[1]) + (v1[2] * v1[2] + v1[3] * v1[3]);
                        *(u32x4*)(VR + (size_t)row * E_ + 256 * (u.pn - 16) + 128 * bj + 32 * wc + 8 * fq) = pack8(v0, v1); }
                    ss = sum_rows4(ss);
                    if (fq == 0) SSV[(size_t)row * 32 + (u.pn - 16) * 4 + wc] = ss; }
        } else {
#pragma unroll
            for (int ai = 0; ai < 2; ++ai)
#pragma unroll
                for (int m = 0; m < 4; ++m) { const int row = row0 + ai * 128 + m * 16; const float r = rs[ai][m] * 0.08838834764831845f;
#pragma unroll
                    for (int bj = 0; bj < 2; ++bj) *(u32x4*)(QB + (size_t)row * XA + 256 * (u.pn - 24) + 128 * bj + 32 * wc + 8 * fq) = pack8(acc[ai][bj][m][0] * r, acc[ai][bj][m][1] * r); }
        }
    }
};

struct EpiInB {
    static constexpr bool PERM = false, AFTER_DRAIN = false;
    const float* ssx; bf16_t* P; bf16_t* G; bf16_t* QB; float* convp; float* convs; const float* cw; bf16_t* A2;
    __device__ __forceinline__ void operator()(const f32x4 (&acc)[2][2][4][2], const Unit& u, int wr, int wc, int fr, int fq) const {
        const int row0 = u.pm * 256 + wr * 64 + fr; float rs[2][4]; rows_rstd16(ssx, row0, fq, rs);
        if (u.pn < 32 && u.pm < MP / 256) {
            const int ch0 = 64 * u.pn + 16 * wc + 4 * fq;
            const f32x4 w0 = *(const f32x4*)(cw + ch0), w1 = *(const f32x4*)(cw + E_ + ch0), w2 = *(const f32x4*)(cw + 2 * E_ + ch0);
#pragma unroll
            for (int ai = 0; ai < 2; ++ai) {
                f32x4 pv = {0.f, 0.f, 0.f, 0.f};
#pragma unroll
                for (int m = 0; m < 4; ++m) { const int row = row0 + ai * 128 + m * 16; const float r = rs[ai][m];
                    const f32x4 bg = acc[ai][0][m][0] * r, cgv = acc[ai][0][m][1] * r, hv = acc[ai][1][m][0] * r, z = acc[ai][1][m][1] * r;
                    f32x4 p = cgv * hv, gg, y;
#pragma unroll
                    for (int e = 0; e < 4; ++e) { gg[e] = bg[e] * siluf_(z[e]);
                        const unsigned o1 = __builtin_amdgcn_update_dpp(0u, __float_as_uint(pv[e]), 0x121, 0xf, 0xf, true), o2 = __builtin_amdgcn_update_dpp(0u, __float_as_uint(pv[e]), 0x122, 0xf, 0xf, true);
                        const float pm1 = __uint_as_float(__builtin_amdgcn_update_dpp(o1, __float_as_uint(p[e]), 0x111, 0xf, 0xf, false));
                        const float pm2 = __uint_as_float(__builtin_amdgcn_update_dpp(o2, __float_as_uint(p[e]), 0x112, 0xf, 0xf, false));
                        y[e] = (w0[e] * pm2 + w1[e] * pm1 + w2[e] * p[e]) * gg[e]; }
                    pv = p;
                    u32x2 wp, wg, wy; wp.x = pk2(p[0], p[1]); wp.y = pk2(p[2], p[3]); wg.x = pk2(gg[0], gg[1]); wg.y = pk2(gg[2], gg[3]); wy.x = pk2(y[0], y[1]); wy.y = pk2(y[2], y[3]);
                    if (m > 0 || fr >= 2) *(u32x2*)(A2 + (size_t)row * KOUT + ch0) = wy;
                    if ((m == 0 && fr < 2) || (m == 3 && fr >= 14)) *(u32x2*)(P + (size_t)row * E_ + ch0) = wp;
                    if (m == 0 && fr < 2) *(u32x2*)(G + (size_t)row * E_ + ch0) = wg;
                    { const int t = row & (PSEQ - 1); if (t >= PSEQ - 2) *(f32x4*)(convp + ((size_t)(row >> 11) * 2 + (t - (PSEQ - 2))) * E_ + ch0) = p; } } }
        } else if (u.pn < 32) {
            const int ch0 = 64 * u.pn + 16 * wc + 4 * fq;
#pragma unroll
            for (int ai = 0; ai < 2; ++ai)
#pragma unroll
                for (int m = 0; m < 4; ++m) { const int row = row0 + ai * 128 + m * 16; const float r = rs[ai][m];
                    const f32x4 bg = acc[ai][0][m][0] * r, cgv = acc[ai][0][m][1] * r, hv = acc[ai][1][m][0] * r, z = acc[ai][1][m][1] * r;
                    f32x4 p = cgv * hv, gg;
#pragma unroll
                    for (int e = 0; e < 4; ++e) gg[e] = bg[e] * siluf_(z[e]);
                    u32x2 wp, wg; wp.x = pk2(p[0], p[1]); wp.y = pk2(p[2], p[3]); wg.x = pk2(gg[0], gg[1]); wg.y = pk2(gg[2], gg[3]);
                    *(u32x2*)(P + (size_t)row * E_ + ch0) = wp; *(u32x2*)(G + (size_t)row * E_ + ch0) = wg;
                    if (row < MP) { const int t = row & (PSEQ - 1); if (t >= PSEQ - 2) *(f32x4*)(convp + ((size_t)(row >> 11) * 2 + (t - (PSEQ - 2))) * E_ + ch0) = p; }
                    else { const int s = row - MP, t = s & 3; if (t >= 2) *(f32x4*)(convs + ((size_t)(s >> 2) * 2 + (t - 2)) * E_ + ch0) = p; } }
        } else {
#pragma unroll
            for (int ai = 0; ai < 2; ++ai)
#pragma unroll
                for (int m = 0; m < 4; ++m) { const int row = row0 + ai * 128 + m * 16; const float r = rs[ai][m] * 0.08838834764831845f;
#pragma unroll
                    for (int bj = 0; bj < 2; ++bj) *(u32x4*)(QB + (size_t)row * XA + 256 * (u.pn - 32) + 128 * bj + 32 * wc + 8 * fq) = pack8(acc[ai][bj][m][0] * r, acc[ai][bj][m][1] * r); }
        }
    }
};

struct EpiInC {
    static constexpr bool PERM = false, AFTER_DRAIN = false;
    const float* ssx; bf16_t* U; bf16_t* SZ; bf16_t* QB;
    __device__ __forceinline__ void operator()(const f32x4 (&acc)[2][2][4][2], const Unit& u, int wr, int wc, int fr, int fq) const {
        const int row0 = u.pm * 256 + wr * 64 + fr; float rs[2][4]; rows_rstd16(ssx, row0, fq, rs);
#pragma unroll
        for (int ai = 0; ai < 2; ++ai)
#pragma unroll
            for (int m = 0; m < 4; ++m) { const int row = row0 + ai * 128 + m * 16; const float r = rs[ai][m];
#pragma unroll
                for (int bj = 0; bj < 2; ++bj) { const int cc = 128 * bj + 32 * wc + 8 * fq;
                    if (u.pn < 8) *(u32x4*)(U + (size_t)row * E_ + 256 * u.pn + cc) = pack8(acc[ai][bj][m][0] * r, acc[ai][bj][m][1] * r);
                    else if (u.pn < 16) { f32x4 a, b2;
#pragma unroll
                        for (int e = 0; e < 4; ++e) { a[e] = siluf_(acc[ai][bj][m][0][e] * r); b2[e] = siluf_(acc[ai][bj][m][1][e] * r); }
                        *(u32x4*)(SZ + (size_t)row * E_ + 256 * (u.pn - 8) + cc) = pack8(a, b2); }
                    else { const float rq = r * 0.08838834764831845f; *(u32x4*)(QB + (size_t)row * XA + 256 * (u.pn - 16) + cc) = pack8(acc[ai][bj][m][0] * rq, acc[ai][bj][m][1] * rq); } } }
    }
};

struct EpiOut {
    static constexpr bool PERM = false, AFTER_DRAIN = false;
    const float* basef; bf16_t* XB; float* SSX;
    __device__ __forceinline__ void operator()(const f32x4 (&acc)[2][2][4][2], const Unit& u, int wr, int wc, int fr, int fq) const {
        const int row0 = u.pm * 256 + wr * 64 + fr;
#pragma unroll
        for (int ai = 0; ai < 2; ++ai)
#pragma unroll
            for (int m = 0; m < 4; ++m) { const int row = row0 + ai * 128 + m * 16; float ss = 0.f;
#pragma unroll
                for (int bj = 0; bj < 2; ++bj) { const int col = 256 * u.pn + 128 * bj + 32 * wc + 8 * fq; f32x4 x0, x1;
                    if (basef) { x0 = *(const f32x4*)(basef + (size_t)row * DM + col); x1 = *(const f32x4*)(basef + (size_t)row * DM + col + 4); }
                    else { float r[8]; unpack8(*(const u32x4*)(XB + (size_t)row * DM + col), r); x0 = (f32x4){r[0], r[1], r[2], r[3]}; x1 = (f32x4){r[4], r[5], r[6], r[7]}; }
                    x0 += acc[ai][bj][m][0]; x1 += acc[ai][bj][m][1];
                    *(u32x4*)(XB + (size_t)row * DM + col) = pack8(x0, x1);
                    ss += (x0[0] * x0[0] + x0[1] * x0[1]) + (x0[2] * x0[2] + x0[3] * x0[3]) + (x1[0] * x1[0] + x1[1] * x1[1]) + (x1[2] * x1[2] + x1[3] * x1[3]); }
                ss = sum_rows4(ss);
                if (fq == 0) SSX[(size_t)row * 16 + u.pn * 4 + wc] = ss; }
    }
};

__device__ __forceinline__ void counter_signal(unsigned* cnt);
__device__ __forceinline__ void counter_wait(unsigned* cnt, unsigned want);
struct EpiOutFinal {
    static constexpr bool PERM = false, AFTER_DRAIN = true;
    const bf16_t* XB; float* SSX; const float* fg; float* Y; unsigned* cnt;
    __device__ __forceinline__ void operator()(f32x4 (&acc)[2][2][4][2], const Unit& u, int wr, int wc, int fr, int fq) const {
        const int row0 = u.pm * 256 + wr * 64 + fr;
#pragma unroll
        for (int ai = 0; ai < 2; ++ai)
#pragma unroll
            for (int m = 0; m < 4; ++m) { const int row = row0 + ai * 128 + m * 16; float ss = 0.f;
#pragma unroll
                for (int bj = 0; bj < 2; ++bj) { const int col = 256 * u.pn + 128 * bj + 32 * wc + 8 * fq;
                    float r[8]; unpack8(*(const u32x4*)(XB + (size_t)row * DM + col), r);
                    const f32x4 x0 = acc[ai][bj][m][0] + (f32x4){r[0], r[1], r[2], r[3]}, x1 = acc[ai][bj][m][1] + (f32x4){r[4], r[5], r[6], r[7]};
                    acc[ai][bj][m][0] = x0; acc[ai][bj][m][1] = x1;
                    ss += (x0[0] * x0[0] + x0[1] * x0[1]) + (x0[2] * x0[2] + x0[3] * x0[3]) + (x1[0] * x1[0] + x1[1] * x1[1]) + (x1[2] * x1[2] + x1[3] * x1[3]); }
                ss = sum_rows4(ss);
                if (fq == 0) SSX[(size_t)row * 16 + u.pn * 4 + wc] = ss; }
        counter_signal(cnt + 64 * u.pm); counter_wait(cnt + 64 * u.pm, 4u);
        float rs[2][4]; rows_rstd16(SSX, row0, fq, rs);
#pragma unroll
        for (int bj = 0; bj < 2; ++bj) { const int col = 256 * u.pn + 128 * bj + 32 * wc + 8 * fq; const f32x4 g0 = *(const f32x4*)(fg + col), g1 = *(const f32x4*)(fg + col + 4);
#pragma unroll
            for (int ai = 0; ai < 2; ++ai)
#pragma unroll
                for (int m = 0; m < 4; ++m) { const int row = row0 + ai * 128 + m * 16; const float r = rs[ai][m];
                    *(f32x4*)(Y + (size_t)row * DM + col) = acc[ai][bj][m][0] * r * g0; *(f32x4*)(Y + (size_t)row * DM + col + 4) = acc[ai][bj][m][1] * r * g1; } }
    }
};

struct EpiGlu {
    static constexpr bool PERM = false, AFTER_DRAIN = false;
    const bf16_t* GB; const bf16_t* SZ; const float* bias; bf16_t* A2;
    __device__ __forceinline__ void operator()(const f32x4 (&acc)[2][2][4][2], const Unit& u, int wr, int wc, int fr, int fq) const {
        const int row0 = u.pm * 256 + wr * 64 + fr;
#pragma unroll
        for (int ai = 0; ai < 2; ++ai)
#pragma unroll
            for (int m = 0; m < 4; ++m) { const int row = row0 + ai * 128 + m * 16;
#pragma unroll
                for (int bj = 0; bj < 2; ++bj) { const int col = 256 * u.pn + 128 * bj + 32 * wc + 8 * fq;
                    const f32x4 b0 = *(const f32x4*)(bias + col), b1 = *(const f32x4*)(bias + col + 4);
                    float gv[8], sz[8]; unpack8(*(const u32x4*)(GB + (size_t)row * E_ + col), gv); unpack8(*(const u32x4*)(SZ + (size_t)row * E_ + col), sz);
                    f32x4 o0, o1;
#pragma unroll
                    for (int e = 0; e < 4; ++e) { o0[e] = gv[e] * sigmoidf_(acc[ai][bj][m][0][e] + b0[e]) * sz[e]; o1[e] = gv[4 + e] * sigmoidf_(acc[ai][bj][m][1][e] + b1[e]) * sz[4 + e]; }
                    *(u32x4*)(A2 + (size_t)row * KOUT + col) = pack8(o0, o1); } }
    }
};

struct EpiSlab {
    static constexpr bool PERM = false, AFTER_DRAIN = false;
    float* S; int ldc; int row0; size_t kstride;
    __device__ __forceinline__ void operator()(const f32x4 (&acc)[2][2][4][2], const Unit& u, int wr, int wc, int fr, int fq) const {
        float* base = S + (size_t)u.ks * kstride + (size_t)(u.pm * 256 + wr * 64 + fr - row0) * ldc + 256 * u.pn + 32 * wc + 8 * fq;
#pragma unroll
        for (int ai = 0; ai < 2; ++ai)
#pragma unroll
            for (int m = 0; m < 4; ++m)
                { float* o = base + (size_t)(ai * 128 + m * 16) * ldc; *(f32x4*)o = acc[ai][0][m][0]; *(f32x4*)(o + 4) = acc[ai][0][m][1]; *(f32x4*)(o + 128) = acc[ai][1][m][0]; *(f32x4*)(o + 132) = acc[ai][1][m][1];
                  asm volatile("" ::: "memory"); }
    }
};

#ifndef PROBE_EPI2
#define PROBE_EPI2 0
#endif
template <class E_> struct EpiTwice { static constexpr bool PERM = false, AFTER_DRAIN = false; E_ e;
    __device__ __forceinline__ void operator()(const f32x4 (&acc)[2][2][4][2], const Unit& u, int wr, int wc, int fr, int fq) const { e(acc, u, wr, wc, fr, fq); asm volatile("" ::: "memory"); e(acc, u, wr, wc, fr, fq); } };

struct Frame {
    LAS unsigned char* lds; int tid, lane, wave, G, bid;
    const float* const* in; float* out; unsigned char* ws;
};

struct WItem { const float* W; const float* gs; bf16_t* WT; int K, N, kind, r; };
__device__ __forceinline__ WItem witem(Frame& F, int it) {
    constexpr int I_A = 16 * (NIN_A / 32), I_B = 16 * (NIN_B / 32), I_C = 16 * (NIN_C / 32), I_O = (KOUT / 64) * (DM / 32), I_KV = 16 * (DM / 32);
    unsigned char* ws = F.ws; int r = it; WItem w;
    if (r < 2 * I_A) { const int j = r / I_A; r -= j * I_A; w = WItem{GIN(13) + (size_t)j * DM * NIN_A, GIN(8) + (j == 0 ? 0 : 3) * DM, (bf16_t*)(ws + WS_WINA) + (size_t)j * NIN_A * DM, DM, NIN_A, 0, r}; return w; } r -= 2 * I_A;
    if (r < I_B) { w = WItem{GIN(17), GIN(8) + 1 * DM, (bf16_t*)(ws + WS_WINB), DM, NIN_B, 1, r}; return w; } r -= I_B;
    if (r < I_C) { w = WItem{GIN(19), GIN(8) + 2 * DM, (bf16_t*)(ws + WS_WINC), DM, NIN_C, 2, r}; return w; } r -= I_C;
    if (r < 4 * I_O) { const int j = r / I_O; r -= j * I_O; w = WItem{GIN(12) + (size_t)j * KOUT * DM, nullptr, (bf16_t*)(ws + WS_WOUT) + (size_t)j * DM * KOUT, KOUT, DM, 2, r}; return w; } r -= 4 * I_O;
    if (r < 4 * I_KV) { const int j = r / I_KV; r -= j * I_KV; w = WItem{GIN(11) + (size_t)j * DM * DM, GIN(10) + j * DM, (bf16_t*)(ws + WS_WKV) + (size_t)j * DM * DM, DM, DM, 2, r}; return w; } r -= 4 * I_KV;
    w = WItem{GIN(28), nullptr, (bf16_t*)(ws + WS_WGLU), E_, E_, 2, r}; return w;
}
__device__ __forceinline__ void witem_load(const WItem& w, int lane, f32x4 (&x)[8]) {
    const int nblk = w.N / 32, kb = w.r / nblk, nb = w.r % nblk, k0 = 64 * kb, n0 = 32 * nb, n4 = lane & 7, kr = lane >> 3;
    const int sc = src_col(w.kind, n0 + 4 * n4);
#pragma unroll
    for (int i = 0; i < 8; ++i) x[i] = *(const f32x4*)(w.W + (size_t)(k0 + kr + 8 * i) * w.N + sc);
}
__device__ __forceinline__ void witem_finish(const WItem& w, int lane, const f32x4 (&x)[8], LAS float* scr) {
    const int nblk = w.N / 32, kb = w.r / nblk, nb = w.r % nblk, k0 = 64 * kb, n0 = 32 * nb, n4 = lane & 7, kr = lane >> 3;
    asm volatile("s_waitcnt vmcnt(8)" ::: "memory");
#pragma unroll
    for (int i = 0; i < 8; ++i) { const int kk = kr + 8 * i; const float g = w.gs ? w.gs[k0 + kk] : 1.f; LAS float* d = scr + kk * 33 + 4 * n4; d[0] = x[i][0] * g; d[1] = x[i][1] * g; d[2] = x[i][2] * g; d[3] = x[i][3] * g; }
    asm volatile("s_waitcnt lgkmcnt(0)" ::: "memory");
    const int c = lane & 7;
#pragma unroll
    for (int j = 0; j < 4; ++j) { const int n = (lane >> 3) + 8 * j; const LAS float* sp = scr + (8 * c) * 33 + n;
        u32x4 o; o.x = pk2(sp[0 * 33], sp[1 * 33]); o.y = pk2(sp[2 * 33], sp[3 * 33]); o.z = pk2(sp[4 * 33], sp[5 * 33]); o.w = pk2(sp[6 * 33], sp[7 * 33]);
        *(u32x4*)(w.WT + (size_t)(n0 + n) * w.K + k0 + 8 * c) = o; }
    asm volatile("s_waitcnt lgkmcnt(0)" ::: "memory");
}

__device__ __forceinline__ void p0_prologue(Frame& F) {
    LAS float* scr = (LAS float*)(F.lds + F.wave * 16384);
    const int gw = F.bid * NWAVES + F.wave, NGW = F.G * NWAVES, lane = F.lane;
    unsigned char* ws = F.ws;
    constexpr int NITEMS = 2 * 16 * (NIN_A / 32) + 16 * (NIN_B / 32) + 16 * (NIN_C / 32) + 4 * (KOUT / 64) * (DM / 32) + 4 * 16 * (DM / 32) + (E_ / 64) * (E_ / 32);
    if (gw < NITEMS) {
        WItem wc = witem(F, gw); f32x4 xa[8]; witem_load(wc, lane, xa);
        for (int it = gw; it < NITEMS; it += NGW) {
            const int nit = it + NGW < NITEMS ? it + NGW : it; const WItem wn = witem(F, nit); f32x4 xb[8]; witem_load(wn, lane, xb);
            witem_finish(wc, lane, xa, scr);
            wc = wn;
#pragma unroll
            for (int i = 0; i < 8; ++i) xa[i] = xb[i];
        }
    }
    {
        bf16_t* XB = (bf16_t*)(ws + WS_XB); float* SSX = (float*)(ws + WS_SSX);
        for (int row = gw; row < M; row += 2 * NGW) {
            const int row2 = row + NGW < M ? row + NGW : row;
            const float* xr = row < MP ? GIN(0) + (size_t)row * DM : GIN(1) + (size_t)(row - MP) * DM;
            const float* xr2 = row2 < MP ? GIN(0) + (size_t)row2 * DM : GIN(1) + (size_t)(row2 - MP) * DM;
            f32x4 v[4], v2[4];
#pragma unroll
            for (int j = 0; j < 4; ++j) { v[j] = *((const f32x4*)xr + lane + 64 * j); v2[j] = *((const f32x4*)xr2 + lane + 64 * j); }
            float ss = 0.f, ss2 = 0.f;
#pragma unroll
            for (int j = 0; j < 4; ++j) { ss += (v[j][0] * v[j][0] + v[j][1] * v[j][1]) + (v[j][2] * v[j][2] + v[j][3] * v[j][3]); ss2 += (v2[j][0] * v2[j][0] + v2[j][1] * v2[j][1]) + (v2[j][2] * v2[j][2] + v2[j][3] * v2[j][3]);
                u32x2 w; w.x = pk2(v[j][0], v[j][1]); w.y = pk2(v[j][2], v[j][3]); *((u32x2*)(XB + (size_t)row * DM) + lane + 64 * j) = w;
                u32x2 w2; w2.x = pk2(v2[j][0], v2[j][1]); w2.y = pk2(v2[j][2], v2[j][3]); *((u32x2*)(XB + (size_t)row2 * DM) + lane + 64 * j) = w2; }
            asm volatile("s_waitcnt vmcnt(0)" ::: "memory");
            ss = wave_sum(ss); ss2 = wave_sum(ss2);
            if (lane < 16) { SSX[(size_t)row * 16 + lane] = lane == 0 ? ss : 0.f; SSX[(size_t)row2 * 16 + lane] = lane == 0 ? ss2 : 0.f; }
        }
    }
    {
        bf16_t* MB = (bf16_t*)(ws + WS_MEMB); float* RM = (float*)(ws + WS_RSTDM);
        for (int row = gw; row < PB * MEML; row += NGW) {
            const float* xr = GIN(2) + (size_t)row * DM; float ss = 0.f;
#pragma unroll
            for (int j = 0; j < 4; ++j) { const f32x4 v = *((const f32x4*)xr + lane + 64 * j); ss += (v[0] * v[0] + v[1] * v[1]) + (v[2] * v[2] + v[3] * v[3]);
                u32x2 w; w.x = pk2(v[0], v[1]); w.y = pk2(v[2], v[3]); *((u32x2*)(MB + (size_t)row * DM) + lane + 64 * j) = w; }
            asm volatile("s_waitcnt vmcnt(0)" ::: "memory");
            ss = wave_sum(ss);
            if (lane == 0) RM[row] = 1.0f / sqrtf(ss * (1.f / DM) + EPS);
        }
    }
    {
        float* TAB = (float*)(ws + WS_TAB);
        for (int g = gw; g < S5G; g += NGW) {
            const int gp = g * S5P + lane;
            const float lr = GIN(20)[gp], li = GIN(21)[gp], dt = expf(GIN(22)[g]);
            const float th = li * dt, em1 = expm1f(lr * dt), mag = em1 + 1.f, cs = cosf(th), sn = sinf(th), sh = sinf(0.5f * th);
            const float ar = mag * cs, ai = mag * sn;
            const float nr = em1 * cs - 2.f * sh * sh, ni = ai;
            const float den = lr * lr + li * li, cr = (nr * lr + ni * li) / den, ci = (ni * lr - nr * li) / den;
            TAB[T_AR + gp] = ar; TAB[T_AI + gp] = ai;
#pragma unroll
            for (int i = 0; i < S5I; ++i) { const float br = GIN(23)[(size_t)gp * S5I + i], bi = GIN(24)[(size_t)gp * S5I + i];
                TAB[T_BBR + (size_t)gp * S5I + i] = cr * br - ci * bi; TAB[T_BBI + (size_t)gp * S5I + i] = cr * bi + ci * br; }
        }
    }
    {
        bf16_t* SW = (bf16_t*)(ws + WS_SGUW);
        for (int i = (F.bid * NTHR + F.tid); i < 2 * 8 * 128 * 128; i += F.G * NTHR) { const int t = (i >> 7) & 127, s = i & 127; SW[i] = f2bf(s <= t ? GIN(15)[i] : 0.f); }
    }
}

typedef short v4i16_t __attribute__((ext_vector_type(4)));
constexpr int SG_VSTR = 576, SG_WSTR = 272, SG_WOFF = 128 * SG_VSTR, SG_ROFF = SG_WOFF + 128 * SG_WSTR;
static_assert(SG_ROFF + 1024 <= RING_BYTES, "sgu LDS");
__device__ __forceinline__ void sgu_phase_mfma(Frame& F, int j) {
    const bf16_t* UZ = (const bf16_t*)(F.ws + WS_B0); const bf16_t* VR = (const bf16_t*)(F.ws + WS_B1); const float* SSV = (const float*)(F.ws + WS_SSV);
    const bf16_t* SW = (const bf16_t*)(F.ws + WS_SGUW) + (size_t)j * 8 * 128 * 128; bf16_t* A2 = (bf16_t*)(F.ws + WS_A2);
    const float* gn = GIN(14) + (size_t)j * E_; const float* bsv = GIN(16) + (size_t)j * 8 * 128;
    LAS unsigned char* lds = F.lds; LAS float* rsl = (LAS float*)(lds + SG_ROFF);
    const int tid = F.tid, lane = F.lane, wid = F.wave, c = lane & 31, hh = lane >> 5;
    const bool same_g = (F.G & 7) == 0; int gld = -1, cur = 0;
    u32x4 vr[8];
    { const int un = F.bid; if (un < 128 * 8) { const int rbase = (un >> 3) * 128, g = un & 7;
#pragma unroll
        for (int i = 0; i < 8; ++i) { const int chn = tid + NTHR * i; vr[i] = *(const u32x4*)(VR + (size_t)(rbase + (chn >> 5)) * E_ + 256 * g + 8 * (chn & 31)); }
        __syncthreads();
        if (tid < 128) { const float* p = SSV + (size_t)(rbase + tid) * 32; float sq = 0.f;
#pragma unroll
            for (int k = 0; k < 8; ++k) { const f32x4 v = *((const f32x4*)p + k); sq += (v[0] + v[1]) + (v[2] + v[3]); }
            rsl[tid] = __builtin_amdgcn_rsqf(sq * (1.f / E_) + EPS); } } }
    for (int un = F.bid; un < 128 * 8; un += F.G) {
        const int ch = un >> 3, g = un & 7, rbase = ch * 128; const int nun = un + F.G < 128 * 8 ? un + F.G : un, nrb = (nun >> 3) * 128, ng = nun & 7;
        asm volatile("s_waitcnt vmcnt(0)" ::: "memory");
        __syncthreads();
        if (!same_g || gld != g) { gld = g;
#pragma unroll
            for (int i = 0; i < 4; ++i) { const int chn = tid + NTHR * i, row = chn >> 4, c16 = chn & 15;
                *(LAS u32x4*)(lds + SG_WOFF + row * SG_WSTR + c16 * 16) = *(const u32x4*)(SW + (size_t)g * 128 * 128 + row * 128 + c16 * 8); } }
#pragma unroll
        for (int i = 0; i < 8; ++i) { const int chn = tid + NTHR * i, sr = chn >> 5, c8 = chn & 31; float v[8]; unpack8(vr[i], v);
            const float r = rsl[cur * 128 + sr]; const f32x4 g0 = *(const f32x4*)(gn + 256 * g + 8 * c8), g1 = *(const f32x4*)(gn + 256 * g + 8 * c8 + 4); f32x4 a, b2;
#pragma unroll
            for (int e = 0; e < 4; ++e) { a[e] = v[e] * r * g0[e]; b2[e] = v[4 + e] * r * g1[e]; }
            *(LAS u32x4*)(lds + sr * SG_VSTR + c8 * 16) = pack8(a, b2); }
#pragma unroll
        for (int i = 0; i < 8; ++i) { const int chn = tid + NTHR * i; vr[i] = *(const u32x4*)(VR + (size_t)(nrb + (chn >> 5)) * E_ + 256 * ng + 8 * (chn & 31)); }
        if (tid < 128) { const float* p = SSV + (size_t)(nrb + tid) * 32; float sq = 0.f;
#pragma unroll
            for (int k = 0; k < 8; ++k) { const f32x4 v = *((const f32x4*)p + k); sq += (v[0] + v[1]) + (v[2] + v[3]); }
            rsl[(cur ^ 1) * 128 + tid] = __builtin_amdgcn_rsqf(sq * (1.f / E_) + EPS); }
        u32x2 uzr[4][4];
#pragma unroll
        for (int ti = 0; ti < 4; ++ti)
#pragma unroll
            for (int g4 = 0; g4 < 4; ++g4) uzr[ti][g4] = *(const u32x2*)(UZ + (size_t)(rbase + 32 * ti + c) * E_ + 256 * g + 32 * wid + 8 * g4 + 4 * hh);
        __syncthreads();
        f32x16 acc[4];
#pragma unroll
        for (int ti = 0; ti < 4; ++ti) acc[ti] = (f32x16){};
        const LAS unsigned char* abase = lds + (8 * hh + ((lane & 15) >> 2)) * SG_VSTR + (32 * wid + 16 * ((lane >> 4) & 1) + 4 * (lane & 3)) * 2;
#pragma unroll
        for (int s2 = 0; s2 < 8; ++s2) {
            const v4i16_t lo = __builtin_amdgcn_ds_read_tr16_b64_v4i16((LAS v4i16_t*)(abase + (16 * s2) * SG_VSTR));
            const v4i16_t hi = __builtin_amdgcn_ds_read_tr16_b64_v4i16((LAS v4i16_t*)(abase + (16 * s2 + 4) * SG_VSTR));
            const bf16x8 a = (bf16x8){lo[0], lo[1], lo[2], lo[3], hi[0], hi[1], hi[2], hi[3]};
#pragma unroll
            for (int ti = s2 >> 1; ti < 4; ++ti) { const bf16x8 b = *(const LAS bf16x8*)(lds + SG_WOFF + (32 * ti + c) * SG_WSTR + (16 * s2 + 8 * hh) * 2);
                acc[ti] = __builtin_amdgcn_mfma_f32_32x32x16_bf16(a, b, acc[ti], 0, 0, 0); }
        }
#pragma unroll
        for (int ti = 0; ti < 4; ++ti) { const int t = 32 * ti + c; const size_t row = (size_t)(rbase + t); const float bias = bsv[g * 128 + t];
#pragma unroll
            for (int g4 = 0; g4 < 4; ++g4) { const int d = 256 * g + 32 * wid + 8 * g4 + 4 * hh; const u32x2 uz = uzr[ti][g4];
                u32x2 w; w.x = pk2(bflo(uz.x) * (acc[ti][4 * g4] + bias), bfhi(uz.x) * (acc[ti][4 * g4 + 1] + bias)); w.y = pk2(bflo(uz.y) * (acc[ti][4 * g4 + 2] + bias), bfhi(uz.y) * (acc[ti][4 * g4 + 3] + bias));
                *(u32x2*)(A2 + row * KOUT + d) = w; } }
        cur ^= 1;
    }
}

__device__ __forceinline__ void sgu_sample_phase(Frame& F, int j) {
    const bf16_t* UZ = (const bf16_t*)(F.ws + WS_B0); const bf16_t* VR = (const bf16_t*)(F.ws + WS_B1); const float* SSV = (const float*)(F.ws + WS_SSV);
    const bf16_t* SW = (const bf16_t*)(F.ws + WS_SGUW) + (size_t)j * 8 * 128 * 128; bf16_t* A2 = (bf16_t*)(F.ws + WS_A2);
    const float* gn = GIN(14) + (size_t)j * E_; const float* bsv = GIN(16) + (size_t)j * 8 * 128; float* cvout = F.out + O_CV + (size_t)j * SBT * SSEQ * E_;
    const int gw = F.bid * NWAVES + F.wave, NGW = F.G * NWAVES, lane = F.lane;
    for (int task = gw; task < SBT * 8; task += NGW) {
        const int b = task >> 3, g = task & 7; const size_t r0 = (size_t)MP + b * SSEQ; const int ch = 256 * g + 4 * lane;
        float rs[SSEQ];
#pragma unroll
        for (int t = 0; t < SSEQ; ++t) { float v = lane < 32 ? SSV[(r0 + t) * 32 + lane] : 0.f; v = wave_sum(v); rs[t] = __builtin_amdgcn_rsqf(v * (1.f / E_) + EPS); }
        const f32x4 g4 = *(const f32x4*)(gn + ch);
        f32x4 vn[SSEQ];
#pragma unroll
        for (int t = 0; t < SSEQ; ++t) { const u32x2 w = *(const u32x2*)(VR + (r0 + t) * E_ + ch); const f32x4 v = (f32x4){bflo(w.x), bfhi(w.x), bflo(w.y), bfhi(w.y)}; vn[t] = v * rs[t] * g4;
            *(f32x4*)(cvout + (size_t)(b * SSEQ + t) * E_ + ch) = vn[t];
            u32x2 q; q.x = pk2(vn[t][0], vn[t][1]); q.y = pk2(vn[t][2], vn[t][3]); vn[t] = (f32x4){bflo(q.x), bfhi(q.x), bflo(q.y), bfhi(q.y)}; }
#pragma unroll
        for (int t = 0; t < SSEQ; ++t) { f32x4 a = {0.f, 0.f, 0.f, 0.f};
#pragma unroll
            for (int sq = 0; sq <= t; ++sq) a += vn[sq] * bf2f(SW[(size_t)g * 128 * 128 + t * 128 + sq]);
            a += bsv[g * 128 + t];
            const u32x2 uz = *(const u32x2*)(UZ + (r0 + t) * E_ + ch);
            u32x2 w; w.x = pk2(bflo(uz.x) * a[0], bfhi(uz.x) * a[1]); w.y = pk2(bflo(uz.y) * a[2], bfhi(uz.y) * a[3]);
            *(u32x2*)(A2 + (r0 + t) * KOUT + ch) = w; }
    }
}

__device__ __forceinline__ void conv_phase(Frame& F) {
    const bf16_t* P = (const bf16_t*)(F.ws + WS_B0); const bf16_t* G = (const bf16_t*)(F.ws + WS_B1); bf16_t* A2 = (bf16_t*)(F.ws + WS_A2);
    const float* cw = GIN(18); const float* st = GIN(5);
    constexpr int NFIX = (MP / 64) * 256, NSMP = (MS / 32) * 256;
    for (int i = F.bid * NTHR + F.tid; i < NFIX + NSMP; i += F.G * NTHR) {
        const bool fix = i < NFIX; const int j = fix ? i : i - NFIX;
        const int c0 = (j & 255) * 8, r0 = fix ? (j >> 8) * 64 : MP + (j >> 8) * 32, nr = fix ? 2 : 32;
        float w0[8], w1[8], w2[8];
#pragma unroll
        for (int e = 0; e < 8; ++e) { w0[e] = cw[c0 + e]; w1[e] = cw[E_ + c0 + e]; w2[e] = cw[2 * E_ + c0 + e]; }
        float x1[8], x2[8];
#pragma unroll
        for (int e = 0; e < 8; ++e) { x1[e] = 0.f; x2[e] = 0.f; }
        if (fix && (r0 & (PSEQ - 1)) != 0) { unpack8(*(const u32x4*)(P + (size_t)(r0 - 1) * E_ + c0), x1); unpack8(*(const u32x4*)(P + (size_t)(r0 - 2) * E_ + c0), x2); }
#pragma unroll 2
        for (int rr = 0; rr < nr; ++rr) {
            const int row = r0 + rr;
            if (row >= MP && ((row - MP) & 3) == 0) { const float* buf = st + (size_t)((row - MP) >> 2) * 2 * E_ + c0;
                for (int e = 0; e < 8; ++e) { x2[e] = buf[e]; x1[e] = buf[E_ + e]; } }
            float x0[8], gg[8]; unpack8(*(const u32x4*)(P + (size_t)row * E_ + c0), x0); unpack8(*(const u32x4*)(G + (size_t)row * E_ + c0), gg);
            f32x4 o0, o1;
#pragma unroll
            for (int e = 0; e < 8; ++e) { const float y = w0[e] * x2[e] + w1[e] * x1[e] + w2[e] * x0[e]; const float r = y * gg[e]; if (e < 4) o0[e] = r; else o1[e - 4] = r; x2[e] = x1[e]; x1[e] = x0[e]; }
            *(u32x4*)(A2 + (size_t)row * KOUT + c0) = pack8(o0, o1);
        }
    }
}

#if XHALF_SHFL
__device__ __forceinline__ void xhalf(float v, float& lo, float& hi) { const int l_ = threadIdx.x & 31; lo = __shfl(v, l_); hi = __shfl(v, l_ + 32); }
#else
__device__ __forceinline__ void xhalf(float v, float& lo, float& hi) { auto rr = __builtin_amdgcn_permlane32_swap(__float_as_uint(v), __float_as_uint(v), false, false); lo = __uint_as_float(rr[0]); hi = __uint_as_float(rr[1]);
 }
#endif
__device__ __forceinline__ void cmuladd(float& xr, float& xi, float ar, float ai, float pr, float pi) { float t = fmaf(-ai, pi, xr); asm("" : "+v"(t)); xr = fmaf(ar, pr, t); xi = fmaf(ar, pi, fmaf(ai, pr, xi)); }
constexpr int S5_HSTR = 272, S5_UOFF = 32 * S5_HSTR, S5_OOFF = S5_UOFF + 1024, S5_HT = S5_OOFF + 4096;
__device__ __forceinline__ void s5_prompt_mfma(Frame& F) {
    const bf16_t* U = (const bf16_t*)(F.ws + WS_B0); bf16_t* GBo = (bf16_t*)(F.ws + WS_GB); const float* TAB = (const float*)(F.ws + WS_TAB);
    const float* cre = GIN(25); const float* cim = GIN(26); const float* dsk = GIN(27);
    const int lane = F.lane, wid = F.wave, c = lane & 31, hh = lane >> 5, col = lane & 15, fq = lane >> 4;
    LAS unsigned char* ht = F.lds + wid * S5_HT;
    for (int task = F.bid * NWAVES + wid; task < PB * S5G; task += F.G * NWAVES) {
        const int b = task >> 7, g = task & 127;
        bf16x8 bfr[2], bfi[2];
#pragma unroll
        for (int st = 0; st < 2; ++st) { const int gp = g * S5P + 32 * st + c;
            const float* pr = TAB + T_BBR + (size_t)gp * 16 + 8 * hh; const float* pi = TAB + T_BBI + (size_t)gp * 16 + 8 * hh;
            bfr[st] = __builtin_bit_cast(bf16x8, pack8(*(const f32x4*)pr, *(const f32x4*)(pr + 4))); bfi[st] = __builtin_bit_cast(bf16x8, pack8(*(const f32x4*)pi, *(const f32x4*)(pi + 4))); }
        const float a1r = TAB[T_AR + g * S5P + lane], a1i = TAB[T_AI + g * S5P + lane];
        bf16x8 cf[4];
#pragma unroll
        for (int s4 = 0; s4 < 4; ++s4) { const size_t o = ((size_t)g * 16 + col) * S5P + 16 * s4 + 4 * fq; const f32x4 cr4 = *(const f32x4*)(cre + o), ci4 = *(const f32x4*)(cim + o);
            u32x4 w; w.x = pk2(cr4[0], -ci4[0]); w.y = pk2(cr4[1], -ci4[1]); w.z = pk2(cr4[2], -ci4[2]); w.w = pk2(cr4[3], -ci4[3]); cf[s4] = __builtin_bit_cast(bf16x8, w); }
        const f32x4 d4 = *(const f32x4*)(dsk + 16 * g + 4 * fq);
        float er = 0.f, ei = 0.f;
        const bf16_t* up = U + ((size_t)b * PSEQ + c) * E_ + 16 * g + 8 * hh;
        bf16x8 ub[4];
#pragma unroll
        for (int q = 0; q < 4; ++q) ub[q] = *(const GAS bf16x8*)(up + (size_t)q * 32 * E_);
        for (int tg = 0; tg < PSEQ / 128; ++tg) {
          bf16x8 nb[4];
#pragma unroll
          for (int q = 0; q < 4; ++q) nb[q] = *(const GAS bf16x8*)(up + (size_t)(4 * (tg + 1 < PSEQ / 128 ? tg + 1 : tg) + q) * 32 * E_);
#pragma unroll
          for (int q = 0; q < 4; ++q) {
            const int ti = 4 * tg + q; const bf16x8 ua = ub[q];
            *(LAS bf16x8*)(ht + S5_UOFF + c * 32 + hh * 16) = ua;
            {
                const f32x16 x0r = __builtin_amdgcn_mfma_f32_32x32x16_bf16(ua, bfr[0], (f32x16){}, 0, 0, 0);
                const f32x16 x1r = __builtin_amdgcn_mfma_f32_32x32x16_bf16(ua, bfr[1], (f32x16){}, 0, 0, 0);
                const f32x16 x0i = __builtin_amdgcn_mfma_f32_32x32x16_bf16(ua, bfi[0], (f32x16){}, 0, 0, 0);
                const f32x16 x1i = __builtin_amdgcn_mfma_f32_32x32x16_bf16(ua, bfi[1], (f32x16){}, 0, 0, 0);
#pragma unroll
                for (int k = 0; k < 4; ++k) {
                    float tr[8], tq[8];
#pragma unroll
                    for (int jj = 0; jj < 4; ++jj) {
                        auto sr = __builtin_amdgcn_permlane32_swap(__float_as_uint(x0r[4 * k + jj]), __float_as_uint(x1r[4 * k + jj]), false, false);
                        auto sq = __builtin_amdgcn_permlane32_swap(__float_as_uint(x0i[4 * k + jj]), __float_as_uint(x1i[4 * k + jj]), false, false);
                        tr[jj] = __uint_as_float(sr[0]); tr[4 + jj] = __uint_as_float(sr[1]); tq[jj] = __uint_as_float(sq[0]); tq[4 + jj] = __uint_as_float(sq[1]); }
#pragma unroll
                    for (int j = 0; j < 8; ++j) { float nr = tr[j], ni = tq[j]; cmuladd(nr, ni, a1r, a1i, er, ei); er = nr; ei = ni;
                        *(LAS unsigned*)(ht + (8 * k + j) * S5_HSTR + 4 * lane) = pk2(er, ei); }
                }
            }
            asm volatile("" ::: "memory");
#pragma unroll
            for (int tt = 0; tt < 2; ++tt) {
                f32x4 y = {0.f, 0.f, 0.f, 0.f};
#pragma unroll
                for (int s4 = 0; s4 < 4; ++s4) { const bf16x8 hb = *(const LAS bf16x8*)(ht + (16 * tt + col) * S5_HSTR + (32 * s4 + 8 * fq) * 2); y = __builtin_amdgcn_mfma_f32_16x16x32_bf16(cf[s4], hb, y, 0, 0, 0); }
                const size_t row = (size_t)b * PSEQ + 32 * ti + 16 * tt + col; const u32x2 uw = *(const LAS u32x2*)(ht + S5_UOFF + (16 * tt + col) * 32 + fq * 8);
                u32x2 w; w.x = pk2(gelu_tanh(y[0] + d4[0] * bflo(uw.x)), gelu_tanh(y[1] + d4[1] * bfhi(uw.x))); w.y = pk2(gelu_tanh(y[2] + d4[2] * bflo(uw.y)), gelu_tanh(y[3] + d4[3] * bfhi(uw.y)));
                *(LAS u32x2*)(ht + S5_OOFF + q * 1024 + (16 * tt + col) * 32 + fq * 8) = w;
            }
            asm volatile("" ::: "memory");
          }
#pragma unroll
          for (int q = 0; q < 4; ++q)
#pragma unroll
            for (int tt = 0; tt < 2; ++tt) *(GAS u32x2*)(GBo + ((size_t)b * PSEQ + 32 * (4 * tg + q) + 16 * tt + col) * E_ + 16 * g + 4 * fq) = *(const LAS u32x2*)(ht + S5_OOFF + q * 1024 + (16 * tt + col) * 32 + fq * 8);
          asm volatile("s_waitcnt vmcnt(0)" ::: "memory");
#pragma unroll
          for (int q = 0; q < 4; ++q) ub[q] = nb[q];
        }
        const size_t so = ((size_t)b * S5G + g) * S5P + lane;
        F.out[O_SRP + so] = er; F.out[O_SIP + so] = ei;
    }
}

__device__ __forceinline__ void s5_sample_mfma(Frame& F) {
    const bf16_t* U = (const bf16_t*)(F.ws + WS_B0); bf16_t* GBo = (bf16_t*)(F.ws + WS_GB); const float* TAB = (const float*)(F.ws + WS_TAB);
    const float* cre = GIN(25); const float* cim = GIN(26); const float* dsk = GIN(27); const float* h0re = GIN(6); const float* h0im = GIN(7);
    const int lane = F.lane, wid = F.wave, c = lane & 31, hh = lane >> 5, col = lane & 15, fq = lane >> 4;
    LAS unsigned char* ht = F.lds + wid * S5_HT;
    for (int task = F.bid * NWAVES + wid; task < S5G * (MS / 64); task += F.G * NWAVES) {
        const int g = task & (S5G - 1), tp = task >> 7;
        bf16x8 bfr[2], bfi[2];
#pragma unroll
        for (int st = 0; st < 2; ++st) { const int gp = g * S5P + 32 * st + c;
            const float* pr = TAB + T_BBR + (size_t)gp * 16 + 8 * hh; const float* pi = TAB + T_BBI + (size_t)gp * 16 + 8 * hh;
            bfr[st] = __builtin_bit_cast(bf16x8, pack8(*(const f32x4*)pr, *(const f32x4*)(pr + 4))); bfi[st] = __builtin_bit_cast(bf16x8, pack8(*(const f32x4*)pi, *(const f32x4*)(pi + 4))); }
        const float a1r = TAB[T_AR + g * S5P + lane], a1i = TAB[T_AI + g * S5P + lane];
        bf16x8 cf[4];
#pragma unroll
        for (int s4 = 0; s4 < 4; ++s4) { const size_t o = ((size_t)g * 16 + col) * S5P + 16 * s4 + 4 * fq; const f32x4 cr4 = *(const f32x4*)(cre + o), ci4 = *(const f32x4*)(cim + o);
            u32x4 w; w.x = pk2(cr4[0], -ci4[0]); w.y = pk2(cr4[1], -ci4[1]); w.z = pk2(cr4[2], -ci4[2]); w.w = pk2(cr4[3], -ci4[3]); cf[s4] = __builtin_bit_cast(bf16x8, w); }
        const f32x4 d4 = *(const f32x4*)(dsk + 16 * g + 4 * fq);
#pragma unroll 1
        for (int q = 0; q < 2; ++q) {
            const int tile = 2 * tp + q; const bf16x8 ua = *(const GAS bf16x8*)(U + ((size_t)MP + 32 * tile + c) * E_ + 16 * g + 8 * hh);
            float sr[8], sq[8];
#pragma unroll
            for (int rr = 0; rr < 8; ++rr) { const size_t so = ((size_t)(8 * tile + rr) * S5G + g) * S5P + lane; sr[rr] = *(const GAS float*)(h0re + so); sq[rr] = *(const GAS float*)(h0im + so); }
            *(LAS bf16x8*)(ht + S5_UOFF + c * 32 + hh * 16) = ua;
            {
                const f32x16 x0r = __builtin_amdgcn_mfma_f32_32x32x16_bf16(ua, bfr[0], (f32x16){}, 0, 0, 0);
                const f32x16 x1r = __builtin_amdgcn_mfma_f32_32x32x16_bf16(ua, bfr[1], (f32x16){}, 0, 0, 0);
                const f32x16 x0i = __builtin_amdgcn_mfma_f32_32x32x16_bf16(ua, bfi[0], (f32x16){}, 0, 0, 0);
                const f32x16 x1i = __builtin_amdgcn_mfma_f32_32x32x16_bf16(ua, bfi[1], (f32x16){}, 0, 0, 0);
#pragma unroll
                for (int k = 0; k < 4; ++k) {
                    float tr[8], tq[8];
#pragma unroll
                    for (int jj = 0; jj < 4; ++jj) {
                        auto s_r = __builtin_amdgcn_permlane32_swap(__float_as_uint(x0r[4 * k + jj]), __float_as_uint(x1r[4 * k + jj]), false, false);
                        auto s_q = __builtin_amdgcn_permlane32_swap(__float_as_uint(x0i[4 * k + jj]), __float_as_uint(x1i[4 * k + jj]), false, false);
                        tr[jj] = __uint_as_float(s_r[0]); tr[4 + jj] = __uint_as_float(s_r[1]); tq[jj] = __uint_as_float(s_q[0]); tq[4 + jj] = __uint_as_float(s_q[1]); }
#pragma unroll
                    for (int j = 0; j < 8; ++j) { const int rr = 2 * k + (j >> 2); float nr = tr[j], ni = tq[j]; cmuladd(nr, ni, a1r, a1i, sr[rr], sq[rr]); sr[rr] = nr; sq[rr] = ni;
                        *(LAS unsigned*)(ht + (8 * k + j) * S5_HSTR + 4 * lane) = pk2(nr, ni); }
                }
            }
            asm volatile("s_waitcnt vmcnt(0)" ::: "memory");
            u32x2 w[2];
#pragma unroll
            for (int tt = 0; tt < 2; ++tt) {
                f32x4 y = {0.f, 0.f, 0.f, 0.f};
#pragma unroll
                for (int s4 = 0; s4 < 4; ++s4) { const bf16x8 hb = *(const LAS bf16x8*)(ht + (16 * tt + col) * S5_HSTR + (32 * s4 + 8 * fq) * 2); y = __builtin_amdgcn_mfma_f32_16x16x32_bf16(cf[s4], hb, y, 0, 0, 0); }
                const u32x2 uw = *(const LAS u32x2*)(ht + S5_UOFF + (16 * tt + col) * 32 + fq * 8);
                w[tt].x = pk2(gelu_tanh(y[0] + d4[0] * bflo(uw.x)), gelu_tanh(y[1] + d4[1] * bfhi(uw.x))); w[tt].y = pk2(gelu_tanh(y[2] + d4[2] * bflo(uw.y)), gelu_tanh(y[3] + d4[3] * bfhi(uw.y)));
            }
            asm volatile("s_waitcnt lgkmcnt(0)" ::: "memory");
#pragma unroll
            for (int tt = 0; tt < 2; ++tt) *(GAS u32x2*)(GBo + ((size_t)MP + 32 * tile + 16 * tt + col) * E_ + 16 * g + 4 * fq) = w[tt];
#pragma unroll
            for (int rr = 0; rr < 8; ++rr) { const size_t so = ((size_t)(8 * tile + rr) * S5G + g) * S5P + lane; *(GAS float*)(F.out + O_SRS + so) = sr[rr]; *(GAS float*)(F.out + O_SIS + so) = sq[rr]; }
        }
        asm volatile("s_waitcnt vmcnt(0)" ::: "memory");
    }
}

constexpr int AK_STR = 272, AV_STR = 520, AV_OFF = 256 * AK_STR;
static_assert(AV_OFF + 128 * AV_STR <= RING_BYTES + 8192, "attention LDS");
__device__ __forceinline__ void attn_prompt_phase(Frame& F, int layer) {
    const bf16_t* QB = (const bf16_t*)(F.ws + WS_QB); const bf16_t* KBp = (const bf16_t*)(F.ws + WS_KB); const bf16_t* VTp = (const bf16_t*)(F.ws + WS_VT); bf16_t* A2 = (bf16_t*)(F.ws + WS_A2);
    const int tid = F.tid, lane = F.lane, wid = F.wave, c = lane & 31, hh = lane >> 5;
    LAS unsigned char* lds = F.lds;
    for (int un = F.bid; un < PB * NH * 8; un += F.G) {
        const int bh = un >> 3, qb = un & 7, b = bh >> 2, h = bh & 3;
        const bf16_t* Kg = KBp + (size_t)((layer * PB + b) * NH + h) * MEML * HD; const bf16_t* Vg = VTp + (size_t)((layer * PB + b) * NH + h) * MEML * HD;
        __syncthreads();
        { u32x4 kr[8], vr[8];
#pragma unroll
          for (int i = 0; i < 8; ++i) { const int chn = tid + NTHR * i; kr[i] = *(const u32x4*)(Kg + (chn >> 4) * HD + (chn & 15) * 8); vr[i] = *(const u32x4*)(Vg + (chn >> 5) * MEML + (chn & 31) * 8); }
#pragma unroll
          for (int i = 0; i < 8; ++i) { const int chn = tid + NTHR * i, row = chn >> 4, c16 = chn & 15; *(LAS u32x4*)(lds + row * AK_STR + c16 * 16) = kr[i]; }
#pragma unroll
          for (int i = 0; i < 8; ++i) { const int chn = tid + NTHR * i, row = chn >> 5, c16 = chn & 31; const u32x4 v = vr[i];
            LAS u32x2* p = (LAS u32x2*)(lds + AV_OFF + row * AV_STR + c16 * 16); u32x2 lo, hi; lo.x = v.x; lo.y = v.y; hi.x = v.z; hi.y = v.w; p[0] = lo; p[1] = hi; } }
        __syncthreads();
        const size_t qrow = (size_t)b * PSEQ + qb * 256 + wid * 32 + c;
        f32x16 S[8];
#pragma unroll
        for (int kt = 0; kt < 8; ++kt) S[kt] = (f32x16){};
#pragma unroll
        for (int s = 0; s < 8; ++s) {
            const bf16x8 qf = *(const bf16x8*)(QB + qrow * XA + h * HD + 16 * s + 8 * hh);
#pragma unroll
            for (int kt = 0; kt < 8; ++kt) { const bf16x8 kf = *(const LAS bf16x8*)(lds + (32 * kt + c) * AK_STR + (16 * s + 8 * hh) * 2); S[kt] = __builtin_amdgcn_mfma_f32_32x32x16_bf16(kf, qf, S[kt], 0, 0, 0); }
        }
        float mx = -3.0e38f;
#pragma unroll
        for (int kt = 0; kt < 8; ++kt)
#pragma unroll
            for (int r = 0; r < 16; ++r) mx = fmaxf(mx, S[kt][r]);
        mx = fmaxf(mx, __shfl_xor(mx, 32));
        float sum = 0.f; bf16x8 pf[8][2];
#pragma unroll
        for (int kt = 0; kt < 8; ++kt) {
            float p[16];
#pragma unroll
            for (int r = 0; r < 16; ++r) { p[r] = __expf(S[kt][r] - mx); sum += p[r]; }
#pragma unroll
            for (int s2 = 0; s2 < 2; ++s2) { u32x4 w; w.x = pk2(p[8 * s2], p[8 * s2 + 1]); w.y = pk2(p[8 * s2 + 2], p[8 * s2 + 3]); w.z = pk2(p[8 * s2 + 4], p[8 * s2 + 5]); w.w = pk2(p[8 * s2 + 6], p[8 * s2 + 7]);
                pf[kt][s2] = __builtin_bit_cast(bf16x8, w); }
        }
        sum += __shfl_xor(sum, 32);
        const float inv = 1.f / sum;
        bf16_t* orow = A2 + qrow * KOUT + E_ + h * HD;
#pragma unroll
        for (int dt = 0; dt < 4; ++dt) {
            f32x16 o = {};
#pragma unroll
            for (int kt = 0; kt < 8; ++kt)
#pragma unroll
                for (int s2 = 0; s2 < 2; ++s2) {
                    const LAS unsigned char* vb = lds + AV_OFF + (32 * dt + c) * AV_STR + (32 * kt + 16 * s2 + 4 * hh) * 2;
                    const u32x2 lo = *(const LAS u32x2*)vb, hi = *(const LAS u32x2*)(vb + 16);
                    u32x4 w; w.x = lo.x; w.y = lo.y; w.z = hi.x; w.w = hi.y;
                    o = __builtin_amdgcn_mfma_f32_32x32x16_bf16(__builtin_bit_cast(bf16x8, w), pf[kt][s2], o, 0, 0, 0);
                }
#pragma unroll
            for (int g4 = 0; g4 < 4; ++g4) { u32x2 w; w.x = pk2(o[4 * g4] * inv, o[4 * g4 + 1] * inv); w.y = pk2(o[4 * g4 + 2] * inv, o[4 * g4 + 3] * inv);
                *(u32x2*)(orow + 32 * dt + 8 * g4 + 4 * hh) = w; }
        }
    }
}

__device__ __forceinline__ void attn_sample_phase(Frame& F, int layer) {
    const bf16_t* QB = (const bf16_t*)(F.ws + WS_QB); bf16_t* A2 = (bf16_t*)(F.ws + WS_A2);
    const float* CK = GIN(3) + (size_t)layer * SBT * MEML * XA; const float* CV = GIN(4) + (size_t)layer * SBT * MEML * XA;
    LAS float* sl = (LAS float*)F.lds;
    LAS float* pt = (LAS float*)(F.lds + 4096);
    LAS float* ol = (LAS float*)(F.lds + 8192);
    const int tid = F.tid, lane = F.lane, wid = F.wave, par = lane >> 5, d4 = lane & 31;
    const size_t lane_off = ((size_t)(32 * wid + par) * NH) * HD + 4 * d4;
    const bool b4 = (lane & 16) != 0, b3 = (lane & 8) != 0;
#define AS_Q(q4, b_, h_) do { _Pragma("unroll") for (int qi = 0; qi < 4; ++qi) { const u32x2 w = *(const u32x2*)(QB + (size_t)(MP + (b_) * 4 + qi) * XA + (h_) * HD + 4 * d4); q4[qi] = (f32x4){bflo(w.x), bfhi(w.x), bflo(w.y), bfhi(w.y)}; } } while (0)
#define AS_LOADROWS(dst, base, b_, h_) do { const size_t o_ = (size_t)(b_) * MEML * XA + (size_t)(h_) * HD + lane_off; _Pragma("unroll") for (int j = 0; j < 16; ++j) dst[j] = *(const f32x4*)((base) + o_ + (size_t)j * 2 * XA); } while (0)
#define AS_SCORES(q4) do { _Pragma("unroll") for (int j = 0; j < 16; ++j) { float v[4]; \
            _Pragma("unroll") for (int qi = 0; qi < 4; ++qi) v[qi] = (kr[j][0] * q4[qi][0] + kr[j][1] * q4[qi][1]) + (kr[j][2] * q4[qi][2] + kr[j][3] * q4[qi][3]); \
            const float w0 = (b4 ? v[2] : v[0]) + __shfl_xor(b4 ? v[0] : v[2], 16), w1 = (b4 ? v[3] : v[1]) + __shfl_xor(b4 ? v[1] : v[3], 16); \
            float z = (b3 ? w1 : w0) + __shfl_xor(b3 ? w0 : w1, 8); \
            z += __shfl_xor(z, 4); z += __shfl_xor(z, 2); z += __shfl_xor(z, 1); \
            if ((lane & 7) == 0) sl[(2 * (int)b4 + (int)b3) * 256 + 32 * wid + 2 * j + par] = z; } } while (0)
#define AS_SOFTMAX() do { if (wid < 4) { float v[4], mx = -3.0e38f; \
            _Pragma("unroll") for (int j = 0; j < 4; ++j) { v[j] = sl[wid * 256 + lane + 64 * j]; mx = fmaxf(mx, v[j]); } \
            mx = wave_max(mx); float sm = 0.f; \
            _Pragma("unroll") for (int j = 0; j < 4; ++j) { v[j] = __expf(v[j] - mx); sm += v[j]; } \
            sm = wave_sum(sm); const float inv = 1.f / sm; \
            _Pragma("unroll") for (int j = 0; j < 4; ++j) pt[(lane + 64 * j) * 4 + wid] = v[j] * inv; } } while (0)
#define AS_PV() do { f32x4 o[4]; _Pragma("unroll") for (int qi = 0; qi < 4; ++qi) o[qi] = (f32x4){0.f, 0.f, 0.f, 0.f}; \
            _Pragma("unroll") for (int j = 0; j < 16; ++j) { const f32x4 p = *(const LAS f32x4*)(pt + (32 * wid + 2 * j + par) * 4); \
                _Pragma("unroll") for (int qi = 0; qi < 4; ++qi) o[qi] += vr[j] * p[qi]; } \
            _Pragma("unroll") for (int qi = 0; qi < 4; ++qi) { _Pragma("unroll") for (int e = 0; e < 4; ++e) o[qi][e] += __shfl_xor(o[qi][e], 32); \
                if (par == 0) *(LAS f32x4*)(ol + (wid * 4 + qi) * 128 + 4 * d4) = o[qi]; } } while (0)
#define AS_OUT(b_, h_) do { const int qi = tid >> 7, d = tid & 127; float acc = 0.f; _Pragma("unroll") for (int w = 0; w < 8; ++w) acc += ol[(w * 4 + qi) * 128 + d]; \
            A2[(size_t)(MP + (b_) * 4 + qi) * KOUT + E_ + (h_) * HD + d] = f2bf(acc); } while (0)
    for (int un = F.bid; un < SBT * NH; un += 2 * F.G) {
        const int unb = un + F.G < SBT * NH ? un + F.G : un; const int ba = un >> 2, ha = un & 3, bb = unb >> 2, hb = unb & 3;
        asm volatile("s_waitcnt vmcnt(0)" ::: "memory");
        f32x4 kr[16], vr[16], q4[4];
        AS_LOADROWS(kr, CK, ba, ha); AS_LOADROWS(vr, CV, ba, ha); AS_Q(q4, ba, ha);
        __syncthreads();
        AS_SCORES(q4);
        AS_LOADROWS(kr, CK, bb, hb);
        __syncthreads();
        AS_SOFTMAX();
        __syncthreads();
        AS_PV();
        __syncthreads();
        AS_Q(q4, bb, hb);
        AS_OUT(ba, ha);
        AS_LOADROWS(vr, CV, bb, hb);
        asm volatile("s_waitcnt vmcnt(16)" ::: "memory");
        AS_SCORES(q4);
        __syncthreads();
        AS_SOFTMAX();
        __syncthreads();
        AS_PV();
        __syncthreads();
        AS_OUT(bb, hb);
    }
#undef AS_Q
#undef AS_LOADROWS
#undef AS_SCORES
#undef AS_SOFTMAX
#undef AS_PV
#undef AS_OUT
}

constexpr int NK_OUT = 5, NK_OUT_LAST = 10, NK_GLU = 8;
__device__ __forceinline__ void fixup_out_rows(Frame& F, const float* basef  , int vb, int nvb  , int nk  ) {
    for (int r = vb * NWAVES + F.wave; r < MS; r += nvb * NWAVES) {
        const int lane = F.lane; const float* slab = (const float*)(F.ws + WS_SLAB);
        bf16_t* XB = (bf16_t*)(F.ws + WS_XB) + (size_t)(MP + r) * DM; float ss = 0.f;
#pragma unroll
        for (int j = 0; j < 4; ++j) { f32x4 v;
            if (basef) v = *((const f32x4*)(basef + (size_t)r * DM) + lane + 64 * j);
            else { const u32x2 w = *((const u32x2*)XB + lane + 64 * j); v = (f32x4){bflo(w.x), bfhi(w.x), bflo(w.y), bfhi(w.y)}; }
            for (int ks = 0; ks < nk; ++ks) v += *((const f32x4*)(slab + ((size_t)ks * MS + r) * DM) + lane + 64 * j);
            u32x2 w; w.x = pk2(v[0], v[1]); w.y = pk2(v[2], v[3]); *((u32x2*)XB + lane + 64 * j) = w;
            ss += (v[0] * v[0] + v[1] * v[1]) + (v[2] * v[2] + v[3] * v[3]); }
        asm volatile("s_waitcnt vmcnt(0)" ::: "memory");
        ss = wave_sum(ss);
        if (lane < 16) ((float*)(F.ws + WS_SSX))[(size_t)(MP + r) * 16 + lane] = lane == 0 ? ss : 0.f;
    }
}
__device__ __forceinline__ void fixup_glu_rows(Frame& F) {
    if (F.wave < 2) for (int r = F.bid * 2 + F.wave; r < MS; r += F.G * 2) {
        const int lane = F.lane; const float* slab = (const float*)(F.ws + WS_SLAB); const float* bias = GIN(29);
        const bf16_t* GBp = (const bf16_t*)(F.ws + WS_GB) + (size_t)(MP + r) * E_; const bf16_t* SZ = (const bf16_t*)(F.ws + WS_B1) + (size_t)(MP + r) * E_; bf16_t* A2 = (bf16_t*)(F.ws + WS_A2) + (size_t)(MP + r) * KOUT;
#pragma unroll
        for (int j = 0; j < 4; ++j) { const int c0 = 8 * (lane + 64 * j); f32x4 t0 = *(const f32x4*)(bias + c0), t1 = *(const f32x4*)(bias + c0 + 4);
#pragma unroll
            for (int ks = 0; ks < NK_GLU; ++ks) { const float* sp = slab + ((size_t)ks * MS + r) * E_ + c0; t0 += *(const f32x4*)sp; t1 += *(const f32x4*)(sp + 4); }
            float gv[8], sz[8]; unpack8(*(const u32x4*)(GBp + c0), gv); unpack8(*(const u32x4*)(SZ + c0), sz); f32x4 o0, o1;
#pragma unroll
            for (int e = 0; e < 4; ++e) { o0[e] = gv[e] * sigmoidf_(t0[e]) * sz[e]; o1[e] = gv[4 + e] * sigmoidf_(t1[e]) * sz[4 + e]; }
            *(u32x4*)(A2 + c0) = pack8(o0, o1); }
    }
}
__device__ __forceinline__ void counter_signal(unsigned* cnt) {
    asm volatile("s_waitcnt vmcnt(0)" ::: "memory"); __syncthreads();
    if (threadIdx.x == 0) { __builtin_amdgcn_fence(__ATOMIC_RELEASE, "agent"); asm volatile("s_waitcnt vmcnt(0)" ::: "memory"); __hip_atomic_fetch_add(cnt, 1u, __ATOMIC_RELAXED, __HIP_MEMORY_SCOPE_AGENT); }
}
__device__ __forceinline__ void counter_wait(unsigned* cnt, unsigned want) {
    if (threadIdx.x == 0) { unsigned sp = 0; while (__hip_atomic_load(cnt, __ATOMIC_RELAXED, __HIP_MEMORY_SCOPE_AGENT) < want) { __builtin_amdgcn_s_sleep(2); if (++sp > (1u << 22)) break; }
        __builtin_amdgcn_fence(__ATOMIC_ACQUIRE, "agent"); asm volatile("s_waitcnt vmcnt(0)" ::: "memory"); }
    __syncthreads();
}

__device__ __forceinline__ void final_row(Frame& F, int row) {
    const bf16_t* XBp = (const bf16_t*)(F.ws + WS_XB); const float* SSX = (const float*)(F.ws + WS_SSX); const float* fg = GIN(9); const int lane = F.lane;
    float s = lane < 16 ? SSX[(size_t)row * 16 + lane] : 0.f; s = wave_sum(s);
    const float r = __builtin_amdgcn_rsqf(s * (1.f / DM) + EPS);
    float* o = row < MP ? F.out + O_YP + (size_t)row * DM : F.out + O_YS + (size_t)(row - MP) * DM;
#pragma unroll
    for (int j = 0; j < 4; ++j) { const u32x2 w = *((const u32x2*)(XBp + (size_t)row * DM) + lane + 64 * j); const f32x4 v = (f32x4){bflo(w.x), bfhi(w.x), bflo(w.y), bfhi(w.y)}; const f32x4 gq = *((const f32x4*)fg + lane + 64 * j); *((f32x4*)o + lane + 64 * j) = v * r * gq; }
}
__device__ __forceinline__ void final_phase(Frame& F) {
    asm volatile("s_waitcnt vmcnt(0)" ::: "memory"); for (int r = F.bid * NWAVES + F.wave; r < MS; r += F.G * NWAVES) final_row(F, MP + r);
}

#define XB_TMO      128
#define XB_XCNT(j)  (256  + 64 * (j))
#define XB_XSUB(j)  (1280 + 64 * (j))
#define XB_XGEN(j)  (2304 + 64 * (j))
#define XB_TOP      3328
#define XB_TOPGEN   3392
#define XCD_BAR_WORDS 3456
#define XB_SPIN_CAP (1u << 20)
__device__ __forceinline__ unsigned xb_ld(unsigned* p)              { return __hip_atomic_load(p, __ATOMIC_RELAXED, __HIP_MEMORY_SCOPE_AGENT); }
__device__ __forceinline__ unsigned xb_add(unsigned* p, unsigned v) { return __hip_atomic_fetch_add(p, v, __ATOMIC_RELAXED, __HIP_MEMORY_SCOPE_AGENT); }
__device__ __forceinline__ unsigned xb_xcc_id() { return (unsigned)__builtin_amdgcn_s_getreg((3 << 11) | 20) & 0xFu; }
#define XB_SPIN(cond, bar) do { unsigned _sp = 0; while (cond) { __builtin_amdgcn_s_sleep(1); \
    if ((++_sp & 255u) == 0u) { if (xb_ld(&(bar)[XB_TMO])) break; if (_sp > XB_SPIN_CAP) { atomicAdd(&(bar)[XB_TMO], 1u); break; } } } } while (0)
struct XcdBarrier { unsigned* bar; unsigned x; volatile LAS unsigned* st; };
__device__ __forceinline__ XcdBarrier xcd_barrier_post(unsigned* bar, volatile LAS unsigned* st) {
    XcdBarrier b; b.bar = bar; b.x = xb_xcc_id(); b.st = st;
    if (threadIdx.x == 0) (void)xb_add(&bar[XB_XCNT(b.x)], 1u);
    return b;
}
__device__ __forceinline__ void xcd_barrier_complete(unsigned* bar, unsigned x, unsigned& nloc, unsigned& nx) {
    const unsigned G = gridDim.x * gridDim.y * gridDim.z;
    unsigned sum, cnt, mine, sp = 0u;
    for (;;) {
        sum = 0u; cnt = 0u; mine = 0u;
#pragma unroll
        for (unsigned j = 0; j < 16; ++j) { const unsigned c = xb_ld(&bar[XB_XCNT(j)]); sum += c; cnt += (c > 0u) ? 1u : 0u; mine = (j == x) ? c : mine; }
        if (sum == G) break;
        __builtin_amdgcn_s_sleep(1);
        if ((++sp & 255u) == 0u) { if (xb_ld(&bar[XB_TMO])) break; if (sp > XB_SPIN_CAP) { atomicAdd(&bar[XB_TMO], 1u); break; } }
    }
    nloc = mine > 0u ? mine : 1u; nx = cnt > 0u ? cnt : 1u;
}
__device__ __forceinline__ void xcd_barrier(const XcdBarrier& b) {
    asm volatile("s_waitcnt vmcnt(0)" ::: "memory");
    __syncthreads();
    if (threadIdx.x == 0) {
        unsigned* bar = b.bar;
        __builtin_amdgcn_s_waitcnt(0);
        unsigned nloc = b.st[0], nx = b.st[1];
        if (nloc == 0u) { xcd_barrier_complete(bar, b.x, nloc, nx); b.st[0] = nloc; b.st[1] = nx; }
        const unsigned old = xb_add(&bar[XB_XSUB(b.x)], 1u);
        const unsigned gen = old / nloc;
        if (old + 1u == (gen + 1u) * nloc) {
            __builtin_amdgcn_fence(__ATOMIC_RELEASE, "agent");
            asm volatile("s_waitcnt vmcnt(0)" ::: "memory");
            const unsigned og = xb_add(&bar[XB_TOP], 1u);
            const unsigned tg = og / nx;
            if (og + 1u == (tg + 1u) * nx) xb_add(&bar[XB_TOPGEN], 1u);
            else XB_SPIN(xb_ld(&bar[XB_TOPGEN]) == tg, bar);
            __builtin_amdgcn_fence(__ATOMIC_ACQUIRE, "agent");
            xb_add(&bar[XB_XGEN(b.x)], 1u);
            asm volatile("s_waitcnt vmcnt(0)" ::: "memory");
        } else {
            XB_SPIN(xb_ld(&bar[XB_XGEN(b.x)]) == gen, bar);
            __builtin_amdgcn_fence(__ATOMIC_ACQUIRE, "agent");
            asm volatile("s_waitcnt vmcnt(0)" ::: "memory");
        }
    }
    __syncthreads();
}

__device__ __forceinline__ void stagger(int bid) {
#if STAGGER_TICKS
    const int grp = (bid >> 3) & 3;
    if (grp) { const unsigned long long t0 = __builtin_amdgcn_s_memrealtime(); while (__builtin_amdgcn_s_memrealtime() - t0 < (unsigned long long)(grp * STAGGER_TICKS)) __builtin_amdgcn_s_sleep(2); }
#endif
}
constexpr int NPHASE = 15;
__global__ void __launch_bounds__(NTHR, 2) fwd_kernel(Args args) {
    extern __shared__ __attribute__((aligned(16))) unsigned char lds_raw[];
    Frame F; F.lds = (LAS unsigned char*)lds_raw; F.G = gridDim.x; F.bid = blockIdx.x;
    F.in = args.in; F.out = (float*)(GAS float*)args.out; F.ws = (unsigned char*)(GAS unsigned char*)args.ws;
    unsigned char* ws = F.ws;
#define REFRESH() do { int t_ = threadIdx.x; asm volatile("" : "+v"(t_)); F.tid = t_; F.lane = t_ & 63; F.wave = __builtin_amdgcn_readfirstlane(t_ >> 6); \
        GAS unsigned char* wsg_ = (GAS unsigned char*)args.ws; asm volatile("" : "+s"(wsg_)); ws = (unsigned char*)wsg_; F.ws = ws; } while (0)
    const int lo = args.ph_lo, hi = args.ph_hi;
#if MK_ONE_LAUNCH
    cg::grid_group grid = cg::this_grid();
    if (lo < 0) grid.sync();
    { volatile LAS unsigned* st0 = (volatile LAS unsigned*)(F.lds + LDS_BYTES - 64); if (threadIdx.x < 16) st0[threadIdx.x] = 0u; }
    __syncthreads();
    const XcdBarrier xbar = xcd_barrier_post((unsigned*)(args.ws + WS_CTL), (volatile LAS unsigned*)(F.lds + LDS_BYTES - 64));
#define SEAM(k) do { if (lo <= (k) && (k) + 1 < hi) xcd_barrier(xbar); } while (0)
#else
#define SEAM(k) do { } while (0)
#endif
#ifndef PHASE_MASK
#define PHASE_MASK 0x7fff
#endif
#define REP(k) for (int rep_ = 0; rep_ <= (((PROBE_REP_MASK) >> (k)) & 1); ++rep_)
#if PROBE_SUB_MASK
#define PREP(b) for (int n_ = __builtin_amdgcn_readfirstlane(1 + ((PROBE_SUB_MASK >> (b)) & 1) + (int)(args.ph_lo > 100)), r_ = 0; r_ < n_; ++r_)
#else
#define PREP(b)
#endif
#define WSSEL(bit) do { if ((FLAT_FN_MASK >> (bit)) & 1) { unsigned char* w_ = args.ws; asm volatile("" : "+s"(w_)); F.ws = w_; } else { GAS unsigned char* g_ = (GAS unsigned char*)args.ws; asm volatile("" : "+s"(g_)); F.ws = (unsigned char*)g_; } } while (0)
#define IN(k) ((((PHASE_MASK) >> (k)) & 1) && lo <= (k) && (k) < hi)
#define XB ((bf16_t*)(ws + WS_XB))
#define X ((float*)(ws + WS_X))
#define SSX ((float*)(ws + WS_SSX))
#define SSV ((float*)(ws + WS_SSV))
#define B0 ((bf16_t*)(ws + WS_B0))
#define B1 ((bf16_t*)(ws + WS_B1))
#define QBp ((bf16_t*)(ws + WS_QB))
#define A2 ((bf16_t*)(ws + WS_A2))
#define GBp ((bf16_t*)(ws + WS_GB))
    const int G = F.G, bid = F.bid;

    if (IN(0)) REP(0) { REFRESH(); WSSEL(0); p0_prologue(F); __syncthreads(); } SEAM(0);
#define CNT(k) ((unsigned*)(ws + WS_CTL) + 4096 + 64 * (k))
#define WOUT(l) ((const bf16_t*)(ws + WS_WOUT) + (size_t)(l) * DM * KOUT)
#define INPROJ(EpiT, E, W, N, cnt, want) do { stagger(bid); \
        pg8::Gemm g{XB, (W), M, (N), DM, DM}; pg8::StaticOrder S; S.init(MP, (N), G, bid); pg8::gemm_phase<EpiT, pg8::StaticOrder, true, true>(F.lds, g, S, E); \
        if (cnt) counter_wait(cnt, (unsigned)(want)); \
        const int rem = ((MP / 256) * ((N) / 256)) % G; pg8::StaticOrder S2; S2.init(MS, (N), G, (bid + G - rem) % G, MP / 256); pg8::gemm_phase<EpiT, pg8::StaticOrder, true, true>(F.lds, g, S2, E); } while (0)
#define OUTPROJ_PROMPT(l, bp) do { pg8::Gemm g{A2, WOUT(l), M, DM, KOUT, KOUT}; pg8::StaticOrder S; S.init(MP, DM, G, bid); EpiOut E{(bp), XB, SSX}; pg8::gemm_phase<EpiOut, pg8::StaticOrder, true, true>(F.lds, g, S, E); } while (0)
#define OUTPROJ_SLICES(l, c, nb, NK) do { pg8::Gemm g{A2, WOUT(l), M, DM, KOUT / (NK), KOUT}; typedef pg8::SliceOrder<MS / 256, DM / 256, (NK)> SO; SO S; S.init((nb), (c), MP / 256); \
        EpiSlab E{(float*)(ws + WS_SLAB), DM, MP, (size_t)MS * DM}; pg8::gemm_phase<EpiSlab, SO, true, true>(F.lds, g, S, E); } while (0)
#define SLICEFIX(l, sb0, basef, cA, cB) do { if (bid >= (sb0)) { const int nsb_ = G - (sb0); OUTPROJ_SLICES(l, bid - (sb0), nsb_, NK_OUT); counter_signal(cA); counter_wait(cA, (unsigned)nsb_); \
        fixup_out_rows(F, (basef), bid - (sb0), nsb_, NK_OUT); counter_signal(cB); } } while (0)
#define KVPROJ(l, c0) do { pg8::Gemm g{(const bf16_t*)(ws + WS_MEMB), (const bf16_t*)(ws + WS_WKV) + (size_t)(l) * DM * DM, PB * MEML, DM, DM, DM}; pg8::StaticOrder S; S.init(g.M, g.N, G, (bid + G - (c0)) % G); \
        EpiKV E{(const float*)(ws + WS_RSTDM), F.out + O_MK, F.out + O_MV, (bf16_t*)(ws + WS_KB), (bf16_t*)(ws + WS_VT), (l)}; pg8::gemm_phase<EpiKV, pg8::StaticOrder, true, true>(F.lds, g, S, E); } while (0)
    if (IN(1)) REP(1) { REFRESH();
        { EpiInA E{SSX, B0, B1, QBp, SSV}; INPROJ(EpiInA, E, (const bf16_t*)(ws + WS_WINA), NIN_A, (unsigned*)nullptr, 0); }
        KVPROJ(0, 180); KVPROJ(1, 212);
    } SEAM(1);
    if (IN(2)) REP(2) { REFRESH(); WSSEL(1);
        PREP(5) sgu_phase_mfma(F, 0); PREP(6) sgu_sample_phase(F, 0); attn_prompt_phase(F, 0); attn_sample_phase(F, 0); } SEAM(2);
    if (IN(3)) REP(3) { REFRESH(); OUTPROJ_PROMPT(0, GIN(0)); } SEAM(3);
    if (IN(4)) REP(4) { REFRESH(); SLICEFIX(0, 196, GIN(1), CNT(0), CNT(4));
        EpiInB E{SSX, B0, B1, QBp, F.out + O_CP, F.out + O_CS, GIN(18), A2}; INPROJ(EpiInB, E, (const bf16_t*)(ws + WS_WINB), NIN_B, CNT(4), G - 196); } SEAM(4);
    if (IN(5)) REP(5) { REFRESH(); WSSEL(3);
        PREP(0) conv_phase(F); PREP(1) attn_prompt_phase(F, 1); PREP(2) attn_sample_phase(F, 1); } SEAM(5);
    if (IN(6)) REP(6) { REFRESH(); OUTPROJ_PROMPT(1, (const float*)nullptr); } SEAM(6);
    if (IN(7)) REP(7) { REFRESH(); SLICEFIX(1, 196, (const float*)nullptr, CNT(1), CNT(5));
        EpiInC E{SSX, B0, B1, QBp}; INPROJ(EpiInC, E, (const bf16_t*)(ws + WS_WINC), NIN_C, CNT(5), G - 196); KVPROJ(2, 164); } SEAM(7);
    if (IN(8)) REP(8) { REFRESH();
        const int half = G / 2; const bool s5h = bid < half;
        F.G = half; F.bid = s5h ? bid : (1 << 20);
        WSSEL(4); s5_prompt_mfma(F);
        F.G = G - half; F.bid = s5h ? (1 << 20) : bid - half;
        WSSEL(6); attn_prompt_phase(F, 2); WSSEL(7); attn_sample_phase(F, 2); WSSEL(5); s5_sample_mfma(F);
        F.bid = bid; F.G = G; } SEAM(8);
    if (IN(9)) REP(9) { REFRESH();
        { pg8::Gemm g{GBp, (const bf16_t*)(ws + WS_WGLU), M, E_, E_, E_}; pg8::StaticOrder S; S.init(MP, E_, G, bid); EpiGlu E{GBp, B1, GIN(29), A2}; pg8::gemm_phase<EpiGlu, pg8::StaticOrder, true, true>(F.lds, g, S, E); }
        { pg8::Gemm g{GBp, (const bf16_t*)(ws + WS_WGLU), M, E_, 256, E_}; typedef pg8::SliceOrder<MS / 256, E_ / 256, NK_GLU> SG; SG S; S.init(G, bid, MP / 256); EpiSlab E{(float*)(ws + WS_SLAB), E_, MP, (size_t)MS * E_}; pg8::gemm_phase<EpiSlab, SG, true, true>(F.lds, g, S, E); } } SEAM(9);
    if (IN(10)) REP(10) { REFRESH(); fixup_glu_rows(F);
        OUTPROJ_PROMPT(2, (const float*)nullptr); } SEAM(10);
    if (IN(11)) REP(11) { REFRESH(); SLICEFIX(2, 212, (const float*)nullptr, CNT(3), CNT(6));
        EpiInA E{SSX, B0, B1, QBp, SSV}; INPROJ(EpiInA, E, (const bf16_t*)(ws + WS_WINA) + (size_t)NIN_A * DM, NIN_A, CNT(6), G - 212); KVPROJ(3, 180); } SEAM(11);
    if (IN(12)) REP(12) { REFRESH(); WSSEL(1);
        sgu_phase_mfma(F, 1); sgu_sample_phase(F, 1); attn_prompt_phase(F, 3); attn_sample_phase(F, 3); } SEAM(12);
    if (IN(13)) REP(13) { REFRESH();
        { pg8::Gemm g{A2, WOUT(3), M, DM, KOUT, KOUT}; pg8::StaticOrder S; S.init(MP, DM, G, bid); EpiOutFinal E{XB, SSX, GIN(9), F.out + O_YP, CNT(16)}; pg8::gemm_phase<EpiOutFinal, pg8::StaticOrder, true, true>(F.lds, g, S, E); }
        OUTPROJ_SLICES(3, bid, G, NK_OUT_LAST);
#if MK_ONE_LAUNCH
        if (bid < (MS / 256) * (DM / 256) * NK_OUT_LAST) counter_signal(CNT(8));
        if (bid * NWAVES < MS) { counter_wait(CNT(8), (unsigned)((MS / 256) * (DM / 256) * NK_OUT_LAST)); WSSEL(8); fixup_out_rows(F, (const float*)nullptr, bid, G, NK_OUT_LAST); final_phase(F); }
#endif
        }
#if !MK_ONE_LAUNCH
    if (IN(14)) REP(14) { REFRESH(); WSSEL(8); fixup_out_rows(F, (const float*)nullptr, bid, G, NK_OUT_LAST); final_phase(F); }
#endif
#undef CNT
#undef WOUT
#undef KVPROJ
#undef INPROJ
#undef OUTPROJ_PROMPT
#undef OUTPROJ_SLICES
#undef SLICEFIX
#undef IN
#undef REP
#undef SEAM
#undef XB
#undef X
#undef SSX
#undef SSV
#undef B0
#undef B1
#undef QBp
#undef A2
#undef GBp
#undef REFRESH
}

extern "C" void kernel_launch(void* const* d_in, const int* in_sizes, int n_in, void* d_out, int out_size, void* d_ws, size_t ws_size, hipStream_t stream) {
    static int grid = 0;
    if (grid == 0) {
        if (n_in != 30 || out_size != (int)O_END || ws_size < WS_END) { fprintf(stderr, "kernel_launch: unexpected shapes (n_in %d out %d ws %zu)\n", n_in, out_size, ws_size); grid = -1; return; }
        int dev = 0, cus = 0, per_cu = 0;
        (void)hipGetDevice(&dev); (void)hipDeviceGetAttribute(&cus, hipDeviceAttributeMultiprocessorCount, dev);
        if (hipFuncSetAttribute((const void*)fwd_kernel, hipFuncAttributeMaxDynamicSharedMemorySize, LDS_BYTES) != hipSuccess) { fprintf(stderr, "kernel_launch: hipFuncSetAttribute failed\n"); grid = -1; return; }
        if (hipOccupancyMaxActiveBlocksPerMultiprocessor(&per_cu, (const void*)fwd_kernel, NTHR, LDS_BYTES) != hipSuccess || per_cu < 1) { fprintf(stderr, "kernel_launch: occupancy query says %d\n", per_cu); (void)hipGetLastError(); per_cu = 1; }
        grid = cus;
    }
    if (grid < 0) return;
    Args a{};
    for (int i = 0; i < 30; ++i) a.in[i] = (const float*)d_in[i];
    a.out = (float*)d_out; a.ws = (unsigned char*)d_ws;
#if MK_ONE_LAUNCH
    (void)hipMemsetAsync((char*)d_ws + WS_CTL, 0, 65536, stream);
    a.ph_lo = 0; a.ph_hi = NPHASE;
    void* kargs[] = {&a};
    hipError_t e = hipLaunchCooperativeKernel((const void*)fwd_kernel, dim3(grid), dim3(NTHR), kargs, LDS_BYTES, stream);
    if (e != hipSuccess) fprintf(stderr, "cooperative launch failed: %s (grid %d)\n", hipGetErrorString(e), grid);
#else
    for (int p = 0; p < NPHASE; ++p) { a.ph_lo = p; a.ph_hi = p + 1; hipLaunchKernelGGL(fwd_kernel, dim3(grid), dim3(NTHR), LDS_BYTES, stream, a); }
#endif
}
```

```cpp
#include <hip/hip_runtime.h>
#include <hip/hip_cooperative_groups.h>
#include <cstdio>
#include <cstdint>
namespace cg = cooperative_groups;

#ifndef MK_ONE_LAUNCH
#define MK_ONE_LAUNCH 1
#endif
#ifndef XHALF_SHFL
#define XHALF_SHFL 0
#endif
#ifndef STAGGER_TICKS
#define STAGGER_TICKS 0
#endif
#ifndef PROBE_RSTD2
#define PROBE_RSTD2 0
#endif
#ifndef EPI_DRAIN
#define EPI_DRAIN 1
#endif
#ifndef FLAT_FN_MASK
#define FLAT_FN_MASK 0x00
#endif
#ifndef PROBE_SUB_MASK
#define PROBE_SUB_MASK 0
#endif
#ifndef PROBE_REP_MASK
#define PROBE_REP_MASK 0
#endif

namespace pg8 {
#define PG8_LAS __attribute__((address_space(3)))
typedef unsigned short bf16_t;
typedef short bf16x8 __attribute__((ext_vector_type(8)));
typedef float f32x4 __attribute__((ext_vector_type(4)));
typedef unsigned u32x4 __attribute__((ext_vector_type(4)));
typedef unsigned u32x2 __attribute__((ext_vector_type(2)));
constexpr int BM = 256, BK = 64, HALF = 128, HTB = HALF * BK * 2, STAGE_BYTES = 8 * HTB, NXCD = 8, WGM = 4;

__host__ __device__ __forceinline__ int lds_byte(int r, int c) { const int st = (r >> 4) * 2 + (c >> 5), rr = r & 15, cc = c & 31, ob = rr * 64 + cc * 2; return st * 1024 + (ob ^ (((ob >> 9) & 1) << 5)); }
__host__ __device__ __forceinline__ void stage_rc(int b, int& R, int& C) { const int st = b / 1024, sb = b % 1024, swz = sb ^ (((sb >> 9) & 1) << 5); R = (st >> 1) * 16 + swz / 64; C = (st & 1) * 32 + (swz % 64) / 2; }
__host__ __device__ __forceinline__ int perm32(int rho) { const int n = rho >> 4, i = rho & 15; return 8 * (i >> 2) + 4 * n + (i & 3); }

struct Unit { int pm, pn, ks; };
struct Gemm { const bf16_t* A; const bf16_t* Bt; int M, N, K, ld; };

struct StaticOrder {
    int nM, nN, nwg, G, c, pm0;
    __host__ __device__ void init(int M, int N, int G_, int c_, int pm0_ = 0) { nM = M / BM; nN = N / BM; nwg = nM * nN; G = G_; c = c_; pm0 = pm0_; }
    __host__ __device__ bool next(int i, Unit& u) const {
        const long L = (long)i * G + c; if (L >= nwg) return false;
        int wgid = (int)L; { const int q = nwg / NXCD, r = nwg % NXCD, xcd = wgid % NXCD, off = wgid / NXCD; wgid = (xcd < r ? xcd * (q + 1) : r * (q + 1) + (xcd - r) * q) + off; }
        const int nig = WGM * nN, gid = wgid / nig, fm = gid * WGM, gsz = (nM - fm) < WGM ? (nM - fm) : WGM;
        u.pm = pm0 + fm + ((wgid % nig) % gsz); u.pn = (wgid % nig) / gsz; u.ks = 0; return true;
    }
    __device__ __forceinline__ void a_ready(const Unit&) const {}
    __device__ __forceinline__ void done(const Unit&) const {}
};
template <int NM_, int NN_, int NK_> struct SliceOrder {
    int G, c, pm0;
    __host__ __device__ void init(int G_, int c_, int pm0_) { G = G_; c = c_; pm0 = pm0_; }
    __host__ __device__ bool next(int i, Unit& u) const {
        const int L = i * G + c; if (L >= NM_ * NN_ * NK_) return false;
        const int t = L / NK_; u.ks = L % NK_; u.pn = t % NN_; u.pm = pm0 + t / NN_; return true;
    }
    __device__ __forceinline__ void a_ready(const Unit&) const {}
    __device__ __forceinline__ void done(const Unit&) const {}
};

template <class Epi, class Sched, bool ALIGN_EPI = false, bool SP2 = false>
__device__ __forceinline__ void gemm_phase(PG8_LAS unsigned char* lds, const Gemm g, const Sched& S, const Epi& E) {
    int tid = threadIdx.x; asm volatile("" : "+v"(tid));
    const int wid = __builtin_amdgcn_readfirstlane(tid >> 6), lane = tid & 63, wr = wid >> 2, wc = wid & 3, fr = lane & 15, fq = lane >> 4;
    const int K = g.K, ld = g.ld, nt = K / BK;
    unsigned voffA[2], voffB[2];
#pragma unroll
    for (int i = 0; i < 2; ++i) { int R, C; stage_rc(tid * 16 + i * 8192, R, C); const int Rb = Epi::PERM ? ((R & ~31) + perm32(R & 31)) : R;
        voffA[i] = (unsigned)(R * ld + C) * 2u; voffB[i] = (unsigned)(Rb * ld + C) * 2u; }
    const size_t kstep = (size_t)(BK * 2);
    const size_t hstep = (size_t)HALF * ld * 2;
    const size_t sstep = (size_t)K * 2;
    const size_t tstep = 2 * hstep;
    const unsigned ldsw = (unsigned)wid * 1024u;
    const int aoff = lds_byte(wr * 64 + fr, fq * 8), boff = lds_byte(wc * 32 + fr, fq * 8);
#define PG8_SA(b, h) (((b) * 2 + (h)) * HTB)
#define PG8_SB(b, h) ((4 + (b) * 2 + (h)) * HTB)
#define PG8_STAGE(bufoff, gbase, voff) do { _Pragma("unroll") for (int _i = 0; _i < 2; ++_i) \
        __builtin_amdgcn_global_load_lds((const unsigned*)((const char*)(gbase) + (voff)[_i]), (PG8_LAS unsigned*)(lds + (bufoff) + ldsw + _i * 8192), 16, 0, 0); } while (0)
#define PG8_LDA(dst, b, h) do { _Pragma("unroll") for (int m = 0; m < 4; ++m) _Pragma("unroll") for (int k = 0; k < 2; ++k) dst[m][k] = *(const PG8_LAS bf16x8*)(lds + PG8_SA(b, h) + aoff + m * 2048 + k * 1024); } while (0)
#define PG8_LDB(dst, b, h) do { _Pragma("unroll") for (int n = 0; n < 2; ++n) _Pragma("unroll") for (int k = 0; k < 2; ++k) dst[n][k] = *(const PG8_LAS bf16x8*)(lds + PG8_SB(b, h) + boff + n * 2048 + k * 1024); } while (0)
#define PG8_MMA(ai, bj, At, Bt) do { __builtin_amdgcn_s_setprio(1); _Pragma("unroll") for (int m = 0; m < 4; ++m) _Pragma("unroll") for (int n = 0; n < 2; ++n) _Pragma("unroll") for (int k = 0; k < 2; ++k) \
        acc[ai][bj][m][n] = __builtin_amdgcn_mfma_f32_16x16x32_bf16(Bt[n][k], At[m][k], acc[ai][bj][m][n], 0, 0, 0); __builtin_amdgcn_s_setprio(0); } while (0)
#define PG8_WAIT_V(n) asm volatile("s_waitcnt vmcnt(" #n ")" ::: "memory")
#define PG8_WAIT_L(n) asm volatile("s_waitcnt lgkmcnt(" #n ")" ::: "memory")
#define PG8_BAR __builtin_amdgcn_s_barrier()
#define PG8_SCHED __builtin_amdgcn_sched_barrier(0)
    Unit cur, nxt; int ui = 0;
    if (!S.next(0, cur)) return;
    f32x4 acc[2][2][4][2];
#pragma unroll
    for (int a = 0; a < 2; ++a)
#pragma unroll
        for (int b = 0; b < 2; ++b)
#pragma unroll
            for (int m = 0; m < 4; ++m)
#pragma unroll
                for (int n = 0; n < 2; ++n) acc[a][b][m][n] = (f32x4){0.f, 0.f, 0.f, 0.f};
    bf16x8 At[4][2], B0[2][2], B1[2][2];
    const char* cA = (const char*)g.A + (size_t)cur.pm * tstep + (size_t)cur.ks * sstep; const char* cB = (const char*)g.Bt + (size_t)cur.pn * tstep + (size_t)cur.ks * sstep;
    S.a_ready(cur);
    if constexpr (SP2) {
        PG8_STAGE(PG8_SB(0, 0), cB, voffB); PG8_STAGE(PG8_SB(0, 1), cB + hstep, voffB); PG8_STAGE(PG8_SA(0, 0), cA, voffA); PG8_STAGE(PG8_SA(0, 1), cA + hstep, voffA);
        if (wr == 1) PG8_BAR;
        PG8_WAIT_V(2); PG8_BAR;
        PG8_STAGE(PG8_SB(1, 0), cB + kstep, voffB); PG8_STAGE(PG8_SA(1, 0), cA + kstep, voffA); PG8_STAGE(PG8_SB(1, 1), cB + hstep + kstep, voffB);
        PG8_WAIT_V(6); PG8_BAR;
    } else {
        PG8_STAGE(PG8_SB(0, 0), cB, voffB); PG8_STAGE(PG8_SA(0, 0), cA, voffA); PG8_STAGE(PG8_SB(0, 1), cB + hstep, voffB); PG8_STAGE(PG8_SA(0, 1), cA + hstep, voffA);
        if (wr == 1) PG8_BAR;
        PG8_WAIT_V(4); PG8_BAR;
        PG8_STAGE(PG8_SB(1, 0), cB + kstep, voffB); PG8_STAGE(PG8_SA(1, 0), cA + kstep, voffA); PG8_STAGE(PG8_SB(1, 1), cB + hstep + kstep, voffB);
        PG8_WAIT_V(6); PG8_BAR;
    }
    for (;;) {
        const bool has_next = S.next(ui + 1, nxt);
        const char* nA = has_next ? (const char*)g.A + (size_t)nxt.pm * tstep + (size_t)nxt.ks * sstep : cA; const char* nB = has_next ? (const char*)g.Bt + (size_t)nxt.pn * tstep + (size_t)nxt.ks * sstep : cB;
        for (int t = 0; t < nt; t += 2) {
            const bool last = (t == nt - 2);
            const char* a1 = cA + (size_t)(t + 1) * kstep;
            const char* a2 = last ? nA : cA + (size_t)(t + 2) * kstep; const char* b2 = last ? nB : cB + (size_t)(t + 2) * kstep;
            const char* a3 = a2 + kstep; const char* b3 = b2 + kstep;
            if (last && has_next) S.a_ready(nxt);
            if constexpr (SP2) {
            PG8_LDB(B0, 0, 0); PG8_LDB(B1, 0, 1); PG8_SCHED; PG8_LDA(At, 0, 0); PG8_STAGE(PG8_SA(1, 1), a1 + hstep, voffA);
            PG8_WAIT_V(8); PG8_WAIT_L(0); PG8_BAR; PG8_MMA(0, 0, At, B0); PG8_MMA(0, 1, At, B1); PG8_BAR; PG8_SCHED;
            PG8_LDA(At, 0, 1); PG8_STAGE(PG8_SB(0, 0), b2, voffB); PG8_STAGE(PG8_SB(0, 1), b2 + hstep, voffB); PG8_STAGE(PG8_SA(0, 0), a2, voffA);
            PG8_WAIT_V(8); PG8_WAIT_L(0); PG8_BAR; PG8_MMA(1, 0, At, B0); PG8_MMA(1, 1, At, B1); PG8_BAR; PG8_SCHED;
            PG8_LDB(B0, 1, 0); PG8_LDB(B1, 1, 1); PG8_SCHED; PG8_LDA(At, 1, 0); PG8_STAGE(PG8_SA(0, 1), a2 + hstep, voffA);
            PG8_WAIT_V(8); PG8_WAIT_L(0); PG8_BAR; PG8_MMA(0, 0, At, B0); PG8_MMA(0, 1, At, B1); PG8_BAR; PG8_SCHED;
            PG8_LDA(At, 1, 1); PG8_STAGE(PG8_SB(1, 0), b3, voffB); PG8_STAGE(PG8_SB(1, 1), b3 + hstep, voffB); PG8_STAGE(PG8_SA(1, 0), a3, voffA);
            PG8_WAIT_V(8); PG8_WAIT_L(0); PG8_BAR; PG8_MMA(1, 0, At, B0); PG8_MMA(1, 1, At, B1); PG8_BAR; PG8_SCHED;
            } else {
            PG8_LDB(B0, 0, 0); PG8_SCHED; PG8_LDA(At, 0, 0); PG8_STAGE(PG8_SA(1, 1), a1 + hstep, voffA);
            PG8_WAIT_L(8); PG8_BAR; PG8_WAIT_L(0); PG8_MMA(0, 0, At, B0); PG8_BAR; PG8_SCHED;
            PG8_LDB(B1, 0, 1); PG8_STAGE(PG8_SB(0, 0), b2, voffB);
            PG8_BAR; PG8_WAIT_L(0); PG8_MMA(0, 1, At, B1); PG8_BAR;
            PG8_LDA(At, 0, 1); PG8_STAGE(PG8_SA(0, 0), a2, voffA);
            PG8_BAR; PG8_WAIT_L(0); PG8_MMA(1, 0, At, B0); PG8_BAR; PG8_SCHED;
            PG8_STAGE(PG8_SB(0, 1), b2 + hstep, voffB);
            PG8_WAIT_V(6); PG8_BAR; PG8_MMA(1, 1, At, B1); PG8_BAR;
            PG8_LDB(B0, 1, 0); PG8_SCHED; PG8_LDA(At, 1, 0); PG8_STAGE(PG8_SA(0, 1), a2 + hstep, voffA);
            PG8_WAIT_L(8); PG8_BAR; PG8_WAIT_L(0); PG8_MMA(0, 0, At, B0); PG8_BAR; PG8_SCHED;
            PG8_LDB(B1, 1, 1); PG8_STAGE(PG8_SB(1, 0), b3, voffB);
            PG8_BAR; PG8_WAIT_L(0); PG8_MMA(0, 1, At, B1); PG8_BAR;
            PG8_LDA(At, 1, 1); PG8_STAGE(PG8_SA(1, 0), a3, voffA);
            PG8_BAR; PG8_WAIT_L(0); PG8_MMA(1, 0, At, B0); PG8_BAR; PG8_SCHED;
            PG8_STAGE(PG8_SB(1, 1), b3 + hstep, voffB);
            PG8_WAIT_V(6); PG8_BAR; PG8_MMA(1, 1, At, B1); PG8_BAR;
            }
        }
        if constexpr (ALIGN_EPI) { if (wr == 0) PG8_BAR; }
        if constexpr (!Epi::AFTER_DRAIN) { E(acc, cur, wr, wc, fr, fq); S.done(cur); }
#if EPI_DRAIN
        PG8_WAIT_V(0);
#endif
        if (!has_next) break;
#pragma unroll
        for (int a = 0; a < 2; ++a)
#pragma unroll
            for (int b = 0; b < 2; ++b)
#pragma unroll
                for (int m = 0; m < 4; ++m)
#pragma unroll
                    for (int n = 0; n < 2; ++n) acc[a][b][m][n] = (f32x4){0.f, 0.f, 0.f, 0.f};
        cur = nxt; cA = nA; cB = nB; ++ui;
        if constexpr (ALIGN_EPI) { if (wr == 1) PG8_BAR; }
    }
    PG8_WAIT_V(0);
    if constexpr (!ALIGN_EPI) { if (wr == 0) PG8_BAR; }
    PG8_BAR;
    if constexpr (Epi::AFTER_DRAIN) { E(acc, cur, wr, wc, fr, fq); S.done(cur); }
#undef PG8_SA
#undef PG8_SB
#undef PG8_STAGE
#undef PG8_LDA
#undef PG8_LDB
#undef PG8_MMA
#undef PG8_WAIT_V
#undef PG8_WAIT_L
#undef PG8_BAR
#undef PG8_SCHED
}
}

using pg8::bf16_t; using pg8::f32x4; using pg8::u32x4; using pg8::u32x2; using pg8::bf16x8; using pg8::Unit;
#define LAS __attribute__((address_space(3)))
#define GAS __attribute__((address_space(1)))
#define GIN(k) ((const float*)(const GAS float*)F.in[k])
typedef float f32x2 __attribute__((ext_vector_type(2)));
typedef __bf16 bf16x2_t __attribute__((ext_vector_type(2)));
typedef float f32x16 __attribute__((ext_vector_type(16)));

constexpr int DM = 1024, E_ = 2048, XA = 512, NH = 4, HD = 128, MEML = 256;
constexpr int PB = 8, PSEQ = 2048, MP = PB * PSEQ;
constexpr int SBT = 128, SSEQ = 4, MS = SBT * SSEQ;
constexpr int M = MP + MS;
constexpr int NIN_A = 3 * E_ + XA, NIN_B = 4 * E_ + XA, NIN_C = 2 * E_ + XA, KOUT = E_ + XA;
constexpr int S5G = 128, S5P = 64, S5I = 16;
constexpr float EPS = 1e-6f;
constexpr int NWAVES = 8, NTHR = 512;

constexpr size_t O_YP = 0, O_YS = O_YP + (size_t)MP * DM, O_MK = O_YS + (size_t)MS * DM, O_MV = O_MK + 4ull * PB * MEML * XA, O_CP = O_MV + 4ull * PB * MEML * XA,
                 O_CS = O_CP + (size_t)PB * 2 * E_, O_SRP = O_CS + (size_t)SBT * 2 * E_, O_SIP = O_SRP + (size_t)PB * S5G * S5P, O_SRS = O_SIP + (size_t)PB * S5G * S5P,
                 O_SIS = O_SRS + (size_t)SBT * S5G * S5P, O_CV = O_SIS + (size_t)SBT * S5G * S5P, O_END = O_CV + 2ull * SBT * SSEQ * E_;
static_assert(O_END == 30572544ull, "output size");

constexpr size_t MiB = 1u << 20;
constexpr size_t WS_CTL = 0, WS_TAB = 1 * MiB, WS_RSTDM = 3 * MiB, WS_SGUW = 4 * MiB, WS_SSX = 5 * MiB, WS_SSV = 7 * MiB, WS_WKV = 10 * MiB, WS_WGLU = 18 * MiB, WS_WOUT = 26 * MiB,
                 WS_WINA = 46 * MiB, WS_WINB = 72 * MiB, WS_WINC = 89 * MiB, WS_MEMB = 98 * MiB, WS_KB = 102 * MiB, WS_VT = 110 * MiB, WS_XB = 118 * MiB, WS_X = 151 * MiB,
                 WS_B0 = 217 * MiB, WS_B1 = 283 * MiB, WS_QB = 349 * MiB, WS_A2 = 366 * MiB, WS_GB = 449 * MiB, WS_SLAB = 515 * MiB  , WS_END = 548 * MiB;
constexpr size_t T_AR = 0, T_AI = 8192, T_BBR = 16384, T_BBI = 16384 + 131072;

constexpr int RING_BYTES = 131072, LDS_BYTES = 147456;

struct Args { const float* in[30]; float* out; unsigned char* ws; int ph_lo, ph_hi; };

__device__ __forceinline__ unsigned pk2(float lo, float hi) { f32x2 v = {lo, hi}; return __builtin_bit_cast(unsigned, __builtin_convertvector(v, bf16x2_t)); }
__device__ __forceinline__ bf16_t f2bf(float f) { return (bf16_t)(pk2(f, 0.f) & 0xffffu); }
__device__ __forceinline__ float bf2f(unsigned short h) { return __uint_as_float((unsigned)h << 16); }
__device__ __forceinline__ float bflo(unsigned w) { return __uint_as_float(w << 16); }
__device__ __forceinline__ float bfhi(unsigned w) { return __uint_as_float(w & 0xffff0000u); }
__device__ __forceinline__ float sigmoidf_(float x) { return __builtin_amdgcn_rcpf(1.f + __expf(-x)); }
__device__ __forceinline__ float siluf_(float x) { return x * sigmoidf_(x); }
__device__ __forceinline__ float gelu_tanh(float x) { const float y = 0.7978845608028654f * (x + 0.044715f * x * x * x); return x * sigmoidf_(2.f * y); }
__device__ __forceinline__ float wave_sum(float v) {
#pragma unroll
    for (int o = 1; o < 64; o <<= 1) v += __shfl_xor(v, o);
    return v;
}
__device__ __forceinline__ float wave_max(float v) {
#pragma unroll
    for (int o = 1; o < 64; o <<= 1) v = fmaxf(v, __shfl_xor(v, o));
    return v;
}
__device__ __forceinline__ u32x4 pack8(f32x4 a, f32x4 b) { u32x4 w; w.x = pk2(a[0], a[1]); w.y = pk2(a[2], a[3]); w.z = pk2(b[0], b[1]); w.w = pk2(b[2], b[3]); return w; }
__device__ __forceinline__ void unpack8(u32x4 w, float (&f)[8]) { f[0] = bflo(w.x); f[1] = bfhi(w.x); f[2] = bflo(w.y); f[3] = bfhi(w.y); f[4] = bflo(w.z); f[5] = bfhi(w.z); f[6] = bflo(w.w); f[7] = bfhi(w.w); }

__device__ __forceinline__ int src_col(int kind, int np) {
    const int pn = np >> 8, p = np & 255, pos = (p & ~31) + pg8::perm32(p & 31);
    if (kind == 0) {
        if (pn < 16) return pos < 128 ? 128 * pn + pos : 2 * E_ + 128 * pn + (pos - 128);
        if (pn < 24) return E_ + 256 * (pn - 16) + pos;
        return 3 * E_ + 256 * (pn - 24) + pos;
    }
    if (kind == 1) {
        if (pn < 32) { const int qs = 2 * (p >> 7) + ((p >> 4) & 1), ch = 64 * pn + 16 * ((p >> 5) & 3) + (p & 15); return qs * E_ + ch; }
        return 4 * E_ + 256 * (pn - 32) + pos;
    }
    return 256 * pn + pos;
}

__device__ __forceinline__ float sum_rows4(float x) {
    auto a = __builtin_amdgcn_permlane16_swap(__float_as_uint(x), __float_as_uint(x), false, false); const float y = __uint_as_float(a[0]) + __uint_as_float(a[1]);
    auto b = __builtin_amdgcn_permlane32_swap(__float_as_uint(y), __float_as_uint(y), false, false); return __uint_as_float(b[0]) + __uint_as_float(b[1]);
}
__device__ __forceinline__ void rows_rstd16(const float* ssx, int row0, int fq, float (&rs)[2][4]) {
#pragma unroll
    for (int ai = 0; ai < 2; ++ai)
#pragma unroll
        for (int m = 0; m < 4; ++m) {
            const f32x4 v = *(const f32x4*)(ssx + (size_t)(row0 + ai * 128 + m * 16) * 16 + fq * 4);
            const float s = sum_rows4((v[0] + v[1]) + (v[2] + v[3]));
            rs[ai][m] = __builtin_amdgcn_rsqf(s * (1.f / DM) + EPS);
        }
#if PROBE_RSTD2
    { const int dep = rs[1][3] == 12345.678f ? 1 : 0;
#pragma unroll
    for (int ai = 0; ai < 2; ++ai)
#pragma unroll
        for (int m = 0; m < 4; ++m) {
            const f32x4 v = *(const f32x4*)(ssx + (size_t)(row0 + dep + ai * 128 + m * 16) * 16 + fq * 4);
            const float s = sum_rows4((v[0] + v[1]) + (v[2] + v[3]));
            rs[ai][m] = fmaxf(rs[ai][m], __builtin_amdgcn_rsqf(s * (1.f / DM) + EPS));
        } }
#endif
}

struct EpiKV {
    static constexpr bool PERM = false, AFTER_DRAIN = false;
    const float* rstdm; float* outk; float* outv; bf16_t* KB; bf16_t* VT; int layer;
    __device__ __forceinline__ void operator()(const f32x4 (&acc)[2][2][4][2], const Unit& u, int wr, int wc, int fr, int fq) const {
        const int sub = u.pn & 3, isv = sub >> 1, b = u.pm;
        const int key0 = wr * 64 + fr, d0 = 32 * wc + 8 * fq;
        const float* rsp = rstdm + b * 256 + key0;
        float* of = (isv ? outv : outk) + (((size_t)(layer * PB + b) * MEML + key0) * NH + (sub & 1) * 2) * HD + d0;
        const size_t bh0 = (size_t)((layer * PB + b) * NH + (sub & 1) * 2);
        if (!isv) {
            bf16_t* kb = KB + (bh0 * MEML + key0) * HD + d0;
#pragma unroll
            for (int ai = 0; ai < 2; ++ai)
#pragma unroll
                for (int m = 0; m < 4; ++m) { const int kk = ai * 128 + m * 16; const float rs = rsp[kk];
#pragma unroll
                    for (int bj = 0; bj < 2; ++bj) { const f32x4 v0 = acc[ai][bj][m][0] * rs, v1 = acc[ai][bj][m][1] * rs;
                        float* o = of + (size_t)kk * XA + bj * HD; *(f32x4*)o = v0; *(f32x4*)(o + 4) = v1;
                        *(u32x4*)(kb + (size_t)bj * MEML * HD + (size_t)kk * HD) = pack8(v0, v1); }
                    asm volatile("" ::: "memory"); }
        } else {
            bf16_t* vt = VT + (bh0 * HD + d0) * MEML + key0;
#pragma unroll
            for (int ai = 0; ai < 2; ++ai)
#pragma unroll
                for (int m = 0; m < 4; ++m) { const int kk = ai * 128 + m * 16; const float rs = rsp[kk];
#pragma unroll
                    for (int bj = 0; bj < 2; ++bj) { const f32x4 v0 = acc[ai][bj][m][0] * rs, v1 = acc[ai][bj][m][1] * rs;
                        float* o = of + (size_t)kk * XA + bj * HD; *(f32x4*)o = v0; *(f32x4*)(o + 4) = v1;
                        bf16_t* q = vt + (size_t)bj * HD * MEML + kk;
#pragma unroll
                        for (int e = 0; e < 4; ++e) { q[e * MEML] = f2bf(v0[e]); q[(e + 4) * MEML] = f2bf(v1[e]); }
                        asm volatile("" ::: "memory"); } }
        }
    }
};

struct EpiInA {
    static constexpr bool PERM = false, AFTER_DRAIN = false;
    const float* ssx; bf16_t* UZ; bf16_t* VR; bf16_t* QB; float* SSV;
    __device__ __forceinline__ void operator()(const f32x4 (&acc)[2][2][4][2], const Unit& u, int wr, int wc, int fr, int fq) const {
        const int row0 = u.pm * 256 + wr * 64 + fr; float rs[2][4]; rows_rstd16(ssx, row0, fq, rs);
        if (u.pn < 16) {
#pragma unroll
            for (int ai = 0; ai < 2; ++ai)
#pragma unroll
                for (int m = 0; m < 4; ++m) { const int row = row0 + ai * 128 + m * 16; const float r = rs[ai][m]; f32x4 o[2];
#pragma unroll
                    for (int n = 0; n < 2; ++n)
#pragma unroll
                        for (int e = 0; e < 4; ++e) o[n][e] = acc[ai][0][m][n][e] * r * siluf_(acc[ai][1][m][n][e] * r);
                    *(u32x4*)(UZ + (size_t)row * E_ + 128 * u.pn + 32 * wc + 8 * fq) = pack8(o[0], o[1]); }
        } else if (u.pn < 24) {
#pragma unroll
            for (int ai = 0; ai < 2; ++ai)
#pragma unroll
                for (int m = 0; m < 4; ++m) { const int row = row0 + ai * 128 + m * 16; const float r = rs[ai][m]; float ss = 0.f;
#pragma unroll
                    for (int bj = 0; bj < 2; ++bj) { const f32x4 v0 = acc[ai][bj][m][0] * r, v1 = acc[ai][bj][m][1] * r;
                        ss += (v0[0] * v0[0] + v0[1] * v0[1]) + (v0[2] * v0[2] + v0[3] * v0[3]) + (v1[0] * v1[0] + v1[1] * v1[1]) + (v1[2] * v1[2] + v1[3] * v1[3]);
                        *(u32x4*)(VR + (size_t)row * E_ + 256 * (u.pn - 16) + 128 * bj + 32 * wc + 8 * fq) = pack8(v0, v1); }
                    ss = sum_rows4(ss);
                    if (fq == 0) SSV[(size_t)row * 32 + (u.pn - 16) * 4 + wc] = ss; }
        } else {
#pragma unroll
            for (int ai = 0; ai < 2; ++ai)
#pragma unroll
                for (int m = 0; m < 4; ++m) { const int row = row0 + ai * 128 + m * 16; const float r = rs[ai][m] * 0.08838834764831845f;
#pragma unroll
                    for (int bj = 0; bj < 2; ++bj) *(u32x4*)(QB + (size_t)row * XA + 256 * (u.pn - 24) + 128 * bj + 32 * wc + 8 * fq) = pack8(acc[ai][bj][m][0] * r, acc[ai][bj][m][1] * r); }
        }
    }
};

struct EpiInB {
    static constexpr bool PERM = false, AFTER_DRAIN = false;
    const float* ssx; bf16_t* P; bf16_t* G; bf16_t* QB; float* convp; float* convs; const float* cw; bf16_t* A2;
    __device__ __forceinline__ void operator()(const f32x4 (&acc)[2][2][4][2], const Unit& u, int wr, int wc, int fr, int fq) const {
        const int row0 = u.pm * 256 + wr * 64 + fr; float rs[2][4]; rows_rstd16(ssx, row0, fq, rs);
        if (u.pn < 32 && u.pm < MP / 256) {
            const int ch0 = 64 * u.pn + 16 * wc + 4 * fq;
            const f32x4 w0 = *(const f32x4*)(cw + ch0), w1 = *(const f32x4*)(cw + E_ + ch0), w2 = *(const f32x4*)(cw + 2 * E_ + ch0);
#pragma unroll
            for (int ai = 0; ai < 2; ++ai) {
                f32x4 pv = {0.f, 0.f, 0.f, 0.f};
#pragma unroll
                for (int m = 0; m < 4; ++m) { const int row = row0 + ai * 128 + m * 16; const float r = rs[ai][m];
                    const f32x4 bg = acc[ai][0][m][0] * r, cgv = acc[ai][0][m][1] * r, hv = acc[ai][1][m][0] * r, z = acc[ai][1][m][1] * r;
                    f32x4 p = cgv * hv, gg, y;
#pragma unroll
                    for (int e = 0; e < 4; ++e) { gg[e] = bg[e] * siluf_(z[e]);
                        const unsigned o1 = __builtin_amdgcn_update_dpp(0u, __float_as_uint(pv[e]), 0x121, 0xf, 0xf, true), o2 = __builtin_amdgcn_update_dpp(0u, __float_as_uint(pv[e]), 0x122, 0xf, 0xf, true);
                        const float pm1 = __uint_as_float(__builtin_amdgcn_update_dpp(o1, __float_as_uint(p[e]), 0x111, 0xf, 0xf, false));
                        const float pm2 = __uint_as_float(__builtin_amdgcn_update_dpp(o2, __float_as_uint(p[e]), 0x112, 0xf, 0xf, false));
                        y[e] = (w0[e] * pm2 + w1[e] * pm1 + w2[e] * p[e]) * gg[e]; }
                    pv = p;
                    u32x2 wp, wg, wy; wp.x = pk2(p[0], p[1]); wp.y = pk2(p[2], p[3]); wg.x = pk2(gg[0], gg[1]); wg.y = pk2(gg[2], gg[3]); wy.x = pk2(y[0], y[1]); wy.y = pk2(y[2], y[3]);
                    if (m > 0 || fr >= 2) *(u32x2*)(A2 + (size_t)row * KOUT + ch0) = wy;
                    if ((m == 0 && fr < 2) || (m == 3 && fr >= 14)) *(u32x2*)(P + (size_t)row * E_ + ch0) = wp;
                    if (m == 0 && fr < 2) *(u32x2*)(G + (size_t)row * E_ + ch0) = wg;
                    { const int t = row & (PSEQ - 1); if (t >= PSEQ - 2) *(f32x4*)(convp + ((size_t)(row >> 11) * 2 + (t - (PSEQ - 2))) * E_ + ch0) = p; } } }
        } else if (u.pn < 32) {
            const int ch0 = 64 * u.pn + 16 * wc + 4 * fq;
#pragma unroll
            for (int ai = 0; ai < 2; ++ai)
#pragma unroll
                for (int m = 0; m < 4; ++m) { const int row = row0 + ai * 128 + m * 16; const float r = rs[ai][m];
                    const f32x4 bg = acc[ai][0][m][0] * r, cgv = acc[ai][0][m][1] * r, hv = acc[ai][1][m][0] * r, z = acc[ai][1][m][1] * r;
                    f32x4 p = cgv * hv, gg;
#pragma unroll
                    for (int e = 0; e < 4; ++e) gg[e] = bg[e] * siluf_(z[e]);
                    u32x2 wp, wg; wp.x = pk2(p[0], p[1]); wp.y = pk2(p[2], p[3]); wg.x = pk2(gg[0], gg[1]); wg.y = pk2(gg[2], gg[3]);
                    *(u32x2*)(P + (size_t)row * E_ + ch0) = wp; *(u32x2*)(G + (size_t)row * E_ + ch0) = wg;
                    if (row < MP) { const int t = row & (PSEQ - 1); if (t >= PSEQ - 2) *(f32x4*)(convp + ((size_t)(row >> 11) * 2 + (t - (PSEQ - 2))) * E_ + ch0) = p; }
                    else { const int s = row - MP, t = s & 3; if (t >= 2) *(f32x4*)(convs + ((size_t)(s >> 2) * 2 + (t - 2)) * E_ + ch0) = p; } }
        } else {
#pragma unroll
            for (int ai = 0; ai < 2; ++ai)
#pragma unroll
                for (int m = 0; m < 4; ++m) { const int row = row0 + ai * 128 + m * 16; const float r = rs[ai][m] * 0.08838834764831845f;
#pragma unroll
                    for (int bj = 0; bj < 2; ++bj) *(u32x4*)(QB + (size_t)row * XA + 256 * (u.pn - 32) + 128 * bj + 32 * wc + 8 * fq) = pack8(acc[ai][bj][m][0] * r, acc[ai][bj][m][1] * r); }
        }
    }
};

struct EpiInC {
    static constexpr bool PERM = false, AFTER_DRAIN = false;
    const float* ssx; bf16_t* U; bf16_t* SZ; bf16_t* QB;
    __device__ __forceinline__ void operator()(const f32x4 (&acc)[2][2][4][2], const Unit& u, int wr, int wc, int fr, int fq) const {
        const int row0 = u.pm * 256 + wr * 64 + fr; float rs[2][4]; rows_rstd16(ssx, row0, fq, rs);
#pragma unroll
        for (int ai = 0; ai < 2; ++ai)
#pragma unroll
            for (int m = 0; m < 4; ++m) { const int row = row0 + ai * 128 + m * 16; const float r = rs[ai][m];
#pragma unroll
                for (int bj = 0; bj < 2; ++bj) { const int cc = 128 * bj + 32 * wc + 8 * fq;
                    if (u.pn < 8) *(u32x4*)(U + (size_t)row * E_ + 256 * u.pn + cc) = pack8(acc[ai][bj][m][0] * r, acc[ai][bj][m][1] * r);
                    else if (u.pn < 16) { f32x4 a, b2;
#pragma unroll
                        for (int e = 0; e < 4; ++e) { a[e] = siluf_(acc[ai][bj][m][0][e] * r); b2[e] = siluf_(acc[ai][bj][m][1][e] * r); }
                        *(u32x4*)(SZ + (size_t)row * E_ + 256 * (u.pn - 8) + cc) = pack8(a, b2); }
                    else { const float rq = r * 0.08838834764831845f; *(u32x4*)(QB + (size_t)row * XA + 256 * (u.pn - 16) + cc) = pack8(acc[ai][bj][m][0] * rq, acc[ai][bj][m][1] * rq); } } }
    }
};

struct EpiOut {
    static constexpr bool PERM = false, AFTER_DRAIN = false;
    const float* basef; bf16_t* XB; float* SSX;
    __device__ __forceinline__ void operator()(const f32x4 (&acc)[2][2][4][2], const Unit& u, int wr, int wc, int fr, int fq) const {
        const int row0 = u.pm * 256 + wr * 64 + fr;
#pragma unroll
        for (int ai = 0; ai < 2; ++ai)
#pragma unroll
            for (int m = 0; m < 4; ++m) { const int row = row0 + ai * 128 + m * 16; float ss = 0.f;
#pragma unroll
                for (int bj = 0; bj < 2; ++bj) { const int col = 256 * u.pn + 128 * bj + 32 * wc + 8 * fq; f32x4 x0, x1;
                    if (basef) { x0 = *(const f32x4*)(basef + (size_t)row * DM + col); x1 = *(const f32x4*)(basef + (size_t)row * DM + col + 4); }
                    else { float r[8]; unpack8(*(const u32x4*)(XB + (size_t)row * DM + col), r); x0 = (f32x4){r[0], r[1], r[2], r[3]}; x1 = (f32x4){r[4], r[5], r[6], r[7]}; }
                    x0 += acc[ai][bj][m][0]; x1 += acc[ai][bj][m][1];
                    *(u32x4*)(XB + (size_t)row * DM + col) = pack8(x0, x1);
                    ss += (x0[0] * x0[0] + x0[1] * x0[1]) + (x0[2] * x0[2] + x0[3] * x0[3]) + (x1[0] * x1[0] + x1[1] * x1[1]) + (x1[2] * x1[2] + x1[3] * x1[3]); }
                ss = sum_rows4(ss);
                if (fq == 0) SSX[(size_t)row * 16 + u.pn * 4 + wc] = ss; }
    }
};

__device__ __forceinline__ void counter_signal(unsigned* cnt);
__device__ __forceinline__ void counter_wait(unsigned* cnt, unsigned want);
struct EpiOutFinal {
    static constexpr bool PERM = false, AFTER_DRAIN = true;
    const bf16_t* XB; float* SSX; const float* fg; float* Y; unsigned* cnt;
    __device__ __forceinline__ void operator()(f32x4 (&acc)[2][2][4][2], const Unit& u, int wr, int wc, int fr, int fq) const {
        const int row0 = u.pm * 256 + wr * 64 + fr;
#pragma unroll
        for (int ai = 0; ai < 2; ++ai)
#pragma unroll
            for (int m = 0; m < 4; ++m) { const int row = row0 + ai * 128 + m * 16; float ss = 0.f;
#pragma unroll
                for (int bj = 0; bj < 2; ++bj) { const int col = 256 * u.pn + 128 * bj + 32 * wc + 8 * fq;
                    float r[8]; unpack8(*(const u32x4*)(XB + (size_t)row * DM + col), r);
                    const f32x4 x0 = acc[ai][bj][m][0] + (f32x4){r[0], r[1], r[2], r[3]}, x1 = acc[ai][bj][m][1] + (f32x4){r[4], r[5], r[6], r[7]};
                    acc[ai][bj][m][0] = x0; acc[ai][bj][m][1] = x1;
                    ss += (x0[0] * x0[0] + x0[1] * x0[1]) + (x0[2] * x0[2] + x0[3] * x0[3]) + (x1[0] * x1[0] + x1[1] * x1[1]) + (x1[2] * x1[2] + x1[3] * x1[3]); }
                ss = sum_rows4(ss);
                if (fq == 0) SSX[(size_t)row * 16 + u.pn * 4 + wc] = ss; }
        counter_signal(cnt + 64 * u.pm); counter_wait(cnt + 64 * u.pm, 4u);
        float rs[2][4]; rows_rstd16(SSX, row0, fq, rs);
#pragma unroll
        for (int bj = 0; bj < 2; ++bj) { const int col = 256 * u.pn + 128 * bj + 32 * wc + 8 * fq; const f32x4 g0 = *(const f32x4*)(fg + col), g1 = *(const f32x4*)(fg + col + 4);
#pragma unroll
            for (int ai = 0; ai < 2; ++ai)
#pragma unroll
                for (int m = 0; m < 4; ++m) { const int row = row0 + ai * 128 + m * 16; const float r = rs[ai][m];
                    *(f32x4*)(Y + (size_t)row * DM + col) = acc[ai][bj][m][0] * r * g0; *(f32x4*)(Y + (size_t)row * DM + col + 4) = acc[ai][bj][m][1] * r * g1; } }
    }
};

struct EpiGlu {
    static constexpr bool PERM = false, AFTER_DRAIN = false;
    const bf16_t* GB; const bf16_t* SZ; const float* bias; bf16_t* A2;
    __device__ __forceinline__ void operator()(const f32x4 (&acc)[2][2][4][2], const Unit& u, int wr, int wc, int fr, int fq) const {
        const int row0 = u.pm * 256 + wr * 64 + fr;
#pragma unroll
        for (int ai = 0; ai < 2; ++ai)
#pragma unroll
            for (int m = 0; m < 4; ++m) { const int row = row0 + ai * 128 + m * 16;
#pragma unroll
                for (int bj = 0; bj < 2; ++bj) { const int col = 256 * u.pn + 128 * bj + 32 * wc + 8 * fq;
                    const f32x4 b0 = *(const f32x4*)(bias + col), b1 = *(const f32x4*)(bias + col + 4);
                    float gv[8], sz[8]; unpack8(*(const u32x4*)(GB + (size_t)row * E_ + col), gv); unpack8(*(const u32x4*)(SZ + (size_t)row * E_ + col), sz);
                    f32x4 o0, o1;
#pragma unroll
                    for (int e = 0; e < 4; ++e) { o0[e] = gv[e] * sigmoidf_(acc[ai][bj][m][0][e] + b0[e]) * sz[e]; o1[e] = gv[4 + e] * sigmoidf_(acc[ai][bj][m][1][e] + b1[e]) * sz[4 + e]; }
                    *(u32x4*)(A2 + (size_t)row * KOUT + col) = pack8(o0, o1); } }
    }
};

struct EpiSlab {
    static constexpr bool PERM = false, AFTER_DRAIN = false;
    float* S; int ldc; int row0; size_t kstride;
    __device__ __forceinline__ void operator()(const f32x4 (&acc)[2][2][4][2], const Unit& u, int wr, int wc, int fr, int fq) const {
        float* base = S + (size_t)u.ks * kstride + (size_t)(u.pm * 256 + wr * 64 + fr - row0) * ldc + 256 * u.pn + 32 * wc + 8 * fq;
#pragma unroll
        for (int ai = 0; ai < 2; ++ai)
#pragma unroll
            for (int m = 0; m < 4; ++m)
                { float* o = base + (size_t)(ai * 128 + m * 16) * ldc; *(f32x4*)o = acc[ai][0][m][0]; *(f32x4*)(o + 4) = acc[ai][0][m][1]; *(f32x4*)(o + 128) = acc[ai][1][m][0]; *(f32x4*)(o + 132) = acc[ai][1][m][1];
                  asm volatile("" ::: "memory"); }
    }
};

#ifndef PROBE_EPI2
#define PROBE_EPI2 0
#endif
template <class E_> struct EpiTwice { static constexpr bool PERM = false, AFTER_DRAIN = false; E_ e;
    __device__ __forceinline__ void operator()(const f32x4 (&acc)[2][2][4][2], const Unit& u, int wr, int wc, int fr, int fq) const { e(acc, u, wr, wc, fr, fq); asm volatile("" ::: "memory"); e(acc, u, wr, wc, fr, fq); } };

struct Frame {
    LAS unsigned char* lds; int tid, lane, wave, G, bid;
    const float* const* in; float* out; unsigned char* ws;
};

struct WItem { const float* W; const float* gs; bf16_t* WT; int K, N, kind, r; };
__device__ __forceinline__ WItem witem(Frame& F, int it) {
    constexpr int I_A = 16 * (NIN_A / 32), I_B = 16 * (NIN_B / 32), I_C = 16 * (NIN_C / 32), I_O = (KOUT / 64) * (DM / 32), I_KV = 16 * (DM / 32);
    unsigned char* ws = F.ws; int r = it; WItem w;
    if (r < 2 * I_A) { const int j = r / I_A; r -= j * I_A; w = WItem{GIN(13) + (size_t)j * DM * NIN_A, GIN(8) + (j == 0 ? 0 : 3) * DM, (bf16_t*)(ws + WS_WINA) + (size_t)j * NIN_A * DM, DM, NIN_A, 0, r}; return w; } r -= 2 * I_A;
    if (r < I_B) { w = WItem{GIN(17), GIN(8) + 1 * DM, (bf16_t*)(ws + WS_WINB), DM, NIN_B, 1, r}; return w; } r -= I_B;
    if (r < I_C) { w = WItem{GIN(19), GIN(8) + 2 * DM, (bf16_t*)(ws + WS_WINC), DM, NIN_C, 2, r}; return w; } r -= I_C;
    if (r < 4 * I_O) { const int j = r / I_O; r -= j * I_O; w = WItem{GIN(12) + (size_t)j * KOUT * DM, nullptr, (bf16_t*)(ws + WS_WOUT) + (size_t)j * DM * KOUT, KOUT, DM, 2, r}; return w; } r -= 4 * I_O;
    if (r < 4 * I_KV) { const int j = r / I_KV; r -= j * I_KV; w = WItem{GIN(11) + (size_t)j * DM * DM, GIN(10) + j * DM, (bf16_t*)(ws + WS_WKV) + (size_t)j * DM * DM, DM, DM, 2, r}; return w; } r -= 4 * I_KV;
    w = WItem{GIN(28), nullptr, (bf16_t*)(ws + WS_WGLU), E_, E_, 2, r}; return w;
}
__device__ __forceinline__ void witem_load(const WItem& w, int lane, f32x4 (&x)[8]) {
    const int nblk = w.N / 32, kb = w.r / nblk, nb = w.r % nblk, k0 = 64 * kb, n0 = 32 * nb, n4 = lane & 7, kr = lane >> 3;
    const int sc = src_col(w.kind, n0 + 4 * n4);
#pragma unroll
    for (int i = 0; i < 8; ++i) x[i] = *(const f32x4*)(w.W + (size_t)(k0 + kr + 8 * i) * w.N + sc);
}
__device__ __forceinline__ void witem_finish(const WItem& w, int lane, const f32x4 (&x)[8], LAS float* scr) {
    const int nblk = w.N / 32, kb = w.r / nblk, nb = w.r % nblk, k0 = 64 * kb, n0 = 32 * nb, n4 = lane & 7, kr = lane >> 3;
    asm volatile("s_waitcnt vmcnt(8)" ::: "memory");
#pragma unroll
    for (int i = 0; i < 8; ++i) { const int kk = kr + 8 * i; const float g = w.gs ? w.gs[k0 + kk] : 1.f; LAS float* d = scr + kk * 33 + 4 * n4; d[0] = x[i][0] * g; d[1] = x[i][1] * g; d[2] = x[i][2] * g; d[3] = x[i][3] * g; }
    asm volatile("s_waitcnt lgkmcnt(0)" ::: "memory");
    const int c = lane & 7;
#pragma unroll
    for (int j = 0; j < 4; ++j) { const int n = (lane >> 3) + 8 * j; const LAS float* sp = scr + (8 * c) * 33 + n;
        u32x4 o; o.x = pk2(sp[0 * 33], sp[1 * 33]); o.y = pk2(sp[2 * 33], sp[3 * 33]); o.z = pk2(sp[4 * 33], sp[5 * 33]); o.w = pk2(sp[6 * 33], sp[7 * 33]);
        *(u32x4*)(w.WT + (size_t)(n0 + n) * w.K + k0 + 8 * c) = o; }
    asm volatile("s_waitcnt lgkmcnt(0)" ::: "memory");
}

__device__ __forceinline__ void p0_prologue(Frame& F) {
    LAS float* scr = (LAS float*)(F.lds + F.wave * 16384);
    const int gw = F.bid * NWAVES + F.wave, NGW = F.G * NWAVES, lane = F.lane;
    unsigned char* ws = F.ws;
    constexpr int NITEMS = 2 * 16 * (NIN_A / 32) + 16 * (NIN_B / 32) + 16 * (NIN_C / 32) + 4 * (KOUT / 64) * (DM / 32) + 4 * 16 * (DM / 32) + (E_ / 64) * (E_ / 32);
    if (gw < NITEMS) {
        WItem wc = witem(F, gw); f32x4 xa[8]; witem_load(wc, lane, xa);
        for (int it = gw; it < NITEMS; it += NGW) {
            const int nit = it + NGW < NITEMS ? it + NGW : it; const WItem wn = witem(F, nit); f32x4 xb[8]; witem_load(wn, lane, xb);
            witem_finish(wc, lane, xa, scr);
            wc = wn;
#pragma unroll
            for (int i = 0; i < 8; ++i) xa[i] = xb[i];
        }
    }
    {
        bf16_t* XB = (bf16_t*)(ws + WS_XB); float* SSX = (float*)(ws + WS_SSX);
        for (int row = gw; row < M; row += 2 * NGW) {
            const int row2 = row + NGW < M ? row + NGW : row;
            const float* xr = row < MP ? GIN(0) + (size_t)row * DM : GIN(1) + (size_t)(row - MP) * DM;
            const float* xr2 = row2 < MP ? GIN(0) + (size_t)row2 * DM : GIN(1) + (size_t)(row2 - MP) * DM;
            f32x4 v[4], v2[4];
#pragma unroll
            for (int j = 0; j < 4; ++j) { v[j] = *((const f32x4*)xr + lane + 64 * j); v2[j] = *((const f32x4*)xr2 + lane + 64 * j); }
            float ss = 0.f, ss2 = 0.f;
#pragma unroll
            for (int j = 0; j < 4; ++j) { ss += (v[j][0] * v[j][0] + v[j][1] * v[j][1]) + (v[j][2] * v[j][2] + v[j][3] * v[j][3]); ss2 += (v2[j][0] * v2[j][0] + v2[j][1] * v2[j][1]) + (v2[j][2] * v2[j][2] + v2[j][3] * v2[j][3]);
                u32x2 w; w.x = pk2(v[j][0], v[j][1]); w.y = pk2(v[j][2], v[j][3]); *((u32x2*)(XB + (size_t)row * DM) + lane + 64 * j) = w;
                u32x2 w2; w2.x = pk2(v2[j][0], v2[j][1]); w2.y = pk2(v2[j][2], v2[j][3]); *((u32x2*)(XB + (size_t)row2 * DM) + lane + 64 * j) = w2; }
            asm volatile("s_waitcnt vmcnt(0)" ::: "memory");
            ss = wave_sum(ss); ss2 = wave_sum(ss2);
            if (lane < 16) { SSX[(size_t)row * 16 + lane] = lane == 0 ? ss : 0.f; SSX[(size_t)row2 * 16 + lane] = lane == 0 ? ss2 : 0.f; }
        }
    }
    {
        bf16_t* MB = (bf16_t*)(ws + WS_MEMB); float* RM = (float*)(ws + WS_RSTDM);
        for (int row = gw; row < PB * MEML; row += NGW) {
            const float* xr = GIN(2) + (size_t)row * DM; float ss = 0.f;
#pragma unroll
            for (int j = 0; j < 4; ++j) { const f32x4 v = *((const f32x4*)xr + lane + 64 * j); ss += (v[0] * v[0] + v[1] * v[1]) + (v[2] * v[2] + v[3] * v[3]);
                u32x2 w; w.x = pk2(v[0], v[1]); w.y = pk2(v[2], v[3]); *((u32x2*)(MB + (size_t)row * DM) + lane + 64 * j) = w; }
            asm volatile("s_waitcnt vmcnt(0)" ::: "memory");
            ss = wave_sum(ss);
            if (lane == 0) RM[row] = 1.0f / sqrtf(ss * (1.f / DM) + EPS);
        }
    }
    {
        float* TAB = (float*)(ws + WS_TAB);
        for (int g = gw; g < S5G; g += NGW) {
            const int gp = g * S5P + lane;
            const float lr = GIN(20)[gp], li = GIN(21)[gp], dt = expf(GIN(22)[g]);
            const float th = li * dt, em1 = expm1f(lr * dt), mag = em1 + 1.f, cs = cosf(th), sn = sinf(th), sh = sinf(0.5f * th);
            const float ar = mag * cs, ai = mag * sn;
            const float nr = em1 * cs - 2.f * sh * sh, ni = ai;
            const float den = lr * lr + li * li, cr = (nr * lr + ni * li) / den, ci = (ni * lr - nr * li) / den;
            TAB[T_AR + gp] = ar; TAB[T_AI + gp] = ai;
#pragma unroll
            for (int i = 0; i < S5I; ++i) { const float br = GIN(23)[(size_t)gp * S5I + i], bi = GIN(24)[(size_t)gp * S5I + i];
                TAB[T_BBR + (size_t)gp * S5I + i] = cr * br - ci * bi; TAB[T_BBI + (size_t)gp * S5I + i] = cr * bi + ci * br; }
        }
    }
    {
        bf16_t* SW = (bf16_t*)(ws + WS_SGUW);
        for (int i = (F.bid * NTHR + F.tid); i < 2 * 8 * 128 * 128; i += F.G * NTHR) { const int t = (i >> 7) & 127, s = i & 127; SW[i] = f2bf(s <= t ? GIN(15)[i] : 0.f); }
    }
}

typedef short v4i16_t __attribute__((ext_vector_type(4)));
constexpr int SG_VSTR = 576, SG_WSTR = 272, SG_WOFF = 128 * SG_VSTR, SG_ROFF = SG_WOFF + 128 * SG_WSTR;
static_assert(SG_ROFF + 1024 <= RING_BYTES, "sgu LDS");
__device__ __forceinline__ void sgu_phase_mfma(Frame& F, int j) {
    const bf16_t* UZ = (const bf16_t*)(F.ws + WS_B0); const bf16_t* VR = (const bf16_t*)(F.ws + WS_B1); const float* SSV = (const float*)(F.ws + WS_SSV);
    const bf16_t* SW = (const bf16_t*)(F.ws + WS_SGUW) + (size_t)j * 8 * 128 * 128; bf16_t* A2 = (bf16_t*)(F.ws + WS_A2);
    const float* gn = GIN(14) + (size_t)j * E_; const float* bsv = GIN(16) + (size_t)j * 8 * 128;
    LAS unsigned char* lds = F.lds; LAS float* rsl = (LAS float*)(lds + SG_ROFF);
    const int tid = F.tid, lane = F.lane, wid = F.wave, c = lane & 31, hh = lane >> 5;
    const bool same_g = (F.G & 7) == 0; int gld = -1, cur = 0;
    u32x4 vr[8];
    { const int un = F.bid; if (un < 128 * 8) { const int rbase = (un >> 3) * 128, g = un & 7;
#pragma unroll
        for (int i = 0; i < 8; ++i) { const int chn = tid + NTHR * i; vr[i] = *(const u32x4*)(VR + (size_t)(rbase + (chn >> 5)) * E_ + 256 * g + 8 * (chn & 31)); }
        __syncthreads();
        if (tid < 128) { const float* p = SSV + (size_t)(rbase + tid) * 32; float sq = 0.f;
#pragma unroll
            for (int k = 0; k < 8; ++k) { const f32x4 v = *((const f32x4*)p + k); sq += (v[0] + v[1]) + (v[2] + v[3]); }
            rsl[tid] = __builtin_amdgcn_rsqf(sq * (1.f / E_) + EPS); } } }
    for (int un = F.bid; un < 128 * 8; un += F.G) {
        const int ch = un >> 3, g = un & 7, rbase = ch * 128; const int nun = un + F.G < 128 * 8 ? un + F.G : un, nrb = (nun >> 3) * 128, ng = nun & 7;
        asm volatile("s_waitcnt vmcnt(0)" ::: "memory");
        __syncthreads();
        if (!same_g || gld != g) { gld = g;
#pragma unroll
            for (int i = 0; i < 4; ++i) { const int chn = tid + NTHR * i, row = chn >> 4, c16 = chn & 15;
                *(LAS u32x4*)(lds + SG_WOFF + row * SG_WSTR + c16 * 16) = *(const u32x4*)(SW + (size_t)g * 128 * 128 + row * 128 + c16 * 8); } }
#pragma unroll
        for (int i = 0; i < 8; ++i) { const int chn = tid + NTHR * i, sr = chn >> 5, c8 = chn & 31; float v[8]; unpack8(vr[i], v);
            const float r = rsl[cur * 128 + sr]; const f32x4 g0 = *(const f32x4*)(gn + 256 * g + 8 * c8), g1 = *(const f32x4*)(gn + 256 * g + 8 * c8 + 4); f32x4 a, b2;
#pragma unroll
            for (int e = 0; e < 4; ++e) { a[e] = v[e] * r * g0[e]; b2[e] = v[4 + e] * r * g1[e]; }
            *(LAS u32x4*)(lds + sr * SG_VSTR + c8 * 16) = pack8(a, b2); }
#pragma unroll
        for (int i = 0; i < 8; ++i) { const int chn = tid + NTHR * i; vr[i] = *(const u32x4*)(VR + (size_t)(nrb + (chn >> 5)) * E_ + 256 * ng + 8 * (chn & 31)); }
        if (tid < 128) { const float* p = SSV + (size_t)(nrb + tid) * 32; float sq = 0.f;
#pragma unroll
            for (int k = 0; k < 8; ++k) { const f32x4 v = *((const f32x4*)p + k); sq += (v[0] + v[1]) + (v[2] + v[3]); }
            rsl[(cur ^ 1) * 128 + tid] = __builtin_amdgcn_rsqf(sq * (1.f / E_) + EPS); }
        u32x2 uzr[4][4];
#pragma unroll
        for (int ti = 0; ti < 4; ++ti)
#pragma unroll
            for (int g4 = 0; g4 < 4; ++g4) uzr[ti][g4] = *(const u32x2*)(UZ + (size_t)(rbase + 32 * ti + c) * E_ + 256 * g + 32 * wid + 8 * g4 + 4 * hh);
        __syncthreads();
        f32x16 acc[4];
#pragma unroll
        for (int ti = 0; ti < 4; ++ti) acc[ti] = (f32x16){};
        const LAS unsigned char* abase = lds + (8 * hh + ((lane & 15) >> 2)) * SG_VSTR + (32 * wid + 16 * ((lane >> 4) & 1) + 4 * (lane & 3)) * 2;
#pragma unroll
        for (int s2 = 0; s2 < 8; ++s2) {
            const v4i16_t lo = __builtin_amdgcn_ds_read_tr16_b64_v4i16((LAS v4i16_t*)(abase + (16 * s2) * SG_VSTR));
            const v4i16_t hi = __builtin_amdgcn_ds_read_tr16_b64_v4i16((LAS v4i16_t*)(abase + (16 * s2 + 4) * SG_VSTR));
            const bf16x8 a = (bf16x8){lo[0], lo[1], lo[2], lo[3], hi[0], hi[1], hi[2], hi[3]};
#pragma unroll
            for (int ti = s2 >> 1; ti < 4; ++ti) { const bf16x8 b = *(const LAS bf16x8*)(lds + SG_WOFF + (32 * ti + c) * SG_WSTR + (16 * s2 + 8 * hh) * 2);
                acc[ti] = __builtin_amdgcn_mfma_f32_32x32x16_bf16(a, b, acc[ti], 0, 0, 0); }
        }
#pragma unroll
        for (int ti = 0; ti < 4; ++ti) { const int t = 32 * ti + c; const size_t row = (size_t)(rbase + t); const float bias = bsv[g * 128 + t];
#pragma unroll
            for (int g4 = 0; g4 < 4; ++g4) { const int d = 256 * g + 32 * wid + 8 * g4 + 4 * hh; const u32x2 uz = uzr[ti][g4];
                u32x2 w; w.x = pk2(bflo(uz.x) * (acc[ti][4 * g4] + bias), bfhi(uz.x) * (acc[ti][4 * g4 + 1] + bias)); w.y = pk2(bflo(uz.y) * (acc[ti][4 * g4 + 2] + bias), bfhi(uz.y) * (acc[ti][4 * g4 + 3] + bias));
                *(u32x2*)(A2 + row * KOUT + d) = w; } }
        cur ^= 1;
    }
}

__device__ __forceinline__ void sgu_sample_phase(Frame& F, int j) {
    const bf16_t* UZ = (const bf16_t*)(F.ws + WS_B0); const bf16_t* VR = (const bf16_t*)(F.ws + WS_B1); const float* SSV = (const float*)(F.ws + WS_SSV);
    const bf16_t* SW = (const bf16_t*)(F.ws + WS_SGUW) + (size_t)j * 8 * 128 * 128; bf16_t* A2 = (bf16_t*)(F.ws + WS_A2);
    const float* gn = GIN(14) + (size_t)j * E_; const float* bsv = GIN(16) + (size_t)j * 8 * 128; float* cvout = F.out + O_CV + (size_t)j * SBT * SSEQ * E_;
    const int gw = F.bid * NWAVES + F.wave, NGW = F.G * NWAVES, lane = F.lane;
    for (int task = gw; task < SBT * 8; task += NGW) {
        const int b = task >> 3, g = task & 7; const size_t r0 = (size_t)MP + b * SSEQ; const int ch = 256 * g + 4 * lane;
        float rs[SSEQ];
#pragma unroll
        for (int t = 0; t < SSEQ; ++t) { float v = lane < 32 ? SSV[(r0 + t) * 32 + lane] : 0.f; v = wave_sum(v); rs[t] = __builtin_amdgcn_rsqf(v * (1.f / E_) + EPS); }
        const f32x4 g4 = *(const f32x4*)(gn + ch);
        f32x4 vn[SSEQ];
#pragma unroll
        for (int t = 0; t < SSEQ; ++t) { const u32x2 w = *(const u32x2*)(VR + (r0 + t) * E_ + ch); const f32x4 v = (f32x4){bflo(w.x), bfhi(w.x), bflo(w.y), bfhi(w.y)}; vn[t] = v * rs[t] * g4;
            *(f32x4*)(cvout + (size_t)(b * SSEQ + t) * E_ + ch) = vn[t];
            u32x2 q; q.x = pk2(vn[t][0], vn[t][1]); q.y = pk2(vn[t][2], vn[t][3]); vn[t] = (f32x4){bflo(q.x), bfhi(q.x), bflo(q.y), bfhi(q.y)}; }
#pragma unroll
        for (int t = 0; t < SSEQ; ++t) { f32x4 a = {0.f, 0.f, 0.f, 0.f};
#pragma unroll
            for (int sq = 0; sq <= t; ++sq) a += vn[sq] * bf2f(SW[(size_t)g * 128 * 128 + t * 128 + sq]);
            a += bsv[g * 128 + t];
            const u32x2 uz = *(const u32x2*)(UZ + (r0 + t) * E_ + ch);
            u32x2 w; w.x = pk2(bflo(uz.x) * a[0], bfhi(uz.x) * a[1]); w.y = pk2(bflo(uz.y) * a[2], bfhi(uz.y) * a[3]);
            *(u32x2*)(A2 + (r0 + t) * KOUT + ch) = w; }
    }
}

__device__ __forceinline__ void conv_phase(Frame& F) {
    const bf16_t* P = (const bf16_t*)(F.ws + WS_B0); const bf16_t* G = (const bf16_t*)(F.ws + WS_B1); bf16_t* A2 = (bf16_t*)(F.ws + WS_A2);
    const float* cw = GIN(18); const float* st = GIN(5);
    constexpr int NFIX = (MP / 64) * 256, NSMP = (MS / 32) * 256;
    for (int i = F.bid * NTHR + F.tid; i < NFIX + NSMP; i += F.G * NTHR) {
        const bool fix = i < NFIX; const int j = fix ? i : i - NFIX;
        const int c0 = (j & 255) * 8, r0 = fix ? (j >> 8) * 64 : MP + (j >> 8) * 32, nr = fix ? 2 : 32;
        float w0[8], w1[8], w2[8];
#pragma unroll
        for (int e = 0; e < 8; ++e) { w0[e] = cw[c0 + e]; w1[e] = cw[E_ + c0 + e]; w2[e] = cw[2 * E_ + c0 + e]; }
        float x1[8], x2[8];
#pragma unroll
        for (int e = 0; e < 8; ++e) { x1[e] = 0.f; x2[e] = 0.f; }
        if (fix && (r0 & (PSEQ - 1)) != 0) { unpack8(*(const u32x4*)(P + (size_t)(r0 - 1) * E_ + c0), x1); unpack8(*(const u32x4*)(P + (size_t)(r0 - 2) * E_ + c0), x2); }
#pragma unroll 2
        for (int rr = 0; rr < nr; ++rr) {
            const int row = r0 + rr;
            if (row >= MP && ((row - MP) & 3) == 0) { const float* buf = st + (size_t)((row - MP) >> 2) * 2 * E_ + c0;
                for (int e = 0; e < 8; ++e) { x2[e] = buf[e]; x1[e] = buf[E_ + e]; } }
            float x0[8], gg[8]; unpack8(*(const u32x4*)(P + (size_t)row * E_ + c0), x0); unpack8(*(const u32x4*)(G + (size_t)row * E_ + c0), gg);
            f32x4 o0, o1;
#pragma unroll
            for (int e = 0; e < 8; ++e) { const float y = w0[e] * x2[e] + w1[e] * x1[e] + w2[e] * x0[e]; const float r = y * gg[e]; if (e < 4) o0[e] = r; else o1[e - 4] = r; x2[e] = x1[e]; x1[e] = x0[e]; }
            *(u32x4*)(A2 + (size_t)row * KOUT + c0) = pack8(o0, o1);
        }
    }
}

#if XHALF_SHFL
__device__ __forceinline__ void xhalf(float v, float& lo, float& hi) { const int l_ = threadIdx.x & 31; lo = __shfl(v, l_); hi = __shfl(v, l_ + 32); }
#else
__device__ __forceinline__ void xhalf(float v, float& lo, float& hi) { auto rr = __builtin_amdgcn_permlane32_swap(__float_as_uint(v), __float_as_uint(v), false, false); lo = __uint_as_float(rr[0]); hi = __uint_as_float(rr[1]);
 }
#endif
__device__ __forceinline__ void cmuladd(float& xr, float& xi, float ar, float ai, float pr, float pi) { float t = fmaf(-ai, pi, xr); asm("" : "+v"(t)); xr = fmaf(ar, pr, t); xi = fmaf(ar, pi, fmaf(ai, pr, xi)); }
constexpr int S5_HSTR = 272, S5_UOFF = 32 * S5_HSTR, S5_OOFF = S5_UOFF + 1024, S5_HT = S5_OOFF + 4096;
__device__ __forceinline__ void s5_prompt_mfma(Frame& F) {
    const bf16_t* U = (const bf16_t*)(F.ws + WS_B0); bf16_t* GBo = (bf16_t*)(F.ws + WS_GB); const float* TAB = (const float*)(F.ws + WS_TAB);
    const float* cre = GIN(25); const float* cim = GIN(26); const float* dsk = GIN(27);
    const int lane = F.lane, wid = F.wave, c = lane & 31, hh = lane >> 5, col = lane & 15, fq = lane >> 4;
    LAS unsigned char* ht = F.lds + wid * S5_HT;
    for (int task = F.bid * NWAVES + wid; task < PB * S5G; task += F.G * NWAVES) {
        const int b = task >> 7, g = task & 127;
        bf16x8 bfr[2], bfi[2];
#pragma unroll
        for (int st = 0; st < 2; ++st) { const int gp = g * S5P + 32 * st + c;
            const float* pr = TAB + T_BBR + (size_t)gp * 16 + 8 * hh; const float* pi = TAB + T_BBI + (size_t)gp * 16 + 8 * hh;
            bfr[st] = __builtin_bit_cast(bf16x8, pack8(*(const f32x4*)pr, *(const f32x4*)(pr + 4))); bfi[st] = __builtin_bit_cast(bf16x8, pack8(*(const f32x4*)pi, *(const f32x4*)(pi + 4))); }
        const float a1r = TAB[T_AR + g * S5P + lane], a1i = TAB[T_AI + g * S5P + lane];
        bf16x8 cf[4];
#pragma unroll
        for (int s4 = 0; s4 < 4; ++s4) { const size_t o = ((size_t)g * 16 + col) * S5P + 16 * s4 + 4 * fq; const f32x4 cr4 = *(const f32x4*)(cre + o), ci4 = *(const f32x4*)(cim + o);
            u32x4 w; w.x = pk2(cr4[0], -ci4[0]); w.y = pk2(cr4[1], -ci4[1]); w.z = pk2(cr4[2], -ci4[2]); w.w = pk2(cr4[3], -ci4[3]); cf[s4] = __builtin_bit_cast(bf16x8, w); }
        const f32x4 d4 = *(const f32x4*)(dsk + 16 * g + 4 * fq);
        float er = 0.f, ei = 0.f;
        const bf16_t* up = U + ((size_t)b * PSEQ + c) * E_ + 16 * g + 8 * hh;
        bf16x8 ub[4];
#pragma unroll
        for (int q = 0; q < 4; ++q) ub[q] = *(const GAS bf16x8*)(up + (size_t)q * 32 * E_);
        for (int tg = 0; tg < PSEQ / 128; ++tg) {
          bf16x8 nb[4];
#pragma unroll
          for (int q = 0; q < 4; ++q) nb[q] = *(const GAS bf16x8*)(up + (size_t)(4 * (tg + 1 < PSEQ / 128 ? tg + 1 : tg) + q) * 32 * E_);
#pragma unroll
          for (int q = 0; q < 4; ++q) {
            const int ti = 4 * tg + q; const bf16x8 ua = ub[q];
            *(LAS bf16x8*)(ht + S5_UOFF + c * 32 + hh * 16) = ua;
            {
                const f32x16 x0r = __builtin_amdgcn_mfma_f32_32x32x16_bf16(ua, bfr[0], (f32x16){}, 0, 0, 0);
                const f32x16 x1r = __builtin_amdgcn_mfma_f32_32x32x16_bf16(ua, bfr[1], (f32x16){}, 0, 0, 0);
                const f32x16 x0i = __builtin_amdgcn_mfma_f32_32x32x16_bf16(ua, bfi[0], (f32x16){}, 0, 0, 0);
                const f32x16 x1i = __builtin_amdgcn_mfma_f32_32x32x16_bf16(ua, bfi[1], (f32x16){}, 0, 0, 0);
#pragma unroll
                for (int k = 0; k < 4; ++k) {
                    float tr[8], tq[8];
#pragma unroll
                    for (int jj = 0; jj < 4; ++jj) {
                        auto sr = __builtin_amdgcn_permlane32_swap(__float_as_uint(x0r[4 * k + jj]), __float_as_uint(x1r[4 * k + jj]), false, false);
                        auto sq = __builtin_amdgcn_permlane32_swap(__float_as_uint(x0i[4 * k + jj]), __float_as_uint(x1i[4 * k + jj]), false, false);
                        tr[jj] = __uint_as_float(sr[0]); tr[4 + jj] = __uint_as_float(sr[1]); tq[jj] = __uint_as_float(sq[0]); tq[4 + jj] = __uint_as_float(sq[1]); }
#pragma unroll
                    for (int j = 0; j < 8; ++j) { float nr = tr[j], ni = tq[j]; cmuladd(nr, ni, a1r, a1i, er, ei); er = nr; ei = ni;
                        *(LAS unsigned*)(ht + (8 * k + j) * S5_HSTR + 4 * lane) = pk2(er, ei); }
                }
            }
            asm volatile("" ::: "memory");
#pragma unroll
            for (int tt = 0; tt < 2; ++tt) {
                f32x4 y = {0.f, 0.f, 0.f, 0.f};
#pragma unroll
                for (int s4 = 0; s4 < 4; ++s4) { const bf16x8 hb = *(const LAS bf16x8*)(ht + (16 * tt + col) * S5_HSTR + (32 * s4 + 8 * fq) * 2); y = __builtin_amdgcn_mfma_f32_16x16x32_bf16(cf[s4], hb, y, 0, 0, 0); }
                const size_t row = (size_t)b * PSEQ + 32 * ti + 16 * tt + col; const u32x2 uw = *(const LAS u32x2*)(ht + S5_UOFF + (16 * tt + col) * 32 + fq * 8);
                u32x2 w; w.x = pk2(gelu_tanh(y[0] + d4[0] * bflo(uw.x)), gelu_tanh(y[1] + d4[1] * bfhi(uw.x))); w.y = pk2(gelu_tanh(y[2] + d4[2] * bflo(uw.y)), gelu_tanh(y[3] + d4[3] * bfhi(uw.y)));
                *(LAS u32x2*)(ht + S5_OOFF + q * 1024 + (16 * tt + col) * 32 + fq * 8) = w;
            }
            asm volatile("" ::: "memory");
          }
#pragma unroll
          for (int q = 0; q < 4; ++q)
#pragma unroll
            for (int tt = 0; tt < 2; ++tt) *(GAS u32x2*)(GBo + ((size_t)b * PSEQ + 32 * (4 * tg + q) + 16 * tt + col) * E_ + 16 * g + 4 * fq) = *(const LAS u32x2*)(ht + S5_OOFF + q * 1024 + (16 * tt + col) * 32 + fq * 8);
          asm volatile("s_waitcnt vmcnt(0)" ::: "memory");
#pragma unroll
          for (int q = 0; q < 4; ++q) ub[q] = nb[q];
        }
        const size_t so = ((size_t)b * S5G + g) * S5P + lane;
        F.out[O_SRP + so] = er; F.out[O_SIP + so] = ei;
    }
}

__device__ __forceinline__ void s5_sample_mfma(Frame& F) {
    const bf16_t* U = (const bf16_t*)(F.ws + WS_B0); bf16_t* GBo = (bf16_t*)(F.ws + WS_GB); const float* TAB = (const float*)(F.ws + WS_TAB);
    const float* cre = GIN(25); const float* cim = GIN(26); const float* dsk = GIN(27); const float* h0re = GIN(6); const float* h0im = GIN(7);
    const int lane = F.lane, wid = F.wave, c = lane & 31, hh = lane >> 5, col = lane & 15, fq = lane >> 4;
    LAS unsigned char* ht = F.lds + wid * S5_HT;
    for (int task = F.bid * NWAVES + wid; task < S5G * (MS / 64); task += F.G * NWAVES) {
        const int g = task & (S5G - 1), tp = task >> 7;
        bf16x8 bfr[2], bfi[2];
#pragma unroll
        for (int st = 0; st < 2; ++st) { const int gp = g * S5P + 32 * st + c;
            const float* pr = TAB + T_BBR + (size_t)gp * 16 + 8 * hh; const float* pi = TAB + T_BBI + (size_t)gp * 16 + 8 * hh;
            bfr[st] = __builtin_bit_cast(bf16x8, pack8(*(const f32x4*)pr, *(const f32x4*)(pr + 4))); bfi[st] = __builtin_bit_cast(bf16x8, pack8(*(const f32x4*)pi, *(const f32x4*)(pi + 4))); }
        const float a1r = TAB[T_AR + g * S5P + lane], a1i = TAB[T_AI + g * S5P + lane];
        bf16x8 cf[4];
#pragma unroll
        for (int s4 = 0; s4 < 4; ++s4) { const size_t o = ((size_t)g * 16 + col) * S5P + 16 * s4 + 4 * fq; const f32x4 cr4 = *(const f32x4*)(cre + o), ci4 = *(const f32x4*)(cim + o);
            u32x4 w; w.x = pk2(cr4[0], -ci4[0]); w.y = pk2(cr4[1], -ci4[1]); w.z = pk2(cr4[2], -ci4[2]); w.w = pk2(cr4[3], -ci4[3]); cf[s4] = __builtin_bit_cast(bf16x8, w); }
        const f32x4 d4 = *(const f32x4*)(dsk + 16 * g + 4 * fq);
#pragma unroll 1
        for (int q = 0; q < 2; ++q) {
            const int tile = 2 * tp + q; const bf16x8 ua = *(const GAS bf16x8*)(U + ((size_t)MP + 32 * tile + c) * E_ + 16 * g + 8 * hh);
            float sr[8], sq[8];
#pragma unroll
            for (int rr = 0; rr < 8; ++rr) { const size_t so = ((size_t)(8 * tile + rr) * S5G + g) * S5P + lane; sr[rr] = *(const GAS float*)(h0re + so); sq[rr] = *(const GAS float*)(h0im + so); }
            *(LAS bf16x8*)(ht + S5_UOFF + c * 32 + hh * 16) = ua;
            {
                const f32x16 x0r = __builtin_amdgcn_mfma_f32_32x32x16_bf16(ua, bfr[0], (f32x16){}, 0, 0, 0);
                const f32x16 x1r = __builtin_amdgcn_mfma_f32_32x32x16_bf16(ua, bfr[1], (f32x16){}, 0, 0, 0);
                const f32x16 x0i = __builtin_amdgcn_mfma_f32_32x32x16_bf16(ua, bfi[0], (f32x16){}, 0, 0, 0);
                const f32x16 x1i = __builtin_amdgcn_mfma_f32_32x32x16_bf16(ua, bfi[1], (f32x16){}, 0, 0, 0);
#pragma unroll
                for (int k = 0; k < 4; ++k) {
                    float tr[8], tq[8];
#pragma unroll
                    for (int jj = 0; jj < 4; ++jj) {
                        auto s_r = __builtin_amdgcn_permlane32_swap(__float_as_uint(x0r[4 * k + jj]), __float_as_uint(x1r[4 * k + jj]), false, false);
                        auto s_q = __builtin_amdgcn_permlane32_swap(__float_as_uint(x0i[4 * k + jj]), __float_as_uint(x1i[4 * k + jj]), false, false);
                        tr[jj] = __uint_as_float(s_r[0]); tr[4 + jj] = __uint_as_float(s_r[1]); tq[jj] = __uint_as_float(s_q[0]); tq[4 + jj] = __uint_as_float(s_q[1]); }
#pragma unroll
                    for (int j = 0; j < 8; ++j) { const int rr = 2 * k + (j >> 2); float nr = tr[j], ni = tq[j]; cmuladd(nr, ni, a1r, a1i, sr[rr], sq[rr]); sr[rr] = nr; sq[rr] = ni;
                        *(LAS unsigned*)(ht + (8 * k + j) * S5_HSTR + 4 * lane) = pk2(nr, ni); }
                }
            }
            asm volatile("s_waitcnt vmcnt(0)" ::: "memory");
            u32x2 w[2];
#pragma unroll
            for (int tt = 0; tt < 2; ++tt) {
                f32x4 y = {0.f, 0.f, 0.f, 0.f};
#pragma unroll
                for (int s4 = 0; s4 < 4; ++s4) { const bf16x8 hb = *(const LAS bf16x8*)(ht + (16 * tt + col) * S5_HSTR + (32 * s4 + 8 * fq) * 2); y = __builtin_amdgcn_mfma_f32_16x16x32_bf16(cf[s4], hb, y, 0, 0, 0); }
                const u32x2 uw = *(const LAS u32x2*)(ht + S5_UOFF + (16 * tt + col) * 32 + fq * 8);
                w[tt].x = pk2(gelu_tanh(y[0] + d4[0] * bflo(uw.x)), gelu_tanh(y[1] + d4[1] * bfhi(uw.x))); w[tt].y = pk2(gelu_tanh(y[2] + d4[2] * bflo(uw.y)), gelu_tanh(y[3] + d4[3] * bfhi(uw.y)));
            }
            asm volatile("s_waitcnt lgkmcnt(0)" ::: "memory");
#pragma unroll
            for (int tt = 0; tt < 2; ++tt) *(GAS u32x2*)(GBo + ((size_t)MP + 32 * tile + 16 * tt + col) * E_ + 16 * g + 4 * fq) = w[tt];
#pragma unroll
            for (int rr = 0; rr < 8; ++rr) { const size_t so = ((size_t)(8 * tile + rr) * S5G + g) * S5P + lane; *(GAS float*)(F.out + O_SRS + so) = sr[rr]; *(GAS float*)(F.out + O_SIS + so) = sq[rr]; }
        }
        asm volatile("s_waitcnt vmcnt(0)" ::: "memory");
    }
}

constexpr int AK_STR = 272, AV_STR = 520, AV_OFF = 256 * AK_STR;
static_assert(AV_OFF + 128 * AV_STR <= RING_BYTES + 8192, "attention LDS");
__device__ __forceinline__ void attn_prompt_phase(Frame& F, int layer) {
    const bf16_t* QB = (const bf16_t*)(F.ws + WS_QB); const bf16_t* KBp = (const bf16_t*)(F.ws + WS_KB); const bf16_t* VTp = (const bf16_t*)(F.ws + WS_VT); bf16_t* A2 = (bf16_t*)(F.ws + WS_A2);
    const int tid = F.tid, lane = F.lane, wid = F.wave, c = lane & 31, hh = lane >> 5;
    LAS unsigned char* lds = F.lds;
    for (int un = F.bid; un < PB * NH * 8; un += F.G) {
        const int bh = un >> 3, qb = un & 7, b = bh >> 2, h = bh & 3;
        const bf16_t* Kg = KBp + (size_t)((layer * PB + b) * NH + h) * MEML * HD; const bf16_t* Vg = VTp + (size_t)((layer * PB + b) * NH + h) * MEML * HD;
        __syncthreads();
        { u32x4 kr[8], vr[8];
#pragma unroll
          for (int i = 0; i < 8; ++i) { const int chn = tid + NTHR * i; kr[i] = *(const u32x4*)(Kg + (chn >> 4) * HD + (chn & 15) * 8); vr[i] = *(const u32x4*)(Vg + (chn >> 5) * MEML + (chn & 31) * 8); }
#pragma unroll
          for (int i = 0; i < 8; ++i) { const int chn = tid + NTHR * i, row = chn >> 4, c16 = chn & 15; *(LAS u32x4*)(lds + row * AK_STR + c16 * 16) = kr[i]; }
#pragma unroll
          for (int i = 0; i < 8; ++i) { const int chn = tid + NTHR * i, row = chn >> 5, c16 = chn & 31; const u32x4 v = vr[i];
            LAS u32x2* p = (LAS u32x2*)(lds + AV_OFF + row * AV_STR + c16 * 16); u32x2 lo, hi; lo.x = v.x; lo.y = v.y; hi.x = v.z; hi.y = v.w; p[0] = lo; p[1] = hi; } }
        __syncthreads();
        const size_t qrow = (size_t)b * PSEQ + qb * 256 + wid * 32 + c;
        f32x16 S[8];
#pragma unroll
        for (int kt = 0; kt < 8; ++kt) S[kt] = (f32x16){};
#pragma unroll
        for (int s = 0; s < 8; ++s) {
            const bf16x8 qf = *(const bf16x8*)(QB + qrow * XA + h * HD + 16 * s + 8 * hh);
#pragma unroll
            for (int kt = 0; kt < 8; ++kt) { const bf16x8 kf = *(const LAS bf16x8*)(lds + (32 * kt + c) * AK_STR + (16 * s + 8 * hh) * 2); S[kt] = __builtin_amdgcn_mfma_f32_32x32x16_bf16(kf, qf, S[kt], 0, 0, 0); }
        }
        float mx = -3.0e38f;
#pragma unroll
        for (int kt = 0; kt < 8; ++kt)
#pragma unroll
            for (int r = 0; r < 16; ++r) mx = fmaxf(mx, S[kt][r]);
        mx = fmaxf(mx, __shfl_xor(mx, 32));
        float sum = 0.f; bf16x8 pf[8][2];
#pragma unroll
        for (int kt = 0; kt < 8; ++kt) {
            float p[16];
#pragma unroll
            for (int r = 0; r < 16; ++r) { p[r] = __expf(S[kt][r] - mx); sum += p[r]; }
#pragma unroll
            for (int s2 = 0; s2 < 2; ++s2) { u32x4 w; w.x = pk2(p[8 * s2], p[8 * s2 + 1]); w.y = pk2(p[8 * s2 + 2], p[8 * s2 + 3]); w.z = pk2(p[8 * s2 + 4], p[8 * s2 + 5]); w.w = pk2(p[8 * s2 + 6], p[8 * s2 + 7]);
                pf[kt][s2] = __builtin_bit_cast(bf16x8, w); }
        }
        sum += __shfl_xor(sum, 32);
        const float inv = 1.f / sum;
        bf16_t* orow = A2 + qrow * KOUT + E_ + h * HD;
#pragma unroll
        for (int dt = 0; dt < 4; ++dt) {
            f32x16 o = {};
#pragma unroll
            for (int kt = 0; kt < 8; ++kt)
#pragma unroll
                for (int s2 = 0; s2 < 2; ++s2) {
                    const LAS unsigned char* vb = lds + AV_OFF + (32 * dt + c) * AV_STR + (32 * kt + 16 * s2 + 4 * hh) * 2;
                    const u32x2 lo = *(const LAS u32x2*)vb, hi = *(const LAS u32x2*)(vb + 16);
                    u32x4 w; w.x = lo.x; w.y = lo.y; w.z = hi.x; w.w = hi.y;
                    o = __builtin_amdgcn_mfma_f32_32x32x16_bf16(__builtin_bit_cast(bf16x8, w), pf[kt][s2], o, 0, 0, 0);
                }
#pragma unroll
            for (int g4 = 0; g4 < 4; ++g4) { u32x2 w; w.x = pk2(o[4 * g4] * inv, o[4 * g4 + 1] * inv); w.y = pk2(o[4 * g4 + 2] * inv, o[4 * g4 + 3] * inv);
                *(u32x2*)(orow + 32 * dt + 8 * g4 + 4 * hh) = w; }
        }
    }
}

__device__ __forceinline__ void attn_sample_phase(Frame& F, int layer) {
    const bf16_t* QB = (const bf16_t*)(F.ws + WS_QB); bf16_t* A2 = (bf16_t*)(F.ws + WS_A2);
    const float* CK = GIN(3) + (size_t)layer * SBT * MEML * XA; const float* CV = GIN(4) + (size_t)layer * SBT * MEML * XA;
    LAS float* sl = (LAS float*)F.lds;
    LAS float* pt = (LAS float*)(F.lds + 4096);
    LAS float* ol = (LAS float*)(F.lds + 8192);
    const int tid = F.tid, lane = F.lane, wid = F.wave, par = lane >> 5, d4 = lane & 31;
    const size_t lane_off = ((size_t)(32 * wid + par) * NH) * HD + 4 * d4;
    const bool b4 = (lane & 16) != 0, b3 = (lane & 8) != 0;
#define AS_Q(q4, b_, h_) do { _Pragma("unroll") for (int qi = 0; qi < 4; ++qi) { const u32x2 w = *(const u32x2*)(QB + (size_t)(MP + (b_) * 4 + qi) * XA + (h_) * HD + 4 * d4); q4[qi] = (f32x4){bflo(w.x), bfhi(w.x), bflo(w.y), bfhi(w.y)}; } } while (0)
#define AS_LOADROWS(dst, base, b_, h_) do { const size_t o_ = (size_t)(b_) * MEML * XA + (size_t)(h_) * HD + lane_off; _Pragma("unroll") for (int j = 0; j < 16; ++j) dst[j] = *(const f32x4*)((base) + o_ + (size_t)j * 2 * XA); } while (0)
#define AS_SCORES(q4) do { _Pragma("unroll") for (int j = 0; j < 16; ++j) { float v[4]; \
            _Pragma("unroll") for (int qi = 0; qi < 4; ++qi) v[qi] = (kr[j][0] * q4[qi][0] + kr[j][1] * q4[qi][1]) + (kr[j][2] * q4[qi][2] + kr[j][3] * q4[qi][3]); \
            const float w0 = (b4 ? v[2] : v[0]) + __shfl_xor(b4 ? v[0] : v[2], 16), w1 = (b4 ? v[3] : v[1]) + __shfl_xor(b4 ? v[1] : v[3], 16); \
            float z = (b3 ? w1 : w0) + __shfl_xor(b3 ? w0 : w1, 8); \
            z += __shfl_xor(z, 4); z += __shfl_xor(z, 2); z += __shfl_xor(z, 1); \
            if ((lane & 7) == 0) sl[(2 * (int)b4 + (int)b3) * 256 + 32 * wid + 2 * j + par] = z; } } while (0)
#define AS_SOFTMAX() do { if (wid < 4) { float v[4], mx = -3.0e38f; \
            _Pragma("unroll") for (int j = 0; j < 4; ++j) { v[j] = sl[wid * 256 + lane + 64 * j]; mx = fmaxf(mx, v[j]); } \
            mx = wave_max(mx); float sm = 0.f; \
            _Pragma("unroll") for (int j = 0; j < 4; ++j) { v[j] = __expf(v[j] - mx); sm += v[j]; } \
            sm = wave_sum(sm); const float inv = 1.f / sm; \
            _Pragma("unroll") for (int j = 0; j < 4; ++j) pt[(lane + 64 * j) * 4 + wid] = v[j] * inv; } } while (0)
#define AS_PV() do { f32x4 o[4]; _Pragma("unroll") for (int qi = 0; qi < 4; ++qi) o[qi] = (f32x4){0.f, 0.f, 0.f, 0.f}; \
            _Pragma("unroll") for (int j = 0; j < 16; ++j) { const f32x4 p = *(const LAS f32x4*)(pt + (32 * wid + 2 * j + par) * 4); \
                _Pragma("unroll") for (int qi = 0; qi < 4; ++qi) o[qi] += vr[j] * p[qi]; } \
            _Pragma("unroll") for (int qi = 0; qi < 4; ++qi) { _Pragma("unroll") for (int e = 0; e < 4; ++e) o[qi][e] += __shfl_xor(o[qi][e], 32); \
                if (par == 0) *(LAS f32x4*)(ol + (wid * 4 + qi) * 128 + 4 * d4) = o[qi]; } } while (0)
#define AS_OUT(b_, h_) do { const int qi = tid >> 7, d = tid & 127; float acc = 0.f; _Pragma("unroll") for (int w = 0; w < 8; ++w) acc += ol[(w * 4 + qi) * 128 + d]; \
            A2[(size_t)(MP + (b_) * 4 + qi) * KOUT + E_ + (h_) * HD + d] = f2bf(acc); } while (0)
    for (int un = F.bid; un < SBT * NH; un += 2 * F.G) {
        const int unb = un + F.G < SBT * NH ? un + F.G : un; const int ba = un >> 2, ha = un & 3, bb = unb >> 2, hb = unb & 3;
        asm volatile("s_waitcnt vmcnt(0)" ::: "memory");
        f32x4 kr[16], vr[16], q4[4];
        AS_LOADROWS(kr, CK, ba, ha); AS_LOADROWS(vr, CV, ba, ha); AS_Q(q4, ba, ha);
        __syncthreads();
        AS_SCORES(q4);
        AS_LOADROWS(kr, CK, bb, hb);
        __syncthreads();
        AS_SOFTMAX();
        __syncthreads();
        AS_PV();
        __syncthreads();
        AS_Q(q4, bb, hb);
        AS_OUT(ba, ha);
        AS_LOADROWS(vr, CV, bb, hb);
        asm volatile("s_waitcnt vmcnt(16)" ::: "memory");
        AS_SCORES(q4);
        __syncthreads();
        AS_SOFTMAX();
        __syncthreads();
        AS_PV();
        __syncthreads();
        AS_OUT(bb, hb);
    }
#undef AS_Q
#undef AS_LOADROWS
#undef AS_SCORES
#undef AS_SOFTMAX
#undef AS_PV
#undef AS_OUT
}

constexpr int NK_OUT = 5, NK_OUT_LAST = 10, NK_GLU = 8;
__device__ __forceinline__ void fixup_out_rows(Frame& F, const float* basef  , int vb, int nvb  , int nk  ) {
    for (int r = vb * NWAVES + F.wave; r < MS; r += nvb * NWAVES) {
        const int lane = F.lane; const float* slab = (const float*)(F.ws + WS_SLAB);
        bf16_t* XB = (bf16_t*)(F.ws + WS_XB) + (size_t)(MP + r) * DM; float ss = 0.f;
#pragma unroll
        for (int j = 0; j < 4; ++j) { f32x4 v;
            if (basef) v = *((const f32x4*)(basef + (size_t)r * DM) + lane + 64 * j);
            else { const u32x2 w = *((const u32x2*)XB + lane + 64 * j); v = (f32x4){bflo(w.x), bfhi(w.x), bflo(w.y), bfhi(w.y)}; }
            for (int ks = 0; ks < nk; ++ks) v += *((const f32x4*)(slab + ((size_t)ks * MS + r) * DM) + lane + 64 * j);
            u32x2 w; w.x = pk2(v[0], v[1]); w.y = pk2(v[2], v[3]); *((u32x2*)XB + lane + 64 * j) = w;
            ss += (v[0] * v[0] + v[1] * v[1]) + (v[2] * v[2] + v[3] * v[3]); }
        asm volatile("s_waitcnt vmcnt(0)" ::: "memory");
        ss = wave_sum(ss);
        if (lane < 16) ((float*)(F.ws + WS_SSX))[(size_t)(MP + r) * 16 + lane] = lane == 0 ? ss : 0.f;
    }
}
__device__ __forceinline__ void fixup_glu_rows(Frame& F) {
    if (F.wave < 2) for (int r = F.bid * 2 + F.wave; r < MS; r += F.G * 2) {
        const int lane = F.lane; const float* slab = (const float*)(F.ws + WS_SLAB); const float* bias = GIN(29);
        const bf16_t* GBp = (const bf16_t*)(F.ws + WS_GB) + (size_t)(MP + r) * E_; const bf16_t* SZ = (const bf16_t*)(F.ws + WS_B1) + (size_t)(MP + r) * E_; bf16_t* A2 = (bf16_t*)(F.ws + WS_A2) + (size_t)(MP + r) * KOUT;
#pragma unroll
        for (int j = 0; j < 4; ++j) { const int c0 = 8 * (lane + 64 * j); f32x4 t0 = *(const f32x4*)(bias + c0), t1 = *(const f32x4*)(bias + c0 + 4);
#pragma unroll
            for (int ks = 0; ks < NK_GLU; ++ks) { const float* sp = slab + ((size_t)ks * MS + r) * E_ + c0; t0 += *(const f32x4*)sp; t1 += *(const f32x4*)(sp + 4); }
            float gv[8], sz[8]; unpack8(*(const u32x4*)(GBp + c0), gv); unpack8(*(const u32x4*)(SZ + c0), sz); f32x4 o0, o1;
#pragma unroll
            for (int e = 0; e < 4; ++e) { o0[e] = gv[e] * sigmoidf_(t0[e]) * sz[e]; o1[e] = gv[4 + e] * sigmoidf_(t1[e]) * sz[4 + e]; }
            *(u32x4*)(A2 + c0) = pack8(o0, o1); }
    }
}
__device__ __forceinline__ void counter_signal(unsigned* cnt) {
    asm volatile("s_waitcnt vmcnt(0)" ::: "memory"); __syncthreads();
    if (threadIdx.x == 0) { __builtin_amdgcn_fence(__ATOMIC_RELEASE, "agent"); asm volatile("s_waitcnt vmcnt(0)" ::: "memory"); __hip_atomic_fetch_add(cnt, 1u, __ATOMIC_RELAXED, __HIP_MEMORY_SCOPE_AGENT); }
}
__device__ __forceinline__ void counter_wait(unsigned* cnt, unsigned want) {
    if (threadIdx.x == 0) { unsigned sp = 0; while (__hip_atomic_load(cnt, __ATOMIC_RELAXED, __HIP_MEMORY_SCOPE_AGENT) < want) { __builtin_amdgcn_s_sleep(2); if (++sp > (1u << 22)) break; }
        __builtin_amdgcn_fence(__ATOMIC_ACQUIRE, "agent"); asm volatile("s_waitcnt vmcnt(0)" ::: "memory"); }
    __syncthreads();
}

__device__ __forceinline__ void final_row(Frame& F, int row) {
    const bf16_t* XBp = (const bf16_t*)(F.ws + WS_XB); const float* SSX = (const float*)(F.ws + WS_SSX); const float* fg = GIN(9); const int lane = F.lane;
    float s = lane < 16 ? SSX[(size_t)row * 16 + lane] : 0.f; s = wave_sum(s);
    const float r = __builtin_amdgcn_rsqf(s * (1.f / DM) + EPS);
    float* o = row < MP ? F.out + O_YP + (size_t)row * DM : F.out + O_YS + (size_t)(row - MP) * DM;
#pragma unroll
    for (int j = 0; j < 4; ++j) { const u32x2 w = *((const u32x2*)(XBp + (size_t)row * DM) + lane + 64 * j); const f32x4 v = (f32x4){bflo(w.x), bfhi(w.x), bflo(w.y), bfhi(w.y)}; const f32x4 gq = *((const f32x4*)fg + lane + 64 * j); *((f32x4*)o + lane + 64 * j) = v * r * gq; }
}
__device__ __forceinline__ void final_phase(Frame& F) {
    asm volatile("s_waitcnt vmcnt(0)" ::: "memory"); for (int r = F.bid * NWAVES + F.wave; r < MS; r += F.G * NWAVES) final_row(F, MP + r);
}

#define XB_TMO      128
#define XB_XCNT(j)  (256  + 64 * (j))
#define XB_XSUB(j)  (1280 + 64 * (j))
#define XB_XGEN(j)  (2304 + 64 * (j))
#define XB_TOP      3328
#define XB_TOPGEN   3392
#define XCD_BAR_WORDS 3456
#define XB_SPIN_CAP (1u << 20)
__device__ __forceinline__ unsigned xb_ld(unsigned* p)              { return __hip_atomic_load(p, __ATOMIC_RELAXED, __HIP_MEMORY_SCOPE_AGENT); }
__device__ __forceinline__ unsigned xb_add(unsigned* p, unsigned v) { return __hip_atomic_fetch_add(p, v, __ATOMIC_RELAXED, __HIP_MEMORY_SCOPE_AGENT); }
__device__ __forceinline__ unsigned xb_xcc_id() { return (unsigned)__builtin_amdgcn_s_getreg((3 << 11) | 20) & 0xFu; }
#define XB_SPIN(cond, bar) do { unsigned _sp = 0; while (cond) { __builtin_amdgcn_s_sleep(1); \
    if ((++_sp & 255u) == 0u) { if (xb_ld(&(bar)[XB_TMO])) break; if (_sp > XB_SPIN_CAP) { atomicAdd(&(bar)[XB_TMO], 1u); break; } } } } while (0)
struct XcdBarrier { unsigned* bar; unsigned x; volatile LAS unsigned* st; };
__device__ __forceinline__ XcdBarrier xcd_barrier_post(unsigned* bar, volatile LAS unsigned* st) {
    XcdBarrier b; b.bar = bar; b.x = xb_xcc_id(); b.st = st;
    if (threadIdx.x == 0) (void)xb_add(&bar[XB_XCNT(b.x)], 1u);
    return b;
}
__device__ __forceinline__ void xcd_barrier_complete(unsigned* bar, unsigned x, unsigned& nloc, unsigned& nx) {
    const unsigned G = gridDim.x * gridDim.y * gridDim.z;
    unsigned sum, cnt, mine, sp = 0u;
    for (;;) {
        sum = 0u; cnt = 0u; mine = 0u;
#pragma unroll
        for (unsigned j = 0; j < 16; ++j) { const unsigned c = xb_ld(&bar[XB_XCNT(j)]); sum += c; cnt += (c > 0u) ? 1u : 0u; mine = (j == x) ? c : mine; }
        if (sum == G) break;
        __builtin_amdgcn_s_sleep(1);
        if ((++sp & 255u) == 0u) { if (xb_ld(&bar[XB_TMO])) break; if (sp > XB_SPIN_CAP) { atomicAdd(&bar[XB_TMO], 1u); break; } }
    }
    nloc = mine > 0u ? mine : 1u; nx = cnt > 0u ? cnt : 1u;
}
__device__ __forceinline__ void xcd_barrier(const XcdBarrier& b) {
    asm volatile("s_waitcnt vmcnt(0)" ::: "memory");
    __syncthreads();
    if (threadIdx.x == 0) {
        unsigned* bar = b.bar;
        __builtin_amdgcn_s_waitcnt(0);
        unsigned nloc = b.st[0], nx = b.st[1];
        if (nloc == 0u) { xcd_barrier_complete(bar, b.x, nloc, nx); b.st[0] = nloc; b.st[1] = nx; }
        const unsigned old = xb_add(&bar[XB_XSUB(b.x)], 1u);
        const unsigned gen = old / nloc;
        if (old + 1u == (gen + 1u) * nloc) {
            __builtin_amdgcn_fence(__ATOMIC_RELEASE, "agent");
            asm volatile("s_waitcnt vmcnt(0)" ::: "memory");
            const unsigned og = xb_add(&bar[XB_TOP], 1u);
            const unsigned tg = og / nx;
            if (og + 1u == (tg + 1u) * nx) xb_add(&bar[XB_TOPGEN], 1u);
            else XB_SPIN(xb_ld(&bar[XB_TOPGEN]) == tg, bar);
            __builtin_amdgcn_fence(__ATOMIC_ACQUIRE, "agent");
            xb_add(&bar[XB_XGEN(b.x)], 1u);
            asm volatile("s_waitcnt vmcnt(0)" ::: "memory");
        } else {
            XB_SPIN(xb_ld(&bar[XB_XGEN(b.x)]) == gen, bar);
            __builtin_amdgcn_fence(__ATOMIC_ACQUIRE, "agent");
            asm volatile("s_waitcnt vmcnt(0)" ::: "memory");
        }
    }
    __syncthreads();
}

__device__ __forceinline__ void stagger(int bid) {
#if STAGGER_TICKS
    const int grp = (bid >> 3) & 3;
    if (grp) { const unsigned long long t0 = __builtin_amdgcn_s_memrealtime(); while (__builtin_amdgcn_s_memrealtime() - t0 < (unsigned long long)(grp * STAGGER_TICKS)) __builtin_amdgcn_s_sleep(2); }
#endif
}
constexpr int NPHASE = 15;
__global__ void __launch_bounds__(NTHR, 2) fwd_kernel(Args args) {
    extern __shared__ __attribute__((aligned(16))) unsigned char lds_raw[];
    Frame F; F.lds = (LAS unsigned char*)lds_raw; F.G = gridDim.x; F.bid = blockIdx.x;
    F.in = args.in; F.out = (float*)(GAS float*)args.out; F.ws = (unsigned char*)(GAS unsigned char*)args.ws;
    unsigned char* ws = F.ws;
#define REFRESH() do { int t_ = threadIdx.x; asm volatile("" : "+v"(t_)); F.tid = t_; F.lane = t_ & 63; F.wave = __builtin_amdgcn_readfirstlane(t_ >> 6); \
        GAS unsigned char* wsg_ = (GAS unsigned char*)args.ws; asm volatile("" : "+s"(wsg_)); ws = (unsigned char*)wsg_; F.ws = ws; } while (0)
    const int lo = args.ph_lo, hi = args.ph_hi;
#if MK_ONE_LAUNCH
    cg::grid_group grid = cg::this_grid();
    if (lo < 0) grid.sync();
    { volatile LAS unsigned* st0 = (volatile LAS unsigned*)(F.lds + LDS_BYTES - 64); if (threadIdx.x < 16) st0[threadIdx.x] = 0u; }
    __syncthreads();
    const XcdBarrier xbar = xcd_barrier_post((unsigned*)(args.ws + WS_CTL), (volatile LAS unsigned*)(F.lds + LDS_BYTES - 64));
#define SEAM(k) do { if (lo <= (k) && (k) + 1 < hi) xcd_barrier(xbar); } while (0)
#else
#define SEAM(k) do { } while (0)
#endif
#ifndef PHASE_MASK
#define PHASE_MASK 0x7fff
#endif
#define REP(k) for (int rep_ = 0; rep_ <= (((PROBE_REP_MASK) >> (k)) & 1); ++rep_)
#if PROBE_SUB_MASK
#define PREP(b) for (int n_ = __builtin_amdgcn_readfirstlane(1 + ((PROBE_SUB_MASK >> (b)) & 1) + (int)(args.ph_lo > 100)), r_ = 0; r_ < n_; ++r_)
#else
#define PREP(b)
#endif
#define WSSEL(bit) do { if ((FLAT_FN_MASK >> (bit)) & 1) { unsigned char* w_ = args.ws; asm volatile("" : "+s"(w_)); F.ws = w_; } else { GAS unsigned char* g_ = (GAS unsigned char*)args.ws; asm volatile("" : "+s"(g_)); F.ws = (unsigned char*)g_; } } while (0)
#define IN(k) ((((PHASE_MASK) >> (k)) & 1) && lo <= (k) && (k) < hi)
#define XB ((bf16_t*)(ws + WS_XB))
#define X ((float*)(ws + WS_X))
#define SSX ((float*)(ws + WS_SSX))
#define SSV ((float*)(ws + WS_SSV))
#define B0 ((bf16_t*)(ws + WS_B0))
#define B1 ((bf16_t*)(ws + WS_B1))
#define QBp ((bf16_t*)(ws + WS_QB))
#define A2 ((bf16_t*)(ws + WS_A2))
#define GBp ((bf16_t*)(ws + WS_GB))
    const int G = F.G, bid = F.bid;

    if (IN(0)) REP(0) { REFRESH(); WSSEL(0); p0_prologue(F); __syncthreads(); } SEAM(0);
#define CNT(k) ((unsigned*)(ws + WS_CTL) + 4096 + 64 * (k))
#define WOUT(l) ((const bf16_t*)(ws + WS_WOUT) + (size_t)(l) * DM * KOUT)
#define INPROJ(EpiT, E, W, N, cnt, want) do { stagger(bid); \
        pg8::Gemm g{XB, (W), M, (N), DM, DM}; pg8::StaticOrder S; S.init(MP, (N), G, bid); pg8::gemm_phase<EpiT, pg8::StaticOrder, true, true>(F.lds, g, S, E); \
        if (cnt) counter_wait(cnt, (unsigned)(want)); \
        const int rem = ((MP / 256) * ((N) / 256)) % G; pg8::StaticOrder S2; S2.init(MS, (N), G, (bid + G - rem) % G, MP / 256); pg8::gemm_phase<EpiT, pg8::StaticOrder, true, true>(F.lds, g, S2, E); } while (0)
#define OUTPROJ_PROMPT(l, bp) do { pg8::Gemm g{A2, WOUT(l), M, DM, KOUT, KOUT}; pg8::StaticOrder S; S.init(MP, DM, G, bid); EpiOut E{(bp), XB, SSX}; pg8::gemm_phase<EpiOut, pg8::StaticOrder, true, true>(F.lds, g, S, E); } while (0)
#define OUTPROJ_SLICES(l, c, nb, NK) do { pg8::Gemm g{A2, WOUT(l), M, DM, KOUT / (NK), KOUT}; typedef pg8::SliceOrder<MS / 256, DM / 256, (NK)> SO; SO S; S.init((nb), (c), MP / 256); \
        EpiSlab E{(float*)(ws + WS_SLAB), DM, MP, (size_t)MS * DM}; pg8::gemm_phase<EpiSlab, SO, true, true>(F.lds, g, S, E); } while (0)
#define SLICEFIX(l, sb0, basef, cA, cB) do { if (bid >= (sb0)) { const int nsb_ = G - (sb0); OUTPROJ_SLICES(l, bid - (sb0), nsb_, NK_OUT); counter_signal(cA); counter_wait(cA, (unsigned)nsb_); \
        fixup_out_rows(F, (basef), bid - (sb0), nsb_, NK_OUT); counter_signal(cB); } } while (0)
#define KVPROJ(l, c0) do { pg8::Gemm g{(const bf16_t*)(ws + WS_MEMB), (const bf16_t*)(ws + WS_WKV) + (size_t)(l) * DM * DM, PB * MEML, DM, DM, DM}; pg8::StaticOrder S; S.init(g.M, g.N, G, (bid + G - (c0)) % G); \
        EpiKV E{(const float*)(ws + WS_RSTDM), F.out + O_MK, F.out + O_MV, (bf16_t*)(ws + WS_KB), (bf16_t*)(ws + WS_VT), (l)}; pg8::gemm_phase<EpiKV, pg8::StaticOrder, true, true>(F.lds, g, S, E); } while (0)
    if (IN(1)) REP(1) { REFRESH();
        { EpiInA E{SSX, B0, B1, QBp, SSV}; INPROJ(EpiInA, E, (const bf16_t*)(ws + WS_WINA), NIN_A, (unsigned*)nullptr, 0); }
        KVPROJ(0, 180); KVPROJ(1, 212);
    } SEAM(1);
    if (IN(2)) REP(2) { REFRESH(); WSSEL(1);
        PREP(5) sgu_phase_mfma(F, 0); PREP(6) sgu_sample_phase(F, 0); attn_prompt_phase(F, 0); attn_sample_phase(F, 0); } SEAM(2);
    if (IN(3)) REP(3) { REFRESH(); OUTPROJ_PROMPT(0, GIN(0)); } SEAM(3);
    if (IN(4)) REP(4) { REFRESH(); SLICEFIX(0, 196, GIN(1), CNT(0), CNT(4));
        EpiInB E{SSX, B0, B1, QBp, F.out + O_CP, F.out + O_CS, GIN(18), A2}; INPROJ(EpiInB, E, (const bf16_t*)(ws + WS_WINB), NIN_B, CNT(4), G - 196); } SEAM(4);
    if (IN(5)) REP(5) { REFRESH(); WSSEL(3);
        PREP(0) conv_phase(F); PREP(1) attn_prompt_phase(F, 1); PREP(2) attn_sample_phase(F, 1); } SEAM(5);
    if (IN(6)) REP(6) { REFRESH(); OUTPROJ_PROMPT(1, (const float*)nullptr); } SEAM(6);
    if (IN(7)) REP(7) { REFRESH(); SLICEFIX(1, 196, (const float*)nullptr, CNT(1), CNT(5));
        EpiInC E{SSX, B0, B1, QBp}; INPROJ(EpiInC, E, (const bf16_t*)(ws + WS_WINC), NIN_C, CNT(5), G - 196); KVPROJ(2, 164); } SEAM(7);
    if (IN(8)) REP(8) { REFRESH();
        const int half = G / 2; const bool s5h = bid < half;
        F.G = half; F.bid = s5h ? bid : (1 << 20);
        WSSEL(4); s5_prompt_mfma(F);
        F.G = G - half; F.bid = s5h ? (1 << 20) : bid - half;
        WSSEL(6); attn_prompt_phase(F, 2); WSSEL(7); attn_sample_phase(F, 2); WSSEL(5); s5_sample_mfma(F);
        F.bid = bid; F.G = G; } SEAM(8);
    if (IN(9)) REP(9) { REFRESH();
        { pg8::Gemm g{GBp, (const bf16_t*)(ws + WS_WGLU), M, E_, E_, E_}; pg8::StaticOrder S; S.init(MP, E_, G, bid); EpiGlu E{GBp, B1, GIN(29), A2}; pg8::gemm_phase<EpiGlu, pg8::StaticOrder, true, true>(F.lds, g, S, E); }
        { pg8::Gemm g{GBp, (const bf16_t*)(ws + WS_WGLU), M, E_, 256, E_}; typedef pg8::SliceOrder<MS / 256, E_ / 256, NK_GLU> SG; SG S; S.init(G, bid, MP / 256); EpiSlab E{(float*)(ws + WS_SLAB), E_, MP, (size_t)MS * E_}; pg8::gemm_phase<EpiSlab, SG, true, true>(F.lds, g, S, E); } } SEAM(9);
    if (IN(10)) REP(10) { REFRESH(); fixup_glu_rows(F);
        OUTPROJ_PROMPT(2, (const float*)nullptr); } SEAM(10);
    if (IN(11)) REP(11) { REFRESH(); SLICEFIX(2, 212, (const float*)nullptr, CNT(3), CNT(6));
        EpiInA E{SSX, B0, B1, QBp, SSV}; INPROJ(EpiInA, E, (const bf16_t*)(ws + WS_WINA) + (size_t)NIN_A * DM, NIN_A, CNT(6), G - 212); KVPROJ(3, 180); } SEAM(11);
    if (IN(12)) REP(12) { REFRESH(); WSSEL(1);
        sgu_phase_mfma(F, 1); sgu_sample_phase(F, 1); attn_prompt_phase(F, 3); attn_sample_phase(F, 3); } SEAM(12);
    if (IN(13)) REP(13) { REFRESH();
        { pg8::Gemm g{A2, WOUT(3), M, DM, KOUT, KOUT}; pg8::StaticOrder S; S.init(MP, DM, G, bid); EpiOutFinal E{XB, SSX, GIN(9), F.out + O_YP, CNT(16)}; pg8::gemm_phase<EpiOutFinal, pg8::StaticOrder, true, true>(F.lds, g, S, E); }
        OUTPROJ_SLICES(3, bid, G, NK_OUT_LAST);
#if MK_ONE_LAUNCH
        if (bid < (MS / 256) * (DM / 256) * NK_OUT_LAST) counter_signal(CNT(8));
        if (bid * NWAVES < MS) { counter_wait(CNT(8), (unsigned)((MS / 256) * (DM / 256) * NK_OUT_LAST)); WSSEL(8); fixup_out_rows(F, (const float*)nullptr, bid, G, NK_OUT_LAST); final_phase(F); }
#endif
        }
#if !MK_ONE_LAUNCH
    if (IN(14)) REP(14) { REFRESH(); WSSEL(8); fixup_out_rows(F, (const float*)nullptr, bid, G, NK_OUT_LAST); final_phase(F); }
#endif
#undef CNT
#undef WOUT
#undef KVPROJ
#undef INPROJ
#undef OUTPROJ_PROMPT
#undef OUTPROJ_SLICES
#undef SLICEFIX
#undef IN
#undef REP
#undef SEAM
#undef XB
#undef X
#undef SSX
#undef SSV
#undef B0
#undef B1
#undef QBp
#undef A2
#undef GBp
#undef REFRESH
}

extern "C" void kernel_launch(void* const* d_in, const int* in_sizes, int n_in, void* d_out, int out_size, void* d_ws, size_t ws_size, hipStream_t stream) {
    static int grid = 0;
    if (grid == 0) {
        if (n_in != 30 || out_size != (int)O_END || ws_size < WS_END) { fprintf(stderr, "kernel_launch: unexpected shapes (n_in %d out %d ws %zu)\n", n_in, out_size, ws_size); grid = -1; return; }
        int dev = 0, cus = 0, per_cu = 0;
        (void)hipGetDevice(&dev); (void)hipDeviceGetAttribute(&cus, hipDeviceAttributeMultiprocessorCount, dev);
        if (hipFuncSetAttribute((const void*)fwd_kernel, hipFuncAttributeMaxDynamicSharedMemorySize, LDS_BYTES) != hipSuccess) { fprintf(stderr, "kernel_launch: hipFuncSetAttribute failed\n"); grid = -1; return; }
        if (hipOccupancyMaxActiveBlocksPerMultiprocessor(&per_cu, (const void*)fwd_kernel, NTHR, LDS_BYTES) != hipSuccess || per_cu < 1) { fprintf(stderr, "kernel_launch: occupancy query says %d\n", per_cu); (void)hipGetLastError(); per_cu = 1; }
        grid = cus;
    }
    if (grid < 0) return;
    Args a{};
    for (int i = 0; i < 30; ++i) a.in[i] = (const float*)d_in[i];
    a.out = (float*)d_out; a.ws = (unsigned char*)d_ws;
#if MK_ONE_LAUNCH
    (void)hipMemsetAsync((char*)d_ws + WS_CTL, 0, 65536, stream);
    a.ph_lo = 0; a.ph_hi = NPHASE;
    void* kargs[] = {&a};
    hipError_t e = hipLaunchCooperativeKernel((const void*)fwd_kernel, dim3(grid), dim3(NTHR), kargs, LDS_BYTES, stream);
    if (e != hipSuccess) fprintf(stderr, "cooperative launch failed: %s (grid %d)\n", hipGetErrorString(e), grid);
#else
    for (int p = 0; p < NPHASE; ++p) { a.ph_lo = p; a.ph_hi = p + 1; hipLaunchKernelGGL(fwd_kernel, dim3(grid), dim3(NTHR), LDS_BYTES, stream, a); }
#endif
}
```

```cpp
#include <hip/hip_runtime.h>
#include <hip/hip_cooperative_groups.h>
#include <cstdio>
#include <cstdint>
namespace cg = cooperative_groups;

#ifndef MK_ONE_LAUNCH
#define MK_ONE_LAUNCH 1
#endif
#ifndef XHALF_SHFL
#define XHALF_SHFL 0
#endif
#ifndef STAGGER_TICKS
#define STAGGER_TICKS 0
#endif
#ifndef PROBE_RSTD2
#define PROBE_RSTD2 0
#endif
#ifndef GLU_WGM
#define GLU_WGM 8
#endif
#ifndef EPI_DRAIN
#define EPI_DRAIN 1
#endif
#ifndef FLAT_FN_MASK
#define FLAT_FN_MASK 0x00
#endif
#ifndef PROBE_SUB_MASK
#define PROBE_SUB_MASK 0
#endif
#ifndef PROBE_REP_MASK
#define PROBE_REP_MASK 0
#endif

namespace pg8 {
#define PG8_LAS __attribute__((address_space(3)))
typedef unsigned short bf16_t;
typedef short bf16x8 __attribute__((ext_vector_type(8)));
typedef float f32x4 __attribute__((ext_vector_type(4)));
typedef unsigned u32x4 __attribute__((ext_vector_type(4)));
typedef unsigned u32x2 __attribute__((ext_vector_type(2)));
constexpr int BM = 256, BK = 64, HALF = 128, HTB = HALF * BK * 2, STAGE_BYTES = 8 * HTB, NXCD = 8, WGM = 4;

__host__ __device__ __forceinline__ int lds_byte(int r, int c) { const int st = (r >> 4) * 2 + (c >> 5), rr = r & 15, cc = c & 31, ob = rr * 64 + cc * 2; return st * 1024 + (ob ^ (((ob >> 9) & 1) << 5)); }
__host__ __device__ __forceinline__ void stage_rc(int b, int& R, int& C) { const int st = b / 1024, sb = b % 1024, swz = sb ^ (((sb >> 9) & 1) << 5); R = (st >> 1) * 16 + swz / 64; C = (st & 1) * 32 + (swz % 64) / 2; }
__host__ __device__ __forceinline__ int perm32(int rho) { const int n = rho >> 4, i = rho & 15; return 8 * (i >> 2) + 4 * n + (i & 3); }

struct Unit { int pm, pn, ks; };
struct Gemm { const bf16_t* A; const bf16_t* Bt; int M, N, K, ld; };

struct StaticOrder {
    int nM, nN, nwg, G, c, pm0, wgm;
    __host__ __device__ void init(int M, int N, int G_, int c_, int pm0_ = 0, int wgm_ = WGM) { nM = M / BM; nN = N / BM; nwg = nM * nN; G = G_; c = c_; pm0 = pm0_; wgm = wgm_; }
    __host__ __device__ bool next(int i, Unit& u) const {
        const long L = (long)i * G + c; if (L >= nwg) return false;
        int wgid = (int)L; { const int q = nwg / NXCD, r = nwg % NXCD, xcd = wgid % NXCD, off = wgid / NXCD; wgid = (xcd < r ? xcd * (q + 1) : r * (q + 1) + (xcd - r) * q) + off; }
        const int nig = wgm * nN, gid = wgid / nig, fm = gid * wgm, gsz = (nM - fm) < wgm ? (nM - fm) : wgm;
        u.pm = pm0 + fm + ((wgid % nig) % gsz); u.pn = (wgid % nig) / gsz; u.ks = 0; return true;
    }
    __device__ __forceinline__ void a_ready(const Unit&) const {}
    __device__ __forceinline__ void done(const Unit&) const {}
};
template <int NM_, int NN_, int NK_> struct SliceOrder {
    int G, c, pm0;
    __host__ __device__ void init(int G_, int c_, int pm0_) { G = G_; c = c_; pm0 = pm0_; }
    __host__ __device__ bool next(int i, Unit& u) const {
        const int L = i * G + c; if (L >= NM_ * NN_ * NK_) return false;
        const int t = L / NK_; u.ks = L % NK_; u.pn = t % NN_; u.pm = pm0 + t / NN_; return true;
    }
    __device__ __forceinline__ void a_ready(const Unit&) const {}
    __device__ __forceinline__ void done(const Unit&) const {}
};

template <class Epi, class Sched, bool ALIGN_EPI = false, bool SP2 = false>
__device__ __forceinline__ void gemm_phase(PG8_LAS unsigned char* lds, const Gemm g, const Sched& S, const Epi& E) {
    int tid = threadIdx.x; asm volatile("" : "+v"(tid));
    const int wid = __builtin_amdgcn_readfirstlane(tid >> 6), lane = tid & 63, wr = wid >> 2, wc = wid & 3, fr = lane & 15, fq = lane >> 4;
    const int K = g.K, ld = g.ld, nt = K / BK;
    unsigned voffA[2], voffB[2];
#pragma unroll
    for (int i = 0; i < 2; ++i) { int R, C; stage_rc(tid * 16 + i * 8192, R, C); const int Rb = Epi::PERM ? ((R & ~31) + perm32(R & 31)) : R;
        voffA[i] = (unsigned)(R * ld + C) * 2u; voffB[i] = (unsigned)(Rb * ld + C) * 2u; }
    const size_t kstep = (size_t)(BK * 2);
    const size_t hstep = (size_t)HALF * ld * 2;
    const size_t sstep = (size_t)K * 2;
    const size_t tstep = 2 * hstep;
    const unsigned ldsw = (unsigned)wid * 1024u;
    const int aoff = lds_byte(wr * 64 + fr, fq * 8), boff = lds_byte(wc * 32 + fr, fq * 8);
#define PG8_SA(b, h) (((b) * 2 + (h)) * HTB)
#define PG8_SB(b, h) ((4 + (b) * 2 + (h)) * HTB)
#define PG8_STAGE(bufoff, gbase, voff) do { _Pragma("unroll") for (int _i = 0; _i < 2; ++_i) \
        __builtin_amdgcn_global_load_lds((const unsigned*)((const char*)(gbase) + (voff)[_i]), (PG8_LAS unsigned*)(lds + (bufoff) + ldsw + _i * 8192), 16, 0, 0); } while (0)
#define PG8_LDA(dst, b, h) do { _Pragma("unroll") for (int m = 0; m < 4; ++m) _Pragma("unroll") for (int k = 0; k < 2; ++k) dst[m][k] = *(const PG8_LAS bf16x8*)(lds + PG8_SA(b, h) + aoff + m * 2048 + k * 1024); } while (0)
#define PG8_LDB(dst, b, h) do { _Pragma("unroll") for (int n = 0; n < 2; ++n) _Pragma("unroll") for (int k = 0; k < 2; ++k) dst[n][k] = *(const PG8_LAS bf16x8*)(lds + PG8_SB(b, h) + boff + n * 2048 + k * 1024); } while (0)
#define PG8_MMA(ai, bj, At, Bt) do { __builtin_amdgcn_s_setprio(1); _Pragma("unroll") for (int m = 0; m < 4; ++m) _Pragma("unroll") for (int n = 0; n < 2; ++n) _Pragma("unroll") for (int k = 0; k < 2; ++k) \
        acc[ai][bj][m][n] = __builtin_amdgcn_mfma_f32_16x16x32_bf16(Bt[n][k], At[m][k], acc[ai][bj][m][n], 0, 0, 0); __builtin_amdgcn_s_setprio(0); } while (0)
#define PG8_WAIT_V(n) asm volatile("s_waitcnt vmcnt(" #n ")" ::: "memory")
#define PG8_WAIT_L(n) asm volatile("s_waitcnt lgkmcnt(" #n ")" ::: "memory")
#define PG8_BAR __builtin_amdgcn_s_barrier()
#define PG8_SCHED __builtin_amdgcn_sched_barrier(0)
    Unit cur, nxt; int ui = 0;
    if (!S.next(0, cur)) return;
    f32x4 acc[2][2][4][2];
#pragma unroll
    for (int a = 0; a < 2; ++a)
#pragma unroll
        for (int b = 0; b < 2; ++b)
#pragma unroll
            for (int m = 0; m < 4; ++m)
#pragma unroll
                for (int n = 0; n < 2; ++n) acc[a][b][m][n] = (f32x4){0.f, 0.f, 0.f, 0.f};
    bf16x8 At[4][2], B0[2][2], B1[2][2];
    const char* cA = (const char*)g.A + (size_t)cur.pm * tstep + (size_t)cur.ks * sstep; const char* cB = (const char*)g.Bt + (size_t)cur.pn * tstep + (size_t)cur.ks * sstep;
    S.a_ready(cur);
    if constexpr (SP2) {
        PG8_STAGE(PG8_SB(0, 0), cB, voffB); PG8_STAGE(PG8_SB(0, 1), cB + hstep, voffB); PG8_STAGE(PG8_SA(0, 0), cA, voffA); PG8_STAGE(PG8_SA(0, 1), cA + hstep, voffA);
        if (wr == 1) PG8_BAR;
        PG8_WAIT_V(2); PG8_BAR;
        PG8_STAGE(PG8_SB(1, 0), cB + kstep, voffB); PG8_STAGE(PG8_SA(1, 0), cA + kstep, voffA); PG8_STAGE(PG8_SB(1, 1), cB + hstep + kstep, voffB);
        PG8_WAIT_V(6); PG8_BAR;
    } else {
        PG8_STAGE(PG8_SB(0, 0), cB, voffB); PG8_STAGE(PG8_SA(0, 0), cA, voffA); PG8_STAGE(PG8_SB(0, 1), cB + hstep, voffB); PG8_STAGE(PG8_SA(0, 1), cA + hstep, voffA);
        if (wr == 1) PG8_BAR;
        PG8_WAIT_V(4); PG8_BAR;
        PG8_STAGE(PG8_SB(1, 0), cB + kstep, voffB); PG8_STAGE(PG8_SA(1, 0), cA + kstep, voffA); PG8_STAGE(PG8_SB(1, 1), cB + hstep + kstep, voffB);
        PG8_WAIT_V(6); PG8_BAR;
    }
    for (;;) {
        const bool has_next = S.next(ui + 1, nxt);
        const char* nA = has_next ? (const char*)g.A + (size_t)nxt.pm * tstep + (size_t)nxt.ks * sstep : cA; const char* nB = has_next ? (const char*)g.Bt + (size_t)nxt.pn * tstep + (size_t)nxt.ks * sstep : cB;
        for (int t = 0; t < nt; t += 2) {
            const bool last = (t == nt - 2);
            const char* a1 = cA + (size_t)(t + 1) * kstep;
            const char* a2 = last ? nA : cA + (size_t)(t + 2) * kstep; const char* b2 = last ? nB : cB + (size_t)(t + 2) * kstep;
            const char* a3 = a2 + kstep; const char* b3 = b2 + kstep;
            if (last && has_next) S.a_ready(nxt);
            if constexpr (SP2) {
            PG8_LDB(B0, 0, 0); PG8_LDB(B1, 0, 1); PG8_SCHED; PG8_LDA(At, 0, 0); PG8_STAGE(PG8_SA(1, 1), a1 + hstep, voffA);
            PG8_WAIT_V(8); PG8_WAIT_L(0); PG8_BAR; PG8_MMA(0, 0, At, B0); PG8_MMA(0, 1, At, B1); PG8_BAR; PG8_SCHED;
            PG8_LDA(At, 0, 1); PG8_STAGE(PG8_SB(0, 0), b2, voffB); PG8_STAGE(PG8_SB(0, 1), b2 + hstep, voffB); PG8_STAGE(PG8_SA(0, 0), a2, voffA);
            PG8_WAIT_V(8); PG8_WAIT_L(0); PG8_BAR; PG8_MMA(1, 0, At, B0); PG8_MMA(1, 1, At, B1); PG8_BAR; PG8_SCHED;
            PG8_LDB(B0, 1, 0); PG8_LDB(B1, 1, 1); PG8_SCHED; PG8_LDA(At, 1, 0); PG8_STAGE(PG8_SA(0, 1), a2 + hstep, voffA);
            PG8_WAIT_V(8); PG8_WAIT_L(0); PG8_BAR; PG8_MMA(0, 0, At, B0); PG8_MMA(0, 1, At, B1); PG8_BAR; PG8_SCHED;
            PG8_LDA(At, 1, 1); PG8_STAGE(PG8_SB(1, 0), b3, voffB); PG8_STAGE(PG8_SB(1, 1), b3 + hstep, voffB); PG8_STAGE(PG8_SA(1, 0), a3, voffA);
            PG8_WAIT_V(8); PG8_WAIT_L(0); PG8_BAR; PG8_MMA(1, 0, At, B0); PG8_MMA(1, 1, At, B1); PG8_BAR; PG8_SCHED;
            } else {
            PG8_LDB(B0, 0, 0); PG8_SCHED; PG8_LDA(At, 0, 0); PG8_STAGE(PG8_SA(1, 1), a1 + hstep, voffA);
            PG8_WAIT_L(8); PG8_BAR; PG8_WAIT_L(0); PG8_MMA(0, 0, At, B0); PG8_BAR; PG8_SCHED;
            PG8_LDB(B1, 0, 1); PG8_STAGE(PG8_SB(0, 0), b2, voffB);
            PG8_BAR; PG8_WAIT_L(0); PG8_MMA(0, 1, At, B1); PG8_BAR;
            PG8_LDA(At, 0, 1); PG8_STAGE(PG8_SA(0, 0), a2, voffA);
            PG8_BAR; PG8_WAIT_L(0); PG8_MMA(1, 0, At, B0); PG8_BAR; PG8_SCHED;
            PG8_STAGE(PG8_SB(0, 1), b2 + hstep, voffB);
            PG8_WAIT_V(6); PG8_BAR; PG8_MMA(1, 1, At, B1); PG8_BAR;
            PG8_LDB(B0, 1, 0); PG8_SCHED; PG8_LDA(At, 1, 0); PG8_STAGE(PG8_SA(0, 1), a2 + hstep, voffA);
            PG8_WAIT_L(8); PG8_BAR; PG8_WAIT_L(0); PG8_MMA(0, 0, At, B0); PG8_BAR; PG8_SCHED;
            PG8_LDB(B1, 1, 1); PG8_STAGE(PG8_SB(1, 0), b3, voffB);
            PG8_BAR; PG8_WAIT_L(0); PG8_MMA(0, 1, At, B1); PG8_BAR;
            PG8_LDA(At, 1, 1); PG8_STAGE(PG8_SA(1, 0), a3, voffA);
            PG8_BAR; PG8_WAIT_L(0); PG8_MMA(1, 0, At, B0); PG8_BAR; PG8_SCHED;
            PG8_STAGE(PG8_SB(1, 1), b3 + hstep, voffB);
            PG8_WAIT_V(6); PG8_BAR; PG8_MMA(1, 1, At, B1); PG8_BAR;
            }
        }
        if constexpr (ALIGN_EPI) { if (wr == 0) PG8_BAR; }
        if constexpr (!Epi::AFTER_DRAIN) { E(acc, cur, wr, wc, fr, fq); S.done(cur); }
#if EPI_DRAIN
        PG8_WAIT_V(0);
#endif
        if (!has_next) break;
#pragma unroll
        for (int a = 0; a < 2; ++a)
#pragma unroll
            for (int b = 0; b < 2; ++b)
#pragma unroll
                for (int m = 0; m < 4; ++m)
#pragma unroll
                    for (int n = 0; n < 2; ++n) acc[a][b][m][n] = (f32x4){0.f, 0.f, 0.f, 0.f};
        cur = nxt; cA = nA; cB = nB; ++ui;
        if constexpr (ALIGN_EPI) { if (wr == 1) PG8_BAR; }
    }
    PG8_WAIT_V(0);
    if constexpr (!ALIGN_EPI) { if (wr == 0) PG8_BAR; }
    PG8_BAR;
    if constexpr (Epi::AFTER_DRAIN) { E(acc, cur, wr, wc, fr, fq); S.done(cur); }
#undef PG8_SA
#undef PG8_SB
#undef PG8_STAGE
#undef PG8_LDA
#undef PG8_LDB
#undef PG8_MMA
#undef PG8_WAIT_V
#undef PG8_WAIT_L
#undef PG8_BAR
#undef PG8_SCHED
}
}

using pg8::bf16_t; using pg8::f32x4; using pg8::u32x4; using pg8::u32x2; using pg8::bf16x8; using pg8::Unit;
#define LAS __attribute__((address_space(3)))
#define GAS __attribute__((address_space(1)))
#define GIN(k) ((const float*)(const GAS float*)F.in[k])
typedef float f32x2 __attribute__((ext_vector_type(2)));
typedef __bf16 bf16x2_t __attribute__((ext_vector_type(2)));
typedef float f32x16 __attribute__((ext_vector_type(16)));

constexpr int DM = 1024, E_ = 2048, XA = 512, NH = 4, HD = 128, MEML = 256;
constexpr int PB = 8, PSEQ = 2048, MP = PB * PSEQ;
constexpr int SBT = 128, SSEQ = 4, MS = SBT * SSEQ;
constexpr int M = MP + MS;
constexpr int NIN_A = 3 * E_ + XA, NIN_B = 4 * E_ + XA, NIN_C = 2 * E_ + XA, KOUT = E_ + XA;
constexpr int S5G = 128, S5P = 64, S5I = 16;
constexpr float EPS = 1e-6f;
constexpr int NWAVES = 8, NTHR = 512;

constexpr size_t O_YP = 0, O_YS = O_YP + (size_t)MP * DM, O_MK = O_YS + (size_t)MS * DM, O_MV = O_MK + 4ull * PB * MEML * XA, O_CP = O_MV + 4ull * PB * MEML * XA,
                 O_CS = O_CP + (size_t)PB * 2 * E_, O_SRP = O_CS + (size_t)SBT * 2 * E_, O_SIP = O_SRP + (size_t)PB * S5G * S5P, O_SRS = O_SIP + (size_t)PB * S5G * S5P,
                 O_SIS = O_SRS + (size_t)SBT * S5G * S5P, O_CV = O_SIS + (size_t)SBT * S5G * S5P, O_END = O_CV + 2ull * SBT * SSEQ * E_;
static_assert(O_END == 30572544ull, "output size");

constexpr size_t MiB = 1u << 20;
constexpr size_t WS_CTL = 0, WS_TAB = 1 * MiB, WS_RSTDM = 3 * MiB, WS_SGUW = 4 * MiB, WS_SSX = 5 * MiB, WS_SSV = 7 * MiB, WS_WKV = 10 * MiB, WS_WGLU = 18 * MiB, WS_WOUT = 26 * MiB,
                 WS_WINA = 46 * MiB, WS_WINB = 72 * MiB, WS_WINC = 89 * MiB, WS_MEMB = 98 * MiB, WS_KB = 102 * MiB, WS_VT = 110 * MiB, WS_XB = 118 * MiB, WS_X = 151 * MiB,
                 WS_B0 = 217 * MiB, WS_B1 = 283 * MiB, WS_QB = 349 * MiB, WS_A2 = 366 * MiB, WS_GB = 449 * MiB, WS_SLAB = 515 * MiB  , WS_END = 548 * MiB;
constexpr size_t T_AR = 0, T_AI = 8192, T_BBR = 16384, T_BBI = 16384 + 131072;

constexpr int RING_BYTES = 131072, LDS_BYTES = 147456;

struct Args { const float* in[30]; float* out; unsigned char* ws; int ph_lo, ph_hi; };

__device__ __forceinline__ unsigned pk2(float lo, float hi) { f32x2 v = {lo, hi}; return __builtin_bit_cast(unsigned, __builtin_convertvector(v, bf16x2_t)); }
__device__ __forceinline__ bf16_t f2bf(float f) { return (bf16_t)(pk2(f, 0.f) & 0xffffu); }
__device__ __forceinline__ float bf2f(unsigned short h) { return __uint_as_float((unsigned)h << 16); }
__device__ __forceinline__ float bflo(unsigned w) { return __uint_as_float(w << 16); }
__device__ __forceinline__ float bfhi(unsigned w) { return __uint_as_float(w & 0xffff0000u); }
__device__ __forceinline__ float sigmoidf_(float x) { return __builtin_amdgcn_rcpf(1.f + __expf(-x)); }
__device__ __forceinline__ float siluf_(float x) { return x * sigmoidf_(x); }
__device__ __forceinline__ float gelu_tanh(float x) { const float y = 0.7978845608028654f * (x + 0.044715f * x * x * x); return x * sigmoidf_(2.f * y); }
__device__ __forceinline__ float wave_sum(float v) {
#pragma unroll
    for (int o = 1; o < 64; o <<= 1) v += __shfl_xor(v, o);
    return v;
}
__device__ __forceinline__ float wave_max(float v) {
#pragma unroll
    for (int o = 1; o < 64; o <<= 1) v = fmaxf(v, __shfl_xor(v, o));
    return v;
}
__device__ __forceinline__ u32x4 pack8(f32x4 a, f32x4 b) { u32x4 w; w.x = pk2(a[0], a[1]); w.y = pk2(a[2], a[3]); w.z = pk2(b[0], b[1]); w.w = pk2(b[2], b[3]); return w; }
__device__ __forceinline__ void unpack8(u32x4 w, float (&f)[8]) { f[0] = bflo(w.x); f[1] = bfhi(w.x); f[2] = bflo(w.y); f[3] = bfhi(w.y); f[4] = bflo(w.z); f[5] = bfhi(w.z); f[6] = bflo(w.w); f[7] = bfhi(w.w); }

__device__ __forceinline__ int src_col(int kind, int np) {
    const int pn = np >> 8, p = np & 255, pos = (p & ~31) + pg8::perm32(p & 31);
    if (kind == 0) {
        if (pn < 16) return pos < 128 ? 128 * pn + pos : 2 * E_ + 128 * pn + (pos - 128);
        if (pn < 24) return E_ + 256 * (pn - 16) + pos;
        return 3 * E_ + 256 * (pn - 24) + pos;
    }
    if (kind == 1) {
        if (pn < 32) { const int qs = 2 * (p >> 7) + ((p >> 4) & 1), ch = 64 * pn + 16 * ((p >> 5) & 3) + (p & 15); return qs * E_ + ch; }
        return 4 * E_ + 256 * (pn - 32) + pos;
    }
    return 256 * pn + pos;
}

__device__ __forceinline__ float sum_rows4(float x) {
    auto a = __builtin_amdgcn_permlane16_swap(__float_as_uint(x), __float_as_uint(x), false, false); const float y = __uint_as_float(a[0]) + __uint_as_float(a[1]);
    auto b = __builtin_amdgcn_permlane32_swap(__float_as_uint(y), __float_as_uint(y), false, false); return __uint_as_float(b[0]) + __uint_as_float(b[1]);
}
__device__ __forceinline__ void rows_rstd16(const float* ssx, int row0, int fq, float (&rs)[2][4]) {
#pragma unroll
    for (int ai = 0; ai < 2; ++ai)
#pragma unroll
        for (int m = 0; m < 4; ++m) {
            const f32x4 v = *(const f32x4*)(ssx + (size_t)(row0 + ai * 128 + m * 16) * 16 + fq * 4);
            const float s = sum_rows4((v[0] + v[1]) + (v[2] + v[3]));
            rs[ai][m] = __builtin_amdgcn_rsqf(s * (1.f / DM) + EPS);
        }
#if PROBE_RSTD2
    { const int dep = rs[1][3] == 12345.678f ? 1 : 0;
#pragma unroll
    for (int ai = 0; ai < 2; ++ai)
#pragma unroll
        for (int m = 0; m < 4; ++m) {
            const f32x4 v = *(const f32x4*)(ssx + (size_t)(row0 + dep + ai * 128 + m * 16) * 16 + fq * 4);
            const float s = sum_rows4((v[0] + v[1]) + (v[2] + v[3]));
            rs[ai][m] = fmaxf(rs[ai][m], __builtin_amdgcn_rsqf(s * (1.f / DM) + EPS));
        } }
#endif
}

struct EpiKV {
    static constexpr bool PERM = false, AFTER_DRAIN = false;
    const float* rstdm; float* outk; float* outv; bf16_t* KB; bf16_t* VT; int layer;
    __device__ __forceinline__ void operator()(const f32x4 (&acc)[2][2][4][2], const Unit& u, int wr, int wc, int fr, int fq) const {
        const int sub = u.pn & 3, isv = sub >> 1, b = u.pm;
        const int key0 = wr * 64 + fr, d0 = 32 * wc + 8 * fq;
        const float* rsp = rstdm + b * 256 + key0;
        float* of = (isv ? outv : outk) + (((size_t)(layer * PB + b) * MEML + key0) * NH + (sub & 1) * 2) * HD + d0;
        const size_t bh0 = (size_t)((layer * PB + b) * NH + (sub & 1) * 2);
        if (!isv) {
            bf16_t* kb = KB + (bh0 * MEML + key0) * HD + d0;
#pragma unroll
            for (int ai = 0; ai < 2; ++ai)
#pragma unroll
                for (int m = 0; m < 4; ++m) { const int kk = ai * 128 + m * 16; const float rs = rsp[kk];
#pragma unroll
                    for (int bj = 0; bj < 2; ++bj) { const f32x4 v0 = acc[ai][bj][m][0] * rs, v1 = acc[ai][bj][m][1] * rs;
                        float* o = of + (size_t)kk * XA + bj * HD; *(f32x4*)o = v0; *(f32x4*)(o + 4) = v1;
                        *(u32x4*)(kb + (size_t)bj * MEML * HD + (size_t)kk * HD) = pack8(v0, v1); }
                    asm volatile("" ::: "memory"); }
        } else {
            bf16_t* vt = VT + (bh0 * HD + d0) * MEML + key0;
#pragma unroll
            for (int ai = 0; ai < 2; ++ai)
#pragma unroll
                for (int m = 0; m < 4; ++m) { const int kk = ai * 128 + m * 16; const float rs = rsp[kk];
#pragma unroll
                    for (int bj = 0; bj < 2; ++bj) { const f32x4 v0 = acc[ai][bj][m][0] * rs, v1 = acc[ai][bj][m][1] * rs;
                        float* o = of + (size_t)kk * XA + bj * HD; *(f32x4*)o = v0; *(f32x4*)(o + 4) = v1;
                        bf16_t* q = vt + (size_t)bj * HD * MEML + kk;
#pragma unroll
                        for (int e = 0; e < 4; ++e) { q[e * MEML] = f2bf(v0[e]); q[(e + 4) * MEML] = f2bf(v1[e]); }
                        asm volatile("" ::: "memory"); } }
        }
    }
};

struct EpiInA {
    static constexpr bool PERM = false, AFTER_DRAIN = false;
    const float* ssx; bf16_t* UZ; bf16_t* VR; bf16_t* QB; float* SSV;
    __device__ __forceinline__ void operator()(const f32x4 (&acc)[2][2][4][2], const Unit& u, int wr, int wc, int fr, int fq) const {
        const int row0 = u.pm * 256 + wr * 64 + fr; float rs[2][4]; rows_rstd16(ssx, row0, fq, rs);
        if (u.pn < 16) {
#pragma unroll
            for (int ai = 0; ai < 2; ++ai)
#pragma unroll
                for (int m = 0; m < 4; ++m) { const int row = row0 + ai * 128 + m * 16; const float r = rs[ai][m]; f32x4 o[2];
#pragma unroll
                    for (int n = 0; n < 2; ++n)
#pragma unroll
                        for (int e = 0; e < 4; ++e) o[n][e] = acc[ai][0][m][n][e] * r * siluf_(acc[ai][1][m][n][e] * r);
                    *(u32x4*)(UZ + (size_t)row * E_ + 128 * u.pn + 32 * wc + 8 * fq) = pack8(o[0], o[1]); }
        } else if (u.pn < 24) {
#pragma unroll
            for (int ai = 0; ai < 2; ++ai)
#pragma unroll
                for (int m = 0; m < 4; ++m) { const int row = row0 + ai * 128 + m * 16; const float r = rs[ai][m]; float ss = 0.f;
#pragma unroll
                    for (int bj = 0; bj < 2; ++bj) { const f32x4 v0 = acc[ai][bj][m][0] * r, v1 = acc[ai][bj][m][1] * r;
                        ss += (v0[0] * v0[0] + v0[1] * v0[1]) + (v0[2] * v0[2] + v0[3] * v0[3]) + (v1[0] * v1[0] + v1[1] * v1[1]) + (v1[2] * v1[2] + v1[3] * v1[3]);
                        *(u32x4*)(VR + (size_t)row * E_ + 256 * (u.pn - 16) + 128 * bj + 32 * wc + 8 * fq) = pack8(v0, v1); }
                    ss = sum_rows4(ss);
                    if (fq == 0) SSV[(size_t)row * 32 + (u.pn - 16) * 4 + wc] = ss; }
        } else {
#pragma unroll
            for (int ai = 0; ai < 2; ++ai)
#pragma unroll
                for (int m = 0; m < 4; ++m) { const int row = row0 + ai * 128 + m * 16; const float r = rs[ai][m] * 0.08838834764831845f;
#pragma unroll
                    for (int bj = 0; bj < 2; ++bj) *(u32x4*)(QB + (size_t)row * XA + 256 * (u.pn - 24) + 128 * bj + 32 * wc + 8 * fq) = pack8(acc[ai][bj][m][0] * r, acc[ai][bj][m][1] * r); }
        }
    }
};

struct EpiInB {
    static constexpr bool PERM = false, AFTER_DRAIN = false;
    const float* ssx; bf16_t* P; bf16_t* G; bf16_t* QB; float* convp; float* convs; const float* cw; bf16_t* A2;
    __device__ __forceinline__ void operator()(const f32x4 (&acc)[2][2][4][2], const Unit& u, int wr, int wc, int fr, int fq) const {
        const int row0 = u.pm * 256 + wr * 64 + fr; float rs[2][4]; rows_rstd16(ssx, row0, fq, rs);
        if (u.pn < 32 && u.pm < MP / 256) {
            const int ch0 = 64 * u.pn + 16 * wc + 4 * fq;
            const f32x4 w0 = *(const f32x4*)(cw + ch0), w1 = *(const f32x4*)(cw + E_ + ch0), w2 = *(const f32x4*)(cw + 2 * E_ + ch0);
#pragma unroll
            for (int ai = 0; ai < 2; ++ai) {
                f32x4 pv = {0.f, 0.f, 0.f, 0.f};
#pragma unroll
                for (int m = 0; m < 4; ++m) { const int row = row0 + ai * 128 + m * 16; const float r = rs[ai][m];
                    const f32x4 bg = acc[ai][0][m][0] * r, cgv = acc[ai][0][m][1] * r, hv = acc[ai][1][m][0] * r, z = acc[ai][1][m][1] * r;
                    f32x4 p = cgv * hv, gg, y;
#pragma unroll
                    for (int e = 0; e < 4; ++e) { gg[e] = bg[e] * siluf_(z[e]);
                        const unsigned o1 = __builtin_amdgcn_update_dpp(0u, __float_as_uint(pv[e]), 0x121, 0xf, 0xf, true), o2 = __builtin_amdgcn_update_dpp(0u, __float_as_uint(pv[e]), 0x122, 0xf, 0xf, true);
                        const float pm1 = __uint_as_float(__builtin_amdgcn_update_dpp(o1, __float_as_uint(p[e]), 0x111, 0xf, 0xf, false));
                        const float pm2 = __uint_as_float(__builtin_amdgcn_update_dpp(o2, __float_as_uint(p[e]), 0x112, 0xf, 0xf, false));
                        y[e] = (w0[e] * pm2 + w1[e] * pm1 + w2[e] * p[e]) * gg[e]; }
                    pv = p;
                    u32x2 wp, wg, wy; wp.x = pk2(p[0], p[1]); wp.y = pk2(p[2], p[3]); wg.x = pk2(gg[0], gg[1]); wg.y = pk2(gg[2], gg[3]); wy.x = pk2(y[0], y[1]); wy.y = pk2(y[2], y[3]);
                    if (m > 0 || fr >= 2) *(u32x2*)(A2 + (size_t)row * KOUT + ch0) = wy;
                    if ((m == 0 && fr < 2) || (m == 3 && fr >= 14)) *(u32x2*)(P + (size_t)row * E_ + ch0) = wp;
                    if (m == 0 && fr < 2) *(u32x2*)(G + (size_t)row * E_ + ch0) = wg;
                    { const int t = row & (PSEQ - 1); if (t >= PSEQ - 2) *(f32x4*)(convp + ((size_t)(row >> 11) * 2 + (t - (PSEQ - 2))) * E_ + ch0) = p; } } }
        } else if (u.pn < 32) {
            const int ch0 = 64 * u.pn + 16 * wc + 4 * fq;
#pragma unroll
            for (int ai = 0; ai < 2; ++ai)
#pragma unroll
                for (int m = 0; m < 4; ++m) { const int row = row0 + ai * 128 + m * 16; const float r = rs[ai][m];
                    const f32x4 bg = acc[ai][0][m][0] * r, cgv = acc[ai][0][m][1] * r, hv = acc[ai][1][m][0] * r, z = acc[ai][1][m][1] * r;
                    f32x4 p = cgv * hv, gg;
#pragma unroll
                    for (int e = 0; e < 4; ++e) gg[e] = bg[e] * siluf_(z[e]);
                    u32x2 wp, wg; wp.x = pk2(p[0], p[1]); wp.y = pk2(p[2], p[3]); wg.x = pk2(gg[0], gg[1]); wg.y = pk2(gg[2], gg[3]);
                    *(u32x2*)(P + (size_t)row * E_ + ch0) = wp; *(u32x2*)(G + (size_t)row * E_ + ch0) = wg;
                    if (row < MP) { const int t = row & (PSEQ - 1); if (t >= PSEQ - 2) *(f32x4*)(convp + ((size_t)(row >> 11) * 2 + (t - (PSEQ - 2))) * E_ + ch0) = p; }
                    else { const int s = row - MP, t = s & 3; if (t >= 2) *(f32x4*)(convs + ((size_t)(s >> 2) * 2 + (t - 2)) * E_ + ch0) = p; } }
        } else {
#pragma unroll
            for (int ai = 0; ai < 2; ++ai)
#pragma unroll
                for (int m = 0; m < 4; ++m) { const int row = row0 + ai * 128 + m * 16; const float r = rs[ai][m] * 0.08838834764831845f;
#pragma unroll
                    for (int bj = 0; bj < 2; ++bj) *(u32x4*)(QB + (size_t)row * XA + 256 * (u.pn - 32) + 128 * bj + 32 * wc + 8 * fq) = pack8(acc[ai][bj][m][0] * r, acc[ai][bj][m][1] * r); }
        }
    }
};

struct EpiInC {
    static constexpr bool PERM = false, AFTER_DRAIN = false;
    const float* ssx; bf16_t* U; bf16_t* SZ; bf16_t* QB;
    __device__ __forceinline__ void operator()(const f32x4 (&acc)[2][2][4][2], const Unit& u, int wr, int wc, int fr, int fq) const {
        const int row0 = u.pm * 256 + wr * 64 + fr; float rs[2][4]; rows_rstd16(ssx, row0, fq, rs);
#pragma unroll
        for (int ai = 0; ai < 2; ++ai)
#pragma unroll
            for (int m = 0; m < 4; ++m) { const int row = row0 + ai * 128 + m * 16; const float r = rs[ai][m];
#pragma unroll
                for (int bj = 0; bj < 2; ++bj) { const int cc = 128 * bj + 32 * wc + 8 * fq;
                    if (u.pn < 8) *(u32x4*)(U + (size_t)row * E_ + 256 * u.pn + cc) = pack8(acc[ai][bj][m][0] * r, acc[ai][bj][m][1] * r);
                    else if (u.pn < 16) { f32x4 a, b2;
#pragma unroll
                        for (int e = 0; e < 4; ++e) { a[e] = siluf_(acc[ai][bj][m][0][e] * r); b2[e] = siluf_(acc[ai][bj][m][1][e] * r); }
                        *(u32x4*)(SZ + (size_t)row * E_ + 256 * (u.pn - 8) + cc) = pack8(a, b2); }
                    else { const float rq = r * 0.08838834764831845f; *(u32x4*)(QB + (size_t)row * XA + 256 * (u.pn - 16) + cc) = pack8(acc[ai][bj][m][0] * rq, acc[ai][bj][m][1] * rq); } } }
    }
};

struct EpiOut {
    static constexpr bool PERM = false, AFTER_DRAIN = false;
    const float* basef; bf16_t* XB; float* SSX;
    __device__ __forceinline__ void operator()(const f32x4 (&acc)[2][2][4][2], const Unit& u, int wr, int wc, int fr, int fq) const {
        const int row0 = u.pm * 256 + wr * 64 + fr;
#pragma unroll
        for (int ai = 0; ai < 2; ++ai)
#pragma unroll
            for (int m = 0; m < 4; ++m) { const int row = row0 + ai * 128 + m * 16; float ss = 0.f;
#pragma unroll
                for (int bj = 0; bj < 2; ++bj) { const int col = 256 * u.pn + 128 * bj + 32 * wc + 8 * fq; f32x4 x0, x1;
                    if (basef) { x0 = *(const f32x4*)(basef + (size_t)row * DM + col); x1 = *(const f32x4*)(basef + (size_t)row * DM + col + 4); }
                    else { float r[8]; unpack8(*(const u32x4*)(XB + (size_t)row * DM + col), r); x0 = (f32x4){r[0], r[1], r[2], r[3]}; x1 = (f32x4){r[4], r[5], r[6], r[7]}; }
                    x0 += acc[ai][bj][m][0]; x1 += acc[ai][bj][m][1];
                    *(u32x4*)(XB + (size_t)row * DM + col) = pack8(x0, x1);
                    ss += (x0[0] * x0[0] + x0[1] * x0[1]) + (x0[2] * x0[2] + x0[3] * x0[3]) + (x1[0] * x1[0] + x1[1] * x1[1]) + (x1[2] * x1[2] + x1[3] * x1[3]); }
                ss = sum_rows4(ss);
                if (fq == 0) SSX[(size_t)row * 16 + u.pn * 4 + wc] = ss; }
    }
};

__device__ __forceinline__ void counter_signal(unsigned* cnt);
__device__ __forceinline__ void counter_wait(unsigned* cnt, unsigned want);
struct EpiOutFinal {
    static constexpr bool PERM = false, AFTER_DRAIN = true;
    const bf16_t* XB; float* SSX; const float* fg; float* Y; unsigned* cnt;
    __device__ __forceinline__ void operator()(f32x4 (&acc)[2][2][4][2], const Unit& u, int wr, int wc, int fr, int fq) const {
        const int row0 = u.pm * 256 + wr * 64 + fr;
#pragma unroll
        for (int ai = 0; ai < 2; ++ai)
#pragma unroll
            for (int m = 0; m < 4; ++m) { const int row = row0 + ai * 128 + m * 16; float ss = 0.f;
#pragma unroll
                for (int bj = 0; bj < 2; ++bj) { const int col = 256 * u.pn + 128 * bj + 32 * wc + 8 * fq;
                    float r[8]; unpack8(*(const u32x4*)(XB + (size_t)row * DM + col), r);
                    const f32x4 x0 = acc[ai][bj][m][0] + (f32x4){r[0], r[1], r[2], r[3]}, x1 = acc[ai][bj][m][1] + (f32x4){r[4], r[5], r[6], r[7]};
                    acc[ai][bj][m][0] = x0; acc[ai][bj][m][1] = x1;
                    ss += (x0[0] * x0[0] + x0[1] * x0[1]) + (x0[2] * x0[2] + x0[3] * x0[3]) + (x1[0] * x1[0] + x1[1] * x1[1]) + (x1[2] * x1[2] + x1[3] * x1[3]); }
                ss = sum_rows4(ss);
                if (fq == 0) SSX[(size_t)row * 16 + u.pn * 4 + wc] = ss; }
        counter_signal(cnt + 64 * u.pm); counter_wait(cnt + 64 * u.pm, 4u);
        float rs[2][4]; rows_rstd16(SSX, row0, fq, rs);
#pragma unroll
        for (int bj = 0; bj < 2; ++bj) { const int col = 256 * u.pn + 128 * bj + 32 * wc + 8 * fq; const f32x4 g0 = *(const f32x4*)(fg + col), g1 = *(const f32x4*)(fg + col + 4);
#pragma unroll
            for (int ai = 0; ai < 2; ++ai)
#pragma unroll
                for (int m = 0; m < 4; ++m) { const int row = row0 + ai * 128 + m * 16; const float r = rs[ai][m];
                    *(f32x4*)(Y + (size_t)row * DM + col) = acc[ai][bj][m][0] * r * g0; *(f32x4*)(Y + (size_t)row * DM + col + 4) = acc[ai][bj][m][1] * r * g1; } }
    }
};

struct EpiGlu {
    static constexpr bool PERM = false, AFTER_DRAIN = false;
    const bf16_t* GB; const bf16_t* SZ; const float* bias; bf16_t* A2;
    __device__ __forceinline__ void operator()(const f32x4 (&acc)[2][2][4][2], const Unit& u, int wr, int wc, int fr, int fq) const {
        const int row0 = u.pm * 256 + wr * 64 + fr;
#pragma unroll
        for (int ai = 0; ai < 2; ++ai)
#pragma unroll
            for (int m = 0; m < 4; ++m) { const int row = row0 + ai * 128 + m * 16;
#pragma unroll
                for (int bj = 0; bj < 2; ++bj) { const int col = 256 * u.pn + 128 * bj + 32 * wc + 8 * fq;
                    const f32x4 b0 = *(const f32x4*)(bias + col), b1 = *(const f32x4*)(bias + col + 4);
                    float gv[8], sz[8]; unpack8(*(const u32x4*)(GB + (size_t)row * E_ + col), gv); unpack8(*(const u32x4*)(SZ + (size_t)row * E_ + col), sz);
                    f32x4 o0, o1;
#pragma unroll
                    for (int e = 0; e < 4; ++e) { o0[e] = gv[e] * sigmoidf_(acc[ai][bj][m][0][e] + b0[e]) * sz[e]; o1[e] = gv[4 + e] * sigmoidf_(acc[ai][bj][m][1][e] + b1[e]) * sz[4 + e]; }
                    *(u32x4*)(A2 + (size_t)row * KOUT + col) = pack8(o0, o1); } }
    }
};

struct EpiSlab {
    static constexpr bool PERM = false, AFTER_DRAIN = false;
    float* S; int ldc; int row0; size_t kstride;
    __device__ __forceinline__ void operator()(const f32x4 (&acc)[2][2][4][2], const Unit& u, int wr, int wc, int fr, int fq) const {
        float* base = S + (size_t)u.ks * kstride + (size_t)(u.pm * 256 + wr * 64 + fr - row0) * ldc + 256 * u.pn + 32 * wc + 8 * fq;
#pragma unroll
        for (int ai = 0; ai < 2; ++ai)
#pragma unroll
            for (int m = 0; m < 4; ++m)
                { float* o = base + (size_t)(ai * 128 + m * 16) * ldc; *(f32x4*)o = acc[ai][0][m][0]; *(f32x4*)(o + 4) = acc[ai][0][m][1]; *(f32x4*)(o + 128) = acc[ai][1][m][0]; *(f32x4*)(o + 132) = acc[ai][1][m][1];
                  asm volatile("" ::: "memory"); }
    }
};

#ifndef PROBE_EPI2
#define PROBE_EPI2 0
#endif
template <class E_> struct EpiTwice { static constexpr bool PERM = false, AFTER_DRAIN = false; E_ e;
    __device__ __forceinline__ void operator()(const f32x4 (&acc)[2][2][4][2], const Unit& u, int wr, int wc, int fr, int fq) const { e(acc, u, wr, wc, fr, fq); asm volatile("" ::: "memory"); e(acc, u, wr, wc, fr, fq); } };

struct Frame {
    LAS unsigned char* lds; int tid, lane, wave, G, bid;
    const float* const* in; float* out; unsigned char* ws;
};

struct WItem { const float* W; const float* gs; bf16_t* WT; int K, N, kind, r; };
__device__ __forceinline__ WItem witem(Frame& F, int it) {
    constexpr int I_A = 16 * (NIN_A / 32), I_B = 16 * (NIN_B / 32), I_C = 16 * (NIN_C / 32), I_O = (KOUT / 64) * (DM / 32), I_KV = 16 * (DM / 32);
    unsigned char* ws = F.ws; int r = it; WItem w;
    if (r < 2 * I_A) { const int j = r / I_A; r -= j * I_A; w = WItem{GIN(13) + (size_t)j * DM * NIN_A, GIN(8) + (j == 0 ? 0 : 3) * DM, (bf16_t*)(ws + WS_WINA) + (size_t)j * NIN_A * DM, DM, NIN_A, 0, r}; return w; } r -= 2 * I_A;
    if (r < I_B) { w = WItem{GIN(17), GIN(8) + 1 * DM, (bf16_t*)(ws + WS_WINB), DM, NIN_B, 1, r}; return w; } r -= I_B;
    if (r < I_C) { w = WItem{GIN(19), GIN(8) + 2 * DM, (bf16_t*)(ws + WS_WINC), DM, NIN_C, 2, r}; return w; } r -= I_C;
    if (r < 4 * I_O) { const int j = r / I_O; r -= j * I_O; w = WItem{GIN(12) + (size_t)j * KOUT * DM, nullptr, (bf16_t*)(ws + WS_WOUT) + (size_t)j * DM * KOUT, KOUT, DM, 2, r}; return w; } r -= 4 * I_O;
    if (r < 4 * I_KV) { const int j = r / I_KV; r -= j * I_KV; w = WItem{GIN(11) + (size_t)j * DM * DM, GIN(10) + j * DM, (bf16_t*)(ws + WS_WKV) + (size_t)j * DM * DM, DM, DM, 2, r}; return w; } r -= 4 * I_KV;
    w = WItem{GIN(28), nullptr, (bf16_t*)(ws + WS_WGLU), E_, E_, 2, r}; return w;
}
__device__ __forceinline__ void witem_load(const WItem& w, int lane, f32x4 (&x)[8]) {
    const int nblk = w.N / 32, kb = w.r / nblk, nb = w.r % nblk, k0 = 64 * kb, n0 = 32 * nb, n4 = lane & 7, kr = lane >> 3;
    const int sc = src_col(w.kind, n0 + 4 * n4);
#pragma unroll
    for (int i = 0; i < 8; ++i) x[i] = *(const f32x4*)(w.W + (size_t)(k0 + kr + 8 * i) * w.N + sc);
}
__device__ __forceinline__ void witem_finish(const WItem& w, int lane, const f32x4 (&x)[8], LAS float* scr) {
    const int nblk = w.N / 32, kb = w.r / nblk, nb = w.r % nblk, k0 = 64 * kb, n0 = 32 * nb, n4 = lane & 7, kr = lane >> 3;
    asm volatile("s_waitcnt vmcnt(8)" ::: "memory");
#pragma unroll
    for (int i = 0; i < 8; ++i) { const int kk = kr + 8 * i; const float g = w.gs ? w.gs[k0 + kk] : 1.f; LAS float* d = scr + kk * 33 + 4 * n4; d[0] = x[i][0] * g; d[1] = x[i][1] * g; d[2] = x[i][2] * g; d[3] = x[i][3] * g; }
    asm volatile("s_waitcnt lgkmcnt(0)" ::: "memory");
    const int c = lane & 7;
#pragma unroll
    for (int j = 0; j < 4; ++j) { const int n = (lane >> 3) + 8 * j; const LAS float* sp = scr + (8 * c) * 33 + n;
        u32x4 o; o.x = pk2(sp[0 * 33], sp[1 * 33]); o.y = pk2(sp[2 * 33], sp[3 * 33]); o.z = pk2(sp[4 * 33], sp[5 * 33]); o.w = pk2(sp[6 * 33], sp[7 * 33]);
        *(u32x4*)(w.WT + (size_t)(n0 + n) * w.K + k0 + 8 * c) = o; }
    asm volatile("s_waitcnt lgkmcnt(0)" ::: "memory");
}

__device__ __forceinline__ void p0_prologue(Frame& F) {
    LAS float* scr = (LAS float*)(F.lds + F.wave * 16384);
    const int gw = F.bid * NWAVES + F.wave, NGW = F.G * NWAVES, lane = F.lane;
    unsigned char* ws = F.ws;
    constexpr int NITEMS = 2 * 16 * (NIN_A / 32) + 16 * (NIN_B / 32) + 16 * (NIN_C / 32) + 4 * (KOUT / 64) * (DM / 32) + 4 * 16 * (DM / 32) + (E_ / 64) * (E_ / 32);
    if (gw < NITEMS) {
        WItem wc = witem(F, gw); f32x4 xa[8]; witem_load(wc, lane, xa);
        for (int it = gw; it < NITEMS; it += NGW) {
            const int nit = it + NGW < NITEMS ? it + NGW : it; const WItem wn = witem(F, nit); f32x4 xb[8]; witem_load(wn, lane, xb);
            witem_finish(wc, lane, xa, scr);
            wc = wn;
#pragma unroll
            for (int i = 0; i < 8; ++i) xa[i] = xb[i];
        }
    }
    {
        bf16_t* XB = (bf16_t*)(ws + WS_XB); float* SSX = (float*)(ws + WS_SSX);
        for (int row = gw; row < M; row += 2 * NGW) {
            const int row2 = row + NGW < M ? row + NGW : row;
            const float* xr = row < MP ? GIN(0) + (size_t)row * DM : GIN(1) + (size_t)(row - MP) * DM;
            const float* xr2 = row2 < MP ? GIN(0) + (size_t)row2 * DM : GIN(1) + (size_t)(row2 - MP) * DM;
            f32x4 v[4], v2[4];
#pragma unroll
            for (int j = 0; j < 4; ++j) { v[j] = *((const f32x4*)xr + lane + 64 * j); v2[j] = *((const f32x4*)xr2 + lane + 64 * j); }
            float ss = 0.f, ss2 = 0.f;
#pragma unroll
            for (int j = 0; j < 4; ++j) { ss += (v[j][0] * v[j][0] + v[j][1] * v[j][1]) + (v[j][2] * v[j][2] + v[j][3] * v[j][3]); ss2 += (v2[j][0] * v2[j][0] + v2[j][1] * v2[j][1]) + (v2[j][2] * v2[j][2] + v2[j][3] * v2[j][3]);
                u32x2 w; w.x = pk2(v[j][0], v[j][1]); w.y = pk2(v[j][2], v[j][3]); *((u32x2*)(XB + (size_t)row * DM) + lane + 64 * j) = w;
                u32x2 w2; w2.x = pk2(v2[j][0], v2[j][1]); w2.y = pk2(v2[j][2], v2[j][3]); *((u32x2*)(XB + (size_t)row2 * DM) + lane + 64 * j) = w2; }
            asm volatile("s_waitcnt vmcnt(0)" ::: "memory");
            ss = wave_sum(ss); ss2 = wave_sum(ss2);
            if (lane < 16) { SSX[(size_t)row * 16 + lane] = lane == 0 ? ss : 0.f; SSX[(size_t)row2 * 16 + lane] = lane == 0 ? ss2 : 0.f; }
        }
    }
    {
        bf16_t* MB = (bf16_t*)(ws + WS_MEMB); float* RM = (float*)(ws + WS_RSTDM);
        for (int row = gw; row < PB * MEML; row += NGW) {
            const float* xr = GIN(2) + (size_t)row * DM; float ss = 0.f;
#pragma unroll
            for (int j = 0; j < 4; ++j) { const f32x4 v = *((const f32x4*)xr + lane + 64 * j); ss += (v[0] * v[0] + v[1] * v[1]) + (v[2] * v[2] + v[3] * v[3]);
                u32x2 w; w.x = pk2(v[0], v[1]); w.y = pk2(v[2], v[3]); *((u32x2*)(MB + (size_t)row * DM) + lane + 64 * j) = w; }
            asm volatile("s_waitcnt vmcnt(0)" ::: "memory");
            ss = wave_sum(ss);
            if (lane == 0) RM[row] = 1.0f / sqrtf(ss * (1.f / DM) + EPS);
        }
    }
    {
        float* TAB = (float*)(ws + WS_TAB);
        for (int g = gw; g < S5G; g += NGW) {
            const int gp = g * S5P + lane;
            const float lr = GIN(20)[gp], li = GIN(21)[gp], dt = expf(GIN(22)[g]);
            const float th = li * dt, em1 = expm1f(lr * dt), mag = em1 + 1.f, cs = cosf(th), sn = sinf(th), sh = sinf(0.5f * th);
            const float ar = mag * cs, ai = mag * sn;
            const float nr = em1 * cs - 2.f * sh * sh, ni = ai;
            const float den = lr * lr + li * li, cr = (nr * lr + ni * li) / den, ci = (ni * lr - nr * li) / den;
            TAB[T_AR + gp] = ar; TAB[T_AI + gp] = ai;
#pragma unroll
            for (int i = 0; i < S5I; ++i) { const float br = GIN(23)[(size_t)gp * S5I + i], bi = GIN(24)[(size_t)gp * S5I + i];
                TAB[T_BBR + (size_t)gp * S5I + i] = cr * br - ci * bi; TAB[T_BBI + (size_t)gp * S5I + i] = cr * bi + ci * br; }
        }
    }
    {
        bf16_t* SW = (bf16_t*)(ws + WS_SGUW);
        for (int i = (F.bid * NTHR + F.tid); i < 2 * 8 * 128 * 128; i += F.G * NTHR) { const int t = (i >> 7) & 127, s = i & 127; SW[i] = f2bf(s <= t ? GIN(15)[i] : 0.f); }
    }
}

typedef short v4i16_t __attribute__((ext_vector_type(4)));
constexpr int SG_VSTR = 576, SG_WSTR = 272, SG_WOFF = 128 * SG_VSTR, SG_ROFF = SG_WOFF + 128 * SG_WSTR;
static_assert(SG_ROFF + 1024 <= RING_BYTES, "sgu LDS");
__device__ __forceinline__ void sgu_phase_mfma(Frame& F, int j) {
    const bf16_t* UZ = (const bf16_t*)(F.ws + WS_B0); const bf16_t* VR = (const bf16_t*)(F.ws + WS_B1); const float* SSV = (const float*)(F.ws + WS_SSV);
    const bf16_t* SW = (const bf16_t*)(F.ws + WS_SGUW) + (size_t)j * 8 * 128 * 128; bf16_t* A2 = (bf16_t*)(F.ws + WS_A2);
    const float* gn = GIN(14) + (size_t)j * E_; const float* bsv = GIN(16) + (size_t)j * 8 * 128;
    LAS unsigned char* lds = F.lds; LAS float* rsl = (LAS float*)(lds + SG_ROFF);
    const int tid = F.tid, lane = F.lane, wid = F.wave, c = lane & 31, hh = lane >> 5;
    const bool same_g = (F.G & 7) == 0; int gld = -1, cur = 0;
    u32x4 vr[8];
    { const int un = F.bid; if (un < 128 * 8) { const int rbase = (un >> 3) * 128, g = un & 7;
#pragma unroll
        for (int i = 0; i < 8; ++i) { const int chn = tid + NTHR * i; vr[i] = *(const u32x4*)(VR + (size_t)(rbase + (chn >> 5)) * E_ + 256 * g + 8 * (chn & 31)); }
        __syncthreads();
        if (tid < 128) { const float* p = SSV + (size_t)(rbase + tid) * 32; float sq = 0.f;
#pragma unroll
            for (int k = 0; k < 8; ++k) { const f32x4 v = *((const f32x4*)p + k); sq += (v[0] + v[1]) + (v[2] + v[3]); }
            rsl[tid] = __builtin_amdgcn_rsqf(sq * (1.f / E_) + EPS); } } }
    for (int un = F.bid; un < 128 * 8; un += F.G) {
        const int ch = un >> 3, g = un & 7, rbase = ch * 128; const int nun = un + F.G < 128 * 8 ? un + F.G : un, nrb = (nun >> 3) * 128, ng = nun & 7;
        asm volatile("s_waitcnt vmcnt(0)" ::: "memory");
        __syncthreads();
        if (!same_g || gld != g) { gld = g;
#pragma unroll
            for (int i = 0; i < 4; ++i) { const int chn = tid + NTHR * i, row = chn >> 4, c16 = chn & 15;
                *(LAS u32x4*)(lds + SG_WOFF + row * SG_WSTR + c16 * 16) = *(const u32x4*)(SW + (size_t)g * 128 * 128 + row * 128 + c16 * 8); } }
#pragma unroll
        for (int i = 0; i < 8; ++i) { const int chn = tid + NTHR * i, sr = chn >> 5, c8 = chn & 31; float v[8]; unpack8(vr[i], v);
            const float r = rsl[cur * 128 + sr]; const f32x4 g0 = *(const f32x4*)(gn + 256 * g + 8 * c8), g1 = *(const f32x4*)(gn + 256 * g + 8 * c8 + 4); f32x4 a, b2;
#pragma unroll
            for (int e = 0; e < 4; ++e) { a[e] = v[e] * r * g0[e]; b2[e] = v[4 + e] * r * g1[e]; }
            *(LAS u32x4*)(lds + sr * SG_VSTR + c8 * 16) = pack8(a, b2); }
#pragma unroll
        for (int i = 0; i < 8; ++i) { const int chn = tid + NTHR * i; vr[i] = *(const u32x4*)(VR + (size_t)(nrb + (chn >> 5)) * E_ + 256 * ng + 8 * (chn & 31)); }
        if (tid < 128) { const float* p = SSV + (size_t)(nrb + tid) * 32; float sq = 0.f;
#pragma unroll
            for (int k = 0; k < 8; ++k) { const f32x4 v = *((const f32x4*)p + k); sq += (v[0] + v[1]) + (v[2] + v[3]); }
            rsl[(cur ^ 1) * 128 + tid] = __builtin_amdgcn_rsqf(sq * (1.f / E_) + EPS); }
        u32x2 uzr[4][4];
#pragma unroll
        for (int ti = 0; ti < 4; ++ti)
#pragma unroll
            for (int g4 = 0; g4 < 4; ++g4) uzr[ti][g4] = *(const u32x2*)(UZ + (size_t)(rbase + 32 * ti + c) * E_ + 256 * g + 32 * wid + 8 * g4 + 4 * hh);
        __syncthreads();
        f32x16 acc[4];
#pragma unroll
        for (int ti = 0; ti < 4; ++ti) acc[ti] = (f32x16){};
        const LAS unsigned char* abase = lds + (8 * hh + ((lane & 15) >> 2)) * SG_VSTR + (32 * wid + 16 * ((lane >> 4) & 1) + 4 * (lane & 3)) * 2;
#pragma unroll
        for (int s2 = 0; s2 < 8; ++s2) {
            const v4i16_t lo = __builtin_amdgcn_ds_read_tr16_b64_v4i16((LAS v4i16_t*)(abase + (16 * s2) * SG_VSTR));
            const v4i16_t hi = __builtin_amdgcn_ds_read_tr16_b64_v4i16((LAS v4i16_t*)(abase + (16 * s2 + 4) * SG_VSTR));
            const bf16x8 a = (bf16x8){lo[0], lo[1], lo[2], lo[3], hi[0], hi[1], hi[2], hi[3]};
#pragma unroll
            for (int ti = s2 >> 1; ti < 4; ++ti) { const bf16x8 b = *(const LAS bf16x8*)(lds + SG_WOFF + (32 * ti + c) * SG_WSTR + (16 * s2 + 8 * hh) * 2);
                acc[ti] = __builtin_amdgcn_mfma_f32_32x32x16_bf16(a, b, acc[ti], 0, 0, 0); }
        }
#pragma unroll
        for (int ti = 0; ti < 4; ++ti) { const int t = 32 * ti + c; const size_t row = (size_t)(rbase + t); const float bias = bsv[g * 128 + t];
#pragma unroll
            for (int g4 = 0; g4 < 4; ++g4) { const int d = 256 * g + 32 * wid + 8 * g4 + 4 * hh; const u32x2 uz = uzr[ti][g4];
                u32x2 w; w.x = pk2(bflo(uz.x) * (acc[ti][4 * g4] + bias), bfhi(uz.x) * (acc[ti][4 * g4 + 1] + bias)); w.y = pk2(bflo(uz.y) * (acc[ti][4 * g4 + 2] + bias), bfhi(uz.y) * (acc[ti][4 * g4 + 3] + bias));
                *(u32x2*)(A2 + row * KOUT + d) = w; } }
        cur ^= 1;
    }
}

__device__ __forceinline__ void sgu_sample_phase(Frame& F, int j) {
    const bf16_t* UZ = (const bf16_t*)(F.ws + WS_B0); const bf16_t* VR = (const bf16_t*)(F.ws + WS_B1); const float* SSV = (const float*)(F.ws + WS_SSV);
    const bf16_t* SW = (const bf16_t*)(F.ws + WS_SGUW) + (size_t)j * 8 * 128 * 128; bf16_t* A2 = (bf16_t*)(F.ws + WS_A2);
    const float* gn = GIN(14) + (size_t)j * E_; const float* bsv = GIN(16) + (size_t)j * 8 * 128; float* cvout = F.out + O_CV + (size_t)j * SBT * SSEQ * E_;
    const int gw = F.bid * NWAVES + F.wave, NGW = F.G * NWAVES, lane = F.lane;
    for (int task = gw; task < SBT * 8; task += NGW) {
        const int b = task >> 3, g = task & 7; const size_t r0 = (size_t)MP + b * SSEQ; const int ch = 256 * g + 4 * lane;
        float rs[SSEQ];
#pragma unroll
        for (int t = 0; t < SSEQ; ++t) { float v = lane < 32 ? SSV[(r0 + t) * 32 + lane] : 0.f; v = wave_sum(v); rs[t] = __builtin_amdgcn_rsqf(v * (1.f / E_) + EPS); }
        const f32x4 g4 = *(const f32x4*)(gn + ch);
        f32x4 vn[SSEQ];
#pragma unroll
        for (int t = 0; t < SSEQ; ++t) { const u32x2 w = *(const u32x2*)(VR + (r0 + t) * E_ + ch); const f32x4 v = (f32x4){bflo(w.x), bfhi(w.x), bflo(w.y), bfhi(w.y)}; vn[t] = v * rs[t] * g4;
            *(f32x4*)(cvout + (size_t)(b * SSEQ + t) * E_ + ch) = vn[t];
            u32x2 q; q.x = pk2(vn[t][0], vn[t][1]); q.y = pk2(vn[t][2], vn[t][3]); vn[t] = (f32x4){bflo(q.x), bfhi(q.x), bflo(q.y), bfhi(q.y)}; }
#pragma unroll
        for (int t = 0; t < SSEQ; ++t) { f32x4 a = {0.f, 0.f, 0.f, 0.f};
#pragma unroll
            for (int sq = 0; sq <= t; ++sq) a += vn[sq] * bf2f(SW[(size_t)g * 128 * 128 + t * 128 + sq]);
            a += bsv[g * 128 + t];
            const u32x2 uz = *(const u32x2*)(UZ + (r0 + t) * E_ + ch);
            u32x2 w; w.x = pk2(bflo(uz.x) * a[0], bfhi(uz.x) * a[1]); w.y = pk2(bflo(uz.y) * a[2], bfhi(uz.y) * a[3]);
            *(u32x2*)(A2 + (r0 + t) * KOUT + ch) = w; }
    }
}

__device__ __forceinline__ void conv_phase(Frame& F) {
    const bf16_t* P = (const bf16_t*)(F.ws + WS_B0); const bf16_t* G = (const bf16_t*)(F.ws + WS_B1); bf16_t* A2 = (bf16_t*)(F.ws + WS_A2);
    const float* cw = GIN(18); const float* st = GIN(5);
    constexpr int NFIX = (MP / 64) * 256, NSMP = (MS / 32) * 256;
    for (int i = F.bid * NTHR + F.tid; i < NFIX + NSMP; i += F.G * NTHR) {
        const bool fix = i < NFIX; const int j = fix ? i : i - NFIX;
        const int c0 = (j & 255) * 8, r0 = fix ? (j >> 8) * 64 : MP + (j >> 8) * 32, nr = fix ? 2 : 32;
        float w0[8], w1[8], w2[8];
#pragma unroll
        for (int e = 0; e < 8; ++e) { w0[e] = cw[c0 + e]; w1[e] = cw[E_ + c0 + e]; w2[e] = cw[2 * E_ + c0 + e]; }
        float x1[8], x2[8];
#pragma unroll
        for (int e = 0; e < 8; ++e) { x1[e] = 0.f; x2[e] = 0.f; }
        if (fix && (r0 & (PSEQ - 1)) != 0) { unpack8(*(const u32x4*)(P + (size_t)(r0 - 1) * E_ + c0), x1); unpack8(*(const u32x4*)(P + (size_t)(r0 - 2) * E_ + c0), x2); }
#pragma unroll 2
        for (int rr = 0; rr < nr; ++rr) {
            const int row = r0 + rr;
            if (row >= MP && ((row - MP) & 3) == 0) { const float* buf = st + (size_t)((row - MP) >> 2) * 2 * E_ + c0;
                for (int e = 0; e < 8; ++e) { x2[e] = buf[e]; x1[e] = buf[E_ + e]; } }
            float x0[8], gg[8]; unpack8(*(const u32x4*)(P + (size_t)row * E_ + c0), x0); unpack8(*(const u32x4*)(G + (size_t)row * E_ + c0), gg);
            f32x4 o0, o1;
#pragma unroll
            for (int e = 0; e < 8; ++e) { const float y = w0[e] * x2[e] + w1[e] * x1[e] + w2[e] * x0[e]; const float r = y * gg[e]; if (e < 4) o0[e] = r; else o1[e - 4] = r; x2[e] = x1[e]; x1[e] = x0[e]; }
            *(u32x4*)(A2 + (size_t)row * KOUT + c0) = pack8(o0, o1);
        }
    }
}

#if XHALF_SHFL
__device__ __forceinline__ void xhalf(float v, float& lo, float& hi) { const int l_ = threadIdx.x & 31; lo = __shfl(v, l_); hi = __shfl(v, l_ + 32); }
#else
__device__ __forceinline__ void xhalf(float v, float& lo, float& hi) { auto rr = __builtin_amdgcn_permlane32_swap(__float_as_uint(v), __float_as_uint(v), false, false); lo = __uint_as_float(rr[0]); hi = __uint_as_float(rr[1]);
 }
#endif
__device__ __forceinline__ void cmuladd(float& xr, float& xi, float ar, float ai, float pr, float pi) { float t = fmaf(-ai, pi, xr); asm("" : "+v"(t)); xr = fmaf(ar, pr, t); xi = fmaf(ar, pi, fmaf(ai, pr, xi)); }
constexpr int S5_HSTR = 272, S5_UOFF = 32 * S5_HSTR, S5_OOFF = S5_UOFF + 1024, S5_HT = S5_OOFF + 4096;
__device__ __forceinline__ void s5_prompt_mfma(Frame& F) {
    const bf16_t* U = (const bf16_t*)(F.ws + WS_B0); bf16_t* GBo = (bf16_t*)(F.ws + WS_GB); const float* TAB = (const float*)(F.ws + WS_TAB);
    const float* cre = GIN(25); const float* cim = GIN(26); const float* dsk = GIN(27);
    const int lane = F.lane, wid = F.wave, c = lane & 31, hh = lane >> 5, col = lane & 15, fq = lane >> 4;
    LAS unsigned char* ht = F.lds + wid * S5_HT;
    for (int task = F.bid * NWAVES + wid; task < PB * S5G; task += F.G * NWAVES) {
        const int b = task >> 7, g = task & 127;
        bf16x8 bfr[2], bfi[2];
#pragma unroll
        for (int st = 0; st < 2; ++st) { const int gp = g * S5P + 32 * st + c;
            const float* pr = TAB + T_BBR + (size_t)gp * 16 + 8 * hh; const float* pi = TAB + T_BBI + (size_t)gp * 16 + 8 * hh;
            bfr[st] = __builtin_bit_cast(bf16x8, pack8(*(const f32x4*)pr, *(const f32x4*)(pr + 4))); bfi[st] = __builtin_bit_cast(bf16x8, pack8(*(const f32x4*)pi, *(const f32x4*)(pi + 4))); }
        const float a1r = TAB[T_AR + g * S5P + lane], a1i = TAB[T_AI + g * S5P + lane];
        bf16x8 cf[4];
#pragma unroll
        for (int s4 = 0; s4 < 4; ++s4) { const size_t o = ((size_t)g * 16 + col) * S5P + 16 * s4 + 4 * fq; const f32x4 cr4 = *(const f32x4*)(cre + o), ci4 = *(const f32x4*)(cim + o);
            u32x4 w; w.x = pk2(cr4[0], -ci4[0]); w.y = pk2(cr4[1], -ci4[1]); w.z = pk2(cr4[2], -ci4[2]); w.w = pk2(cr4[3], -ci4[3]); cf[s4] = __builtin_bit_cast(bf16x8, w); }
        const f32x4 d4 = *(const f32x4*)(dsk + 16 * g + 4 * fq);
        float er = 0.f, ei = 0.f;
        const bf16_t* up = U + ((size_t)b * PSEQ + c) * E_ + 16 * g + 8 * hh;
        bf16x8 ub[4];
#pragma unroll
        for (int q = 0; q < 4; ++q) ub[q] = *(const GAS bf16x8*)(up + (size_t)q * 32 * E_);
        for (int tg = 0; tg < PSEQ / 128; ++tg) {
          bf16x8 nb[4];
#pragma unroll
          for (int q = 0; q < 4; ++q) nb[q] = *(const GAS bf16x8*)(up + (size_t)(4 * (tg + 1 < PSEQ / 128 ? tg + 1 : tg) + q) * 32 * E_);
#pragma unroll
          for (int q = 0; q < 4; ++q) {
            const int ti = 4 * tg + q; const bf16x8 ua = ub[q];
            *(LAS bf16x8*)(ht + S5_UOFF + c * 32 + hh * 16) = ua;
            {
                const f32x16 x0r = __builtin_amdgcn_mfma_f32_32x32x16_bf16(ua, bfr[0], (f32x16){}, 0, 0, 0);
                const f32x16 x1r = __builtin_amdgcn_mfma_f32_32x32x16_bf16(ua, bfr[1], (f32x16){}, 0, 0, 0);
                const f32x16 x0i = __builtin_amdgcn_mfma_f32_32x32x16_bf16(ua, bfi[0], (f32x16){}, 0, 0, 0);
                const f32x16 x1i = __builtin_amdgcn_mfma_f32_32x32x16_bf16(ua, bfi[1], (f32x16){}, 0, 0, 0);
#pragma unroll
                for (int k = 0; k < 4; ++k) {
                    float tr[8], tq[8];
#pragma unroll
                    for (int jj = 0; jj < 4; ++jj) {
                        auto sr = __builtin_amdgcn_permlane32_swap(__float_as_uint(x0r[4 * k + jj]), __float_as_uint(x1r[4 * k + jj]), false, false);
                        auto sq = __builtin_amdgcn_permlane32_swap(__float_as_uint(x0i[4 * k + jj]), __float_as_uint(x1i[4 * k + jj]), false, false);
                        tr[jj] = __uint_as_float(sr[0]); tr[4 + jj] = __uint_as_float(sr[1]); tq[jj] = __uint_as_float(sq[0]); tq[4 + jj] = __uint_as_float(sq[1]); }
#pragma unroll
                    for (int j = 0; j < 8; ++j) { float nr = tr[j], ni = tq[j]; cmuladd(nr, ni, a1r, a1i, er, ei); er = nr; ei = ni;
                        *(LAS unsigned*)(ht + (8 * k + j) * S5_HSTR + 4 * lane) = pk2(er, ei); }
                }
            }
            asm volatile("" ::: "memory");
#pragma unroll
            for (int tt = 0; tt < 2; ++tt) {
                f32x4 y = {0.f, 0.f, 0.f, 0.f};
#pragma unroll
                for (int s4 = 0; s4 < 4; ++s4) { const bf16x8 hb = *(const LAS bf16x8*)(ht + (16 * tt + col) * S5_HSTR + (32 * s4 + 8 * fq) * 2); y = __builtin_amdgcn_mfma_f32_16x16x32_bf16(cf[s4], hb, y, 0, 0, 0); }
                const size_t row = (size_t)b * PSEQ + 32 * ti + 16 * tt + col; const u32x2 uw = *(const LAS u32x2*)(ht + S5_UOFF + (16 * tt + col) * 32 + fq * 8);
                u32x2 w; w.x = pk2(gelu_tanh(y[0] + d4[0] * bflo(uw.x)), gelu_tanh(y[1] + d4[1] * bfhi(uw.x))); w.y = pk2(gelu_tanh(y[2] + d4[2] * bflo(uw.y)), gelu_tanh(y[3] + d4[3] * bfhi(uw.y)));
                *(LAS u32x2*)(ht + S5_OOFF + q * 1024 + (16 * tt + col) * 32 + fq * 8) = w;
            }
            asm volatile("" ::: "memory");
          }
#pragma unroll
          for (int q = 0; q < 4; ++q)
#pragma unroll
            for (int tt = 0; tt < 2; ++tt) *(GAS u32x2*)(GBo + ((size_t)b * PSEQ + 32 * (4 * tg + q) + 16 * tt + col) * E_ + 16 * g + 4 * fq) = *(const LAS u32x2*)(ht + S5_OOFF + q * 1024 + (16 * tt + col) * 32 + fq * 8);
          asm volatile("s_waitcnt vmcnt(0)" ::: "memory");
#pragma unroll
          for (int q = 0; q < 4; ++q) ub[q] = nb[q];
        }
        const size_t so = ((size_t)b * S5G + g) * S5P + lane;
        F.out[O_SRP + so] = er; F.out[O_SIP + so] = ei;
    }
}

__device__ __forceinline__ void s5_sample_mfma(Frame& F) {
    const bf16_t* U = (const bf16_t*)(F.ws + WS_B0); bf16_t* GBo = (bf16_t*)(F.ws + WS_GB); const float* TAB = (const float*)(F.ws + WS_TAB);
    const float* cre = GIN(25); const float* cim = GIN(26); const float* dsk = GIN(27); const float* h0re = GIN(6); const float* h0im = GIN(7);
    const int lane = F.lane, wid = F.wave, c = lane & 31, hh = lane >> 5, col = lane & 15, fq = lane >> 4;
    LAS unsigned char* ht = F.lds + wid * S5_HT;
    for (int task = F.bid * NWAVES + wid; task < S5G * (MS / 64); task += F.G * NWAVES) {
        const int g = task & (S5G - 1), tp = task >> 7;
        bf16x8 bfr[2], bfi[2];
#pragma unroll
        for (int st = 0; st < 2; ++st) { const int gp = g * S5P + 32 * st + c;
            const float* pr = TAB + T_BBR + (size_t)gp * 16 + 8 * hh; const float* pi = TAB + T_BBI + (size_t)gp * 16 + 8 * hh;
            bfr[st] = __builtin_bit_cast(bf16x8, pack8(*(const f32x4*)pr, *(const f32x4*)(pr + 4))); bfi[st] = __builtin_bit_cast(bf16x8, pack8(*(const f32x4*)pi, *(const f32x4*)(pi + 4))); }
        const float a1r = TAB[T_AR + g * S5P + lane], a1i = TAB[T_AI + g * S5P + lane];
        bf16x8 cf[4];
#pragma unroll
        for (int s4 = 0; s4 < 4; ++s4) { const size_t o = ((size_t)g * 16 + col) * S5P + 16 * s4 + 4 * fq; const f32x4 cr4 = *(const f32x4*)(cre + o), ci4 = *(const f32x4*)(cim + o);
            u32x4 w; w.x = pk2(cr4[0], -ci4[0]); w.y = pk2(cr4[1], -ci4[1]); w.z = pk2(cr4[2], -ci4[2]); w.w = pk2(cr4[3], -ci4[3]); cf[s4] = __builtin_bit_cast(bf16x8, w); }
        const f32x4 d4 = *(const f32x4*)(dsk + 16 * g + 4 * fq);
#pragma unroll 1
        for (int q = 0; q < 2; ++q) {
            const int tile = 2 * tp + q; const bf16x8 ua = *(const GAS bf16x8*)(U + ((size_t)MP + 32 * tile + c) * E_ + 16 * g + 8 * hh);
            float sr[8], sq[8];
#pragma unroll
            for (int rr = 0; rr < 8; ++rr) { const size_t so = ((size_t)(8 * tile + rr) * S5G + g) * S5P + lane; sr[rr] = *(const GAS float*)(h0re + so); sq[rr] = *(const GAS float*)(h0im + so); }
            *(LAS bf16x8*)(ht + S5_UOFF + c * 32 + hh * 16) = ua;
            {
                const f32x16 x0r = __builtin_amdgcn_mfma_f32_32x32x16_bf16(ua, bfr[0], (f32x16){}, 0, 0, 0);
                const f32x16 x1r = __builtin_amdgcn_mfma_f32_32x32x16_bf16(ua, bfr[1], (f32x16){}, 0, 0, 0);
                const f32x16 x0i = __builtin_amdgcn_mfma_f32_32x32x16_bf16(ua, bfi[0], (f32x16){}, 0, 0, 0);
                const f32x16 x1i = __builtin_amdgcn_mfma_f32_32x32x16_bf16(ua, bfi[1], (f32x16){}, 0, 0, 0);
#pragma unroll
                for (int k = 0; k < 4; ++k) {
                    float tr[8], tq[8];
#pragma unroll
                    for (int jj = 0; jj < 4; ++jj) {
                        auto s_r = __builtin_amdgcn_permlane32_swap(__float_as_uint(x0r[4 * k + jj]), __float_as_uint(x1r[4 * k + jj]), false, false);
                        auto s_q = __builtin_amdgcn_permlane32_swap(__float_as_uint(x0i[4 * k + jj]), __float_as_uint(x1i[4 * k + jj]), false, false);
                        tr[jj] = __uint_as_float(s_r[0]); tr[4 + jj] = __uint_as_float(s_r[1]); tq[jj] = __uint_as_float(s_q[0]); tq[4 + jj] = __uint_as_float(s_q[1]); }
#pragma unroll
                    for (int j = 0; j < 8; ++j) { const int rr = 2 * k + (j >> 2); float nr = tr[j], ni = tq[j]; cmuladd(nr, ni, a1r, a1i, sr[rr], sq[rr]); sr[rr] = nr; sq[rr] = ni;
                        *(LAS unsigned*)(ht + (8 * k + j) * S5_HSTR + 4 * lane) = pk2(nr, ni); }
                }
            }
            asm volatile("s_waitcnt vmcnt(0)" ::: "memory");
            u32x2 w[2];
#pragma unroll
            for (int tt = 0; tt < 2; ++tt) {
                f32x4 y = {0.f, 0.f, 0.f, 0.f};
#pragma unroll
                for (int s4 = 0; s4 < 4; ++s4) { const bf16x8 hb = *(const LAS bf16x8*)(ht + (16 * tt + col) * S5_HSTR + (32 * s4 + 8 * fq) * 2); y = __builtin_amdgcn_mfma_f32_16x16x32_bf16(cf[s4], hb, y, 0, 0, 0); }
                const u32x2 uw = *(const LAS u32x2*)(ht + S5_UOFF + (16 * tt + col) * 32 + fq * 8);
                w[tt].x = pk2(gelu_tanh(y[0] + d4[0] * bflo(uw.x)), gelu_tanh(y[1] + d4[1] * bfhi(uw.x))); w[tt].y = pk2(gelu_tanh(y[2] + d4[2] * bflo(uw.y)), gelu_tanh(y[3] + d4[3] * bfhi(uw.y)));
            }
            asm volatile("s_waitcnt lgkmcnt(0)" ::: "memory");
#pragma unroll
            for (int tt = 0; tt < 2; ++tt) *(GAS u32x2*)(GBo + ((size_t)MP + 32 * tile + 16 * tt + col) * E_ + 16 * g + 4 * fq) = w[tt];
#pragma unroll
            for (int rr = 0; rr < 8; ++rr) { const size_t so = ((size_t)(8 * tile + rr) * S5G + g) * S5P + lane; *(GAS float*)(F.out + O_SRS + so) = sr[rr]; *(GAS float*)(F.out + O_SIS + so) = sq[rr]; }
        }
        asm volatile("s_waitcnt vmcnt(0)" ::: "memory");
    }
}

constexpr int AK_STR = 272, AV_STR = 520, AV_OFF = 256 * AK_STR;
static_assert(AV_OFF + 128 * AV_STR <= RING_BYTES + 8192, "attention LDS");
__device__ __forceinline__ void attn_prompt_phase(Frame& F, int layer) {
    const bf16_t* QB = (const bf16_t*)(F.ws + WS_QB); const bf16_t* KBp = (const bf16_t*)(F.ws + WS_KB); const bf16_t* VTp = (const bf16_t*)(F.ws + WS_VT); bf16_t* A2 = (bf16_t*)(F.ws + WS_A2);
    const int tid = F.tid, lane = F.lane, wid = F.wave, c = lane & 31, hh = lane >> 5;
    LAS unsigned char* lds = F.lds;
    for (int un = F.bid; un < PB * NH * 8; un += F.G) {
        const int bh = un >> 3, qb = un & 7, b = bh >> 2, h = bh & 3;
        const bf16_t* Kg = KBp + (size_t)((layer * PB + b) * NH + h) * MEML * HD; const bf16_t* Vg = VTp + (size_t)((layer * PB + b) * NH + h) * MEML * HD;
        __syncthreads();
        { u32x4 kr[8], vr[8];
#pragma unroll
          for (int i = 0; i < 8; ++i) { const int chn = tid + NTHR * i; kr[i] = *(const u32x4*)(Kg + (chn >> 4) * HD + (chn & 15) * 8); vr[i] = *(const u32x4*)(Vg + (chn >> 5) * MEML + (chn & 31) * 8); }
#pragma unroll
          for (int i = 0; i < 8; ++i) { const int chn = tid + NTHR * i, row = chn >> 4, c16 = chn & 15; *(LAS u32x4*)(lds + row * AK_STR + c16 * 16) = kr[i]; }
#pragma unroll
          for (int i = 0; i < 8; ++i) { const int chn = tid + NTHR * i, row = chn >> 5, c16 = chn & 31; const u32x4 v = vr[i];
            LAS u32x2* p = (LAS u32x2*)(lds + AV_OFF + row * AV_STR + c16 * 16); u32x2 lo, hi; lo.x = v.x; lo.y = v.y; hi.x = v.z; hi.y = v.w; p[0] = lo; p[1] = hi; } }
        __syncthreads();
        const size_t qrow = (size_t)b * PSEQ + qb * 256 + wid * 32 + c;
        f32x16 S[8];
#pragma unroll
        for (int kt = 0; kt < 8; ++kt) S[kt] = (f32x16){};
#pragma unroll
        for (int s = 0; s < 8; ++s) {
            const bf16x8 qf = *(const bf16x8*)(QB + qrow * XA + h * HD + 16 * s + 8 * hh);
#pragma unroll
            for (int kt = 0; kt < 8; ++kt) { const bf16x8 kf = *(const LAS bf16x8*)(lds + (32 * kt + c) * AK_STR + (16 * s + 8 * hh) * 2); S[kt] = __builtin_amdgcn_mfma_f32_32x32x16_bf16(kf, qf, S[kt], 0, 0, 0); }
        }
        float mx = -3.0e38f;
#pragma unroll
        for (int kt = 0; kt < 8; ++kt)
#pragma unroll
            for (int r = 0; r < 16; ++r) mx = fmaxf(mx, S[kt][r]);
        mx = fmaxf(mx, __shfl_xor(mx, 32));
        float sum = 0.f; bf16x8 pf[8][2];
#pragma unroll
        for (int kt = 0; kt < 8; ++kt) {
            float p[16];
#pragma unroll
            for (int r = 0; r < 16; ++r) { p[r] = __expf(S[kt][r] - mx); sum += p[r]; }
#pragma unroll
            for (int s2 = 0; s2 < 2; ++s2) { u32x4 w; w.x = pk2(p[8 * s2], p[8 * s2 + 1]); w.y = pk2(p[8 * s2 + 2], p[8 * s2 + 3]); w.z = pk2(p[8 * s2 + 4], p[8 * s2 + 5]); w.w = pk2(p[8 * s2 + 6], p[8 * s2 + 7]);
                pf[kt][s2] = __builtin_bit_cast(bf16x8, w); }
        }
        sum += __shfl_xor(sum, 32);
        const float inv = 1.f / sum;
        bf16_t* orow = A2 + qrow * KOUT + E_ + h * HD;
#pragma unroll
        for (int dt = 0; dt < 4; ++dt) {
            f32x16 o = {};
#pragma unroll
            for (int kt = 0; kt < 8; ++kt)
#pragma unroll
                for (int s2 = 0; s2 < 2; ++s2) {
                    const LAS unsigned char* vb = lds + AV_OFF + (32 * dt + c) * AV_STR + (32 * kt + 16 * s2 + 4 * hh) * 2;
                    const u32x2 lo = *(const LAS u32x2*)vb, hi = *(const LAS u32x2*)(vb + 16);
                    u32x4 w; w.x = lo.x; w.y = lo.y; w.z = hi.x; w.w = hi.y;
                    o = __builtin_amdgcn_mfma_f32_32x32x16_bf16(__builtin_bit_cast(bf16x8, w), pf[kt][s2], o, 0, 0, 0);
                }
#pragma unroll
            for (int g4 = 0; g4 < 4; ++g4) { u32x2 w; w.x = pk2(o[4 * g4] * inv, o[4 * g4 + 1] * inv); w.y = pk2(o[4 * g4 + 2] * inv, o[4 * g4 + 3] * inv);
                *(u32x2*)(orow + 32 * dt + 8 * g4 + 4 * hh) = w; }
        }
    }
}

__device__ __forceinline__ void attn_sample_phase(Frame& F, int layer) {
    const bf16_t* QB = (const bf16_t*)(F.ws + WS_QB); bf16_t* A2 = (bf16_t*)(F.ws + WS_A2);
    const float* CK = GIN(3) + (size_t)layer * SBT * MEML * XA; const float* CV = GIN(4) + (size_t)layer * SBT * MEML * XA;
    LAS float* sl = (LAS float*)F.lds;
    LAS float* pt = (LAS float*)(F.lds + 4096);
    LAS float* ol = (LAS float*)(F.lds + 8192);
    const int tid = F.tid, lane = F.lane, wid = F.wave, par = lane >> 5, d4 = lane & 31;
    const size_t lane_off = ((size_t)(32 * wid + par) * NH) * HD + 4 * d4;
    const bool b4 = (lane & 16) != 0, b3 = (lane & 8) != 0;
#define AS_Q(q4, b_, h_) do { _Pragma("unroll") for (int qi = 0; qi < 4; ++qi) { const u32x2 w = *(const u32x2*)(QB + (size_t)(MP + (b_) * 4 + qi) * XA + (h_) * HD + 4 * d4); q4[qi] = (f32x4){bflo(w.x), bfhi(w.x), bflo(w.y), bfhi(w.y)}; } } while (0)
#define AS_LOADROWS(dst, base, b_, h_) do { const size_t o_ = (size_t)(b_) * MEML * XA + (size_t)(h_) * HD + lane_off; _Pragma("unroll") for (int j = 0; j < 16; ++j) dst[j] = *(const f32x4*)((base) + o_ + (size_t)j * 2 * XA); } while (0)
#define AS_SCORES(q4) do { _Pragma("unroll") for (int j = 0; j < 16; ++j) { float v[4]; \
            _Pragma("unroll") for (int qi = 0; qi < 4; ++qi) v[qi] = (kr[j][0] * q4[qi][0] + kr[j][1] * q4[qi][1]) + (kr[j][2] * q4[qi][2] + kr[j][3] * q4[qi][3]); \
            const float w0 = (b4 ? v[2] : v[0]) + __shfl_xor(b4 ? v[0] : v[2], 16), w1 = (b4 ? v[3] : v[1]) + __shfl_xor(b4 ? v[1] : v[3], 16); \
            float z = (b3 ? w1 : w0) + __shfl_xor(b3 ? w0 : w1, 8); \
            z += __shfl_xor(z, 4); z += __shfl_xor(z, 2); z += __shfl_xor(z, 1); \
            if ((lane & 7) == 0) sl[(2 * (int)b4 + (int)b3) * 256 + 32 * wid + 2 * j + par] = z; } } while (0)
#define AS_SOFTMAX() do { if (wid < 4) { float v[4], mx = -3.0e38f; \
            _Pragma("unroll") for (int j = 0; j < 4; ++j) { v[j] = sl[wid * 256 + lane + 64 * j]; mx = fmaxf(mx, v[j]); } \
            mx = wave_max(mx); float sm = 0.f; \
            _Pragma("unroll") for (int j = 0; j < 4; ++j) { v[j] = __expf(v[j] - mx); sm += v[j]; } \
            sm = wave_sum(sm); const float inv = 1.f / sm; \
            _Pragma("unroll") for (int j = 0; j < 4; ++j) pt[(lane + 64 * j) * 4 + wid] = v[j] * inv; } } while (0)
#define AS_PV() do { f32x4 o[4]; _Pragma("unroll") for (int qi = 0; qi < 4; ++qi) o[qi] = (f32x4){0.f, 0.f, 0.f, 0.f}; \
            _Pragma("unroll") for (int j = 0; j < 16; ++j) { const f32x4 p = *(const LAS f32x4*)(pt + (32 * wid + 2 * j + par) * 4); \
                _Pragma("unroll") for (int qi = 0; qi < 4; ++qi) o[qi] += vr[j] * p[qi]; } \
            _Pragma("unroll") for (int qi = 0; qi < 4; ++qi) { _Pragma("unroll") for (int e = 0; e < 4; ++e) o[qi][e] += __shfl_xor(o[qi][e], 32); \
                if (par == 0) *(LAS f32x4*)(ol + (wid * 4 + qi) * 128 + 4 * d4) = o[qi]; } } while (0)
#define AS_OUT(b_, h_) do { const int qi = tid >> 7, d = tid & 127; float acc = 0.f; _Pragma("unroll") for (int w = 0; w < 8; ++w) acc += ol[(w * 4 + qi) * 128 + d]; \
            A2[(size_t)(MP + (b_) * 4 + qi) * KOUT + E_ + (h_) * HD + d] = f2bf(acc); } while (0)
    for (int un = F.bid; un < SBT * NH; un += 2 * F.G) {
        const int unb = un + F.G < SBT * NH ? un + F.G : un; const int ba = un >> 2, ha = un & 3, bb = unb >> 2, hb = unb & 3;
        asm volatile("s_waitcnt vmcnt(0)" ::: "memory");
        f32x4 kr[16], vr[16], q4[4];
        AS_LOADROWS(kr, CK, ba, ha); AS_LOADROWS(vr, CV, ba, ha); AS_Q(q4, ba, ha);
        __syncthreads();
        AS_SCORES(q4);
        AS_LOADROWS(kr, CK, bb, hb);
        __syncthreads();
        AS_SOFTMAX();
        __syncthreads();
        AS_PV();
        __syncthreads();
        AS_Q(q4, bb, hb);
        AS_OUT(ba, ha);
        AS_LOADROWS(vr, CV, bb, hb);
        asm volatile("s_waitcnt vmcnt(16)" ::: "memory");
        AS_SCORES(q4);
        __syncthreads();
        AS_SOFTMAX();
        __syncthreads();
        AS_PV();
        __syncthreads();
        AS_OUT(bb, hb);
    }
#undef AS_Q
#undef AS_LOADROWS
#undef AS_SCORES
#undef AS_SOFTMAX
#undef AS_PV
#undef AS_OUT
}

constexpr int NK_OUT = 5, NK_OUT_LAST = 10, NK_GLU = 8;
__device__ __forceinline__ void fixup_out_rows(Frame& F, const float* basef  , int vb, int nvb  , int nk  ) {
    for (int r = vb * NWAVES + F.wave; r < MS; r += nvb * NWAVES) {
        const int lane = F.lane; const float* slab = (const float*)(F.ws + WS_SLAB);
        bf16_t* XB = (bf16_t*)(F.ws + WS_XB) + (size_t)(MP + r) * DM; float ss = 0.f;
#pragma unroll
        for (int j = 0; j < 4; ++j) { f32x4 v;
            if (basef) v = *((const f32x4*)(basef + (size_t)r * DM) + lane + 64 * j);
            else { const u32x2 w = *((const u32x2*)XB + lane + 64 * j); v = (f32x4){bflo(w.x), bfhi(w.x), bflo(w.y), bfhi(w.y)}; }
            for (int ks = 0; ks < nk; ++ks) v += *((const f32x4*)(slab + ((size_t)ks * MS + r) * DM) + lane + 64 * j);
            u32x2 w; w.x = pk2(v[0], v[1]); w.y = pk2(v[2], v[3]); *((u32x2*)XB + lane + 64 * j) = w;
            ss += (v[0] * v[0] + v[1] * v[1]) + (v[2] * v[2] + v[3] * v[3]); }
        asm volatile("s_waitcnt vmcnt(0)" ::: "memory");
        ss = wave_sum(ss);
        if (lane < 16) ((float*)(F.ws + WS_SSX))[(size_t)(MP + r) * 16 + lane] = lane == 0 ? ss : 0.f;
    }
}
__device__ __forceinline__ void fixup_glu_rows(Frame& F) {
    if (F.wave < 2) for (int r = F.bid * 2 + F.wave; r < MS; r += F.G * 2) {
        const int lane = F.lane; const float* slab = (const float*)(F.ws + WS_SLAB); const float* bias = GIN(29);
        const bf16_t* GBp = (const bf16_t*)(F.ws + WS_GB) + (size_t)(MP + r) * E_; const bf16_t* SZ = (const bf16_t*)(F.ws + WS_B1) + (size_t)(MP + r) * E_; bf16_t* A2 = (bf16_t*)(F.ws + WS_A2) + (size_t)(MP + r) * KOUT;
#pragma unroll
        for (int j = 0; j < 4; ++j) { const int c0 = 8 * (lane + 64 * j); f32x4 t0 = *(const f32x4*)(bias + c0), t1 = *(const f32x4*)(bias + c0 + 4);
#pragma unroll
            for (int ks = 0; ks < NK_GLU; ++ks) { const float* sp = slab + ((size_t)ks * MS + r) * E_ + c0; t0 += *(const f32x4*)sp; t1 += *(const f32x4*)(sp + 4); }
            float gv[8], sz[8]; unpack8(*(const u32x4*)(GBp + c0), gv); unpack8(*(const u32x4*)(SZ + c0), sz); f32x4 o0, o1;
#pragma unroll
            for (int e = 0; e < 4; ++e) { o0[e] = gv[e] * sigmoidf_(t0[e]) * sz[e]; o1[e] = gv[4 + e] * sigmoidf_(t1[e]) * sz[4 + e]; }
            *(u32x4*)(A2 + c0) = pack8(o0, o1); }
    }
}
__device__ __forceinline__ void counter_signal(unsigned* cnt) {
    asm volatile("s_waitcnt vmcnt(0)" ::: "memory"); __syncthreads();
    if (threadIdx.x == 0) { __builtin_amdgcn_fence(__ATOMIC_RELEASE, "agent"); asm volatile("s_waitcnt vmcnt(0)" ::: "memory"); __hip_atomic_fetch_add(cnt, 1u, __ATOMIC_RELAXED, __HIP_MEMORY_SCOPE_AGENT); }
}
__device__ __forceinline__ void counter_wait(unsigned* cnt, unsigned want) {
    if (threadIdx.x == 0) { unsigned sp = 0; while (__hip_atomic_load(cnt, __ATOMIC_RELAXED, __HIP_MEMORY_SCOPE_AGENT) < want) { __builtin_amdgcn_s_sleep(2); if (++sp > (1u << 22)) break; }
        __builtin_amdgcn_fence(__ATOMIC_ACQUIRE, "agent"); asm volatile("s_waitcnt vmcnt(0)" ::: "memory"); }
    __syncthreads();
}

__device__ __forceinline__ void final_row(Frame& F, int row) {
    const bf16_t* XBp = (const bf16_t*)(F.ws + WS_XB); const float* SSX = (const float*)(F.ws + WS_SSX); const float* fg = GIN(9); const int lane = F.lane;
    float s = lane < 16 ? SSX[(size_t)row * 16 + lane] : 0.f; s = wave_sum(s);
    const float r = __builtin_amdgcn_rsqf(s * (1.f / DM) + EPS);
    float* o = row < MP ? F.out + O_YP + (size_t)row * DM : F.out + O_YS + (size_t)(row - MP) * DM;
#pragma unroll
    for (int j = 0; j < 4; ++j) { const u32x2 w = *((const u32x2*)(XBp + (size_t)row * DM) + lane + 64 * j); const f32x4 v = (f32x4){bflo(w.x), bfhi(w.x), bflo(w.y), bfhi(w.y)}; const f32x4 gq = *((const f32x4*)fg + lane + 64 * j); *((f32x4*)o + lane + 64 * j) = v * r * gq; }
}
__device__ __forceinline__ void final_phase(Frame& F) {
    asm volatile("s_waitcnt vmcnt(0)" ::: "memory"); for (int r = F.bid * NWAVES + F.wave; r < MS; r += F.G * NWAVES) final_row(F, MP + r);
}

#define XB_TMO      128
#define XB_XCNT(j)  (256  + 64 * (j))
#define XB_XSUB(j)  (1280 + 64 * (j))
#define XB_XGEN(j)  (2304 + 64 * (j))
#define XB_TOP      3328
#define XB_TOPGEN   3392
#define XCD_BAR_WORDS 3456
#define XB_SPIN_CAP (1u << 20)
__device__ __forceinline__ unsigned xb_ld(unsigned* p)              { return __hip_atomic_load(p, __ATOMIC_RELAXED, __HIP_MEMORY_SCOPE_AGENT); }
__device__ __forceinline__ unsigned xb_add(unsigned* p, unsigned v) { return __hip_atomic_fetch_add(p, v, __ATOMIC_RELAXED, __HIP_MEMORY_SCOPE_AGENT); }
__device__ __forceinline__ unsigned xb_xcc_id() { return (unsigned)__builtin_amdgcn_s_getreg((3 << 11) | 20) & 0xFu; }
#define XB_SPIN(cond, bar) do { unsigned _sp = 0; while (cond) { __builtin_amdgcn_s_sleep(1); \
    if ((++_sp & 255u) == 0u) { if (xb_ld(&(bar)[XB_TMO])) break; if (_sp > XB_SPIN_CAP) { atomicAdd(&(bar)[XB_TMO], 1u); break; } } } } while (0)
struct XcdBarrier { unsigned* bar; unsigned x; volatile LAS unsigned* st; };
__device__ __forceinline__ XcdBarrier xcd_barrier_post(unsigned* bar, volatile LAS unsigned* st) {
    XcdBarrier b; b.bar = bar; b.x = xb_xcc_id(); b.st = st;
    if (threadIdx.x == 0) (void)xb_add(&bar[XB_XCNT(b.x)], 1u);
    return b;
}
__device__ __forceinline__ void xcd_barrier_complete(unsigned* bar, unsigned x, unsigned& nloc, unsigned& nx) {
    const unsigned G = gridDim.x * gridDim.y * gridDim.z;
    unsigned sum, cnt, mine, sp = 0u;
    for (;;) {
        sum = 0u; cnt = 0u; mine = 0u;
#pragma unroll
        for (unsigned j = 0; j < 16; ++j) { const unsigned c = xb_ld(&bar[XB_XCNT(j)]); sum += c; cnt += (c > 0u) ? 1u : 0u; mine = (j == x) ? c : mine; }
        if (sum == G) break;
        __builtin_amdgcn_s_sleep(1);
        if ((++sp & 255u) == 0u) { if (xb_ld(&bar[XB_TMO])) break; if (sp > XB_SPIN_CAP) { atomicAdd(&bar[XB_TMO], 1u); break; } }
    }
    nloc = mine > 0u ? mine : 1u; nx = cnt > 0u ? cnt : 1u;
}
__device__ __forceinline__ void xcd_barrier(const XcdBarrier& b) {
    asm volatile("s_waitcnt vmcnt(0)" ::: "memory");
    __syncthreads();
    if (threadIdx.x == 0) {
        unsigned* bar = b.bar;
        __builtin_amdgcn_s_waitcnt(0);
        unsigned nloc = b.st[0], nx = b.st[1];
        if (nloc == 0u) { xcd_barrier_complete(bar, b.x, nloc, nx); b.st[0] = nloc; b.st[1] = nx; }
        const unsigned old = xb_add(&bar[XB_XSUB(b.x)], 1u);
        const unsigned gen = old / nloc;
        if (old + 1u == (gen + 1u) * nloc) {
            __builtin_amdgcn_fence(__ATOMIC_RELEASE, "agent");
            asm volatile("s_waitcnt vmcnt(0)" ::: "memory");
            const unsigned og = xb_add(&bar[XB_TOP], 1u);
            const unsigned tg = og / nx;
            if (og + 1u == (tg + 1u) * nx) xb_add(&bar[XB_TOPGEN], 1u);
            else XB_SPIN(xb_ld(&bar[XB_TOPGEN]) == tg, bar);
            __builtin_amdgcn_fence(__ATOMIC_ACQUIRE, "agent");
            xb_add(&bar[XB_XGEN(b.x)], 1u);
            asm volatile("s_waitcnt vmcnt(0)" ::: "memory");
        } else {
            XB_SPIN(xb_ld(&bar[XB_XGEN(b.x)]) == gen, bar);
            __builtin_amdgcn_fence(__ATOMIC_ACQUIRE, "agent");
            asm volatile("s_waitcnt vmcnt(0)" ::: "memory");
        }
    }
    __syncthreads();
}

__device__ __forceinline__ void stagger(int bid) {
#if STAGGER_TICKS
    const int grp = (bid >> 3) & 3;
    if (grp) { const unsigned long long t0 = __builtin_amdgcn_s_memrealtime(); while (__builtin_amdgcn_s_memrealtime() - t0 < (unsigned long long)(grp * STAGGER_TICKS)) __builtin_amdgcn_s_sleep(2); }
#endif
}
constexpr int NPHASE = 15;
__global__ void __launch_bounds__(NTHR, 2) fwd_kernel(Args args) {
    extern __shared__ __attribute__((aligned(16))) unsigned char lds_raw[];
    Frame F; F.lds = (LAS unsigned char*)lds_raw; F.G = gridDim.x; F.bid = blockIdx.x;
    F.in = args.in; F.out = (float*)(GAS float*)args.out; F.ws = (unsigned char*)(GAS unsigned char*)args.ws;
    unsigned char* ws = F.ws;
#define REFRESH() do { int t_ = threadIdx.x; asm volatile("" : "+v"(t_)); F.tid = t_; F.lane = t_ & 63; F.wave = __builtin_amdgcn_readfirstlane(t_ >> 6); \
        GAS unsigned char* wsg_ = (GAS unsigned char*)args.ws; asm volatile("" : "+s"(wsg_)); ws = (unsigned char*)wsg_; F.ws = ws; } while (0)
    const int lo = args.ph_lo, hi = args.ph_hi;
#if MK_ONE_LAUNCH
    cg::grid_group grid = cg::this_grid();
    if (lo < 0) grid.sync();
    { volatile LAS unsigned* st0 = (volatile LAS unsigned*)(F.lds + LDS_BYTES - 64); if (threadIdx.x < 16) st0[threadIdx.x] = 0u; }
    __syncthreads();
    const XcdBarrier xbar = xcd_barrier_post((unsigned*)(args.ws + WS_CTL), (volatile LAS unsigned*)(F.lds + LDS_BYTES - 64));
#define SEAM(k) do { if (lo <= (k) && (k) + 1 < hi) xcd_barrier(xbar); } while (0)
#else
#define SEAM(k) do { } while (0)
#endif
#ifndef PHASE_MASK
#define PHASE_MASK 0x7fff
#endif
#define REP(k) for (int rep_ = 0; rep_ <= (((PROBE_REP_MASK) >> (k)) & 1); ++rep_)
#if PROBE_SUB_MASK
#define PREP(b) for (int n_ = __builtin_amdgcn_readfirstlane(1 + ((PROBE_SUB_MASK >> (b)) & 1) + (int)(args.ph_lo > 100)), r_ = 0; r_ < n_; ++r_)
#else
#define PREP(b)
#endif
#define WSSEL(bit) do { if ((FLAT_FN_MASK >> (bit)) & 1) { unsigned char* w_ = args.ws; asm volatile("" : "+s"(w_)); F.ws = w_; } else { GAS unsigned char* g_ = (GAS unsigned char*)args.ws; asm volatile("" : "+s"(g_)); F.ws = (unsigned char*)g_; } } while (0)
#define IN(k) ((((PHASE_MASK) >> (k)) & 1) && lo <= (k) && (k) < hi)
#define XB ((bf16_t*)(ws + WS_XB))
#define X ((float*)(ws + WS_X))
#define SSX ((float*)(ws + WS_SSX))
#define SSV ((float*)(ws + WS_SSV))
#define B0 ((bf16_t*)(ws + WS_B0))
#define B1 ((bf16_t*)(ws + WS_B1))
#define QBp ((bf16_t*)(ws + WS_QB))
#define A2 ((bf16_t*)(ws + WS_A2))
#define GBp ((bf16_t*)(ws + WS_GB))
    const int G = F.G, bid = F.bid;

    if (IN(0)) REP(0) { REFRESH(); WSSEL(0); p0_prologue(F); __syncthreads(); } SEAM(0);
#define CNT(k) ((unsigned*)(ws + WS_CTL) + 4096 + 64 * (k))
#define WOUT(l) ((const bf16_t*)(ws + WS_WOUT) + (size_t)(l) * DM * KOUT)
#define INPROJ(EpiT, E, W, N, cnt, want) do { stagger(bid); \
        pg8::Gemm g{XB, (W), M, (N), DM, DM}; pg8::StaticOrder S; S.init(MP, (N), G, bid); pg8::gemm_phase<EpiT, pg8::StaticOrder, true, true>(F.lds, g, S, E); \
        if (cnt) counter_wait(cnt, (unsigned)(want)); \
        const int rem = ((MP / 256) * ((N) / 256)) % G; pg8::StaticOrder S2; S2.init(MS, (N), G, (bid + G - rem) % G, MP / 256); pg8::gemm_phase<EpiT, pg8::StaticOrder, true, true>(F.lds, g, S2, E); } while (0)
#define OUTPROJ_PROMPT(l, bp) do { pg8::Gemm g{A2, WOUT(l), M, DM, KOUT, KOUT}; pg8::StaticOrder S; S.init(MP, DM, G, bid); EpiOut E{(bp), XB, SSX}; pg8::gemm_phase<EpiOut, pg8::StaticOrder, true, true>(F.lds, g, S, E); } while (0)
#define OUTPROJ_SLICES(l, c, nb, NK) do { pg8::Gemm g{A2, WOUT(l), M, DM, KOUT / (NK), KOUT}; typedef pg8::SliceOrder<MS / 256, DM / 256, (NK)> SO; SO S; S.init((nb), (c), MP / 256); \
        EpiSlab E{(float*)(ws + WS_SLAB), DM, MP, (size_t)MS * DM}; pg8::gemm_phase<EpiSlab, SO, true, true>(F.lds, g, S, E); } while (0)
#define SLICEFIX(l, sb0, basef, cA, cB) do { if (bid >= (sb0)) { const int nsb_ = G - (sb0); OUTPROJ_SLICES(l, bid - (sb0), nsb_, NK_OUT); counter_signal(cA); counter_wait(cA, (unsigned)nsb_); \
        fixup_out_rows(F, (basef), bid - (sb0), nsb_, NK_OUT); counter_signal(cB); } } while (0)
#define KVPROJ(l, c0) do { pg8::Gemm g{(const bf16_t*)(ws + WS_MEMB), (const bf16_t*)(ws + WS_WKV) + (size_t)(l) * DM * DM, PB * MEML, DM, DM, DM}; pg8::StaticOrder S; S.init(g.M, g.N, G, (bid + G - (c0)) % G); \
        EpiKV E{(const float*)(ws + WS_RSTDM), F.out + O_MK, F.out + O_MV, (bf16_t*)(ws + WS_KB), (bf16_t*)(ws + WS_VT), (l)}; pg8::gemm_phase<EpiKV, pg8::StaticOrder, true, true>(F.lds, g, S, E); } while (0)
    if (IN(1)) REP(1) { REFRESH();
        { EpiInA E{SSX, B0, B1, QBp, SSV}; INPROJ(EpiInA, E, (const bf16_t*)(ws + WS_WINA), NIN_A, (unsigned*)nullptr, 0); }
        KVPROJ(0, 180); KVPROJ(1, 212);
    } SEAM(1);
    if (IN(2)) REP(2) { REFRESH(); WSSEL(1);
        PREP(5) sgu_phase_mfma(F, 0); PREP(6) sgu_sample_phase(F, 0); attn_prompt_phase(F, 0); attn_sample_phase(F, 0); } SEAM(2);
    if (IN(3)) REP(3) { REFRESH(); OUTPROJ_PROMPT(0, GIN(0)); } SEAM(3);
    if (IN(4)) REP(4) { REFRESH(); SLICEFIX(0, 196, GIN(1), CNT(0), CNT(4));
        EpiInB E{SSX, B0, B1, QBp, F.out + O_CP, F.out + O_CS, GIN(18), A2}; INPROJ(EpiInB, E, (const bf16_t*)(ws + WS_WINB), NIN_B, CNT(4), G - 196); } SEAM(4);
    if (IN(5)) REP(5) { REFRESH(); WSSEL(3);
        PREP(0) conv_phase(F); PREP(1) attn_prompt_phase(F, 1); PREP(2) attn_sample_phase(F, 1); } SEAM(5);
    if (IN(6)) REP(6) { REFRESH(); OUTPROJ_PROMPT(1, (const float*)nullptr); } SEAM(6);
    if (IN(7)) REP(7) { REFRESH(); SLICEFIX(1, 196, (const float*)nullptr, CNT(1), CNT(5));
        EpiInC E{SSX, B0, B1, QBp}; INPROJ(EpiInC, E, (const bf16_t*)(ws + WS_WINC), NIN_C, CNT(5), G - 196); KVPROJ(2, 164); } SEAM(7);
    if (IN(8)) REP(8) { REFRESH();
        const int half = G / 2; const bool s5h = bid < half;
        F.G = half; F.bid = s5h ? bid : (1 << 20);
        WSSEL(4); s5_prompt_mfma(F);
        F.G = G - half; F.bid = s5h ? (1 << 20) : bid - half;
        WSSEL(6); attn_prompt_phase(F, 2); WSSEL(7); attn_sample_phase(F, 2); WSSEL(5); s5_sample_mfma(F);
        F.bid = bid; F.G = G; } SEAM(8);
    if (IN(9)) REP(9) { REFRESH();
        { pg8::Gemm g{GBp, (const bf16_t*)(ws + WS_WGLU), M, E_, E_, E_}; pg8::StaticOrder S; S.init(MP, E_, G, bid, 0, GLU_WGM); EpiGlu E{GBp, B1, GIN(29), A2}; pg8::gemm_phase<EpiGlu, pg8::StaticOrder, true, true>(F.lds, g, S, E); }
        { pg8::Gemm g{GBp, (const bf16_t*)(ws + WS_WGLU), M, E_, 256, E_}; typedef pg8::SliceOrder<MS / 256, E_ / 256, NK_GLU> SG; SG S; S.init(G, bid, MP / 256); EpiSlab E{(float*)(ws + WS_SLAB), E_, MP, (size_t)MS * E_}; pg8::gemm_phase<EpiSlab, SG, true, true>(F.lds, g, S, E); } } SEAM(9);
    if (IN(10)) REP(10) { REFRESH(); fixup_glu_rows(F);
        OUTPROJ_PROMPT(2, (const float*)nullptr); } SEAM(10);
    if (IN(11)) REP(11) { REFRESH(); SLICEFIX(2, 212, (const float*)nullptr, CNT(3), CNT(6));
        EpiInA E{SSX, B0, B1, QBp, SSV}; INPROJ(EpiInA, E, (const bf16_t*)(ws + WS_WINA) + (size_t)NIN_A * DM, NIN_A, CNT(6), G - 212); KVPROJ(3, 180); } SEAM(11);
    if (IN(12)) REP(12) { REFRESH(); WSSEL(1);
        sgu_phase_mfma(F, 1); sgu_sample_phase(F, 1); attn_prompt_phase(F, 3); attn_sample_phase(F, 3); } SEAM(12);
    if (IN(13)) REP(13) { REFRESH();
        { pg8::Gemm g{A2, WOUT(3), M, DM, KOUT, KOUT}; pg8::StaticOrder S; S.init(MP, DM, G, bid); EpiOutFinal E{XB, SSX, GIN(9), F.out + O_YP, CNT(16)}; pg8::gemm_phase<EpiOutFinal, pg8::StaticOrder, true, true>(F.lds, g, S, E); }
        OUTPROJ_SLICES(3, bid, G, NK_OUT_LAST);
#if MK_ONE_LAUNCH
        if (bid < (MS / 256) * (DM / 256) * NK_OUT_LAST) counter_signal(CNT(8));
        if (bid * NWAVES < MS) { counter_wait(CNT(8), (unsigned)((MS / 256) * (DM / 256) * NK_OUT_LAST)); WSSEL(8); fixup_out_rows(F, (const float*)nullptr, bid, G, NK_OUT_LAST); final_phase(F); }
#endif
        }
#if !MK_ONE_LAUNCH
    if (IN(14)) REP(14) { REFRESH(); WSSEL(8); fixup_out_rows(F, (const float*)nullptr, bid, G, NK_OUT_LAST); final_phase(F); }
#endif
#undef CNT
#undef WOUT
#undef KVPROJ
#undef INPROJ
#undef OUTPROJ_PROMPT
#undef OUTPROJ_SLICES
#undef SLICEFIX
#undef IN
#undef REP
#undef SEAM
#undef XB
#undef X
#undef SSX
#undef SSV
#undef B0
#undef B1
#undef QBp
#undef A2
#undef GBp
#undef REFRESH
}

extern "C" void kernel_launch(void* const* d_in, const int* in_sizes, int n_in, void* d_out, int out_size, void* d_ws, size_t ws_size, hipStream_t stream) {
    static int grid = 0;
    if (grid == 0) {
        if (n_in != 30 || out_size != (int)O_END || ws_size < WS_END) { fprintf(stderr, "kernel_launch: unexpected shapes (n_in %d out %d ws %zu)\n", n_in, out_size, ws_size); grid = -1; return; }
        int dev = 0, cus = 0, per_cu = 0;
        (void)hipGetDevice(&dev); (void)hipDeviceGetAttribute(&cus, hipDeviceAttributeMultiprocessorCount, dev);
        if (hipFuncSetAttribute((const void*)fwd_kernel, hipFuncAttributeMaxDynamicSharedMemorySize, LDS_BYTES) != hipSuccess) { fprintf(stderr, "kernel_launch: hipFuncSetAttribute failed\n"); grid = -1; return; }
        if (hipOccupancyMaxActiveBlocksPerMultiprocessor(&per_cu, (const void*)fwd_kernel, NTHR, LDS_BYTES) != hipSuccess || per_cu < 1) { fprintf(stderr, "kernel_launch: occupancy query says %d\n", per_cu); (void)hipGetLastError(); per_cu = 1; }
        grid = cus;
    }
    if (grid < 0) return;
    Args a{};
    for (int i = 0; i < 30; ++i) a.in[i] = (const float*)d_in[i];
    a.out = (float*)d_out; a.ws = (unsigned char*)d_ws;
#if MK_ONE_LAUNCH
    (void)hipMemsetAsync((char*)d_ws + WS_CTL, 0, 65536, stream);
    a.ph_lo = 0; a.ph_hi = NPHASE;
    void* kargs[] = {&a};
    hipError_t e = hipLaunchCooperativeKernel((const void*)fwd_kernel, dim3(grid), dim3(NTHR), kargs, LDS_BYTES, stream);
    if (e != hipSuccess) fprintf(stderr, "cooperative launch failed: %s (grid %d)\n", hipGetErrorString(e), grid);
#else
    for (int p = 0; p < NPHASE; ++p) { a.ph_lo = p; a.ph_hi = p + 1; hipLaunchKernelGGL(fwd_kernel, dim3(grid), dim3(NTHR), LDS_BYTES, stream, a); }
#endif
}
```
